# Optimizing an MI355X kernel written in HIP

```python
import numpy as np
import jax
import jax.numpy as jnp
from jax import lax

D_MODEL = 1024
BATCH = 8
SEQ = 4096
DEPTH = 2

D_MIX = D_MODEL
NSA_HEADS = 8
NSA_KV_GROUPS = 2
NSA_HEAD_DIM = 64
NSA_WIDTH = NSA_HEADS * NSA_HEAD_DIM
NSA_KV_WIDTH = NSA_KV_GROUPS * NSA_HEAD_DIM
CMP_BLOCK = 32
CMP_STRIDE = 16
CMP_HIDDEN = 2 * NSA_HEAD_DIM
SLC_BLOCK = 64
SLC_TOPN = 16
WINDOW = 512
Q_BLOCK = 64
FORCE_BONUS = 1e4
M_HEADS = 4
M_WIDTH = D_MIX - NSA_WIDTH
M_HEAD_DIM = M_WIDTH // M_HEADS
M_CHUNK = 64
CONV_WIDTH = 4
FFN_HIDDEN = ((8 * D_MODEL + 3 * 256 - 1) // (3 * 256)) * 256
D_IN_PROJ = NSA_WIDTH + 6 * NSA_KV_WIDTH + 3 * NSA_HEADS + 4 * M_WIDTH + 2 * M_HEADS
RMS_EPS = 1e-6
NEG_INF = -1e30

kernel_name = "hybrid_nsa_mlstm_block"


def rmsnorm(x, g):
    xf = x.astype(jnp.float32)
    y = xf * lax.rsqrt(jnp.mean(xf * xf, axis=-1, keepdims=True) + RMS_EPS)
    return (y * g.astype(jnp.float32)).astype(x.dtype)


def in_proj_sizes():
    return ([NSA_WIDTH] + [NSA_KV_WIDTH] * 6 + [3 * NSA_HEADS]
            + [M_WIDTH] * 3 + [M_HEADS, M_HEADS, M_WIDTH])


def compress_blocks(a, pe, w1, w2):
    B, G, T, dh = a.shape
    ac = a.reshape(B, G, T // CMP_STRIDE, CMP_STRIDE, dh)
    blocks = jnp.concatenate([ac[:, :, :-1], ac[:, :, 1:]], axis=3) + pe
    flat = blocks.reshape(B, G, T // CMP_STRIDE - 1, CMP_BLOCK * dh)
    return jax.nn.silu(flat @ w1) @ w2


def nsa_mixer(q, kvs, gates, q_g, k_g, pe, w1, w2, out_g):
    B, T, _ = q.shape
    H, G, dh = NSA_HEADS, NSA_KV_GROUPS, NSA_HEAD_DIM
    HG = H // G
    scale = dh ** -0.5
    q = rmsnorm(q.reshape(B, T, G, HG, dh), q_g).transpose(0, 2, 3, 1, 4)
    k_c, v_c, k_s, v_s, k_w, v_w = [a.reshape(B, T, G, dh).transpose(0, 2, 1, 3) for a in kvs]
    k_s = rmsnorm(k_s, k_g[1])
    k_w = rmsnorm(k_w, k_g[2])
    t_pos = jnp.arange(T)

    k_cmp = rmsnorm(compress_blocks(k_c, pe[0], w1[0], w2[0]), k_g[0])
    v_cmp = compress_blocks(v_c, pe[1], w1[1], w2[1])
    n_cmp = T // CMP_STRIDE - 1
    cmp_start = jnp.arange(n_cmp) * CMP_STRIDE
    cmp_end = cmp_start + CMP_BLOCK - 1
    cmp_valid = cmp_end[None, :] <= t_pos[:, None]
    s = jnp.einsum("bghtd,bgnd->bghtn", q, k_cmp).astype(jnp.float32) * scale
    p_cmp = jax.nn.softmax(jnp.where(cmp_valid, s, NEG_INF), axis=-1) * cmp_valid
    o_cmp = jnp.einsum("bghtn,bgnd->bghtd", p_cmp.astype(v_cmp.dtype), v_cmp)

    n_blk = T // SLC_BLOCK
    n_sel = min(SLC_TOPN, n_blk)
    blk = jnp.arange(n_blk)
    overlap = ((cmp_start[:, None] < (blk[None, :] + 1) * SLC_BLOCK)
               & (cmp_end[:, None] >= blk[None, :] * SLC_BLOCK)).astype(jnp.float32)
    imp = jnp.einsum("bghtn,nj->bgtj", p_cmp, overlap)
    cur = t_pos // SLC_BLOCK
    forced = (blk[None] == 0) | (blk[None] == cur[:, None]) | (blk[None] == cur[:, None] - 1)
    sel_valid = blk[None] * SLC_BLOCK <= t_pos[:, None]
    score = jnp.where(sel_valid, imp + FORCE_BONUS * forced.astype(jnp.float32), NEG_INF)
    _, sel_idx = lax.top_k(score, n_sel)

    n_qb = T // Q_BLOCK
    span = WINDOW + Q_BLOCK
    ks_blk = k_s.reshape(B, G, n_blk, SLC_BLOCK, dh)
    vs_blk = v_s.reshape(B, G, n_blk, SLC_BLOCK, dh)
    kw_pad = jnp.pad(k_w, ((0, 0), (0, 0), (WINDOW, 0), (0, 0)))
    vw_pad = jnp.pad(v_w, ((0, 0), (0, 0), (WINDOW, 0), (0, 0)))
    q_blocks = q.reshape(B, G, HG, n_qb, Q_BLOCK, dh).transpose(3, 0, 1, 2, 4, 5)
    idx_blocks = sel_idx.reshape(B, G, n_qb, Q_BLOCK, n_sel).transpose(2, 0, 1, 3, 4)
    gather = jax.vmap(jax.vmap(lambda kv_blk, ind: kv_blk[ind]))

    def step(args):
        c, qb, ib = args
        t = c * Q_BLOCK + jnp.arange(Q_BLOCK)
        k_sel = gather(ks_blk, ib)
        v_sel = gather(vs_blk, ib)
        pos = ib[..., None] * SLC_BLOCK + jnp.arange(SLC_BLOCK)
        msk = pos <= t[:, None, None]
        s_sel = jnp.einsum("bghqd,bgqnld->bghqnl", qb, k_sel).astype(jnp.float32) * scale
        s_sel = jnp.where(msk[:, :, None], s_sel, NEG_INF).reshape(B, G, HG, Q_BLOCK, n_sel * SLC_BLOCK)
        p_sel = jax.nn.softmax(s_sel, axis=-1)
        o_sel = jnp.einsum("bghqm,bgqmd->bghqd", p_sel.astype(v_sel.dtype),
                           v_sel.reshape(B, G, Q_BLOCK, n_sel * SLC_BLOCK, dh))
        k_win = lax.dynamic_slice_in_dim(kw_pad, c * Q_BLOCK, span, axis=2)
        v_win = lax.dynamic_slice_in_dim(vw_pad, c * Q_BLOCK, span, axis=2)
        s_pos = c * Q_BLOCK - WINDOW + jnp.arange(span)
        w_mask = ((s_pos[None] <= t[:, None]) & (s_pos[None] > t[:, None] - WINDOW)
                  & (s_pos[None] >= 0))
        s_w = jnp.einsum("bghqd,bgkd->bghqk", qb, k_win).astype(jnp.float32) * scale
        p_w = jax.nn.softmax(jnp.where(w_mask, s_w, NEG_INF), axis=-1)
        o_win = jnp.einsum("bghqk,bgkd->bghqd", p_w.astype(v_win.dtype), v_win)
        return o_sel, o_win

    o_sel, o_win = lax.map(step, (jnp.arange(n_qb), q_blocks, idx_blocks))
    o_sel = o_sel.transpose(1, 2, 3, 0, 4, 5).reshape(B, G, HG, T, dh)
    o_win = o_win.transpose(1, 2, 3, 0, 4, 5).reshape(B, G, HG, T, dh)

    g = jax.nn.sigmoid(gates).reshape(B, T, G, HG, 3).transpose(0, 2, 3, 1, 4)
    o = g[..., 0:1] * o_cmp + g[..., 1:2] * o_sel + g[..., 2:3] * o_win
    o = o.transpose(0, 3, 1, 2, 4).reshape(B, T, H, dh)
    return rmsnorm(o, out_g.reshape(H, dh)).reshape(B, T, NSA_WIDTH)


def causal_dwconv(u, w, b):
    C = u.shape[-1]
    y = lax.conv_general_dilated(u, w[:, None, :].astype(u.dtype), window_strides=(1,),
                                 padding=[(CONV_WIDTH - 1, 0)],
                                 dimension_numbers=("NWC", "WIO", "NWC"),
                                 feature_group_count=C)
    return y + b


def mlstm_mixer(q, k, v, i_pre, f_pre, o_pre, conv_w, conv_b, f_bias, out_g):
    B, T, _ = q.shape
    NH, DH, L = M_HEADS, M_HEAD_DIM, M_CHUNK
    n_ck = T // L
    f32 = jnp.float32
    qk = jax.nn.silu(causal_dwconv(jnp.concatenate([q, k], axis=-1), conv_w, conv_b))
    q, k = qk[..., :M_WIDTH], qk[..., M_WIDTH:]

    def heads(a):
        return a.astype(f32).reshape(B, n_ck, L, NH, DH).transpose(1, 0, 3, 2, 4)

    def gate(a):
        return a.astype(f32).reshape(B, n_ck, L, NH).transpose(1, 0, 3, 2)

    qh, kh, vh = heads(q), heads(k) * (DH ** -0.5), heads(v)
    log_f = gate(jax.nn.log_sigmoid(f_pre.astype(f32) + f_bias.astype(f32)))
    log_i = gate(i_pre)
    b_cum = jnp.cumsum(log_f, axis=-1)
    causal = jnp.tril(jnp.ones((L, L), dtype=bool))

    def chunk_step(carry, xs):
        C, n, m = carry
        qc, kc, vc, bc, ic = xs
        a = bc + m[..., None]
        d = jnp.where(causal, bc[..., :, None] - bc[..., None, :] + ic[..., None, :], NEG_INF)
        m_t = jnp.maximum(a, jnp.max(d, axis=-1))
        w_inter = jnp.exp(a - m_t)
        w_intra = jnp.exp(d - m_t[..., None]) * jnp.einsum("bhtd,bhsd->bhts", qc, kc)
        num = (w_inter[..., None] * jnp.einsum("bhtd,bhde->bhte", qc, C)
               + jnp.einsum("bhts,bhse->bhte", w_intra, vc))
        den = w_inter * jnp.einsum("bhtd,bhd->bht", qc, n) + jnp.sum(w_intra, axis=-1)
        h = num / jnp.maximum(jnp.abs(den), jnp.exp(-m_t))[..., None]
        b_last = bc[..., -1]
        g = b_last[..., None] - bc + ic
        m_new = jnp.maximum(b_last + m, jnp.max(g, axis=-1))
        decay = jnp.exp(b_last + m - m_new)
        w_s = jnp.exp(g - m_new[..., None])
        C_new = decay[..., None, None] * C + jnp.einsum("bhs,bhsd,bhse->bhde", w_s, kc, vc)
        n_new = decay[..., None] * n + jnp.einsum("bhs,bhsd->bhd", w_s, kc)
        return (C_new, n_new, m_new), h

    init = (jnp.zeros((B, NH, DH, DH), f32), jnp.zeros((B, NH, DH), f32), jnp.zeros((B, NH), f32))
    _, h = lax.scan(chunk_step, init, (qh, kh, vh, b_cum, log_i))
    h = h.transpose(1, 0, 3, 2, 4).reshape(B, T, NH, DH)
    h = rmsnorm(h, out_g.reshape(NH, DH)).reshape(B, T, M_WIDTH).astype(o_pre.dtype)
    return jax.nn.sigmoid(o_pre) * h


def setup_inputs(seed: int = 0) -> dict:
    key = jax.random.key(seed)
    ks = jax.random.split(key, 20)
    nrm = lambda k, shape, s: jax.random.normal(k, shape, jnp.float32) * s
    dh = NSA_HEAD_DIM
    return {
        "x": nrm(ks[0], (BATCH, SEQ, D_MODEL), 1.0),
        "ln1_g": 1.0 + nrm(ks[1], (DEPTH, D_MODEL), 0.02),
        "w_in": nrm(ks[2], (DEPTH, D_MODEL, D_IN_PROJ), D_MODEL ** -0.5),
        "b_in": nrm(ks[3], (DEPTH, D_IN_PROJ), 0.02),
        "nsa_q_norm_g": 1.0 + nrm(ks[4], (DEPTH, dh), 0.02),
        "nsa_k_norm_g": 1.0 + nrm(ks[5], (DEPTH, 3, dh), 0.02),
        "cmp_pe": nrm(ks[6], (DEPTH, 2, CMP_BLOCK, dh), 0.02),
        "cmp_w1": nrm(ks[7], (DEPTH, 2, CMP_BLOCK * dh, CMP_HIDDEN), (CMP_BLOCK * dh) ** -0.5),
        "cmp_w2": nrm(ks[8], (DEPTH, 2, CMP_HIDDEN, dh), CMP_HIDDEN ** -0.5),
        "m_conv_w": nrm(ks[9], (DEPTH, CONV_WIDTH, 2 * M_WIDTH), CONV_WIDTH ** -0.5),
        "m_conv_b": nrm(ks[10], (DEPTH, 2 * M_WIDTH), 0.02),
        "m_fgate_b": jnp.linspace(3.0, 6.0, M_HEADS, dtype=jnp.float32)[None, :] + nrm(ks[11], (DEPTH, M_HEADS), 0.1),
        "nsa_out_norm_g": 1.0 + nrm(ks[12], (DEPTH, NSA_WIDTH), 0.02),
        "m_out_norm_g": 1.0 + nrm(ks[13], (DEPTH, M_WIDTH), 0.02),
        "w_out": nrm(ks[14], (DEPTH, D_MIX, D_MODEL), D_MIX ** -0.5),
        "ln2_g": 1.0 + nrm(ks[15], (DEPTH, D_MODEL), 0.02),
        "w_gate_up": nrm(ks[16], (DEPTH, D_MODEL, 2 * FFN_HIDDEN), D_MODEL ** -0.5),
        "w_down": nrm(ks[17], (DEPTH, FFN_HIDDEN, D_MODEL), FFN_HIDDEN ** -0.5),
    }


def reference(x, ln1_g, w_in, b_in, nsa_q_norm_g, nsa_k_norm_g, cmp_pe, cmp_w1, cmp_w2,
              m_conv_w, m_conv_b, m_fgate_b, nsa_out_norm_g, m_out_norm_g, w_out,
              ln2_g, w_gate_up, w_down):
    offsets = np.cumsum(in_proj_sizes())[:-1].tolist()
    for l in range(DEPTH):
        h = rmsnorm(x, ln1_g[l])
        proj = h @ w_in[l] + b_in[l]
        (q_a, kc, vc, ksl, vsl, kwn, vwn, g_a,
         q_b, k_b, v_b, i_b, f_b, o_b) = jnp.split(proj, offsets, axis=-1)
        y_a = nsa_mixer(q_a, (kc, vc, ksl, vsl, kwn, vwn), g_a, nsa_q_norm_g[l], nsa_k_norm_g[l],
                        cmp_pe[l], cmp_w1[l], cmp_w2[l], nsa_out_norm_g[l])
        y_b = mlstm_mixer(q_b, k_b, v_b, i_b, f_b, o_b, m_conv_w[l], m_conv_b[l],
                          m_fgate_b[l], m_out_norm_g[l])
        x = x + jnp.concatenate([y_a, y_b.astype(y_a.dtype)], axis=-1) @ w_out[l]
        h = rmsnorm(x, ln2_g[l])
        gu = h @ w_gate_up[l]
        x = x + (jax.nn.silu(gu[..., :FFN_HIDDEN]) * gu[..., FFN_HIDDEN:]) @ w_down[l]
    return x
```

```cpp
#include <hip/hip_runtime.h>
#include <hip/hip_cooperative_groups.h>
#include <cstdint>
#include <cstdio>
namespace cg = cooperative_groups;

typedef unsigned short bf16_t;
typedef unsigned u32x4 __attribute__((ext_vector_type(4)));
typedef unsigned u32x2 __attribute__((ext_vector_type(2)));
typedef float f32x4 __attribute__((ext_vector_type(4)));

constexpr int BATCH = 8, SEQ = 4096, DM = 1024, M = BATCH * SEQ, DEPTH = 2;
constexpr int NIN = 3360, NPROJ = 3328, NPAD = 3584, FF = 2816, NGU = 2 * FF;
constexpr int NCMP = 255, NCMPP = 256;
constexpr float EPS = 1e-6f;
constexpr int NT = 512;
constexpr int LDS_BYTES = 152 * 1024;

constexpr int C_QA = 0, C_KC = 512, C_VC = 640, C_KS = 768, C_VS = 896, C_KW = 1024, C_VW = 1152, C_QB = 1280, C_KB = 1792, C_VB = 2304, C_OB = 2816;

constexpr size_t MiB = 1u << 20;
constexpr size_t WS_CTL = 0;
constexpr size_t WS_WIN = 1 * MiB;
constexpr size_t WS_WOUT = 15 * MiB;
constexpr size_t WS_WGU = 19 * MiB;
constexpr size_t WS_WD = 41 * MiB;
constexpr size_t WS_BIAS = 52 * MiB;
constexpr size_t WS_SS = 53 * MiB;
constexpr size_t WS_GATES = 55 * MiB;
constexpr size_t WS_KCMP = 59 * MiB;
constexpr size_t WS_VCMP = 59 * MiB + 512 * 1024;
constexpr size_t WS_STN = 60 * MiB;
constexpr size_t WS_STM = 61 * MiB;
constexpr size_t WS_XB = 64 * MiB;
constexpr size_t WS_Y = 128 * MiB;
constexpr size_t WS_ST = 192 * MiB;
constexpr size_t WS_PROJ = 256 * MiB;
constexpr size_t WS_END = 464 * MiB;

struct Params {
    const float* in[18];
    float* out;
    unsigned char* ws;
    int lo, hi;
};
enum { I_X = 0, I_LN1, I_WIN, I_BIN, I_QG, I_KG, I_PE, I_W1, I_W2, I_CW, I_CB, I_FB, I_OGA, I_OGM, I_WOUT, I_LN2, I_WGU, I_WD };

__device__ __forceinline__ float bf2f(bf16_t v) { return __uint_as_float(((unsigned)v) << 16); }
__device__ __forceinline__ bf16_t f2bf(float f) { unsigned u = __float_as_uint(f); return (bf16_t)((u + 0x7fffu + ((u >> 16) & 1u)) >> 16); }
__device__ __forceinline__ unsigned pk2(float lo, float hi) { return (unsigned)f2bf(lo) | ((unsigned)f2bf(hi) << 16); }
__device__ __forceinline__ float lo16(unsigned w) { return __uint_as_float(w << 16); }
__device__ __forceinline__ float hi16(unsigned w) { return __uint_as_float(w & 0xffff0000u); }
__device__ __forceinline__ float silu_f(float x) { return x / (1.f + __expf(-x)); }
__device__ __forceinline__ float sigmoid_f(float x) { return 1.f / (1.f + __expf(-x)); }
__device__ __forceinline__ float wave_sum(float v) {
#pragma unroll
    for (int o = 1; o < 64; o <<= 1) v += __shfl_xor(v, o);
    return v;
}
__device__ __forceinline__ float wave_max(float v) {
#pragma unroll
    for (int o = 1; o < 64; o <<= 1) v = fmaxf(v, __shfl_xor(v, o));
    return v;
}
__device__ __forceinline__ void unpack8(u32x4 w, float* f) {
    f[0] = lo16(w.x); f[1] = hi16(w.x); f[2] = lo16(w.y); f[3] = hi16(w.y);
    f[4] = lo16(w.z); f[5] = hi16(w.z); f[6] = lo16(w.w); f[7] = hi16(w.w);
}

__device__ __forceinline__ int in_srccol(int n) {
    if (n < 1280) return n;
    if (n < 2816) return n + 24;
    if (n < 3328) return n + 32;
    if (n < 3352) return n - 3328 + 1280;
    if (n < 3360) return n - 3352 + 2840;
    return -1;
}
__device__ __forceinline__ int gu_srccol(int n) {
    const int t = n >> 8, w = n & 255;
    return (w < 128) ? (t * 128 + w) : (FF + t * 128 + (w - 128));
}

template <int MODE>
__device__ void conv_job(const float* W, int K, int Nsrc, bf16_t* WT, int Nout, const float* kscale, float* tile) {
    const int tid = threadIdx.x;
    const int nk = K / 64, nn = Nout / 64;
    for (int u = blockIdx.x; u < nk * nn; u += gridDim.x) {
        const int k0 = (u % nk) * 64, n0 = (u / nk) * 64;
#pragma unroll
        for (int i = 0; i < 8; ++i) {
            const int r = (tid >> 6) + 8 * i, c = tid & 63;
            const int n = n0 + c;
            const int sc = MODE == 0 ? n : (MODE == 1 ? in_srccol(n) : gu_srccol(n));
            float v = 0.f;
            if (sc >= 0) v = W[(size_t)(k0 + r) * Nsrc + sc] * (kscale ? kscale[k0 + r] : 1.f);
            tile[r * 65 + c] = v;
        }
        __syncthreads();
#pragma unroll
        for (int i = 0; i < 8; ++i) {
            const int r = (tid >> 6) + 8 * i, c = tid & 63;
            WT[(size_t)(n0 + r) * K + k0 + c] = f2bf(tile[c * 65 + r]);
        }
        __syncthreads();
    }
}

__device__ void phase_prologue(const Params& p, float* lds) {
    unsigned char* ws = p.ws;
    const int tid = threadIdx.x, lane = tid & 63, wave = tid >> 6;
    for (int l = 0; l < DEPTH; ++l) {
        conv_job<1>(p.in[I_WIN] + (size_t)l * DM * NIN, DM, NIN, (bf16_t*)(ws + WS_WIN) + (size_t)l * NPAD * DM, NPAD, p.in[I_LN1] + l * DM, lds);
        conv_job<0>(p.in[I_WOUT] + (size_t)l * DM * DM, DM, DM, (bf16_t*)(ws + WS_WOUT) + (size_t)l * DM * DM, DM, nullptr, lds);
        conv_job<2>(p.in[I_WGU] + (size_t)l * DM * NGU, DM, NGU, (bf16_t*)(ws + WS_WGU) + (size_t)l * NGU * DM, NGU, p.in[I_LN2] + l * DM, lds);
        conv_job<0>(p.in[I_WD] + (size_t)l * FF * DM, FF, DM, (bf16_t*)(ws + WS_WD) + (size_t)l * DM * FF, DM, nullptr, lds);
    }
    float* biasP = (float*)(ws + WS_BIAS);
    for (int i = blockIdx.x * NT + tid; i < DEPTH * NPAD; i += gridDim.x * NT) {
        const int l = i / NPAD, n = i % NPAD; const int sc = in_srccol(n);
        biasP[i] = sc >= 0 ? p.in[I_BIN][l * NIN + sc] : 0.f;
    }
    const float* x = p.in[I_X]; bf16_t* xb = (bf16_t*)(ws + WS_XB); float* ss = (float*)(ws + WS_SS);
    for (int m = blockIdx.x * 8 + wave; m < M; m += gridDim.x * 8) {
        const f32x4* xr = (const f32x4*)(x + (size_t)m * DM) + lane;
#pragma unroll
        for (int j = 0; j < 4; ++j) {
            const f32x4 v = xr[64 * j];
            float s = (v.x * v.x + v.y * v.y) + (v.z * v.z + v.w * v.w);
            s += __shfl_xor(s, 1); s += __shfl_xor(s, 2); s += __shfl_xor(s, 4); s += __shfl_xor(s, 8);
            if ((lane & 15) == 0) ss[(size_t)m * 16 + 4 * j + (lane >> 4)] = s;
            u32x2 o; o.x = pk2(v.x, v.y); o.y = pk2(v.z, v.w);
            *(u32x2*)(xb + (size_t)m * DM + 256 * j + 4 * lane) = o;
        }
    }
}

struct EpiIn {
    const float* ss; const float* bias; bf16_t* proj; float* gates;
    __device__ __forceinline__ void row(int m, int c0, int tx, const float (&v)[16]) const {
        float s = 0.f;
#pragma unroll
        for (int q = 0; q < 16; ++q) s += ss[(size_t)m * 16 + q];
        const float r = rsqrtf(s * (1.f / DM) + EPS);
#pragma unroll
        for (int h = 0; h < 2; ++h)
#pragma unroll
            for (int j = 0; j < 8; ++j) {
                const int col = c0 + h * 128 + tx * 8 + j;
                const float val = v[h * 8 + j] * r + bias[col];
                if (col < NPROJ) proj[(size_t)m * NPROJ + col] = f2bf(val);
                else if (col < NIN) gates[(size_t)m * 32 + (col - NPROJ)] = val;
            }
    }
};
struct EpiRes {
    const float* base; float* out; bf16_t* xb; float* ss;
    __device__ __forceinline__ void row(int m, int c0, int tx, const float (&v)[16]) const {
#pragma unroll
        for (int h = 0; h < 2; ++h) {
            float sq = 0.f;
#pragma unroll
            for (int j = 0; j < 8; ++j) {
                const size_t idx = (size_t)m * DM + c0 + h * 128 + tx * 8 + j;
                const float x1 = base[idx] + v[h * 8 + j];
                out[idx] = x1; xb[idx] = f2bf(x1); sq += x1 * x1;
            }
            sq += __shfl_xor(sq, 1); sq += __shfl_xor(sq, 2); sq += __shfl_xor(sq, 4);
            if ((tx & 7) == 0) ss[(size_t)m * 16 + (c0 >> 6) + h * 2 + (tx >> 3)] = sq;
        }
    }
};
struct EpiGU {
    const float* ss; bf16_t* act;
    __device__ __forceinline__ void row(int m, int c0, int tx, const float (&v)[16]) const {
        float s = 0.f;
#pragma unroll
        for (int q = 0; q < 16; ++q) s += ss[(size_t)m * 16 + q];
        const float r = rsqrtf(s * (1.f / DM) + EPS);
#pragma unroll
        for (int j = 0; j < 8; ++j) {
            const float g = v[j] * r, u = v[8 + j] * r;
            act[(size_t)m * FF + (c0 >> 8) * 128 + tx * 8 + j] = f2bf(silu_f(g) * u);
        }
    }
};

template <class Epi>
__device__ void gemm_naive(const bf16_t* A, const bf16_t* Bt, int Mr, int N, int K, const Epi& E, float* lds) {
    float* As = lds;
    float* Bs = lds + 32 * 132;
    const int tid = threadIdx.x, ty = tid >> 4, tx = tid & 15;
    const int nN = N / 256, nM = Mr / 128;
    const int lrow = tid >> 2, lk = (tid & 3) * 8;
    for (int u = blockIdx.x; u < nN * nM; u += gridDim.x) {
        const int pm = u / nN, pn = u % nN;
        float acc[4][16];
#pragma unroll
        for (int i = 0; i < 4; ++i)
#pragma unroll
            for (int j = 0; j < 16; ++j) acc[i][j] = 0.f;
        const bf16_t* Ap = A + (size_t)(pm * 128 + lrow) * K + lk;
        const bf16_t* Bp0 = Bt + (size_t)(pn * 256 + lrow) * K + lk;
        const bf16_t* Bp1 = Bp0 + (size_t)128 * K;
        for (int k0 = 0; k0 < K; k0 += 32) {
            const u32x4 av = *(const u32x4*)(Ap + k0), b0 = *(const u32x4*)(Bp0 + k0), b1 = *(const u32x4*)(Bp1 + k0);
            float fa[8], fb0[8], fb1[8]; unpack8(av, fa); unpack8(b0, fb0); unpack8(b1, fb1);
            __syncthreads();
#pragma unroll
            for (int j = 0; j < 8; ++j) { As[(lk + j) * 132 + lrow] = fa[j]; Bs[(lk + j) * 260 + lrow] = fb0[j]; Bs[(lk + j) * 260 + 128 + lrow] = fb1[j]; }
            __syncthreads();
#pragma unroll 4
            for (int k = 0; k < 32; ++k) {
                const f32x4 a = *(const f32x4*)(As + k * 132 + ty * 4);
                const f32x4 p0 = *(const f32x4*)(Bs + k * 260 + tx * 8), p1 = *(const f32x4*)(Bs + k * 260 + tx * 8 + 4);
                const f32x4 q0 = *(const f32x4*)(Bs + k * 260 + 128 + tx * 8), q1 = *(const f32x4*)(Bs + k * 260 + 128 + tx * 8 + 4);
                const float bb[16] = {p0.x, p0.y, p0.z, p0.w, p1.x, p1.y, p1.z, p1.w, q0.x, q0.y, q0.z, q0.w, q1.x, q1.y, q1.z, q1.w};
                const float aa[4] = {a.x, a.y, a.z, a.w};
#pragma unroll
                for (int i = 0; i < 4; ++i)
#pragma unroll
                    for (int j = 0; j < 16; ++j) acc[i][j] += aa[i] * bb[j];
            }
        }
#pragma unroll
        for (int i = 0; i < 4; ++i) E.row(pm * 128 + ty * 4 + i, pn * 256, tx, acc[i]);
    }
}

__device__ void phase_rowpass(const Params& p, int l) {
    unsigned char* ws = p.ws;
    bf16_t* proj = (bf16_t*)(ws + WS_PROJ); bf16_t* qkc = (bf16_t*)(ws + WS_XB);
    const float* qg = p.in[I_QG] + l * 64; const float* kg = p.in[I_KG] + l * 192;
    const float* cw = p.in[I_CW] + l * 4096; const float* cb = p.in[I_CB] + l * 1024;
    const int tid = threadIdx.x, lane = tid & 63, wave = tid >> 6;
    for (int m = blockIdx.x * 8 + wave; m < M; m += gridDim.x * 8) {
        const int t = m % SEQ;
        bf16_t* row = proj + (size_t)m * NPROJ;
        {
            const u32x4 raw = *(const u32x4*)(row + C_QA + lane * 8); float f[8]; unpack8(raw, f);
            float s = 0.f;
#pragma unroll
            for (int j = 0; j < 8; ++j) s += f[j] * f[j];
            s += __shfl_xor(s, 1); s += __shfl_xor(s, 2); s += __shfl_xor(s, 4);
            const float r = rsqrtf(s * (1.f / 64.f) + EPS);
            const int d0 = (lane & 7) * 8;
            u32x4 o; o.x = pk2(f[0] * r * qg[d0], f[1] * r * qg[d0 + 1]); o.y = pk2(f[2] * r * qg[d0 + 2], f[3] * r * qg[d0 + 3]);
            o.z = pk2(f[4] * r * qg[d0 + 4], f[5] * r * qg[d0 + 5]); o.w = pk2(f[6] * r * qg[d0 + 6], f[7] * r * qg[d0 + 7]);
            *(u32x4*)(row + C_QA + lane * 8) = o;
        }
        {
            const int which = lane >> 5, w4 = (lane & 31) * 4;
            bf16_t* pp = row + (which ? C_KW : C_KS) + w4;
            const u32x2 raw = *(const u32x2*)pp;
            float f[4] = {lo16(raw.x), hi16(raw.x), lo16(raw.y), hi16(raw.y)};
            float s = (f[0] * f[0] + f[1] * f[1]) + (f[2] * f[2] + f[3] * f[3]);
            s += __shfl_xor(s, 1); s += __shfl_xor(s, 2); s += __shfl_xor(s, 4); s += __shfl_xor(s, 8);
            const float r = rsqrtf(s * (1.f / 64.f) + EPS);
            const float* g = kg + (1 + which) * 64 + (w4 & 63);
            u32x2 o; o.x = pk2(f[0] * r * g[0], f[1] * r * g[1]); o.y = pk2(f[2] * r * g[2], f[3] * r * g[3]);
            *(u32x2*)pp = o;
        }
#pragma unroll
        for (int part = 0; part < 2; ++part) {
            const int c0 = part * 512 + lane * 8;
            float acc[8];
#pragma unroll
            for (int j = 0; j < 8; ++j) acc[j] = cb[c0 + j];
#pragma unroll
            for (int w = 0; w < 4; ++w) {
                if (t - 3 + w >= 0) {
                    const u32x4 raw = *(const u32x4*)(proj + (size_t)(m - 3 + w) * NPROJ + C_QB + c0); float f[8]; unpack8(raw, f);
#pragma unroll
                    for (int j = 0; j < 8; ++j) acc[j] += f[j] * cw[w * 1024 + c0 + j];
                }
            }
            const float sc = part ? 0.08838834764831845f : 1.f;
            float y[8];
#pragma unroll
            for (int j = 0; j < 8; ++j) y[j] = silu_f(acc[j]) * sc;
            u32x4 o; o.x = pk2(y[0], y[1]); o.y = pk2(y[2], y[3]); o.z = pk2(y[4], y[5]); o.w = pk2(y[6], y[7]);
            *(u32x4*)(qkc + (size_t)m * 1024 + c0) = o;
        }
    }
}

__device__ void phase_compress(const Params& p, int l, float* lds) {
    unsigned char* ws = p.ws;
    const bf16_t* proj = (const bf16_t*)(ws + WS_PROJ);
    const float* pe = p.in[I_PE] + (size_t)l * 2 * 2048; const float* w1 = p.in[I_W1] + (size_t)l * 2 * 2048 * 128; const float* w2 = p.in[I_W2] + (size_t)l * 2 * 128 * 64;
    const float* kg0 = p.in[I_KG] + l * 192;
    float* tok = lds;
    float* red = lds + 144 * 64;
    float* hidb = red + 4 * 8 * 128;
    const int tid = threadIdx.x, lane = tid & 63;
    for (int u = blockIdx.x; u < BATCH * 2 * 2 * 32; u += gridDim.x) {
        const int ib = u & 31, kv = (u >> 5) & 1, g = (u >> 6) & 1, b = u >> 7;
        const int i0 = ib * 8, ni = (NCMP - i0) < 8 ? (NCMP - i0) : 8;
        const int ntok = 16 * ni + 16;
        const int col = (kv ? C_VC : C_KC) + g * 64;
        __syncthreads();
        for (int e = tid; e < 144 * 64; e += NT) {
            const int tt = e >> 6, d = e & 63;
            tok[e] = tt < ntok ? bf2f(proj[(size_t)(b * SEQ + 16 * i0 + tt) * NPROJ + col + d]) : 0.f;
        }
        __syncthreads();
        {
            const int hid = tid & 127, part = tid >> 7;
            float acc[8], accP = 0.f;
#pragma unroll
            for (int ii = 0; ii < 8; ++ii) acc[ii] = 0.f;
            const float* w1p = w1 + (size_t)kv * 2048 * 128 + hid; const float* pep = pe + kv * 2048;
            for (int f = part * 512; f < part * 512 + 512; ++f) {
                const float w = w1p[(size_t)f * 128];
                accP += w * pep[f];
#pragma unroll
                for (int ii = 0; ii < 8; ++ii) acc[ii] += w * tok[16 * 64 * ii + f];
            }
#pragma unroll
            for (int ii = 0; ii < 8; ++ii) red[(part * 8 + ii) * 128 + hid] = acc[ii] + accP;
        }
        __syncthreads();
        for (int e = tid; e < 8 * 128; e += NT) {
            const float s = (red[e] + red[1024 + e]) + (red[2048 + e] + red[3072 + e]);
            hidb[e] = silu_f(s);
        }
        __syncthreads();
        {
            const int ii = tid >> 6, d = lane;
            float o = 0.f;
            const float* w2p = w2 + (size_t)kv * 128 * 64 + d;
            for (int h = 0; h < 128; ++h) o += hidb[ii * 128 + h] * w2p[h * 64];
            if (kv == 0) { const float s = wave_sum(o * o); o = o * rsqrtf(s * (1.f / 64.f) + EPS) * kg0[d]; }
            bf16_t* dst = (bf16_t*)(ws + (kv ? WS_VCMP : WS_KCMP));
            if (ii < ni) dst[(size_t)((b * 2 + g) * NCMPP + i0 + ii) * 64 + d] = f2bf(o);
        }
    }
    __syncthreads();
}

__device__ __forceinline__ float log_sigmoid_f(float x) { return fminf(x, 0.f) - log1pf(__expf(-fabsf(x))); }
__device__ void mlstm_gates(const float* gates, const float* fb, int m0, int h, float* bcum, float* ig) {
    const int tid = threadIdx.x;
    __syncthreads();
    if (tid < 64) {
        const float lf = log_sigmoid_f(gates[(size_t)(m0 + tid) * 32 + 28 + h] + fb[h]);
        ig[tid] = gates[(size_t)(m0 + tid) * 32 + 24 + h];
        float v = lf;
#pragma unroll
        for (int o = 1; o < 64; o <<= 1) { const float t = __shfl_up(v, o); if (tid >= o) v += t; }
        bcum[tid] = v;
    }
    __syncthreads();
}

__device__ void phase_chunkstate(const Params& p, int l, float* lds) {
    unsigned char* ws = p.ws;
    const bf16_t* proj = (const bf16_t*)(ws + WS_PROJ); const float* gates = (const float*)(ws + WS_GATES);
    const float* cw = p.in[I_CW] + l * 4096; const float* cb = p.in[I_CB] + l * 1024; const float* fb = p.in[I_FB] + l * 4;
    bf16_t* ST = (bf16_t*)(ws + WS_ST); float* STN = (float*)(ws + WS_STN); float* STM = (float*)(ws + WS_STM);
    float* kw = lds;
    float* vv = lds + 8192;
    float* bcum = lds + 16384; float* ig = bcum + 64; float* wsc = ig + 64; float* misc = wsc + 64;
    const int tid = threadIdx.x;
    for (int u = blockIdx.x; u < BATCH * 4 * 64; u += gridDim.x) {
        const int c = u & 63, h = (u >> 6) & 3, b = u >> 8;
        const int m0 = b * SEQ + c * 64, bh = b * 4 + h;
        mlstm_gates(gates, fb, m0, h, bcum, ig);
        if (tid < 64) {
            const float gv = bcum[63] - bcum[tid] + ig[tid];
            const float mx = wave_max(gv);
            wsc[tid] = __expf(gv - mx);
            if (tid == 0) { misc[0] = mx; STM[bh * 64 + c] = mx; STM[2048 + bh * 64 + c] = bcum[63]; }
        }
        __syncthreads();
        for (int e = tid; e < 64 * 16; e += NT) {
            const int s = e >> 4, d0 = (e & 15) * 8;
            const int t = c * 64 + s, ch = 512 + h * 128 + d0;
            float acc[8];
#pragma unroll
            for (int j = 0; j < 8; ++j) acc[j] = cb[ch + j];
#pragma unroll
            for (int w = 0; w < 4; ++w) {
                if (t - 3 + w >= 0) {
                    const u32x4 raw = *(const u32x4*)(proj + (size_t)(m0 + s - 3 + w) * NPROJ + C_QB + ch); float f[8]; unpack8(raw, f);
#pragma unroll
                    for (int j = 0; j < 8; ++j) acc[j] += f[j] * cw[w * 1024 + ch + j];
                }
            }
            const float sc = 0.08838834764831845f * wsc[s];
#pragma unroll
            for (int j = 0; j < 8; ++j) kw[s * 128 + d0 + j] = silu_f(acc[j]) * sc;
            const u32x4 rv = *(const u32x4*)(proj + (size_t)(m0 + s) * NPROJ + C_VB + h * 128 + d0); float fv[8]; unpack8(rv, fv);
#pragma unroll
            for (int j = 0; j < 8; ++j) vv[s * 128 + d0 + j] = fv[j];
        }
        __syncthreads();
        {
            const int e0 = (tid >> 4) * 4, d0 = (tid & 15) * 8;
            float acc[4][8];
#pragma unroll
            for (int i = 0; i < 4; ++i)
#pragma unroll
                for (int j = 0; j < 8; ++j) acc[i][j] = 0.f;
            for (int s = 0; s < 64; ++s) {
                const f32x4 ve = *(const f32x4*)(vv + s * 128 + e0);
                const f32x4 k0 = *(const f32x4*)(kw + s * 128 + d0), k1 = *(const f32x4*)(kw + s * 128 + d0 + 4);
                const float va[4] = {ve.x, ve.y, ve.z, ve.w}; const float ka[8] = {k0.x, k0.y, k0.z, k0.w, k1.x, k1.y, k1.z, k1.w};
#pragma unroll
                for (int i = 0; i < 4; ++i)
#pragma unroll
                    for (int j = 0; j < 8; ++j) acc[i][j] += va[i] * ka[j];
            }
#pragma unroll
            for (int i = 0; i < 4; ++i) {
                u32x4 o; o.x = pk2(acc[i][0], acc[i][1]); o.y = pk2(acc[i][2], acc[i][3]); o.z = pk2(acc[i][4], acc[i][5]); o.w = pk2(acc[i][6], acc[i][7]);
                *(u32x4*)(ST + ((size_t)(bh * 64 + c) * 128 + e0 + i) * 128 + d0) = o;
            }
        }
        if (tid < 128) {
            float s = 0.f;
            for (int q = 0; q < 64; ++q) s += kw[q * 128 + tid];
            STN[(size_t)(bh * 64 + c) * 128 + tid] = s;
        }
    }
    __syncthreads();
}

__device__ void phase_scan(const Params& p) {
    unsigned char* ws = p.ws;
    bf16_t* ST = (bf16_t*)(ws + WS_ST); float* STN = (float*)(ws + WS_STN); float* STM = (float*)(ws + WS_STM);
    const int tid = threadIdx.x;
    for (int u = blockIdx.x; u < 128; u += gridDim.x) {
        const int bh = u >> 2, idx = ((u & 3) * NT + tid) * 8;
        float C[8];
#pragma unroll
        for (int j = 0; j < 8; ++j) C[j] = 0.f;
        float nval = 0.f; const bool do_n = (u & 3) == 0 && tid < 128;
        float m = 0.f;
        for (int c = 0; c < 64; ++c) {
            const float mloc = STM[bh * 64 + c], bl = STM[2048 + bh * 64 + c];
            const float mnew = fmaxf(bl + m, mloc);
            const float decay = __expf(bl + m - mnew), scale = __expf(mloc - mnew);
            bf16_t* sp = ST + (size_t)(bh * 64 + c) * 16384 + idx;
            const u32x4 raw = *(const u32x4*)sp; float f[8]; unpack8(raw, f);
            u32x4 o; o.x = pk2(C[0], C[1]); o.y = pk2(C[2], C[3]); o.z = pk2(C[4], C[5]); o.w = pk2(C[6], C[7]);
            *(u32x4*)sp = o;
#pragma unroll
            for (int j = 0; j < 8; ++j) C[j] = decay * C[j] + scale * f[j];
            if (do_n) {
                float* np = STN + (size_t)(bh * 64 + c) * 128 + tid;
                const float dn = *np; *np = nval; nval = decay * nval + scale * dn;
            }
            if ((u & 3) == 0 && tid == 0) STM[4096 + bh * 64 + c] = m;
            m = mnew;
        }
    }
}

__device__ void phase_attn_naive(const Params& p, int l, float* lds) {
    unsigned char* ws = p.ws;
    const bf16_t* proj = (const bf16_t*)(ws + WS_PROJ); const float* gates = (const float*)(ws + WS_GATES);
    const bf16_t* kcmp = (const bf16_t*)(ws + WS_KCMP); const bf16_t* vcmp = (const bf16_t*)(ws + WS_VCMP);
    bf16_t* Y = (bf16_t*)(ws + WS_Y);
    const float* oga = p.in[I_OGA] + l * 512;
    const int tid = threadIdx.x, lane = tid & 63, wave = tid >> 6;
    float* qs = lds + wave * (256 + 1024);
    float* pb = qs + 256;
    for (int u = blockIdx.x; u < BATCH * 2 * (SEQ / 8); u += gridDim.x) {
        const int tb = u % (SEQ / 8), g = (u / (SEQ / 8)) & 1, b = u / (SEQ / 4);
        const int t = tb * 8 + wave; const int m = b * SEQ + t;
        const bf16_t* prow = proj + (size_t)m * NPROJ;
#pragma unroll
        for (int hg = 0; hg < 4; ++hg) qs[hg * 64 + lane] = bf2f(prow[C_QA + g * 256 + hg * 64 + lane]);
        float otot[4] = {0.f, 0.f, 0.f, 0.f};
        const float* gt = gates + (size_t)m * 32 + g * 12;
        const int nval = t >= 31 ? ((t - 31) >> 4) + 1 : 0;
        float sc[4][4];
        float mx[4] = {-INFINITY, -INFINITY, -INFINITY, -INFINITY};
        const bf16_t* kc = kcmp + (size_t)(b * 2 + g) * NCMPP * 64; const bf16_t* vc = vcmp + (size_t)(b * 2 + g) * NCMPP * 64;
#pragma unroll
        for (int it = 0; it < 4; ++it) {
            asm volatile("" ::: "memory");
            const int i = it * 64 + lane;
            float a[4] = {0.f, 0.f, 0.f, 0.f};
            if (i < nval) {
#pragma unroll 1
                for (int d8 = 0; d8 < 8; ++d8) {
                    const u32x4 raw = *(const u32x4*)(kc + (size_t)i * 64 + d8 * 8); float f[8]; unpack8(raw, f);
#pragma unroll
                    for (int j = 0; j < 8; ++j)
#pragma unroll
                        for (int hg = 0; hg < 4; ++hg) a[hg] += qs[hg * 64 + d8 * 8 + j] * f[j];
                }
            }
#pragma unroll
            for (int hg = 0; hg < 4; ++hg) { sc[it][hg] = i < nval ? a[hg] * 0.125f : -INFINITY; mx[hg] = fmaxf(mx[hg], sc[it][hg]); }
        }
        float sm[4];
#pragma unroll
        for (int hg = 0; hg < 4; ++hg) {
            mx[hg] = wave_max(mx[hg]);
            float s = 0.f;
#pragma unroll
            for (int it = 0; it < 4; ++it) { const float e = (it * 64 + lane) < nval ? __expf(sc[it][hg] - mx[hg]) : 0.f; sc[it][hg] = e; s += e; }
            sm[hg] = wave_sum(s);
        }
#pragma unroll
        for (int it = 0; it < 4; ++it)
#pragma unroll
            for (int hg = 0; hg < 4; ++hg) pb[hg * 256 + it * 64 + lane] = nval > 0 ? sc[it][hg] / sm[hg] : 0.f;
        {
            float o[4] = {0.f, 0.f, 0.f, 0.f};
            for (int i = 0; i < nval; ++i) {
                const float v = bf2f(vc[(size_t)i * 64 + lane]);
#pragma unroll
                for (int hg = 0; hg < 4; ++hg) o[hg] += pb[hg * 256 + i] * v;
            }
#pragma unroll
            for (int hg = 0; hg < 4; ++hg) otot[hg] += sigmoid_f(gt[hg * 3 + 0]) * o[hg];
        }
        const int cur = t >> 6;
        float imp = 0.f;
#pragma unroll
        for (int k = -1; k < 4; ++k) {
            const int i = 4 * lane + k;
            if (i >= 0 && i < nval) imp += (pb[i] + pb[256 + i]) + (pb[512 + i] + pb[768 + i]);
        }
        const bool valid = lane <= cur;
        const bool forced = (lane == 0) || (lane == cur) || (lane == cur - 1);
        const float score = valid ? imp + (forced ? 1e4f : 0.f) : -1e30f;
        int rank = 0;
        for (int k = 0; k < 64; ++k) {
            const float sk = __shfl(score, k);
            rank += (sk > score || (sk == score && k < lane)) ? 1 : 0;
        }
        const unsigned long long selmask = __ballot(rank < 16 && valid);
#pragma unroll 1
        for (int br = 0; br < 2; ++br) {
            const int kcol = (br ? C_KW : C_KS) + g * 64, vcol = (br ? C_VW : C_VS) + g * 64;
            float mr[4] = {-INFINITY, -INFINITY, -INFINITY, -INFINITY}, lr[4] = {0.f, 0.f, 0.f, 0.f}, o[4] = {0.f, 0.f, 0.f, 0.f};
            const int jlo = br ? (cur >= 8 ? cur - 8 : 0) : 0;
            for (int j = jlo; j <= cur; ++j) {
                if (br == 0 && !((selmask >> j) & 1ull)) continue;
                asm volatile("" ::: "memory");
                const int pos = j * 64 + lane;
                const bool ok = pos <= t && (br == 0 || pos > t - 512);
                float a[4] = {0.f, 0.f, 0.f, 0.f};
                const bf16_t* kr = proj + (size_t)(b * SEQ + pos) * NPROJ + kcol;
#pragma unroll 1
                for (int d8 = 0; d8 < 8; ++d8) {
                    const u32x4 raw = *(const u32x4*)(kr + d8 * 8); float f[8]; unpack8(raw, f);
#pragma unroll
                    for (int jj = 0; jj < 8; ++jj)
#pragma unroll
                        for (int hg = 0; hg < 4; ++hg) a[hg] += qs[hg * 64 + d8 * 8 + jj] * f[jj];
                }
                float alpha[4];
#pragma unroll
                for (int hg = 0; hg < 4; ++hg) {
                    const float s = ok ? a[hg] * 0.125f : -INFINITY;
                    const float bm = wave_max(s);
                    const float mn = fmaxf(mr[hg], bm);
                    alpha[hg] = (mn == -INFINITY) ? 1.f : __expf(mr[hg] - mn);
                    const float e = (ok && mn > -INFINITY) ? __expf(s - mn) : 0.f;
                    lr[hg] = lr[hg] * alpha[hg] + wave_sum(e);
                    mr[hg] = mn;
                    pb[hg * 256 + lane] = e;
                    o[hg] *= alpha[hg];
                }
                const bf16_t* vr = proj + (size_t)(b * SEQ + j * 64) * NPROJ + vcol + lane;
                for (int k = 0; k < 64; ++k) {
                    const float v = bf2f(vr[(size_t)k * NPROJ]);
#pragma unroll
                    for (int hg = 0; hg < 4; ++hg) o[hg] += pb[hg * 256 + k] * v;
                }
            }
#pragma unroll
            for (int hg = 0; hg < 4; ++hg) otot[hg] += sigmoid_f(gt[hg * 3 + 1 + br]) * (lr[hg] > 0.f ? o[hg] / lr[hg] : 0.f);
        }
#pragma unroll
        for (int hg = 0; hg < 4; ++hg) {
            const float s = wave_sum(otot[hg] * otot[hg]);
            const float y = otot[hg] * rsqrtf(s * (1.f / 64.f) + EPS) * oga[(g * 4 + hg) * 64 + lane];
            Y[(size_t)m * 1024 + (g * 4 + hg) * 64 + lane] = f2bf(y);
        }
    }
}

__device__ void phase_mlstm_out(const Params& p, int l, float* lds) {
    unsigned char* ws = p.ws;
    const bf16_t* proj = (const bf16_t*)(ws + WS_PROJ); const float* gates = (const float*)(ws + WS_GATES);
    const bf16_t* qkc = (const bf16_t*)(ws + WS_XB);
    const bf16_t* ST = (const bf16_t*)(ws + WS_ST); const float* STN = (const float*)(ws + WS_STN); const float* STM = (const float*)(ws + WS_STM);
    const float* fb = p.in[I_FB] + l * 4; const float* ogm = p.in[I_OGM] + l * 512;
    bf16_t* Y = (bf16_t*)(ws + WS_Y);
    float* qq = lds;
    float* kk = lds + 8192;
    float* Cs = lds + 16384;
    float* Ws = lds + 32768;
    float* bcum = Ws + 64 * 65; float* ig = bcum + 64; float* mt = ig + 64; float* wint = mt + 64; float* den = wint + 64; float* npv = den + 64;
    const int tid = threadIdx.x, lane = tid & 63, wave = tid >> 6;
    for (int u = blockIdx.x; u < BATCH * 4 * 64; u += gridDim.x) {
        const int c = u & 63, h = (u >> 6) & 3, b = u >> 8;
        const int m0 = b * SEQ + c * 64, bh = b * 4 + h;
        mlstm_gates(gates, fb, m0, h, bcum, ig);
        const float mprev = STM[4096 + bh * 64 + c];
        for (int e = tid; e < 64 * 16; e += NT) {
            const int s = e >> 4, d0 = (e & 15) * 8;
            const u32x4 rq = *(const u32x4*)(qkc + (size_t)(m0 + s) * 1024 + h * 128 + d0); float f[8]; unpack8(rq, f);
            const u32x4 rk = *(const u32x4*)(qkc + (size_t)(m0 + s) * 1024 + 512 + h * 128 + d0); float fk[8]; unpack8(rk, fk);
#pragma unroll
            for (int j = 0; j < 8; ++j) { qq[s * 128 + d0 + j] = f[j]; kk[s * 128 + d0 + j] = fk[j]; }
        }
        if (tid < 128) npv[tid] = STN[(size_t)(bh * 64 + c) * 128 + tid];
        for (int e8 = tid; e8 < 128 * 16; e8 += NT) {
            const int e = e8 >> 4, d0 = (e8 & 15) * 8;
            const u32x4 rc = *(const u32x4*)(ST + ((size_t)(bh * 64 + c) * 128 + e) * 128 + d0); float f[8]; unpack8(rc, f);
#pragma unroll
            for (int j = 0; j < 8; ++j) Cs[(d0 + j) * 128 + e] = f[j];
        }
        __syncthreads();
        {
            const int t = tid >> 3, s0 = (tid & 7) * 8;
            float a[8] = {0.f, 0.f, 0.f, 0.f, 0.f, 0.f, 0.f, 0.f};
            for (int d = 0; d < 128; ++d) {
                const float qv = qq[t * 128 + d];
#pragma unroll
                for (int j = 0; j < 8; ++j) a[j] += qv * kk[(s0 + j) * 128 + d];
            }
#pragma unroll
            for (int j = 0; j < 8; ++j) Ws[t * 65 + s0 + j] = a[j];
        }
        __syncthreads();
        for (int r = 0; r < 8; ++r) {
            const int t = wave * 8 + r;
            const float dv = lane <= t ? bcum[t] - bcum[lane] + ig[lane] : -INFINITY;
            const float a = bcum[t] + mprev;
            const float m_t = fmaxf(a, wave_max(dv));
            const float w = lane <= t ? __expf(dv - m_t) * Ws[t * 65 + lane] : 0.f;
            Ws[t * 65 + lane] = w;
            const float wi = __expf(a - m_t);
            const float qn = wave_sum(qq[t * 128 + lane] * npv[lane] + qq[t * 128 + 64 + lane] * npv[64 + lane]);
            const float dsum = wave_sum(w);
            if (lane == 0) { mt[t] = m_t; wint[t] = wi; den[t] = wi * qn + dsum; }
        }
        __syncthreads();
        for (int e = tid; e < 64 * 16; e += NT) {
            const int s = e >> 4, d0 = (e & 15) * 8;
            const u32x4 rv = *(const u32x4*)(proj + (size_t)(m0 + s) * NPROJ + C_VB + h * 128 + d0); float f[8]; unpack8(rv, f);
#pragma unroll
            for (int j = 0; j < 8; ++j) kk[s * 128 + d0 + j] = f[j];
        }
        __syncthreads();
        float hv[16];
        {
            const int e = tid & 127, t0 = (tid >> 7) * 16;
            float a1[16], a2[16];
#pragma unroll
            for (int i = 0; i < 16; ++i) { a1[i] = 0.f; a2[i] = 0.f; }
            for (int d = 0; d < 128; ++d) {
                const float cv = Cs[d * 128 + e];
#pragma unroll
                for (int i = 0; i < 16; ++i) a1[i] += qq[(t0 + i) * 128 + d] * cv;
            }
            for (int s = 0; s < 64; ++s) {
                const float vv = kk[s * 128 + e];
#pragma unroll
                for (int i = 0; i < 16; ++i) a2[i] += Ws[(t0 + i) * 65 + s] * vv;
            }
#pragma unroll
            for (int i = 0; i < 16; ++i) {
                const int t = t0 + i;
                const float num = wint[t] * a1[i] + a2[i];
                hv[i] = num / fmaxf(fabsf(den[t]), __expf(-mt[t]));
            }
        }
        __syncthreads();
        {
            const int e = tid & 127, t0 = (tid >> 7) * 16;
#pragma unroll
            for (int i = 0; i < 16; ++i) Cs[(t0 + i) * 128 + e] = hv[i];
        }
        __syncthreads();
        for (int r = 0; r < 8; ++r) {
            const int t = wave * 8 + r;
            const float h0 = Cs[t * 128 + lane], h1 = Cs[t * 128 + 64 + lane];
            const float s = wave_sum(h0 * h0 + h1 * h1);
            const float rr = rsqrtf(s * (1.f / 128.f) + EPS);
            const bf16_t* op = proj + (size_t)(m0 + t) * NPROJ + C_OB + h * 128;
            const float y0 = h0 * rr * ogm[h * 128 + lane] * sigmoid_f(bf2f(op[lane]));
            const float y1 = h1 * rr * ogm[h * 128 + 64 + lane] * sigmoid_f(bf2f(op[64 + lane]));
            Y[(size_t)(m0 + t) * 1024 + 512 + h * 128 + lane] = f2bf(y0);
            Y[(size_t)(m0 + t) * 1024 + 512 + h * 128 + 64 + lane] = f2bf(y1);
        }
        __syncthreads();
    }
}

constexpr int NPHASE = 1 + 7 * DEPTH;
template <bool COOP, int PMASK>
__global__ void __launch_bounds__(NT) mega(Params p) {
    extern __shared__ __attribute__((aligned(16))) unsigned char lds_raw[];
    float* lds = (float*)lds_raw;
    unsigned char* ws = p.ws;
    for (int ph = p.lo; ph < p.hi; ++ph) {
        if (ph == 0) {
            if (PMASK & 128) phase_prologue(p, lds);
        } else {
            const int l = (ph - 1) / 7, k = (ph - 1) % 7;
            if (k == 0 && (PMASK & 1)) {
                EpiIn E{(const float*)(ws + WS_SS), (const float*)(ws + WS_BIAS) + l * NPAD, (bf16_t*)(ws + WS_PROJ), (float*)(ws + WS_GATES)};
                gemm_naive((const bf16_t*)(ws + WS_XB), (const bf16_t*)(ws + WS_WIN) + (size_t)l * NPAD * DM, M, NPAD, DM, E, lds);
            } else if (k == 1 && (PMASK & 2)) {
                phase_rowpass(p, l);
                phase_compress(p, l, lds);
                phase_chunkstate(p, l, lds);
            } else if (k == 2 && (PMASK & 4)) {
                phase_scan(p);
                phase_attn_naive(p, l, lds);
            } else if (k == 3 && (PMASK & 8)) {
                phase_mlstm_out(p, l, lds);
            } else if (k == 4 && (PMASK & 16)) {
                EpiRes E{l == 0 ? p.in[I_X] : p.out, p.out, (bf16_t*)(ws + WS_XB), (float*)(ws + WS_SS)};
                gemm_naive((const bf16_t*)(ws + WS_Y), (const bf16_t*)(ws + WS_WOUT) + (size_t)l * DM * DM, M, DM, DM, E, lds);
            } else if (k == 5 && (PMASK & 32)) {
                EpiGU E{(const float*)(ws + WS_SS), (bf16_t*)(ws + WS_PROJ)};
                gemm_naive((const bf16_t*)(ws + WS_XB), (const bf16_t*)(ws + WS_WGU) + (size_t)l * NGU * DM, M, NGU, DM, E, lds);
            } else if (k == 6 && (PMASK & 64)) {
                EpiRes E{p.out, p.out, (bf16_t*)(ws + WS_XB), (float*)(ws + WS_SS)};
                gemm_naive((const bf16_t*)(ws + WS_PROJ), (const bf16_t*)(ws + WS_WD) + (size_t)l * DM * FF, M, DM, FF, E, lds);
            }
        }
        if (COOP && ph + 1 < p.hi) { cg::this_grid().sync(); }
    }
}

template <int PMASK> static void launch_phase(const Params& p, int grid, hipStream_t stream) {
    static bool init = false;
    if (!init) { (void)hipFuncSetAttribute((const void*)mega<false, PMASK>, hipFuncAttributeMaxDynamicSharedMemorySize, LDS_BYTES); init = true; }
    hipLaunchKernelGGL((mega<false, PMASK>), dim3(grid), dim3(NT), LDS_BYTES, stream, p);
}
extern "C" void kernel_launch(void* const* d_in, const int* in_sizes, int n_in, void* d_out, int out_size, void* d_ws, size_t ws_size, hipStream_t stream) {
    static int grid = 0;
    if (grid == 0) {
        if (n_in != 18 || ws_size < WS_END) { fprintf(stderr, "kernel_launch: unexpected n_in %d / ws_size %zu\n", n_in, ws_size); grid = -1; return; }
        int dev = 0, cus = 0;
        (void)hipGetDevice(&dev);
        (void)hipDeviceGetAttribute(&cus, hipDeviceAttributeMultiprocessorCount, dev);
        grid = cus > 0 ? cus : 256;
        (void)hipGetLastError();
    }
    if (grid < 0) return;
    Params p{};
    for (int i = 0; i < 18; ++i) p.in[i] = (const float*)d_in[i];
    p.out = (float*)d_out; p.ws = (unsigned char*)d_ws;
    for (int ph = 0; ph < NPHASE; ++ph) {
        p.lo = ph; p.hi = ph + 1;
        const int k = ph == 0 ? 7 : (ph - 1) % 7;
        switch (k) {
            case 0: launch_phase<1>(p, grid, stream); break;
            case 1: launch_phase<2>(p, grid, stream); break;
            case 2: launch_phase<4>(p, grid, stream); break;
            case 3: launch_phase<8>(p, grid, stream); break;
            case 4: launch_phase<16>(p, grid, stream); break;
            case 5: launch_phase<32>(p, grid, stream); break;
            case 6: launch_phase<64>(p, grid, stream); break;
            default: launch_phase<128>(p, grid, stream); break;
        }
    }
}
```

```cpp
#include <hip/hip_runtime.h>
#include <hip/hip_cooperative_groups.h>
#include <cstdint>
#include <cstdio>
namespace cg = cooperative_groups;

typedef unsigned short bf16_t;
typedef unsigned u32x4 __attribute__((ext_vector_type(4)));
typedef unsigned u32x2 __attribute__((ext_vector_type(2)));
typedef float f32x4 __attribute__((ext_vector_type(4)));

constexpr int BATCH = 8, SEQ = 4096, DM = 1024, M = BATCH * SEQ, DEPTH = 2;
constexpr int NIN = 3360, NPROJ = 3328, NPAD = 3584, FF = 2816, NGU = 2 * FF;
constexpr int NCMP = 255, NCMPP = 256;
constexpr float EPS = 1e-6f;
constexpr int NT = 512;
constexpr int LDS_BYTES = 152 * 1024;

constexpr int C_QA = 0, C_KC = 512, C_VC = 640, C_KS = 768, C_VS = 896, C_KW = 1024, C_VW = 1152, C_QB = 1280, C_KB = 1792, C_VB = 2304, C_OB = 2816;

constexpr size_t MiB = 1u << 20;
constexpr size_t WS_CTL = 0;
constexpr size_t WS_WIN = 1 * MiB;
constexpr size_t WS_WOUT = 15 * MiB;
constexpr size_t WS_WGU = 19 * MiB;
constexpr size_t WS_WD = 41 * MiB;
constexpr size_t WS_BIAS = 52 * MiB;
constexpr size_t WS_SS = 53 * MiB;
constexpr size_t WS_GATES = 55 * MiB;
constexpr size_t WS_KCMP = 59 * MiB;
constexpr size_t WS_VCMP = 59 * MiB + 512 * 1024;
constexpr size_t WS_STN = 60 * MiB;
constexpr size_t WS_STM = 61 * MiB;
constexpr size_t WS_XB = 64 * MiB;
constexpr size_t WS_Y = 128 * MiB;
constexpr size_t WS_ST = 192 * MiB;
constexpr size_t WS_PROJ = 256 * MiB;
constexpr size_t WS_END = 464 * MiB;

struct Params {
    const float* in[18];
    float* out;
    unsigned char* ws;
    int lo, hi;
};
enum { I_X = 0, I_LN1, I_WIN, I_BIN, I_QG, I_KG, I_PE, I_W1, I_W2, I_CW, I_CB, I_FB, I_OGA, I_OGM, I_WOUT, I_LN2, I_WGU, I_WD };

__device__ __forceinline__ float bf2f(bf16_t v) { return __uint_as_float(((unsigned)v) << 16); }
__device__ __forceinline__ bf16_t f2bf(float f) { unsigned u = __float_as_uint(f); return (bf16_t)((u + 0x7fffu + ((u >> 16) & 1u)) >> 16); }
__device__ __forceinline__ unsigned pk2(float lo, float hi) { return (unsigned)f2bf(lo) | ((unsigned)f2bf(hi) << 16); }
__device__ __forceinline__ float lo16(unsigned w) { return __uint_as_float(w << 16); }
__device__ __forceinline__ float hi16(unsigned w) { return __uint_as_float(w & 0xffff0000u); }
__device__ __forceinline__ float silu_f(float x) { return x / (1.f + __expf(-x)); }
__device__ __forceinline__ float sigmoid_f(float x) { return 1.f / (1.f + __expf(-x)); }
__device__ __forceinline__ float wave_sum(float v) {
#pragma unroll
    for (int o = 1; o < 64; o <<= 1) v += __shfl_xor(v, o);
    return v;
}
__device__ __forceinline__ float wave_max(float v) {
#pragma unroll
    for (int o = 1; o < 64; o <<= 1) v = fmaxf(v, __shfl_xor(v, o));
    return v;
}
__device__ __forceinline__ int my_tid() { int t = threadIdx.x; asm volatile("" : "+v"(t)); return t; }
__device__ __forceinline__ int my_bid() { int b = blockIdx.x; asm volatile("" : "+s"(b)); return b; }
__device__ __forceinline__ void unpack8(u32x4 w, float* f) {
    f[0] = lo16(w.x); f[1] = hi16(w.x); f[2] = lo16(w.y); f[3] = hi16(w.y);
    f[4] = lo16(w.z); f[5] = hi16(w.z); f[6] = lo16(w.w); f[7] = hi16(w.w);
}

__device__ __forceinline__ int in_srccol(int n) {
    if (n < 1280) return n;
    if (n < 2816) return n + 24;
    if (n < 3328) return n + 32;
    if (n < 3352) return n - 3328 + 1280;
    if (n < 3360) return n - 3352 + 2840;
    return -1;
}
__device__ __forceinline__ int gu_srccol(int n) {
    const int t = n >> 8, w = n & 255;
    return (w < 128) ? (t * 128 + w) : (FF + t * 128 + (w - 128));
}

template <int MODE>
__device__ void conv_job(const float* W, int K, int Nsrc, bf16_t* WT, int Nout, const float* kscale, float* tile) {
    const int tid = my_tid();
    const int nk = K / 64, nn = Nout / 64;
    for (int u = my_bid(); u < nk * nn; u += gridDim.x) {
        const int k0 = (u % nk) * 64, n0 = (u / nk) * 64;
#pragma unroll
        for (int i = 0; i < 8; ++i) {
            const int r = (tid >> 6) + 8 * i, c = tid & 63;
            const int n = n0 + c;
            const int sc = MODE == 0 ? n : (MODE == 1 ? in_srccol(n) : gu_srccol(n));
            float v = 0.f;
            if (sc >= 0) v = W[(size_t)(k0 + r) * Nsrc + sc] * (kscale ? kscale[k0 + r] : 1.f);
            tile[r * 65 + c] = v;
        }
        __syncthreads();
#pragma unroll
        for (int i = 0; i < 8; ++i) {
            const int r = (tid >> 6) + 8 * i, c = tid & 63;
            WT[(size_t)(n0 + r) * K + k0 + c] = f2bf(tile[c * 65 + r]);
        }
        __syncthreads();
    }
}

__device__ void phase_prologue(const Params& p, float* lds) {
    unsigned char* ws = p.ws;
    const int tid = my_tid(), lane = tid & 63, wave = tid >> 6;
    for (int l = 0; l < DEPTH; ++l) {
        conv_job<1>(p.in[I_WIN] + (size_t)l * DM * NIN, DM, NIN, (bf16_t*)(ws + WS_WIN) + (size_t)l * NPAD * DM, NPAD, p.in[I_LN1] + l * DM, lds);
        conv_job<0>(p.in[I_WOUT] + (size_t)l * DM * DM, DM, DM, (bf16_t*)(ws + WS_WOUT) + (size_t)l * DM * DM, DM, nullptr, lds);
        conv_job<2>(p.in[I_WGU] + (size_t)l * DM * NGU, DM, NGU, (bf16_t*)(ws + WS_WGU) + (size_t)l * NGU * DM, NGU, p.in[I_LN2] + l * DM, lds);
        conv_job<0>(p.in[I_WD] + (size_t)l * FF * DM, FF, DM, (bf16_t*)(ws + WS_WD) + (size_t)l * DM * FF, DM, nullptr, lds);
    }
    float* biasP = (float*)(ws + WS_BIAS);
    for (int i = my_bid() * NT + tid; i < DEPTH * NPAD; i += gridDim.x * NT) {
        const int l = i / NPAD, n = i % NPAD; const int sc = in_srccol(n);
        biasP[i] = sc >= 0 ? p.in[I_BIN][l * NIN + sc] : 0.f;
    }
    const float* x = p.in[I_X]; bf16_t* xb = (bf16_t*)(ws + WS_XB); float* ss = (float*)(ws + WS_SS);
    for (int m = my_bid() * 8 + wave; m < M; m += gridDim.x * 8) {
        const f32x4* xr = (const f32x4*)(x + (size_t)m * DM) + lane;
#pragma unroll
        for (int j = 0; j < 4; ++j) {
            const f32x4 v = xr[64 * j];
            float s = (v.x * v.x + v.y * v.y) + (v.z * v.z + v.w * v.w);
            s += __shfl_xor(s, 1); s += __shfl_xor(s, 2); s += __shfl_xor(s, 4); s += __shfl_xor(s, 8);
            if ((lane & 15) == 0) ss[(size_t)m * 16 + 4 * j + (lane >> 4)] = s;
            u32x2 o; o.x = pk2(v.x, v.y); o.y = pk2(v.z, v.w);
            *(u32x2*)(xb + (size_t)m * DM + 256 * j + 4 * lane) = o;
        }
    }
}

struct EpiIn {
    const float* ss; const float* bias; bf16_t* proj; float* gates;
    __device__ __forceinline__ void row(int m, int c0, int tx, const float (&v)[16]) const {
        float s = 0.f;
#pragma unroll
        for (int q = 0; q < 16; ++q) s += ss[(size_t)m * 16 + q];
        const float r = rsqrtf(s * (1.f / DM) + EPS);
#pragma unroll
        for (int h = 0; h < 2; ++h)
#pragma unroll
            for (int j = 0; j < 8; ++j) {
                const int col = c0 + h * 128 + tx * 8 + j;
                const float val = v[h * 8 + j] * r + bias[col];
                if (col < NPROJ) proj[(size_t)m * NPROJ + col] = f2bf(val);
                else if (col < NIN) gates[(size_t)m * 32 + (col - NPROJ)] = val;
            }
    }
};
struct EpiRes {
    const float* base; float* out; bf16_t* xb; float* ss;
    __device__ __forceinline__ void row(int m, int c0, int tx, const float (&v)[16]) const {
#pragma unroll
        for (int h = 0; h < 2; ++h) {
            float sq = 0.f;
#pragma unroll
            for (int j = 0; j < 8; ++j) {
                const size_t idx = (size_t)m * DM + c0 + h * 128 + tx * 8 + j;
                const float x1 = base[idx] + v[h * 8 + j];
                out[idx] = x1; xb[idx] = f2bf(x1); sq += x1 * x1;
            }
            sq += __shfl_xor(sq, 1); sq += __shfl_xor(sq, 2); sq += __shfl_xor(sq, 4);
            if ((tx & 7) == 0) ss[(size_t)m * 16 + (c0 >> 6) + h * 2 + (tx >> 3)] = sq;
        }
    }
};
struct EpiGU {
    const float* ss; bf16_t* act;
    __device__ __forceinline__ void row(int m, int c0, int tx, const float (&v)[16]) const {
        float s = 0.f;
#pragma unroll
        for (int q = 0; q < 16; ++q) s += ss[(size_t)m * 16 + q];
        const float r = rsqrtf(s * (1.f / DM) + EPS);
#pragma unroll
        for (int j = 0; j < 8; ++j) {
            const float g = v[j] * r, u = v[8 + j] * r;
            act[(size_t)m * FF + (c0 >> 8) * 128 + tx * 8 + j] = f2bf(silu_f(g) * u);
        }
    }
};

template <class Epi>
__device__ void gemm_naive(const bf16_t* A, const bf16_t* Bt, int Mr, int N, int K, const Epi& E, float* lds) {
    float* As = lds;
    float* Bs = lds + 32 * 132;
    const int tid = my_tid(), ty = tid >> 4, tx = tid & 15;
    const int nN = N / 256, nM = Mr / 128;
    const int lrow = tid >> 2, lk = (tid & 3) * 8;
    for (int u = my_bid(); u < nN * nM; u += gridDim.x) {
        const int pm = u / nN, pn = u % nN;
        float acc[4][16];
#pragma unroll
        for (int i = 0; i < 4; ++i)
#pragma unroll
            for (int j = 0; j < 16; ++j) acc[i][j] = 0.f;
        const bf16_t* Ap = A + (size_t)(pm * 128 + lrow) * K + lk;
        const bf16_t* Bp0 = Bt + (size_t)(pn * 256 + lrow) * K + lk;
        const bf16_t* Bp1 = Bp0 + (size_t)128 * K;
        for (int k0 = 0; k0 < K; k0 += 32) {
            const u32x4 av = *(const u32x4*)(Ap + k0), b0 = *(const u32x4*)(Bp0 + k0), b1 = *(const u32x4*)(Bp1 + k0);
            float fa[8], fb0[8], fb1[8]; unpack8(av, fa); unpack8(b0, fb0); unpack8(b1, fb1);
            __syncthreads();
#pragma unroll
            for (int j = 0; j < 8; ++j) { As[(lk + j) * 132 + lrow] = fa[j]; Bs[(lk + j) * 260 + lrow] = fb0[j]; Bs[(lk + j) * 260 + 128 + lrow] = fb1[j]; }
            __syncthreads();
#pragma unroll 4
            for (int k = 0; k < 32; ++k) {
                const f32x4 a = *(const f32x4*)(As + k * 132 + ty * 4);
                const f32x4 p0 = *(const f32x4*)(Bs + k * 260 + tx * 8), p1 = *(const f32x4*)(Bs + k * 260 + tx * 8 + 4);
                const f32x4 q0 = *(const f32x4*)(Bs + k * 260 + 128 + tx * 8), q1 = *(const f32x4*)(Bs + k * 260 + 128 + tx * 8 + 4);
                const float bb[16] = {p0.x, p0.y, p0.z, p0.w, p1.x, p1.y, p1.z, p1.w, q0.x, q0.y, q0.z, q0.w, q1.x, q1.y, q1.z, q1.w};
                const float aa[4] = {a.x, a.y, a.z, a.w};
#pragma unroll
                for (int i = 0; i < 4; ++i)
#pragma unroll
                    for (int j = 0; j < 16; ++j) acc[i][j] += aa[i] * bb[j];
            }
        }
#pragma unroll
        for (int i = 0; i < 4; ++i) E.row(pm * 128 + ty * 4 + i, pn * 256, tx, acc[i]);
    }
}

__device__ void phase_rowpass(const Params& p, int l) {
    unsigned char* ws = p.ws;
    bf16_t* proj = (bf16_t*)(ws + WS_PROJ); bf16_t* qkc = (bf16_t*)(ws + WS_XB);
    const float* qg = p.in[I_QG] + l * 64; const float* kg = p.in[I_KG] + l * 192;
    const float* cw = p.in[I_CW] + l * 4096; const float* cb = p.in[I_CB] + l * 1024;
    const int tid = my_tid(), lane = tid & 63, wave = tid >> 6;
    for (int m = my_bid() * 8 + wave; m < M; m += gridDim.x * 8) {
        const int t = m % SEQ;
        bf16_t* row = proj + (size_t)m * NPROJ;
        {
            const u32x4 raw = *(const u32x4*)(row + C_QA + lane * 8); float f[8]; unpack8(raw, f);
            float s = 0.f;
#pragma unroll
            for (int j = 0; j < 8; ++j) s += f[j] * f[j];
            s += __shfl_xor(s, 1); s += __shfl_xor(s, 2); s += __shfl_xor(s, 4);
            const float r = rsqrtf(s * (1.f / 64.f) + EPS);
            const int d0 = (lane & 7) * 8;
            u32x4 o; o.x = pk2(f[0] * r * qg[d0], f[1] * r * qg[d0 + 1]); o.y = pk2(f[2] * r * qg[d0 + 2], f[3] * r * qg[d0 + 3]);
            o.z = pk2(f[4] * r * qg[d0 + 4], f[5] * r * qg[d0 + 5]); o.w = pk2(f[6] * r * qg[d0 + 6], f[7] * r * qg[d0 + 7]);
            *(u32x4*)(row + C_QA + lane * 8) = o;
        }
        {
            const int which = lane >> 5, w4 = (lane & 31) * 4;
            bf16_t* pp = row + (which ? C_KW : C_KS) + w4;
            const u32x2 raw = *(const u32x2*)pp;
            float f[4] = {lo16(raw.x), hi16(raw.x), lo16(raw.y), hi16(raw.y)};
            float s = (f[0] * f[0] + f[1] * f[1]) + (f[2] * f[2] + f[3] * f[3]);
            s += __shfl_xor(s, 1); s += __shfl_xor(s, 2); s += __shfl_xor(s, 4); s += __shfl_xor(s, 8);
            const float r = rsqrtf(s * (1.f / 64.f) + EPS);
            const float* g = kg + (1 + which) * 64 + (w4 & 63);
            u32x2 o; o.x = pk2(f[0] * r * g[0], f[1] * r * g[1]); o.y = pk2(f[2] * r * g[2], f[3] * r * g[3]);
            *(u32x2*)pp = o;
        }
#pragma unroll
        for (int part = 0; part < 2; ++part) {
            const int c0 = part * 512 + lane * 8;
            float acc[8];
#pragma unroll
            for (int j = 0; j < 8; ++j) acc[j] = cb[c0 + j];
#pragma unroll
            for (int w = 0; w < 4; ++w) {
                if (t - 3 + w >= 0) {
                    const u32x4 raw = *(const u32x4*)(proj + (size_t)(m - 3 + w) * NPROJ + C_QB + c0); float f[8]; unpack8(raw, f);
#pragma unroll
                    for (int j = 0; j < 8; ++j) acc[j] += f[j] * cw[w * 1024 + c0 + j];
                }
            }
            const float sc = part ? 0.08838834764831845f : 1.f;
            float y[8];
#pragma unroll
            for (int j = 0; j < 8; ++j) y[j] = silu_f(acc[j]) * sc;
            u32x4 o; o.x = pk2(y[0], y[1]); o.y = pk2(y[2], y[3]); o.z = pk2(y[4], y[5]); o.w = pk2(y[6], y[7]);
            *(u32x4*)(qkc + (size_t)m * 1024 + c0) = o;
        }
    }
}

__device__ void phase_compress(const Params& p, int l, float* lds) {
    unsigned char* ws = p.ws;
    const bf16_t* proj = (const bf16_t*)(ws + WS_PROJ);
    const float* pe = p.in[I_PE] + (size_t)l * 2 * 2048; const float* w1 = p.in[I_W1] + (size_t)l * 2 * 2048 * 128; const float* w2 = p.in[I_W2] + (size_t)l * 2 * 128 * 64;
    const float* kg0 = p.in[I_KG] + l * 192;
    float* tok = lds;
    float* red = lds + 144 * 64;
    float* hidb = red + 4 * 8 * 128;
    const int tid = my_tid(), lane = tid & 63;
    for (int u = my_bid(); u < BATCH * 2 * 2 * 32; u += gridDim.x) {
        const int ib = u & 31, kv = (u >> 5) & 1, g = (u >> 6) & 1, b = u >> 7;
        const int i0 = ib * 8, ni = (NCMP - i0) < 8 ? (NCMP - i0) : 8;
        const int ntok = 16 * ni + 16;
        const int col = (kv ? C_VC : C_KC) + g * 64;
        __syncthreads();
        for (int e = tid; e < 144 * 64; e += NT) {
            const int tt = e >> 6, d = e & 63;
            tok[e] = tt < ntok ? bf2f(proj[(size_t)(b * SEQ + 16 * i0 + tt) * NPROJ + col + d]) : 0.f;
        }
        __syncthreads();
        {
            const int hid = tid & 127, part = tid >> 7;
            float acc[8], accP = 0.f;
#pragma unroll
            for (int ii = 0; ii < 8; ++ii) acc[ii] = 0.f;
            const float* w1p = w1 + (size_t)kv * 2048 * 128 + hid; const float* pep = pe + kv * 2048;
#pragma unroll 2
            for (int f = part * 512; f < part * 512 + 512; ++f) {
                const float w = w1p[(size_t)f * 128];
                accP += w * pep[f];
#pragma unroll
                for (int ii = 0; ii < 8; ++ii) acc[ii] += w * tok[16 * 64 * ii + f];
            }
#pragma unroll
            for (int ii = 0; ii < 8; ++ii) red[(part * 8 + ii) * 128 + hid] = acc[ii] + accP;
        }
        __syncthreads();
        for (int e = tid; e < 8 * 128; e += NT) {
            const float s = (red[e] + red[1024 + e]) + (red[2048 + e] + red[3072 + e]);
            hidb[e] = silu_f(s);
        }
        __syncthreads();
        {
            const int ii = tid >> 6, d = lane;
            float o = 0.f;
            const float* w2p = w2 + (size_t)kv * 128 * 64 + d;
            for (int h = 0; h < 128; ++h) o += hidb[ii * 128 + h] * w2p[h * 64];
            if (kv == 0) { const float s = wave_sum(o * o); o = o * rsqrtf(s * (1.f / 64.f) + EPS) * kg0[d]; }
            bf16_t* dst = (bf16_t*)(ws + (kv ? WS_VCMP : WS_KCMP));
            if (ii < ni) dst[(size_t)((b * 2 + g) * NCMPP + i0 + ii) * 64 + d] = f2bf(o);
        }
    }
    __syncthreads();
}

__device__ __forceinline__ float log_sigmoid_f(float x) { return fminf(x, 0.f) - log1pf(__expf(-fabsf(x))); }
__device__ void mlstm_gates(const float* gates, const float* fb, int m0, int h, float* bcum, float* ig) {
    const int tid = my_tid();
    __syncthreads();
    if (tid < 64) {
        const float lf = log_sigmoid_f(gates[(size_t)(m0 + tid) * 32 + 28 + h] + fb[h]);
        ig[tid] = gates[(size_t)(m0 + tid) * 32 + 24 + h];
        float v = lf;
#pragma unroll
        for (int o = 1; o < 64; o <<= 1) { const float t = __shfl_up(v, o); if (tid >= o) v += t; }
        bcum[tid] = v;
    }
    __syncthreads();
}

__device__ void phase_chunkstate(const Params& p, int l, float* lds) {
    unsigned char* ws = p.ws;
    const bf16_t* proj = (const bf16_t*)(ws + WS_PROJ); const float* gates = (const float*)(ws + WS_GATES);
    const float* cw = p.in[I_CW] + l * 4096; const float* cb = p.in[I_CB] + l * 1024; const float* fb = p.in[I_FB] + l * 4;
    bf16_t* ST = (bf16_t*)(ws + WS_ST); float* STN = (float*)(ws + WS_STN); float* STM = (float*)(ws + WS_STM);
    float* kw = lds;
    float* vv = lds + 8192;
    float* bcum = lds + 16384; float* ig = bcum + 64; float* wsc = ig + 64; float* misc = wsc + 64;
    const int tid = my_tid();
    for (int u = my_bid(); u < BATCH * 4 * 64; u += gridDim.x) {
        const int c = u & 63, h = (u >> 6) & 3, b = u >> 8;
        const int m0 = b * SEQ + c * 64, bh = b * 4 + h;
        mlstm_gates(gates, fb, m0, h, bcum, ig);
        if (tid < 64) {
            const float gv = bcum[63] - bcum[tid] + ig[tid];
            const float mx = wave_max(gv);
            wsc[tid] = __expf(gv - mx);
            if (tid == 0) { misc[0] = mx; STM[bh * 64 + c] = mx; STM[2048 + bh * 64 + c] = bcum[63]; }
        }
        __syncthreads();
        for (int e = tid; e < 64 * 16; e += NT) {
            const int s = e >> 4, d0 = (e & 15) * 8;
            const int t = c * 64 + s, ch = 512 + h * 128 + d0;
            float acc[8];
#pragma unroll
            for (int j = 0; j < 8; ++j) acc[j] = cb[ch + j];
#pragma unroll
            for (int w = 0; w < 4; ++w) {
                if (t - 3 + w >= 0) {
                    const u32x4 raw = *(const u32x4*)(proj + (size_t)(m0 + s - 3 + w) * NPROJ + C_QB + ch); float f[8]; unpack8(raw, f);
#pragma unroll
                    for (int j = 0; j < 8; ++j) acc[j] += f[j] * cw[w * 1024 + ch + j];
                }
            }
            const float sc = 0.08838834764831845f * wsc[s];
#pragma unroll
            for (int j = 0; j < 8; ++j) kw[s * 128 + d0 + j] = silu_f(acc[j]) * sc;
            const u32x4 rv = *(const u32x4*)(proj + (size_t)(m0 + s) * NPROJ + C_VB + h * 128 + d0); float fv[8]; unpack8(rv, fv);
#pragma unroll
            for (int j = 0; j < 8; ++j) vv[s * 128 + d0 + j] = fv[j];
        }
        __syncthreads();
        {
            const int e0 = (tid >> 4) * 4, d0 = (tid & 15) * 8;
            float acc[4][8];
#pragma unroll
            for (int i = 0; i < 4; ++i)
#pragma unroll
                for (int j = 0; j < 8; ++j) acc[i][j] = 0.f;
#pragma unroll 2
            for (int s = 0; s < 64; ++s) {
                const f32x4 ve = *(const f32x4*)(vv + s * 128 + e0);
                const f32x4 k0 = *(const f32x4*)(kw + s * 128 + d0), k1 = *(const f32x4*)(kw + s * 128 + d0 + 4);
                const float va[4] = {ve.x, ve.y, ve.z, ve.w}; const float ka[8] = {k0.x, k0.y, k0.z, k0.w, k1.x, k1.y, k1.z, k1.w};
#pragma unroll
                for (int i = 0; i < 4; ++i)
#pragma unroll
                    for (int j = 0; j < 8; ++j) acc[i][j] += va[i] * ka[j];
            }
#pragma unroll
            for (int i = 0; i < 4; ++i) {
                u32x4 o; o.x = pk2(acc[i][0], acc[i][1]); o.y = pk2(acc[i][2], acc[i][3]); o.z = pk2(acc[i][4], acc[i][5]); o.w = pk2(acc[i][6], acc[i][7]);
                *(u32x4*)(ST + ((size_t)(bh * 64 + c) * 128 + e0 + i) * 128 + d0) = o;
            }
        }
        if (tid < 128) {
            float s = 0.f;
            for (int q = 0; q < 64; ++q) s += kw[q * 128 + tid];
            STN[(size_t)(bh * 64 + c) * 128 + tid] = s;
        }
    }
    __syncthreads();
}

__device__ void phase_scan(const Params& p) {
    unsigned char* ws = p.ws;
    bf16_t* ST = (bf16_t*)(ws + WS_ST); float* STN = (float*)(ws + WS_STN); float* STM = (float*)(ws + WS_STM);
    const int tid = my_tid();
    for (int u = my_bid(); u < 128; u += gridDim.x) {
        const int bh = u >> 2, idx = ((u & 3) * NT + tid) * 8;
        float C[8];
#pragma unroll
        for (int j = 0; j < 8; ++j) C[j] = 0.f;
        float nval = 0.f; const bool do_n = (u & 3) == 0 && tid < 128;
        float m = 0.f;
        for (int c = 0; c < 64; ++c) {
            const float mloc = STM[bh * 64 + c], bl = STM[2048 + bh * 64 + c];
            const float mnew = fmaxf(bl + m, mloc);
            const float decay = __expf(bl + m - mnew), scale = __expf(mloc - mnew);
            bf16_t* sp = ST + (size_t)(bh * 64 + c) * 16384 + idx;
            const u32x4 raw = *(const u32x4*)sp; float f[8]; unpack8(raw, f);
            u32x4 o; o.x = pk2(C[0], C[1]); o.y = pk2(C[2], C[3]); o.z = pk2(C[4], C[5]); o.w = pk2(C[6], C[7]);
            *(u32x4*)sp = o;
#pragma unroll
            for (int j = 0; j < 8; ++j) C[j] = decay * C[j] + scale * f[j];
            if (do_n) {
                float* np = STN + (size_t)(bh * 64 + c) * 128 + tid;
                const float dn = *np; *np = nval; nval = decay * nval + scale * dn;
            }
            if ((u & 3) == 0 && tid == 0) STM[4096 + bh * 64 + c] = m;
            m = mnew;
        }
    }
}

__device__ void phase_attn_naive(const Params& p, int l, float* lds) {
    unsigned char* ws = p.ws;
    const bf16_t* proj = (const bf16_t*)(ws + WS_PROJ); const float* gates = (const float*)(ws + WS_GATES);
    const bf16_t* kcmp = (const bf16_t*)(ws + WS_KCMP); const bf16_t* vcmp = (const bf16_t*)(ws + WS_VCMP);
    bf16_t* Y = (bf16_t*)(ws + WS_Y);
    const float* oga = p.in[I_OGA] + l * 512;
    const int tid = my_tid(), lane = tid & 63, wave = tid >> 6;
    float* qs = lds + wave * (256 + 1024);
    float* pb = qs + 256;
    for (int u = my_bid(); u < BATCH * 2 * (SEQ / 8); u += gridDim.x) {
        const int tb = u % (SEQ / 8), g = (u / (SEQ / 8)) & 1, b = u / (SEQ / 4);
        const int t = tb * 8 + wave; const int m = b * SEQ + t;
        const bf16_t* prow = proj + (size_t)m * NPROJ;
#pragma unroll
        for (int hg = 0; hg < 4; ++hg) qs[hg * 64 + lane] = bf2f(prow[C_QA + g * 256 + hg * 64 + lane]);
        float otot[4] = {0.f, 0.f, 0.f, 0.f};
        const float* gt = gates + (size_t)m * 32 + g * 12;
        const int nval = t >= 31 ? ((t - 31) >> 4) + 1 : 0;
        float sc[4][4];
        float mx[4] = {-INFINITY, -INFINITY, -INFINITY, -INFINITY};
        const bf16_t* kc = kcmp + (size_t)(b * 2 + g) * NCMPP * 64; const bf16_t* vc = vcmp + (size_t)(b * 2 + g) * NCMPP * 64;
#pragma unroll
        for (int it = 0; it < 4; ++it) {
            asm volatile("" ::: "memory");
            const int i = it * 64 + lane;
            float a[4] = {0.f, 0.f, 0.f, 0.f};
            if (i < nval) {
#pragma unroll 1
                for (int d8 = 0; d8 < 8; ++d8) {
                    const u32x4 raw = *(const u32x4*)(kc + (size_t)i * 64 + d8 * 8); float f[8]; unpack8(raw, f);
#pragma unroll
                    for (int j = 0; j < 8; ++j)
#pragma unroll
                        for (int hg = 0; hg < 4; ++hg) a[hg] += qs[hg * 64 + d8 * 8 + j] * f[j];
                }
            }
#pragma unroll
            for (int hg = 0; hg < 4; ++hg) { sc[it][hg] = i < nval ? a[hg] * 0.125f : -INFINITY; mx[hg] = fmaxf(mx[hg], sc[it][hg]); }
        }
        float sm[4];
#pragma unroll
        for (int hg = 0; hg < 4; ++hg) {
            mx[hg] = wave_max(mx[hg]);
            float s = 0.f;
#pragma unroll
            for (int it = 0; it < 4; ++it) { const float e = (it * 64 + lane) < nval ? __expf(sc[it][hg] - mx[hg]) : 0.f; sc[it][hg] = e; s += e; }
            sm[hg] = wave_sum(s);
        }
#pragma unroll
        for (int it = 0; it < 4; ++it)
#pragma unroll
            for (int hg = 0; hg < 4; ++hg) pb[hg * 256 + it * 64 + lane] = nval > 0 ? sc[it][hg] / sm[hg] : 0.f;
        {
            float o[4] = {0.f, 0.f, 0.f, 0.f};
            for (int i = 0; i < nval; ++i) {
                const float v = bf2f(vc[(size_t)i * 64 + lane]);
#pragma unroll
                for (int hg = 0; hg < 4; ++hg) o[hg] += pb[hg * 256 + i] * v;
            }
#pragma unroll
            for (int hg = 0; hg < 4; ++hg) otot[hg] += sigmoid_f(gt[hg * 3 + 0]) * o[hg];
        }
        const int cur = t >> 6;
        float imp = 0.f;
#pragma unroll
        for (int k = -1; k < 4; ++k) {
            const int i = 4 * lane + k;
            if (i >= 0 && i < nval) imp += (pb[i] + pb[256 + i]) + (pb[512 + i] + pb[768 + i]);
        }
        const bool valid = lane <= cur;
        const bool forced = (lane == 0) || (lane == cur) || (lane == cur - 1);
        const float score = valid ? imp + (forced ? 1e4f : 0.f) : -1e30f;
        int rank = 0;
        for (int k = 0; k < 64; ++k) {
            const float sk = __shfl(score, k);
            rank += (sk > score || (sk == score && k < lane)) ? 1 : 0;
        }
        const unsigned long long selmask = __ballot(rank < 16 && valid);
#pragma unroll 1
        for (int br = 0; br < 2; ++br) {
            const int kcol = (br ? C_KW : C_KS) + g * 64, vcol = (br ? C_VW : C_VS) + g * 64;
            float mr[4] = {-INFINITY, -INFINITY, -INFINITY, -INFINITY}, lr[4] = {0.f, 0.f, 0.f, 0.f}, o[4] = {0.f, 0.f, 0.f, 0.f};
            const int jlo = br ? (cur >= 8 ? cur - 8 : 0) : 0;
            for (int j = jlo; j <= cur; ++j) {
                if (br == 0 && !((selmask >> j) & 1ull)) continue;
                asm volatile("" ::: "memory");
                const int pos = j * 64 + lane;
                const bool ok = pos <= t && (br == 0 || pos > t - 512);
                float a[4] = {0.f, 0.f, 0.f, 0.f};
                const bf16_t* kr = proj + (size_t)(b * SEQ + pos) * NPROJ + kcol;
#pragma unroll 1
                for (int d8 = 0; d8 < 8; ++d8) {
                    const u32x4 raw = *(const u32x4*)(kr + d8 * 8); float f[8]; unpack8(raw, f);
#pragma unroll
                    for (int jj = 0; jj < 8; ++jj)
#pragma unroll
                        for (int hg = 0; hg < 4; ++hg) a[hg] += qs[hg * 64 + d8 * 8 + jj] * f[jj];
                }
                float alpha[4];
#pragma unroll
                for (int hg = 0; hg < 4; ++hg) {
                    const float s = ok ? a[hg] * 0.125f : -INFINITY;
                    const float bm = wave_max(s);
                    const float mn = fmaxf(mr[hg], bm);
                    alpha[hg] = (mn == -INFINITY) ? 1.f : __expf(mr[hg] - mn);
                    const float e = (ok && mn > -INFINITY) ? __expf(s - mn) : 0.f;
                    lr[hg] = lr[hg] * alpha[hg] + wave_sum(e);
                    mr[hg] = mn;
                    pb[hg * 256 + lane] = e;
                    o[hg] *= alpha[hg];
                }
                const bf16_t* vr = proj + (size_t)(b * SEQ + j * 64) * NPROJ + vcol + lane;
                for (int k = 0; k < 64; ++k) {
                    const float v = bf2f(vr[(size_t)k * NPROJ]);
#pragma unroll
                    for (int hg = 0; hg < 4; ++hg) o[hg] += pb[hg * 256 + k] * v;
                }
            }
#pragma unroll
            for (int hg = 0; hg < 4; ++hg) otot[hg] += sigmoid_f(gt[hg * 3 + 1 + br]) * (lr[hg] > 0.f ? o[hg] / lr[hg] : 0.f);
        }
#pragma unroll
        for (int hg = 0; hg < 4; ++hg) {
            const float s = wave_sum(otot[hg] * otot[hg]);
            const float y = otot[hg] * rsqrtf(s * (1.f / 64.f) + EPS) * oga[(g * 4 + hg) * 64 + lane];
            Y[(size_t)m * 1024 + (g * 4 + hg) * 64 + lane] = f2bf(y);
        }
    }
}

__device__ void phase_mlstm_out(const Params& p, int l, float* lds) {
    unsigned char* ws = p.ws;
    const bf16_t* proj = (const bf16_t*)(ws + WS_PROJ); const float* gates = (const float*)(ws + WS_GATES);
    const bf16_t* qkc = (const bf16_t*)(ws + WS_XB);
    const bf16_t* ST = (const bf16_t*)(ws + WS_ST); const float* STN = (const float*)(ws + WS_STN); const float* STM = (const float*)(ws + WS_STM);
    const float* fb = p.in[I_FB] + l * 4; const float* ogm = p.in[I_OGM] + l * 512;
    bf16_t* Y = (bf16_t*)(ws + WS_Y);
    float* qq = lds;
    float* kk = lds + 8192;
    float* Cs = lds + 16384;
    float* Ws = lds + 32768;
    float* bcum = Ws + 64 * 65; float* ig = bcum + 64; float* mt = ig + 64; float* wint = mt + 64; float* den = wint + 64; float* npv = den + 64;
    const int tid = my_tid(), lane = tid & 63, wave = tid >> 6;
    for (int u = my_bid(); u < BATCH * 4 * 64; u += gridDim.x) {
        const int c = u & 63, h = (u >> 6) & 3, b = u >> 8;
        const int m0 = b * SEQ + c * 64, bh = b * 4 + h;
        mlstm_gates(gates, fb, m0, h, bcum, ig);
        const float mprev = STM[4096 + bh * 64 + c];
        for (int e = tid; e < 64 * 16; e += NT) {
            const int s = e >> 4, d0 = (e & 15) * 8;
            const u32x4 rq = *(const u32x4*)(qkc + (size_t)(m0 + s) * 1024 + h * 128 + d0); float f[8]; unpack8(rq, f);
            const u32x4 rk = *(const u32x4*)(qkc + (size_t)(m0 + s) * 1024 + 512 + h * 128 + d0); float fk[8]; unpack8(rk, fk);
#pragma unroll
            for (int j = 0; j < 8; ++j) { qq[s * 128 + d0 + j] = f[j]; kk[s * 128 + d0 + j] = fk[j]; }
        }
        if (tid < 128) npv[tid] = STN[(size_t)(bh * 64 + c) * 128 + tid];
        for (int e8 = tid; e8 < 128 * 16; e8 += NT) {
            const int e = e8 >> 4, d0 = (e8 & 15) * 8;
            const u32x4 rc = *(const u32x4*)(ST + ((size_t)(bh * 64 + c) * 128 + e) * 128 + d0); float f[8]; unpack8(rc, f);
#pragma unroll
            for (int j = 0; j < 8; ++j) Cs[(d0 + j) * 128 + e] = f[j];
        }
        __syncthreads();
        {
            const int t = tid >> 3, s0 = (tid & 7) * 8;
            float a[8] = {0.f, 0.f, 0.f, 0.f, 0.f, 0.f, 0.f, 0.f};
#pragma unroll 2
            for (int d = 0; d < 128; ++d) {
                const float qv = qq[t * 128 + d];
#pragma unroll
                for (int j = 0; j < 8; ++j) a[j] += qv * kk[(s0 + j) * 128 + d];
            }
#pragma unroll
            for (int j = 0; j < 8; ++j) Ws[t * 65 + s0 + j] = a[j];
        }
        __syncthreads();
        for (int r = 0; r < 8; ++r) {
            const int t = wave * 8 + r;
            const float dv = lane <= t ? bcum[t] - bcum[lane] + ig[lane] : -INFINITY;
            const float a = bcum[t] + mprev;
            const float m_t = fmaxf(a, wave_max(dv));
            const float w = lane <= t ? __expf(dv - m_t) * Ws[t * 65 + lane] : 0.f;
            Ws[t * 65 + lane] = w;
            const float wi = __expf(a - m_t);
            const float qn = wave_sum(qq[t * 128 + lane] * npv[lane] + qq[t * 128 + 64 + lane] * npv[64 + lane]);
            const float dsum = wave_sum(w);
            if (lane == 0) { mt[t] = m_t; wint[t] = wi; den[t] = wi * qn + dsum; }
        }
        __syncthreads();
        for (int e = tid; e < 64 * 16; e += NT) {
            const int s = e >> 4, d0 = (e & 15) * 8;
            const u32x4 rv = *(const u32x4*)(proj + (size_t)(m0 + s) * NPROJ + C_VB + h * 128 + d0); float f[8]; unpack8(rv, f);
#pragma unroll
            for (int j = 0; j < 8; ++j) kk[s * 128 + d0 + j] = f[j];
        }
        __syncthreads();
        float hv[16];
        {
            const int e = tid & 127, t0 = (tid >> 7) * 16;
            float a1[16], a2[16];
#pragma unroll
            for (int i = 0; i < 16; ++i) { a1[i] = 0.f; a2[i] = 0.f; }
#pragma unroll 2
            for (int d = 0; d < 128; ++d) {
                const float cv = Cs[d * 128 + e];
#pragma unroll
                for (int i = 0; i < 16; ++i) a1[i] += qq[(t0 + i) * 128 + d] * cv;
            }
#pragma unroll 2
            for (int s = 0; s < 64; ++s) {
                const float vv = kk[s * 128 + e];
#pragma unroll
                for (int i = 0; i < 16; ++i) a2[i] += Ws[(t0 + i) * 65 + s] * vv;
            }
#pragma unroll
            for (int i = 0; i < 16; ++i) {
                const int t = t0 + i;
                const float num = wint[t] * a1[i] + a2[i];
                hv[i] = num / fmaxf(fabsf(den[t]), __expf(-mt[t]));
            }
        }
        __syncthreads();
        {
            const int e = tid & 127, t0 = (tid >> 7) * 16;
#pragma unroll
            for (int i = 0; i < 16; ++i) Cs[(t0 + i) * 128 + e] = hv[i];
        }
        __syncthreads();
        for (int r = 0; r < 8; ++r) {
            const int t = wave * 8 + r;
            const float h0 = Cs[t * 128 + lane], h1 = Cs[t * 128 + 64 + lane];
            const float s = wave_sum(h0 * h0 + h1 * h1);
            const float rr = rsqrtf(s * (1.f / 128.f) + EPS);
            const bf16_t* op = proj + (size_t)(m0 + t) * NPROJ + C_OB + h * 128;
            const float y0 = h0 * rr * ogm[h * 128 + lane] * sigmoid_f(bf2f(op[lane]));
            const float y1 = h1 * rr * ogm[h * 128 + 64 + lane] * sigmoid_f(bf2f(op[64 + lane]));
            Y[(size_t)(m0 + t) * 1024 + 512 + h * 128 + lane] = f2bf(y0);
            Y[(size_t)(m0 + t) * 1024 + 512 + h * 128 + 64 + lane] = f2bf(y1);
        }
        __syncthreads();
    }
}

constexpr int NPHASE = 1 + 7 * DEPTH;
template <bool COOP, int PMASK>
__global__ void __launch_bounds__(NT) mega(Params p) {
    extern __shared__ __attribute__((aligned(16))) unsigned char lds_raw[];
    float* lds = (float*)lds_raw;
    unsigned char* ws = p.ws;
    for (int ph = p.lo; ph < p.hi; ++ph) {
        if (ph == 0) {
            if (PMASK & 128) phase_prologue(p, lds);
        } else {
            const int l = (ph - 1) / 7, k = (ph - 1) % 7;
            if (k == 0 && (PMASK & 1)) {
                EpiIn E{(const float*)(ws + WS_SS), (const float*)(ws + WS_BIAS) + l * NPAD, (bf16_t*)(ws + WS_PROJ), (float*)(ws + WS_GATES)};
                gemm_naive((const bf16_t*)(ws + WS_XB), (const bf16_t*)(ws + WS_WIN) + (size_t)l * NPAD * DM, M, NPAD, DM, E, lds);
            } else if (k == 1 && (PMASK & 2)) {
                phase_rowpass(p, l);
                phase_compress(p, l, lds);
                phase_chunkstate(p, l, lds);
            } else if (k == 2 && (PMASK & 4)) {
                phase_scan(p);
                phase_attn_naive(p, l, lds);
            } else if (k == 3 && (PMASK & 8)) {
                phase_mlstm_out(p, l, lds);
            } else if (k == 4 && (PMASK & 16)) {
                EpiRes E{l == 0 ? p.in[I_X] : p.out, p.out, (bf16_t*)(ws + WS_XB), (float*)(ws + WS_SS)};
                gemm_naive((const bf16_t*)(ws + WS_Y), (const bf16_t*)(ws + WS_WOUT) + (size_t)l * DM * DM, M, DM, DM, E, lds);
            } else if (k == 5 && (PMASK & 32)) {
                EpiGU E{(const float*)(ws + WS_SS), (bf16_t*)(ws + WS_PROJ)};
                gemm_naive((const bf16_t*)(ws + WS_XB), (const bf16_t*)(ws + WS_WGU) + (size_t)l * NGU * DM, M, NGU, DM, E, lds);
            } else if (k == 6 && (PMASK & 64)) {
                EpiRes E{p.out, p.out, (bf16_t*)(ws + WS_XB), (float*)(ws + WS_SS)};
                gemm_naive((const bf16_t*)(ws + WS_PROJ), (const bf16_t*)(ws + WS_WD) + (size_t)l * DM * FF, M, DM, FF, E, lds);
            }
        }
        if (COOP && ph + 1 < p.hi) { cg::this_grid().sync(); }
    }
}

extern "C" void kernel_launch(void* const* d_in, const int* in_sizes, int n_in, void* d_out, int out_size, void* d_ws, size_t ws_size, hipStream_t stream) {
    static int grid = 0;
    if (grid == 0) {
        if (n_in != 18 || ws_size < WS_END) { fprintf(stderr, "kernel_launch: unexpected n_in %d / ws_size %zu\n", n_in, ws_size); grid = -1; return; }
        int dev = 0, cus = 0, per_cu = 0;
        (void)hipGetDevice(&dev);
        (void)hipDeviceGetAttribute(&cus, hipDeviceAttributeMultiprocessorCount, dev);
        (void)hipFuncSetAttribute((const void*)mega<true, 0xff>, hipFuncAttributeMaxDynamicSharedMemorySize, LDS_BYTES);
        (void)hipOccupancyMaxActiveBlocksPerMultiprocessor(&per_cu, (const void*)mega<true, 0xff>, NT, LDS_BYTES);
        if (per_cu < 1) { fprintf(stderr, "kernel_launch: occupancy query reports %d blocks/CU\n", per_cu); grid = -1; return; }
        grid = (cus > 0 ? cus : 256) * 1;
        (void)hipGetLastError();
    }
    if (grid < 0) return;
    Params p{};
    for (int i = 0; i < 18; ++i) p.in[i] = (const float*)d_in[i];
    p.out = (float*)d_out; p.ws = (unsigned char*)d_ws;
    p.lo = 0; p.hi = NPHASE;
    void* args[] = {&p};
    hipError_t e = hipLaunchCooperativeKernel((const void*)mega<true, 0xff>, dim3(grid), dim3(NT), args, LDS_BYTES, stream);
    if (e != hipSuccess) fprintf(stderr, "cooperative launch failed: %s (grid %d)\n", hipGetErrorString(e), grid);
}
```

```cpp
#include <hip/hip_runtime.h>
#include <hip/hip_cooperative_groups.h>
#include <cstdint>
#include <cstdio>
namespace cg = cooperative_groups;

typedef unsigned short bf16_t;
typedef unsigned u32x4 __attribute__((ext_vector_type(4)));
typedef unsigned u32x2 __attribute__((ext_vector_type(2)));
typedef float f32x4 __attribute__((ext_vector_type(4)));

constexpr int BATCH = 8, SEQ = 4096, DM = 1024, M = BATCH * SEQ, DEPTH = 2;
constexpr int NIN = 3360, NPROJ = 3328, NPAD = 3584, FF = 2816, NGU = 2 * FF;
constexpr int NCMP = 255, NCMPP = 256;
constexpr float EPS = 1e-6f;
constexpr int NT = 512;
constexpr int LDS_BYTES = 152 * 1024;

constexpr int C_QA = 0, C_KC = 512, C_VC = 640, C_KS = 768, C_VS = 896, C_KW = 1024, C_VW = 1152, C_QB = 1280, C_KB = 1792, C_VB = 2304, C_OB = 2816;

constexpr size_t MiB = 1u << 20;
constexpr size_t WS_CTL = 0;
constexpr size_t WS_WIN = 1 * MiB;
constexpr size_t WS_WOUT = 15 * MiB;
constexpr size_t WS_WGU = 19 * MiB;
constexpr size_t WS_WD = 41 * MiB;
constexpr size_t WS_BIAS = 52 * MiB;
constexpr size_t WS_SS = 53 * MiB;
constexpr size_t WS_GATES = 55 * MiB;
constexpr size_t WS_KCMP = 59 * MiB;
constexpr size_t WS_VCMP = 59 * MiB + 512 * 1024;
constexpr size_t WS_STN = 60 * MiB;
constexpr size_t WS_STM = 61 * MiB;
constexpr size_t WS_XB = 64 * MiB;
constexpr size_t WS_Y = 128 * MiB;
constexpr size_t WS_ST = 192 * MiB;
constexpr size_t WS_PROJ = 256 * MiB;
constexpr size_t WS_END = 464 * MiB;

struct Params {
    const float* in[18];
    float* out;
    unsigned char* ws;
    int lo, hi;
};
enum { I_X = 0, I_LN1, I_WIN, I_BIN, I_QG, I_KG, I_PE, I_W1, I_W2, I_CW, I_CB, I_FB, I_OGA, I_OGM, I_WOUT, I_LN2, I_WGU, I_WD };

__device__ __forceinline__ float bf2f(bf16_t v) { return __uint_as_float(((unsigned)v) << 16); }
__device__ __forceinline__ bf16_t f2bf(float f) { unsigned u = __float_as_uint(f); return (bf16_t)((u + 0x7fffu + ((u >> 16) & 1u)) >> 16); }
__device__ __forceinline__ unsigned pk2(float lo, float hi) { return (unsigned)f2bf(lo) | ((unsigned)f2bf(hi) << 16); }
__device__ __forceinline__ float lo16(unsigned w) { return __uint_as_float(w << 16); }
__device__ __forceinline__ float hi16(unsigned w) { return __uint_as_float(w & 0xffff0000u); }
__device__ __forceinline__ float silu_f(float x) { return x / (1.f + __expf(-x)); }
__device__ __forceinline__ float sigmoid_f(float x) { return 1.f / (1.f + __expf(-x)); }
__device__ __forceinline__ float wave_sum(float v) {
#pragma unroll
    for (int o = 1; o < 64; o <<= 1) v += __shfl_xor(v, o);
    return v;
}
__device__ __forceinline__ float wave_max(float v) {
#pragma unroll
    for (int o = 1; o < 64; o <<= 1) v = fmaxf(v, __shfl_xor(v, o));
    return v;
}
__device__ __forceinline__ int my_tid() { int t = threadIdx.x; asm volatile("" : "+v"(t)); return t; }
__device__ __forceinline__ int my_bid() { int b = blockIdx.x; asm volatile("" : "+s"(b)); return b; }
__device__ __forceinline__ void unpack8(u32x4 w, float* f) {
    f[0] = lo16(w.x); f[1] = hi16(w.x); f[2] = lo16(w.y); f[3] = hi16(w.y);
    f[4] = lo16(w.z); f[5] = hi16(w.z); f[6] = lo16(w.w); f[7] = hi16(w.w);
}

__device__ __forceinline__ int in_srccol(int n) {
    if (n < 1280) return n;
    if (n < 2816) return n + 24;
    if (n < 3328) return n + 32;
    if (n < 3352) return n - 3328 + 1280;
    if (n < 3360) return n - 3352 + 2840;
    return -1;
}
__device__ __forceinline__ int gu_srccol(int n) {
    const int t = n >> 8, w = n & 255;
    return (w < 128) ? (t * 128 + w) : (FF + t * 128 + (w - 128));
}

template <int MODE>
__device__ void conv_job(const float* W, int K, int Nsrc, bf16_t* WT, int Nout, const float* kscale, float* tile) {
    const int tid = my_tid();
    const int nk = K / 64, nn = Nout / 64;
    for (int u = my_bid(); u < nk * nn; u += gridDim.x) {
        const int k0 = (u % nk) * 64, n0 = (u / nk) * 64;
#pragma unroll
        for (int i = 0; i < 8; ++i) {
            const int r = (tid >> 6) + 8 * i, c = tid & 63;
            const int n = n0 + c;
            const int sc = MODE == 0 ? n : (MODE == 1 ? in_srccol(n) : gu_srccol(n));
            float v = 0.f;
            if (sc >= 0) v = W[(size_t)(k0 + r) * Nsrc + sc] * (kscale ? kscale[k0 + r] : 1.f);
            tile[r * 65 + c] = v;
        }
        __syncthreads();
#pragma unroll
        for (int i = 0; i < 8; ++i) {
            const int r = (tid >> 6) + 8 * i, c = tid & 63;
            WT[(size_t)(n0 + r) * K + k0 + c] = f2bf(tile[c * 65 + r]);
        }
        __syncthreads();
    }
}

__device__ void phase_prologue(const Params& p, float* lds) {
    unsigned char* ws = p.ws;
    const int tid = my_tid(), lane = tid & 63, wave = tid >> 6;
    for (int l = 0; l < DEPTH; ++l) {
        conv_job<1>(p.in[I_WIN] + (size_t)l * DM * NIN, DM, NIN, (bf16_t*)(ws + WS_WIN) + (size_t)l * NPAD * DM, NPAD, p.in[I_LN1] + l * DM, lds);
        conv_job<0>(p.in[I_WOUT] + (size_t)l * DM * DM, DM, DM, (bf16_t*)(ws + WS_WOUT) + (size_t)l * DM * DM, DM, nullptr, lds);
        conv_job<2>(p.in[I_WGU] + (size_t)l * DM * NGU, DM, NGU, (bf16_t*)(ws + WS_WGU) + (size_t)l * NGU * DM, NGU, p.in[I_LN2] + l * DM, lds);
        conv_job<0>(p.in[I_WD] + (size_t)l * FF * DM, FF, DM, (bf16_t*)(ws + WS_WD) + (size_t)l * DM * FF, DM, nullptr, lds);
    }
    float* biasP = (float*)(ws + WS_BIAS);
    for (int i = my_bid() * NT + tid; i < DEPTH * NPAD; i += gridDim.x * NT) {
        const int l = i / NPAD, n = i % NPAD; const int sc = in_srccol(n);
        biasP[i] = sc >= 0 ? p.in[I_BIN][l * NIN + sc] : 0.f;
    }
    const float* x = p.in[I_X]; bf16_t* xb = (bf16_t*)(ws + WS_XB); float* ss = (float*)(ws + WS_SS);
    for (int m = my_bid() * 8 + wave; m < M; m += gridDim.x * 8) {
        const f32x4* xr = (const f32x4*)(x + (size_t)m * DM) + lane;
#pragma unroll
        for (int j = 0; j < 4; ++j) {
            const f32x4 v = xr[64 * j];
            float s = (v.x * v.x + v.y * v.y) + (v.z * v.z + v.w * v.w);
            s += __shfl_xor(s, 1); s += __shfl_xor(s, 2); s += __shfl_xor(s, 4); s += __shfl_xor(s, 8);
            if ((lane & 15) == 0) ss[(size_t)m * 16 + 4 * j + (lane >> 4)] = s;
            u32x2 o; o.x = pk2(v.x, v.y); o.y = pk2(v.z, v.w);
            *(u32x2*)(xb + (size_t)m * DM + 256 * j + 4 * lane) = o;
        }
    }
}

namespace pg8 {
#define PG8_LAS __attribute__((address_space(3)))
typedef short bf16x8 __attribute__((ext_vector_type(8)));
constexpr int BM = 256, BK = 64, HALF = 128, HTB = HALF * BK * 2  , STAGE_BYTES = 8 * HTB, NXCD = 8, WGM = 8;
__host__ __device__ __forceinline__ int lds_byte(int r, int c) { const int st = (r >> 4) * 2 + (c >> 5), rr = r & 15, cc = c & 31, ob = rr * 64 + cc * 2; return st * 1024 + (ob ^ (((ob >> 9) & 1) << 5)); }
__host__ __device__ __forceinline__ void stage_rc(int b, int& R, int& C) { const int st = b / 1024, sb = b % 1024, swz = sb ^ (((sb >> 9) & 1) << 5); R = (st >> 1) * 16 + swz / 64; C = (st & 1) * 32 + (swz % 64) / 2; }
__host__ __device__ __forceinline__ int perm32(int rho) { const int n = rho >> 4, i = rho & 15; return 8 * (i >> 2) + 4 * n + (i & 3); }
struct Unit { int pm, pn; };
struct Gemm { const bf16_t* A; const bf16_t* Bt; int M, N, K; };
struct StaticOrder {
    int nM, nN, nwg, G, c;
    __host__ __device__ void init(int M_, int N_, int G_, int c_) { nM = M_ / BM; nN = N_ / BM; nwg = nM * nN; G = G_; c = c_; }
    __host__ __device__ bool next(int i, Unit& u) const {
        const long L = (long)i * G + c; if (L >= nwg) return false;
        int wgid = (int)L; { const int q = nwg / NXCD, r = nwg % NXCD, xcd = wgid % NXCD, off = wgid / NXCD; wgid = (xcd < r ? xcd * (q + 1) : r * (q + 1) + (xcd - r) * q) + off; }
        const int nig = WGM * nN, gid = wgid / nig, fm = gid * WGM, gsz = (nM - fm) < WGM ? (nM - fm) : WGM;
        u.pm = fm + ((wgid % nig) % gsz); u.pn = (wgid % nig) / gsz; return true;
    }
    __device__ __forceinline__ void a_ready(const Unit&) const {}
    __device__ __forceinline__ void done(const Unit&) const {}
};
__device__ __forceinline__ unsigned cvt_pk_bf16(float lo, float hi) { unsigned r; asm volatile("v_cvt_pk_bf16_f32 %0, %1, %2" : "=v"(r) : "v"(lo), "v"(hi)); return r; }

__device__ __forceinline__ float row_rstd(const float* ss, int row, int fq) {
    const f32x4 pq = *(const f32x4*)(ss + (size_t)row * 16 + 4 * fq);
    float s = (pq.x + pq.y) + (pq.z + pq.w);
    s += __shfl_xor(s, 16); s += __shfl_xor(s, 32);
    return rsqrtf(s * (1.f / DM) + EPS);
}
struct EpiInT {
    static constexpr bool PERM = true, AFTER_DRAIN = false;
    const float* ss; const float* bias; bf16_t* proj; float* gates;
    __device__ __forceinline__ void operator()(const f32x4 (&acc)[2][2][4][2], const Unit& u, int wr, int wc, int fr, int fq) const {
        const int row0 = u.pm * BM + wr * 64 + fr, col0 = u.pn * BM + wc * 32 + 8 * fq;
        f32x4 bv[2][2];
#pragma unroll
        for (int bj = 0; bj < 2; ++bj)
#pragma unroll
            for (int n = 0; n < 2; ++n) bv[bj][n] = *(const f32x4*)(bias + col0 + bj * HALF + 4 * n);
#pragma unroll
        for (int ai = 0; ai < 2; ++ai)
#pragma unroll
            for (int m = 0; m < 4; ++m) {
                const int row = row0 + ai * HALF + m * 16;
                const float r = row_rstd(ss, row, fq);
                if (u.pn < 13) {
                    bf16_t* rowp = proj + (size_t)row * NPROJ + col0;
#pragma unroll
                    for (int bj = 0; bj < 2; ++bj) {
                        const f32x4 v0 = acc[ai][bj][m][0] * r + bv[bj][0], v1 = acc[ai][bj][m][1] * r + bv[bj][1];
                        u32x4 w; w.x = cvt_pk_bf16(v0[0], v0[1]); w.y = cvt_pk_bf16(v0[2], v0[3]); w.z = cvt_pk_bf16(v1[0], v1[1]); w.w = cvt_pk_bf16(v1[2], v1[3]);
                        *(u32x4*)(rowp + bj * HALF) = w;
                    }
                } else if (wc == 0) {
                    const f32x4 v0 = acc[ai][0][m][0] * r + bv[0][0], v1 = acc[ai][0][m][1] * r + bv[0][1];
                    float* gp = gates + (size_t)row * 32 + 8 * fq;
                    *(f32x4*)gp = v0; *(f32x4*)(gp + 4) = v1;
                }
            }
    }
};
struct EpiResT {
    static constexpr bool PERM = true, AFTER_DRAIN = false;
    const float* base; float* out; bf16_t* xb; float* ss;
    __device__ __forceinline__ void operator()(const f32x4 (&acc)[2][2][4][2], const Unit& u, int wr, int wc, int fr, int fq) const {
        const int row0 = u.pm * BM + wr * 64 + fr, col0 = u.pn * BM + wc * 32 + 8 * fq;
#pragma unroll
        for (int ai = 0; ai < 2; ++ai)
#pragma unroll
            for (int m = 0; m < 4; ++m) {
                const int row = row0 + ai * HALF + m * 16;
                const size_t off = (size_t)row * DM + col0;
                float sq = 0.f;
#pragma unroll
                for (int bj = 0; bj < 2; ++bj) {
                    const f32x4 x0 = *(const f32x4*)(base + off + bj * HALF) + acc[ai][bj][m][0];
                    const f32x4 x1 = *(const f32x4*)(base + off + bj * HALF + 4) + acc[ai][bj][m][1];
                    *(f32x4*)(out + off + bj * HALF) = x0; *(f32x4*)(out + off + bj * HALF + 4) = x1;
                    u32x4 w; w.x = cvt_pk_bf16(x0[0], x0[1]); w.y = cvt_pk_bf16(x0[2], x0[3]); w.z = cvt_pk_bf16(x1[0], x1[1]); w.w = cvt_pk_bf16(x1[2], x1[3]);
                    *(u32x4*)(xb + off + bj * HALF) = w;
                    sq += (x0[0] * x0[0] + x0[1] * x0[1]) + (x0[2] * x0[2] + x0[3] * x0[3]) + (x1[0] * x1[0] + x1[1] * x1[1]) + (x1[2] * x1[2] + x1[3] * x1[3]);
                }
                sq += __shfl_xor(sq, 16); sq += __shfl_xor(sq, 32);
                if (fq == 0) ss[(size_t)row * 16 + u.pn * 4 + wc] = sq;
                asm volatile("" ::: "memory");
            }
    }
};
struct EpiGUT {
    static constexpr bool PERM = true, AFTER_DRAIN = false;
    const float* ss; bf16_t* act;
    __device__ __forceinline__ void operator()(const f32x4 (&acc)[2][2][4][2], const Unit& u, int wr, int wc, int fr, int fq) const {
        const int row0 = u.pm * BM + wr * 64 + fr, hid0 = u.pn * HALF + wc * 32 + 8 * fq;
#pragma unroll
        for (int ai = 0; ai < 2; ++ai)
#pragma unroll
            for (int m = 0; m < 4; ++m) {
                const int row = row0 + ai * HALF + m * 16;
                const float r = row_rstd(ss, row, fq);
                float a[8];
#pragma unroll
                for (int n = 0; n < 2; ++n)
#pragma unroll
                    for (int j = 0; j < 4; ++j) {
                        const float g = acc[ai][0][m][n][j] * r, up = acc[ai][1][m][n][j] * r;
                        a[4 * n + j] = g * __builtin_amdgcn_rcpf(1.f + __builtin_amdgcn_exp2f(-1.4426950408889634f * g)) * up;
                    }
                u32x4 w; w.x = cvt_pk_bf16(a[0], a[1]); w.y = cvt_pk_bf16(a[2], a[3]); w.z = cvt_pk_bf16(a[4], a[5]); w.w = cvt_pk_bf16(a[6], a[7]);
                *(u32x4*)(act + (size_t)row * FF + hid0) = w;
            }
    }
};

template <class Epi, class Sched, bool ALIGN_EPI = false, bool SP2 = false>
__device__ __forceinline__ void gemm_phase(PG8_LAS unsigned char* lds, const Gemm g, const Sched& S, const Epi& E) {
    const int tid = my_tid(), wid = __builtin_amdgcn_readfirstlane(tid >> 6), lane = tid & 63, wr = wid >> 2, wc = wid & 3, fr = lane & 15, fq = lane >> 4;
    const int K = g.K, nt = K / BK;
    unsigned voffA[2], voffB[2];
#pragma unroll
    for (int i = 0; i < 2; ++i) { int R, C; stage_rc(tid * 16 + i * 8192, R, C); const int Rb = Epi::PERM ? ((R & ~31) + perm32(R & 31)) : R;
        voffA[i] = (unsigned)(R * K + C) * 2u; voffB[i] = (unsigned)(Rb * K + C) * 2u; }
    const size_t kstep = (size_t)(BK * 2);
    const size_t hstep = (size_t)HALF * K * 2;
    const size_t tstep = 2 * hstep;
    const unsigned ldsw = (unsigned)wid * 1024u;
    const int aoff = lds_byte(wr * 64 + fr, fq * 8), boff = lds_byte(wc * 32 + fr, fq * 8);
#define PG8_SA(b, h) (((b) * 2 + (h)) * HTB)
#define PG8_SB(b, h) ((4 + (b) * 2 + (h)) * HTB)
#define PG8_STAGE(bufoff, gbase, voff) do { _Pragma("unroll") for (int _i = 0; _i < 2; ++_i) \
        __builtin_amdgcn_global_load_lds((const unsigned*)((const char*)(gbase) + (voff)[_i]), (PG8_LAS unsigned*)(lds + (bufoff) + ldsw + _i * 8192), 16, 0, 0); } while (0)
#define PG8_LDA(dst, b, h) do { _Pragma("unroll") for (int m = 0; m < 4; ++m) _Pragma("unroll") for (int k = 0; k < 2; ++k) dst[m][k] = *(const PG8_LAS bf16x8*)(lds + PG8_SA(b, h) + aoff + m * 2048 + k * 1024); } while (0)
#define PG8_LDB(dst, b, h) do { _Pragma("unroll") for (int n = 0; n < 2; ++n) _Pragma("unroll") for (int k = 0; k < 2; ++k) dst[n][k] = *(const PG8_LAS bf16x8*)(lds + PG8_SB(b, h) + boff + n * 2048 + k * 1024); } while (0)
#define PG8_MMA(ai, bj, At, Bt) do { __builtin_amdgcn_s_setprio(1); _Pragma("unroll") for (int m = 0; m < 4; ++m) _Pragma("unroll") for (int n = 0; n < 2; ++n) _Pragma("unroll") for (int k = 0; k < 2; ++k) \
        acc[ai][bj][m][n] = __builtin_amdgcn_mfma_f32_16x16x32_bf16(Bt[n][k], At[m][k], acc[ai][bj][m][n], 0, 0, 0); __builtin_amdgcn_s_setprio(0); } while (0)
#define PG8_WAIT_V(n) asm volatile("s_waitcnt vmcnt(" #n ")" ::: "memory")
#define PG8_WAIT_L(n) asm volatile("s_waitcnt lgkmcnt(" #n ")" ::: "memory")
#define PG8_BAR __builtin_amdgcn_s_barrier()
#define PG8_SCHED __builtin_amdgcn_sched_barrier(0)
    Unit cur, nxt; int ui = 0;
    if (!S.next(0, cur)) return;
    f32x4 acc[2][2][4][2];
#pragma unroll
    for (int a = 0; a < 2; ++a)
#pragma unroll
        for (int b = 0; b < 2; ++b)
#pragma unroll
            for (int m = 0; m < 4; ++m)
#pragma unroll
                for (int n = 0; n < 2; ++n) acc[a][b][m][n] = (f32x4){0.f, 0.f, 0.f, 0.f};
    bf16x8 At[4][2], B0[2][2], B1[2][2];
    const char* cA = (const char*)g.A + (size_t)cur.pm * tstep; const char* cB = (const char*)g.Bt + (size_t)cur.pn * tstep;
    S.a_ready(cur);
    if constexpr (SP2) {
        PG8_STAGE(PG8_SB(0, 0), cB, voffB); PG8_STAGE(PG8_SB(0, 1), cB + hstep, voffB); PG8_STAGE(PG8_SA(0, 0), cA, voffA); PG8_STAGE(PG8_SA(0, 1), cA + hstep, voffA);
        if (wr == 1) PG8_BAR;
        PG8_WAIT_V(2); PG8_BAR;
        PG8_STAGE(PG8_SB(1, 0), cB + kstep, voffB); PG8_STAGE(PG8_SA(1, 0), cA + kstep, voffA); PG8_STAGE(PG8_SB(1, 1), cB + hstep + kstep, voffB);
        PG8_WAIT_V(6); PG8_BAR;
    } else {
        PG8_STAGE(PG8_SB(0, 0), cB, voffB); PG8_STAGE(PG8_SA(0, 0), cA, voffA); PG8_STAGE(PG8_SB(0, 1), cB + hstep, voffB); PG8_STAGE(PG8_SA(0, 1), cA + hstep, voffA);
        if (wr == 1) PG8_BAR;
        PG8_WAIT_V(4); PG8_BAR;
        PG8_STAGE(PG8_SB(1, 0), cB + kstep, voffB); PG8_STAGE(PG8_SA(1, 0), cA + kstep, voffA); PG8_STAGE(PG8_SB(1, 1), cB + hstep + kstep, voffB);
        PG8_WAIT_V(6); PG8_BAR;
    }
    for (;;) {
        const bool has_next = S.next(ui + 1, nxt);
        const char* nA = has_next ? (const char*)g.A + (size_t)nxt.pm * tstep : cA; const char* nB = has_next ? (const char*)g.Bt + (size_t)nxt.pn * tstep : cB;
        for (int t = 0; t < nt; t += 2) {
            const bool last = (t == nt - 2);
            const char* a1 = cA + (size_t)(t + 1) * kstep;
            const char* a2 = last ? nA : cA + (size_t)(t + 2) * kstep; const char* b2 = last ? nB : cB + (size_t)(t + 2) * kstep;
            const char* a3 = a2 + kstep; const char* b3 = b2 + kstep;
            if (last && has_next) S.a_ready(nxt);
            if constexpr (SP2) {
            PG8_LDB(B0, 0, 0); PG8_LDB(B1, 0, 1); PG8_SCHED; PG8_LDA(At, 0, 0); PG8_STAGE(PG8_SA(1, 1), a1 + hstep, voffA);
            PG8_WAIT_V(8); PG8_WAIT_L(0); PG8_BAR; PG8_MMA(0, 0, At, B0); PG8_MMA(0, 1, At, B1); PG8_BAR; PG8_SCHED;
            PG8_LDA(At, 0, 1); PG8_STAGE(PG8_SB(0, 0), b2, voffB); PG8_STAGE(PG8_SB(0, 1), b2 + hstep, voffB); PG8_STAGE(PG8_SA(0, 0), a2, voffA);
            PG8_WAIT_V(8); PG8_WAIT_L(0); PG8_BAR; PG8_MMA(1, 0, At, B0); PG8_MMA(1, 1, At, B1); PG8_BAR; PG8_SCHED;
            PG8_LDB(B0, 1, 0); PG8_LDB(B1, 1, 1); PG8_SCHED; PG8_LDA(At, 1, 0); PG8_STAGE(PG8_SA(0, 1), a2 + hstep, voffA);
            PG8_WAIT_V(8); PG8_WAIT_L(0); PG8_BAR; PG8_MMA(0, 0, At, B0); PG8_MMA(0, 1, At, B1); PG8_BAR; PG8_SCHED;
            PG8_LDA(At, 1, 1); PG8_STAGE(PG8_SB(1, 0), b3, voffB); PG8_STAGE(PG8_SB(1, 1), b3 + hstep, voffB); PG8_STAGE(PG8_SA(1, 0), a3, voffA);
            PG8_WAIT_V(8); PG8_WAIT_L(0); PG8_BAR; PG8_MMA(1, 0, At, B0); PG8_MMA(1, 1, At, B1); PG8_BAR; PG8_SCHED;
            } else {
            PG8_LDB(B0, 0, 0); PG8_SCHED; PG8_LDA(At, 0, 0); PG8_STAGE(PG8_SA(1, 1), a1 + hstep, voffA);
            PG8_WAIT_L(8); PG8_BAR; PG8_WAIT_L(0); PG8_MMA(0, 0, At, B0); PG8_BAR; PG8_SCHED;
            PG8_LDB(B1, 0, 1); PG8_STAGE(PG8_SB(0, 0), b2, voffB);
            PG8_BAR; PG8_WAIT_L(0); PG8_MMA(0, 1, At, B1); PG8_BAR;
            PG8_LDA(At, 0, 1); PG8_STAGE(PG8_SA(0, 0), a2, voffA);
            PG8_BAR; PG8_WAIT_L(0); PG8_MMA(1, 0, At, B0); PG8_BAR; PG8_SCHED;
            PG8_STAGE(PG8_SB(0, 1), b2 + hstep, voffB);
            PG8_WAIT_V(6); PG8_BAR; PG8_MMA(1, 1, At, B1); PG8_BAR;
            PG8_LDB(B0, 1, 0); PG8_SCHED; PG8_LDA(At, 1, 0); PG8_STAGE(PG8_SA(0, 1), a2 + hstep, voffA);
            PG8_WAIT_L(8); PG8_BAR; PG8_WAIT_L(0); PG8_MMA(0, 0, At, B0); PG8_BAR; PG8_SCHED;
            PG8_LDB(B1, 1, 1); PG8_STAGE(PG8_SB(1, 0), b3, voffB);
            PG8_BAR; PG8_WAIT_L(0); PG8_MMA(0, 1, At, B1); PG8_BAR;
            PG8_LDA(At, 1, 1); PG8_STAGE(PG8_SA(1, 0), a3, voffA);
            PG8_BAR; PG8_WAIT_L(0); PG8_MMA(1, 0, At, B0); PG8_BAR; PG8_SCHED;
            PG8_STAGE(PG8_SB(1, 1), b3 + hstep, voffB);
            PG8_WAIT_V(6); PG8_BAR; PG8_MMA(1, 1, At, B1); PG8_BAR;
            }
        }
        if constexpr (ALIGN_EPI) { if (wr == 0) PG8_BAR; }
        if constexpr (!Epi::AFTER_DRAIN) { E(acc, cur, wr, wc, fr, fq); S.done(cur); }
        if (!has_next) break;
#pragma unroll
        for (int a = 0; a < 2; ++a)
#pragma unroll
            for (int b = 0; b < 2; ++b)
#pragma unroll
                for (int m = 0; m < 4; ++m)
#pragma unroll
                    for (int n = 0; n < 2; ++n) acc[a][b][m][n] = (f32x4){0.f, 0.f, 0.f, 0.f};
        cur = nxt; cA = nA; cB = nB; ++ui;
        if constexpr (ALIGN_EPI) { if (wr == 1) PG8_BAR; }
    }
    PG8_WAIT_V(0);
    if constexpr (!ALIGN_EPI) { if (wr == 0) PG8_BAR; }
    PG8_BAR;
#undef PG8_SA
#undef PG8_SB
#undef PG8_STAGE
#undef PG8_LDA
#undef PG8_LDB
#undef PG8_MMA
#undef PG8_WAIT_V
#undef PG8_WAIT_L
#undef PG8_BAR
#undef PG8_SCHED
}
}

__device__ void phase_rowpass(const Params& p, int l) {
    unsigned char* ws = p.ws;
    bf16_t* proj = (bf16_t*)(ws + WS_PROJ); bf16_t* qkc = (bf16_t*)(ws + WS_XB);
    const float* qg = p.in[I_QG] + l * 64; const float* kg = p.in[I_KG] + l * 192;
    const float* cw = p.in[I_CW] + l * 4096; const float* cb = p.in[I_CB] + l * 1024;
    const int tid = my_tid(), lane = tid & 63, wave = tid >> 6;
    for (int m = my_bid() * 8 + wave; m < M; m += gridDim.x * 8) {
        const int t = m % SEQ;
        bf16_t* row = proj + (size_t)m * NPROJ;
        {
            const u32x4 raw = *(const u32x4*)(row + C_QA + lane * 8); float f[8]; unpack8(raw, f);
            float s = 0.f;
#pragma unroll
            for (int j = 0; j < 8; ++j) s += f[j] * f[j];
            s += __shfl_xor(s, 1); s += __shfl_xor(s, 2); s += __shfl_xor(s, 4);
            const float r = rsqrtf(s * (1.f / 64.f) + EPS);
            const int d0 = (lane & 7) * 8;
            u32x4 o; o.x = pk2(f[0] * r * qg[d0], f[1] * r * qg[d0 + 1]); o.y = pk2(f[2] * r * qg[d0 + 2], f[3] * r * qg[d0 + 3]);
            o.z = pk2(f[4] * r * qg[d0 + 4], f[5] * r * qg[d0 + 5]); o.w = pk2(f[6] * r * qg[d0 + 6], f[7] * r * qg[d0 + 7]);
            *(u32x4*)(row + C_QA + lane * 8) = o;
        }
        {
            const int which = lane >> 5, w4 = (lane & 31) * 4;
            bf16_t* pp = row + (which ? C_KW : C_KS) + w4;
            const u32x2 raw = *(const u32x2*)pp;
            float f[4] = {lo16(raw.x), hi16(raw.x), lo16(raw.y), hi16(raw.y)};
            float s = (f[0] * f[0] + f[1] * f[1]) + (f[2] * f[2] + f[3] * f[3]);
            s += __shfl_xor(s, 1); s += __shfl_xor(s, 2); s += __shfl_xor(s, 4); s += __shfl_xor(s, 8);
            const float r = rsqrtf(s * (1.f / 64.f) + EPS);
            const float* g = kg + (1 + which) * 64 + (w4 & 63);
            u32x2 o; o.x = pk2(f[0] * r * g[0], f[1] * r * g[1]); o.y = pk2(f[2] * r * g[2], f[3] * r * g[3]);
            *(u32x2*)pp = o;
        }
#pragma unroll
        for (int part = 0; part < 2; ++part) {
            const int c0 = part * 512 + lane * 8;
            float acc[8];
#pragma unroll
            for (int j = 0; j < 8; ++j) acc[j] = cb[c0 + j];
#pragma unroll
            for (int w = 0; w < 4; ++w) {
                if (t - 3 + w >= 0) {
                    const u32x4 raw = *(const u32x4*)(proj + (size_t)(m - 3 + w) * NPROJ + C_QB + c0); float f[8]; unpack8(raw, f);
#pragma unroll
                    for (int j = 0; j < 8; ++j) acc[j] += f[j] * cw[w * 1024 + c0 + j];
                }
            }
            const float sc = part ? 0.08838834764831845f : 1.f;
            float y[8];
#pragma unroll
            for (int j = 0; j < 8; ++j) y[j] = silu_f(acc[j]) * sc;
            u32x4 o; o.x = pk2(y[0], y[1]); o.y = pk2(y[2], y[3]); o.z = pk2(y[4], y[5]); o.w = pk2(y[6], y[7]);
            *(u32x4*)(qkc + (size_t)m * 1024 + c0) = o;
        }
    }
}

__device__ void phase_compress(const Params& p, int l, float* lds) {
    unsigned char* ws = p.ws;
    const bf16_t* proj = (const bf16_t*)(ws + WS_PROJ);
    const float* pe = p.in[I_PE] + (size_t)l * 2 * 2048; const float* w1 = p.in[I_W1] + (size_t)l * 2 * 2048 * 128; const float* w2 = p.in[I_W2] + (size_t)l * 2 * 128 * 64;
    const float* kg0 = p.in[I_KG] + l * 192;
    float* tok = lds;
    float* red = lds + 144 * 64;
    float* hidb = red + 4 * 8 * 128;
    const int tid = my_tid(), lane = tid & 63;
    for (int u = my_bid(); u < BATCH * 2 * 2 * 32; u += gridDim.x) {
        const int ib = u & 31, kv = (u >> 5) & 1, g = (u >> 6) & 1, b = u >> 7;
        const int i0 = ib * 8, ni = (NCMP - i0) < 8 ? (NCMP - i0) : 8;
        const int ntok = 16 * ni + 16;
        const int col = (kv ? C_VC : C_KC) + g * 64;
        __syncthreads();
        for (int e = tid; e < 144 * 64; e += NT) {
            const int tt = e >> 6, d = e & 63;
            tok[e] = tt < ntok ? bf2f(proj[(size_t)(b * SEQ + 16 * i0 + tt) * NPROJ + col + d]) : 0.f;
        }
        __syncthreads();
        {
            const int hid = tid & 127, part = tid >> 7;
            float acc[8], accP = 0.f;
#pragma unroll
            for (int ii = 0; ii < 8; ++ii) acc[ii] = 0.f;
            const float* w1p = w1 + (size_t)kv * 2048 * 128 + hid; const float* pep = pe + kv * 2048;
#pragma unroll 2
            for (int f = part * 512; f < part * 512 + 512; ++f) {
                const float w = w1p[(size_t)f * 128];
                accP += w * pep[f];
#pragma unroll
                for (int ii = 0; ii < 8; ++ii) acc[ii] += w * tok[16 * 64 * ii + f];
            }
#pragma unroll
            for (int ii = 0; ii < 8; ++ii) red[(part * 8 + ii) * 128 + hid] = acc[ii] + accP;
        }
        __syncthreads();
        for (int e = tid; e < 8 * 128; e += NT) {
            const float s = (red[e] + red[1024 + e]) + (red[2048 + e] + red[3072 + e]);
            hidb[e] = silu_f(s);
        }
        __syncthreads();
        {
            const int ii = tid >> 6, d = lane;
            float o = 0.f;
            const float* w2p = w2 + (size_t)kv * 128 * 64 + d;
            for (int h = 0; h < 128; ++h) o += hidb[ii * 128 + h] * w2p[h * 64];
            if (kv == 0) { const float s = wave_sum(o * o); o = o * rsqrtf(s * (1.f / 64.f) + EPS) * kg0[d]; }
            bf16_t* dst = (bf16_t*)(ws + (kv ? WS_VCMP : WS_KCMP));
            if (ii < ni) dst[(size_t)((b * 2 + g) * NCMPP + i0 + ii) * 64 + d] = f2bf(o);
        }
    }
    __syncthreads();
}

__device__ __forceinline__ float log_sigmoid_f(float x) { return fminf(x, 0.f) - log1pf(__expf(-fabsf(x))); }
__device__ void mlstm_gates(const float* gates, const float* fb, int m0, int h, float* bcum, float* ig) {
    const int tid = my_tid();
    __syncthreads();
    if (tid < 64) {
        const float lf = log_sigmoid_f(gates[(size_t)(m0 + tid) * 32 + 28 + h] + fb[h]);
        ig[tid] = gates[(size_t)(m0 + tid) * 32 + 24 + h];
        float v = lf;
#pragma unroll
        for (int o = 1; o < 64; o <<= 1) { const float t = __shfl_up(v, o); if (tid >= o) v += t; }
        bcum[tid] = v;
    }
    __syncthreads();
}

__device__ void phase_chunkstate(const Params& p, int l, float* lds) {
    unsigned char* ws = p.ws;
    const bf16_t* proj = (const bf16_t*)(ws + WS_PROJ); const float* gates = (const float*)(ws + WS_GATES);
    const float* cw = p.in[I_CW] + l * 4096; const float* cb = p.in[I_CB] + l * 1024; const float* fb = p.in[I_FB] + l * 4;
    bf16_t* ST = (bf16_t*)(ws + WS_ST); float* STN = (float*)(ws + WS_STN); float* STM = (float*)(ws + WS_STM);
    float* kw = lds;
    float* vv = lds + 8192;
    float* bcum = lds + 16384; float* ig = bcum + 64; float* wsc = ig + 64; float* misc = wsc + 64;
    const int tid = my_tid();
    for (int u = my_bid(); u < BATCH * 4 * 64; u += gridDim.x) {
        const int c = u & 63, h = (u >> 6) & 3, b = u >> 8;
        const int m0 = b * SEQ + c * 64, bh = b * 4 + h;
        mlstm_gates(gates, fb, m0, h, bcum, ig);
        if (tid < 64) {
            const float gv = bcum[63] - bcum[tid] + ig[tid];
            const float mx = wave_max(gv);
            wsc[tid] = __expf(gv - mx);
            if (tid == 0) { misc[0] = mx; STM[bh * 64 + c] = mx; STM[2048 + bh * 64 + c] = bcum[63]; }
        }
        __syncthreads();
        for (int e = tid; e < 64 * 16; e += NT) {
            const int s = e >> 4, d0 = (e & 15) * 8;
            const int t = c * 64 + s, ch = 512 + h * 128 + d0;
            float acc[8];
#pragma unroll
            for (int j = 0; j < 8; ++j) acc[j] = cb[ch + j];
#pragma unroll
            for (int w = 0; w < 4; ++w) {
                if (t - 3 + w >= 0) {
                    const u32x4 raw = *(const u32x4*)(proj + (size_t)(m0 + s - 3 + w) * NPROJ + C_QB + ch); float f[8]; unpack8(raw, f);
#pragma unroll
                    for (int j = 0; j < 8; ++j) acc[j] += f[j] * cw[w * 1024 + ch + j];
                }
            }
            const float sc = 0.08838834764831845f * wsc[s];
#pragma unroll
            for (int j = 0; j < 8; ++j) kw[s * 128 + d0 + j] = silu_f(acc[j]) * sc;
            const u32x4 rv = *(const u32x4*)(proj + (size_t)(m0 + s) * NPROJ + C_VB + h * 128 + d0); float fv[8]; unpack8(rv, fv);
#pragma unroll
            for (int j = 0; j < 8; ++j) vv[s * 128 + d0 + j] = fv[j];
        }
        __syncthreads();
        {
            const int e0 = (tid >> 4) * 4, d0 = (tid & 15) * 8;
            float acc[4][8];
#pragma unroll
            for (int i = 0; i < 4; ++i)
#pragma unroll
                for (int j = 0; j < 8; ++j) acc[i][j] = 0.f;
#pragma unroll 2
            for (int s = 0; s < 64; ++s) {
                const f32x4 ve = *(const f32x4*)(vv + s * 128 + e0);
                const f32x4 k0 = *(const f32x4*)(kw + s * 128 + d0), k1 = *(const f32x4*)(kw + s * 128 + d0 + 4);
                const float va[4] = {ve.x, ve.y, ve.z, ve.w}; const float ka[8] = {k0.x, k0.y, k0.z, k0.w, k1.x, k1.y, k1.z, k1.w};
#pragma unroll
                for (int i = 0; i < 4; ++i)
#pragma unroll
                    for (int j = 0; j < 8; ++j) acc[i][j] += va[i] * ka[j];
            }
#pragma unroll
            for (int i = 0; i < 4; ++i) {
                u32x4 o; o.x = pk2(acc[i][0], acc[i][1]); o.y = pk2(acc[i][2], acc[i][3]); o.z = pk2(acc[i][4], acc[i][5]); o.w = pk2(acc[i][6], acc[i][7]);
                *(u32x4*)(ST + ((size_t)(bh * 64 + c) * 128 + e0 + i) * 128 + d0) = o;
            }
        }
        if (tid < 128) {
            float s = 0.f;
            for (int q = 0; q < 64; ++q) s += kw[q * 128 + tid];
            STN[(size_t)(bh * 64 + c) * 128 + tid] = s;
        }
    }
    __syncthreads();
}

__device__ void phase_scan(const Params& p) {
    unsigned char* ws = p.ws;
    bf16_t* ST = (bf16_t*)(ws + WS_ST); float* STN = (float*)(ws + WS_STN); float* STM = (float*)(ws + WS_STM);
    const int tid = my_tid();
    for (int u = my_bid(); u < 128; u += gridDim.x) {
        const int bh = u >> 2, idx = ((u & 3) * NT + tid) * 8;
        float C[8];
#pragma unroll
        for (int j = 0; j < 8; ++j) C[j] = 0.f;
        float nval = 0.f; const bool do_n = (u & 3) == 0 && tid < 128;
        float m = 0.f;
        for (int c = 0; c < 64; ++c) {
            const float mloc = STM[bh * 64 + c], bl = STM[2048 + bh * 64 + c];
            const float mnew = fmaxf(bl + m, mloc);
            const float decay = __expf(bl + m - mnew), scale = __expf(mloc - mnew);
            bf16_t* sp = ST + (size_t)(bh * 64 + c) * 16384 + idx;
            const u32x4 raw = *(const u32x4*)sp; float f[8]; unpack8(raw, f);
            u32x4 o; o.x = pk2(C[0], C[1]); o.y = pk2(C[2], C[3]); o.z = pk2(C[4], C[5]); o.w = pk2(C[6], C[7]);
            *(u32x4*)sp = o;
#pragma unroll
            for (int j = 0; j < 8; ++j) C[j] = decay * C[j] + scale * f[j];
            if (do_n) {
                float* np = STN + (size_t)(bh * 64 + c) * 128 + tid;
                const float dn = *np; *np = nval; nval = decay * nval + scale * dn;
            }
            if ((u & 3) == 0 && tid == 0) STM[4096 + bh * 64 + c] = m;
            m = mnew;
        }
    }
}

__device__ void phase_attn_naive(const Params& p, int l, float* lds) {
    unsigned char* ws = p.ws;
    const bf16_t* proj = (const bf16_t*)(ws + WS_PROJ); const float* gates = (const float*)(ws + WS_GATES);
    const bf16_t* kcmp = (const bf16_t*)(ws + WS_KCMP); const bf16_t* vcmp = (const bf16_t*)(ws + WS_VCMP);
    bf16_t* Y = (bf16_t*)(ws + WS_Y);
    const float* oga = p.in[I_OGA] + l * 512;
    const int tid = my_tid(), lane = tid & 63, wave = tid >> 6;
    float* qs = lds + wave * (256 + 1024);
    float* pb = qs + 256;
    for (int u = my_bid(); u < BATCH * 2 * (SEQ / 8); u += gridDim.x) {
        const int tb = u % (SEQ / 8), g = (u / (SEQ / 8)) & 1, b = u / (SEQ / 4);
        const int t = tb * 8 + wave; const int m = b * SEQ + t;
        const bf16_t* prow = proj + (size_t)m * NPROJ;
#pragma unroll
        for (int hg = 0; hg < 4; ++hg) qs[hg * 64 + lane] = bf2f(prow[C_QA + g * 256 + hg * 64 + lane]);
        float otot[4] = {0.f, 0.f, 0.f, 0.f};
        const float* gt = gates + (size_t)m * 32 + g * 12;
        const int nval = t >= 31 ? ((t - 31) >> 4) + 1 : 0;
        float sc[4][4];
        float mx[4] = {-INFINITY, -INFINITY, -INFINITY, -INFINITY};
        const bf16_t* kc = kcmp + (size_t)(b * 2 + g) * NCMPP * 64; const bf16_t* vc = vcmp + (size_t)(b * 2 + g) * NCMPP * 64;
#pragma unroll
        for (int it = 0; it < 4; ++it) {
            asm volatile("" ::: "memory");
            const int i = it * 64 + lane;
            float a[4] = {0.f, 0.f, 0.f, 0.f};
            if (i < nval) {
#pragma unroll 1
                for (int d8 = 0; d8 < 8; ++d8) {
                    const u32x4 raw = *(const u32x4*)(kc + (size_t)i * 64 + d8 * 8); float f[8]; unpack8(raw, f);
#pragma unroll
                    for (int j = 0; j < 8; ++j)
#pragma unroll
                        for (int hg = 0; hg < 4; ++hg) a[hg] += qs[hg * 64 + d8 * 8 + j] * f[j];
                }
            }
#pragma unroll
            for (int hg = 0; hg < 4; ++hg) { sc[it][hg] = i < nval ? a[hg] * 0.125f : -INFINITY; mx[hg] = fmaxf(mx[hg], sc[it][hg]); }
        }
        float sm[4];
#pragma unroll
        for (int hg = 0; hg < 4; ++hg) {
            mx[hg] = wave_max(mx[hg]);
            float s = 0.f;
#pragma unroll
            for (int it = 0; it < 4; ++it) { const float e = (it * 64 + lane) < nval ? __expf(sc[it][hg] - mx[hg]) : 0.f; sc[it][hg] = e; s += e; }
            sm[hg] = wave_sum(s);
        }
#pragma unroll
        for (int it = 0; it < 4; ++it)
#pragma unroll
            for (int hg = 0; hg < 4; ++hg) pb[hg * 256 + it * 64 + lane] = nval > 0 ? sc[it][hg] / sm[hg] : 0.f;
        {
            float o[4] = {0.f, 0.f, 0.f, 0.f};
            for (int i = 0; i < nval; ++i) {
                const float v = bf2f(vc[(size_t)i * 64 + lane]);
#pragma unroll
                for (int hg = 0; hg < 4; ++hg) o[hg] += pb[hg * 256 + i] * v;
            }
#pragma unroll
            for (int hg = 0; hg < 4; ++hg) otot[hg] += sigmoid_f(gt[hg * 3 + 0]) * o[hg];
        }
        const int cur = t >> 6;
        float imp = 0.f;
#pragma unroll
        for (int k = -1; k < 4; ++k) {
            const int i = 4 * lane + k;
            if (i >= 0 && i < nval) imp += (pb[i] + pb[256 + i]) + (pb[512 + i] + pb[768 + i]);
        }
        const bool valid = lane <= cur;
        const bool forced = (lane == 0) || (lane == cur) || (lane == cur - 1);
        const float score = valid ? imp + (forced ? 1e4f : 0.f) : -1e30f;
        int rank = 0;
        for (int k = 0; k < 64; ++k) {
            const float sk = __shfl(score, k);
            rank += (sk > score || (sk == score && k < lane)) ? 1 : 0;
        }
        const unsigned long long selmask = __ballot(rank < 16 && valid);
#pragma unroll 1
        for (int br = 0; br < 2; ++br) {
            const int kcol = (br ? C_KW : C_KS) + g * 64, vcol = (br ? C_VW : C_VS) + g * 64;
            float mr[4] = {-INFINITY, -INFINITY, -INFINITY, -INFINITY}, lr[4] = {0.f, 0.f, 0.f, 0.f}, o[4] = {0.f, 0.f, 0.f, 0.f};
            const int jlo = br ? (cur >= 8 ? cur - 8 : 0) : 0;
            for (int j = jlo; j <= cur; ++j) {
                if (br == 0 && !((selmask >> j) & 1ull)) continue;
                asm volatile("" ::: "memory");
                const int pos = j * 64 + lane;
                const bool ok = pos <= t && (br == 0 || pos > t - 512);
                float a[4] = {0.f, 0.f, 0.f, 0.f};
                const bf16_t* kr = proj + (size_t)(b * SEQ + pos) * NPROJ + kcol;
#pragma unroll 1
                for (int d8 = 0; d8 < 8; ++d8) {
                    const u32x4 raw = *(const u32x4*)(kr + d8 * 8); float f[8]; unpack8(raw, f);
#pragma unroll
                    for (int jj = 0; jj < 8; ++jj)
#pragma unroll
                        for (int hg = 0; hg < 4; ++hg) a[hg] += qs[hg * 64 + d8 * 8 + jj] * f[jj];
                }
                float alpha[4];
#pragma unroll
                for (int hg = 0; hg < 4; ++hg) {
                    const float s = ok ? a[hg] * 0.125f : -INFINITY;
                    const float bm = wave_max(s);
                    const float mn = fmaxf(mr[hg], bm);
                    alpha[hg] = (mn == -INFINITY) ? 1.f : __expf(mr[hg] - mn);
                    const float e = (ok && mn > -INFINITY) ? __expf(s - mn) : 0.f;
                    lr[hg] = lr[hg] * alpha[hg] + wave_sum(e);
                    mr[hg] = mn;
                    pb[hg * 256 + lane] = e;
                    o[hg] *= alpha[hg];
                }
                const bf16_t* vr = proj + (size_t)(b * SEQ + j * 64) * NPROJ + vcol + lane;
                for (int k = 0; k < 64; ++k) {
                    const float v = bf2f(vr[(size_t)k * NPROJ]);
#pragma unroll
                    for (int hg = 0; hg < 4; ++hg) o[hg] += pb[hg * 256 + k] * v;
                }
            }
#pragma unroll
            for (int hg = 0; hg < 4; ++hg) otot[hg] += sigmoid_f(gt[hg * 3 + 1 + br]) * (lr[hg] > 0.f ? o[hg] / lr[hg] : 0.f);
        }
#pragma unroll
        for (int hg = 0; hg < 4; ++hg) {
            const float s = wave_sum(otot[hg] * otot[hg]);
            const float y = otot[hg] * rsqrtf(s * (1.f / 64.f) + EPS) * oga[(g * 4 + hg) * 64 + lane];
            Y[(size_t)m * 1024 + (g * 4 + hg) * 64 + lane] = f2bf(y);
        }
    }
}

__device__ void phase_mlstm_out(const Params& p, int l, float* lds) {
    unsigned char* ws = p.ws;
    const bf16_t* proj = (const bf16_t*)(ws + WS_PROJ); const float* gates = (const float*)(ws + WS_GATES);
    const bf16_t* qkc = (const bf16_t*)(ws + WS_XB);
    const bf16_t* ST = (const bf16_t*)(ws + WS_ST); const float* STN = (const float*)(ws + WS_STN); const float* STM = (const float*)(ws + WS_STM);
    const float* fb = p.in[I_FB] + l * 4; const float* ogm = p.in[I_OGM] + l * 512;
    bf16_t* Y = (bf16_t*)(ws + WS_Y);
    float* qq = lds;
    float* kk = lds + 8192;
    float* Cs = lds + 16384;
    float* Ws = lds + 32768;
    float* bcum = Ws + 64 * 65; float* ig = bcum + 64; float* mt = ig + 64; float* wint = mt + 64; float* den = wint + 64; float* npv = den + 64;
    const int tid = my_tid(), lane = tid & 63, wave = tid >> 6;
    for (int u = my_bid(); u < BATCH * 4 * 64; u += gridDim.x) {
        const int c = u & 63, h = (u >> 6) & 3, b = u >> 8;
        const int m0 = b * SEQ + c * 64, bh = b * 4 + h;
        mlstm_gates(gates, fb, m0, h, bcum, ig);
        const float mprev = STM[4096 + bh * 64 + c];
        for (int e = tid; e < 64 * 16; e += NT) {
            const int s = e >> 4, d0 = (e & 15) * 8;
            const u32x4 rq = *(const u32x4*)(qkc + (size_t)(m0 + s) * 1024 + h * 128 + d0); float f[8]; unpack8(rq, f);
            const u32x4 rk = *(const u32x4*)(qkc + (size_t)(m0 + s) * 1024 + 512 + h * 128 + d0); float fk[8]; unpack8(rk, fk);
#pragma unroll
            for (int j = 0; j < 8; ++j) { qq[s * 128 + d0 + j] = f[j]; kk[s * 128 + d0 + j] = fk[j]; }
        }
        if (tid < 128) npv[tid] = STN[(size_t)(bh * 64 + c) * 128 + tid];
        for (int e8 = tid; e8 < 128 * 16; e8 += NT) {
            const int e = e8 >> 4, d0 = (e8 & 15) * 8;
            const u32x4 rc = *(const u32x4*)(ST + ((size_t)(bh * 64 + c) * 128 + e) * 128 + d0); float f[8]; unpack8(rc, f);
#pragma unroll
            for (int j = 0; j < 8; ++j) Cs[(d0 + j) * 128 + e] = f[j];
        }
        __syncthreads();
        {
            const int t = tid >> 3, s0 = (tid & 7) * 8;
            float a[8] = {0.f, 0.f, 0.f, 0.f, 0.f, 0.f, 0.f, 0.f};
#pragma unroll 2
            for (int d = 0; d < 128; ++d) {
                const float qv = qq[t * 128 + d];
#pragma unroll
                for (int j = 0; j < 8; ++j) a[j] += qv * kk[(s0 + j) * 128 + d];
            }
#pragma unroll
            for (int j = 0; j < 8; ++j) Ws[t * 65 + s0 + j] = a[j];
        }
        __syncthreads();
        for (int r = 0; r < 8; ++r) {
            const int t = wave * 8 + r;
            const float dv = lane <= t ? bcum[t] - bcum[lane] + ig[lane] : -INFINITY;
            const float a = bcum[t] + mprev;
            const float m_t = fmaxf(a, wave_max(dv));
            const float w = lane <= t ? __expf(dv - m_t) * Ws[t * 65 + lane] : 0.f;
            Ws[t * 65 + lane] = w;
            const float wi = __expf(a - m_t);
            const float qn = wave_sum(qq[t * 128 + lane] * npv[lane] + qq[t * 128 + 64 + lane] * npv[64 + lane]);
            const float dsum = wave_sum(w);
            if (lane == 0) { mt[t] = m_t; wint[t] = wi; den[t] = wi * qn + dsum; }
        }
        __syncthreads();
        for (int e = tid; e < 64 * 16; e += NT) {
            const int s = e >> 4, d0 = (e & 15) * 8;
            const u32x4 rv = *(const u32x4*)(proj + (size_t)(m0 + s) * NPROJ + C_VB + h * 128 + d0); float f[8]; unpack8(rv, f);
#pragma unroll
            for (int j = 0; j < 8; ++j) kk[s * 128 + d0 + j] = f[j];
        }
        __syncthreads();
        float hv[16];
        {
            const int e = tid & 127, t0 = (tid >> 7) * 16;
            float a1[16], a2[16];
#pragma unroll
            for (int i = 0; i < 16; ++i) { a1[i] = 0.f; a2[i] = 0.f; }
#pragma unroll 2
            for (int d = 0; d < 128; ++d) {
                const float cv = Cs[d * 128 + e];
#pragma unroll
                for (int i = 0; i < 16; ++i) a1[i] += qq[(t0 + i) * 128 + d] * cv;
            }
#pragma unroll 2
            for (int s = 0; s < 64; ++s) {
                const float vv = kk[s * 128 + e];
#pragma unroll
                for (int i = 0; i < 16; ++i) a2[i] += Ws[(t0 + i) * 65 + s] * vv;
            }
#pragma unroll
            for (int i = 0; i < 16; ++i) {
                const int t = t0 + i;
                const float num = wint[t] * a1[i] + a2[i];
                hv[i] = num / fmaxf(fabsf(den[t]), __expf(-mt[t]));
            }
        }
        __syncthreads();
        {
            const int e = tid & 127, t0 = (tid >> 7) * 16;
#pragma unroll
            for (int i = 0; i < 16; ++i) Cs[(t0 + i) * 128 + e] = hv[i];
        }
        __syncthreads();
        for (int r = 0; r < 8; ++r) {
            const int t = wave * 8 + r;
            const float h0 = Cs[t * 128 + lane], h1 = Cs[t * 128 + 64 + lane];
            const float s = wave_sum(h0 * h0 + h1 * h1);
            const float rr = rsqrtf(s * (1.f / 128.f) + EPS);
            const bf16_t* op = proj + (size_t)(m0 + t) * NPROJ + C_OB + h * 128;
            const float y0 = h0 * rr * ogm[h * 128 + lane] * sigmoid_f(bf2f(op[lane]));
            const float y1 = h1 * rr * ogm[h * 128 + 64 + lane] * sigmoid_f(bf2f(op[64 + lane]));
            Y[(size_t)(m0 + t) * 1024 + 512 + h * 128 + lane] = f2bf(y0);
            Y[(size_t)(m0 + t) * 1024 + 512 + h * 128 + 64 + lane] = f2bf(y1);
        }
        __syncthreads();
    }
}

constexpr int NPHASE = 1 + 7 * DEPTH;
template <bool COOP, int PMASK>
__global__ void __launch_bounds__(NT) mega(Params p) {
    extern __shared__ __attribute__((aligned(16))) unsigned char lds_raw[];
    float* lds = (float*)lds_raw;
    unsigned char* ws = p.ws;
    for (int ph = p.lo; ph < p.hi; ++ph) {
        if (ph == 0) {
            if (PMASK & 128) phase_prologue(p, lds);
        } else {
            const int l = (ph - 1) / 7, k = (ph - 1) % 7;
            if (k == 0 && (PMASK & 1)) {
                pg8::Gemm g{(const bf16_t*)(ws + WS_XB), (const bf16_t*)(ws + WS_WIN) + (size_t)l * NPAD * DM, M, NPAD, DM};
                pg8::StaticOrder S; S.init(M, NPAD, (int)gridDim.x, (int)blockIdx.x);
                pg8::EpiInT E{(const float*)(ws + WS_SS), (const float*)(ws + WS_BIAS) + l * NPAD, (bf16_t*)(ws + WS_PROJ), (float*)(ws + WS_GATES)};
                pg8::gemm_phase<pg8::EpiInT, pg8::StaticOrder, true, true>((PG8_LAS unsigned char*)lds_raw, g, S, E);
            } else if (k == 1 && (PMASK & 2)) {
                phase_rowpass(p, l);
                phase_compress(p, l, lds);
                phase_chunkstate(p, l, lds);
            } else if (k == 2 && (PMASK & 4)) {
                phase_scan(p);
                phase_attn_naive(p, l, lds);
            } else if (k == 3 && (PMASK & 8)) {
                phase_mlstm_out(p, l, lds);
            } else if (k == 4 && (PMASK & 16)) {
                pg8::Gemm g{(const bf16_t*)(ws + WS_Y), (const bf16_t*)(ws + WS_WOUT) + (size_t)l * DM * DM, M, DM, DM};
                pg8::StaticOrder S; S.init(M, DM, (int)gridDim.x, (int)blockIdx.x);
                pg8::EpiResT E{l == 0 ? p.in[I_X] : p.out, p.out, (bf16_t*)(ws + WS_XB), (float*)(ws + WS_SS)};
                pg8::gemm_phase<pg8::EpiResT, pg8::StaticOrder, true, true>((PG8_LAS unsigned char*)lds_raw, g, S, E);
            } else if (k == 5 && (PMASK & 32)) {
                pg8::Gemm g{(const bf16_t*)(ws + WS_XB), (const bf16_t*)(ws + WS_WGU) + (size_t)l * NGU * DM, M, NGU, DM};
                pg8::StaticOrder S; S.init(M, NGU, (int)gridDim.x, (int)blockIdx.x);
                pg8::EpiGUT E{(const float*)(ws + WS_SS), (bf16_t*)(ws + WS_PROJ)};
                pg8::gemm_phase<pg8::EpiGUT, pg8::StaticOrder, true, true>((PG8_LAS unsigned char*)lds_raw, g, S, E);
            } else if (k == 6 && (PMASK & 64)) {
                pg8::Gemm g{(const bf16_t*)(ws + WS_PROJ), (const bf16_t*)(ws + WS_WD) + (size_t)l * DM * FF, M, DM, FF};
                pg8::StaticOrder S; S.init(M, DM, (int)gridDim.x, (int)blockIdx.x);
                pg8::EpiResT E{p.out, p.out, (bf16_t*)(ws + WS_XB), (float*)(ws + WS_SS)};
                pg8::gemm_phase<pg8::EpiResT, pg8::StaticOrder, true, true>((PG8_LAS unsigned char*)lds_raw, g, S, E);
            }
        }
        if (COOP && ph + 1 < p.hi) { cg::this_grid().sync(); }
    }
}

extern "C" void kernel_launch(void* const* d_in, const int* in_sizes, int n_in, void* d_out, int out_size, void* d_ws, size_t ws_size, hipStream_t stream) {
    static int grid = 0;
    if (grid == 0) {
        if (n_in != 18 || ws_size < WS_END) { fprintf(stderr, "kernel_launch: unexpected n_in %d / ws_size %zu\n", n_in, ws_size); grid = -1; return; }
        int dev = 0, cus = 0, per_cu = 0;
        (void)hipGetDevice(&dev);
        (void)hipDeviceGetAttribute(&cus, hipDeviceAttributeMultiprocessorCount, dev);
        (void)hipFuncSetAttribute((const void*)mega<true, 0xff>, hipFuncAttributeMaxDynamicSharedMemorySize, LDS_BYTES);
        (void)hipOccupancyMaxActiveBlocksPerMultiprocessor(&per_cu, (const void*)mega<true, 0xff>, NT, LDS_BYTES);
        if (per_cu < 1) { fprintf(stderr, "kernel_launch: occupancy query reports %d blocks/CU\n", per_cu); grid = -1; return; }
        grid = (cus > 0 ? cus : 256) * 1;
        (void)hipGetLastError();
    }
    if (grid < 0) return;
    Params p{};
    for (int i = 0; i < 18; ++i) p.in[i] = (const float*)d_in[i];
    p.out = (float*)d_out; p.ws = (unsigned char*)d_ws;
    p.lo = 0; p.hi = NPHASE;
    void* args[] = {&p};
    hipError_t e = hipLaunchCooperativeKernel((const void*)mega<true, 0xff>, dim3(grid), dim3(NT), args, LDS_BYTES, stream);
    if (e != hipSuccess) fprintf(stderr, "cooperative launch failed: %s (grid %d)\n", hipGetErrorString(e), grid);
}
```

```cpp
#include <hip/hip_runtime.h>
#include <hip/hip_cooperative_groups.h>
#include <cstdint>
#include <cstdio>
namespace cg = cooperative_groups;

typedef unsigned short bf16_t;
typedef unsigned u32x4 __attribute__((ext_vector_type(4)));
typedef unsigned u32x2 __attribute__((ext_vector_type(2)));
typedef float f32x4 __attribute__((ext_vector_type(4)));

constexpr int BATCH = 8, SEQ = 4096, DM = 1024, M = BATCH * SEQ, DEPTH = 2;
constexpr int NIN = 3360, NPROJ = 3328, NPAD = 3584, FF = 2816, NGU = 2 * FF;
constexpr int NCMP = 255, NCMPP = 256;
constexpr float EPS = 1e-6f;
constexpr int NT = 512;
constexpr int LDS_BYTES = 152 * 1024;

constexpr int C_QA = 0, C_KC = 512, C_VC = 640, C_KS = 768, C_VS = 896, C_KW = 1024, C_VW = 1152, C_QB = 1280, C_KB = 1792, C_VB = 2304, C_OB = 2816;

constexpr size_t MiB = 1u << 20;
constexpr size_t WS_CTL = 0;
constexpr size_t WS_WIN = 1 * MiB;
constexpr size_t WS_WOUT = 15 * MiB;
constexpr size_t WS_WGU = 19 * MiB;
constexpr size_t WS_WD = 41 * MiB;
constexpr size_t WS_BIAS = 52 * MiB;
constexpr size_t WS_SS = 53 * MiB;
constexpr size_t WS_GATES = 55 * MiB;
constexpr size_t WS_KCMP = 59 * MiB;
constexpr size_t WS_VCMP = 59 * MiB + 512 * 1024;
constexpr size_t WS_STN = 60 * MiB;
constexpr size_t WS_STM = 61 * MiB;
constexpr size_t WS_XB = 64 * MiB;
constexpr size_t WS_Y = 128 * MiB;
constexpr size_t WS_ST = 192 * MiB;
constexpr size_t WS_PROJ = 256 * MiB;
constexpr size_t WS_END = 464 * MiB;

struct Params {
    const float* in[18];
    float* out;
    unsigned char* ws;
    int lo, hi;
};
enum { I_X = 0, I_LN1, I_WIN, I_BIN, I_QG, I_KG, I_PE, I_W1, I_W2, I_CW, I_CB, I_FB, I_OGA, I_OGM, I_WOUT, I_LN2, I_WGU, I_WD };

__device__ __forceinline__ float bf2f(bf16_t v) { return __uint_as_float(((unsigned)v) << 16); }
__device__ __forceinline__ bf16_t f2bf(float f) { unsigned u = __float_as_uint(f); return (bf16_t)((u + 0x7fffu + ((u >> 16) & 1u)) >> 16); }
__device__ __forceinline__ unsigned pk2(float lo, float hi) { return (unsigned)f2bf(lo) | ((unsigned)f2bf(hi) << 16); }
__device__ __forceinline__ float lo16(unsigned w) { return __uint_as_float(w << 16); }
__device__ __forceinline__ float hi16(unsigned w) { return __uint_as_float(w & 0xffff0000u); }
__device__ __forceinline__ float silu_f(float x) { return x / (1.f + __expf(-x)); }
__device__ __forceinline__ float sigmoid_f(float x) { return 1.f / (1.f + __expf(-x)); }
__device__ __forceinline__ float wave_sum(float v) {
#pragma unroll
    for (int o = 1; o < 64; o <<= 1) v += __shfl_xor(v, o);
    return v;
}
__device__ __forceinline__ float wave_max(float v) {
#pragma unroll
    for (int o = 1; o < 64; o <<= 1) v = fmaxf(v, __shfl_xor(v, o));
    return v;
}
__device__ __forceinline__ int my_tid() { int t = threadIdx.x; asm volatile("" : "+v"(t)); return t; }
__device__ __forceinline__ int my_bid() { int b = blockIdx.x; asm volatile("" : "+s"(b)); return b; }
__device__ __forceinline__ void unpack8(u32x4 w, float* f) {
    f[0] = lo16(w.x); f[1] = hi16(w.x); f[2] = lo16(w.y); f[3] = hi16(w.y);
    f[4] = lo16(w.z); f[5] = hi16(w.z); f[6] = lo16(w.w); f[7] = hi16(w.w);
}

__device__ __forceinline__ int in_srccol(int n) {
    if (n < 1280) return n;
    if (n < 2816) return n + 24;
    if (n < 3328) return n + 32;
    if (n < 3352) return n - 3328 + 1280;
    if (n < 3360) return n - 3352 + 2840;
    return -1;
}
__device__ __forceinline__ int gu_srccol(int n) {
    const int t = n >> 8, w = n & 255;
    return (w < 128) ? (t * 128 + w) : (FF + t * 128 + (w - 128));
}

template <int MODE>
__device__ void conv_job(const float* W, int K, int Nsrc, bf16_t* WT, int Nout, const float* kscale, float* tile) {
    const int tid = my_tid();
    const int nk = K / 64, nn = Nout / 64;
    for (int u = my_bid(); u < nk * nn; u += gridDim.x) {
        const int k0 = (u % nk) * 64, n0 = (u / nk) * 64;
#pragma unroll
        for (int i = 0; i < 8; ++i) {
            const int r = (tid >> 6) + 8 * i, c = tid & 63;
            const int n = n0 + c;
            const int sc = MODE == 0 ? n : (MODE == 1 ? in_srccol(n) : gu_srccol(n));
            float v = 0.f;
            if (sc >= 0) v = W[(size_t)(k0 + r) * Nsrc + sc] * (kscale ? kscale[k0 + r] : 1.f);
            tile[r * 65 + c] = v;
        }
        __syncthreads();
#pragma unroll
        for (int i = 0; i < 8; ++i) {
            const int r = (tid >> 6) + 8 * i, c = tid & 63;
            WT[(size_t)(n0 + r) * K + k0 + c] = f2bf(tile[c * 65 + r]);
        }
        __syncthreads();
    }
}

__device__ void phase_prologue(const Params& p, float* lds) {
    unsigned char* ws = p.ws;
    const int tid = my_tid(), lane = tid & 63, wave = tid >> 6;
    for (int l = 0; l < DEPTH; ++l) {
        conv_job<1>(p.in[I_WIN] + (size_t)l * DM * NIN, DM, NIN, (bf16_t*)(ws + WS_WIN) + (size_t)l * NPAD * DM, NPAD, p.in[I_LN1] + l * DM, lds);
        conv_job<0>(p.in[I_WOUT] + (size_t)l * DM * DM, DM, DM, (bf16_t*)(ws + WS_WOUT) + (size_t)l * DM * DM, DM, nullptr, lds);
        conv_job<2>(p.in[I_WGU] + (size_t)l * DM * NGU, DM, NGU, (bf16_t*)(ws + WS_WGU) + (size_t)l * NGU * DM, NGU, p.in[I_LN2] + l * DM, lds);
        conv_job<0>(p.in[I_WD] + (size_t)l * FF * DM, FF, DM, (bf16_t*)(ws + WS_WD) + (size_t)l * DM * FF, DM, nullptr, lds);
    }
    float* biasP = (float*)(ws + WS_BIAS);
    for (int i = my_bid() * NT + tid; i < DEPTH * NPAD; i += gridDim.x * NT) {
        const int l = i / NPAD, n = i % NPAD; const int sc = in_srccol(n);
        biasP[i] = sc >= 0 ? p.in[I_BIN][l * NIN + sc] : 0.f;
    }
    const float* x = p.in[I_X]; bf16_t* xb = (bf16_t*)(ws + WS_XB); float* ss = (float*)(ws + WS_SS);
    for (int m = my_bid() * 8 + wave; m < M; m += gridDim.x * 8) {
        const f32x4* xr = (const f32x4*)(x + (size_t)m * DM) + lane;
#pragma unroll
        for (int j = 0; j < 4; ++j) {
            const f32x4 v = xr[64 * j];
            float s = (v.x * v.x + v.y * v.y) + (v.z * v.z + v.w * v.w);
            s += __shfl_xor(s, 1); s += __shfl_xor(s, 2); s += __shfl_xor(s, 4); s += __shfl_xor(s, 8);
            if ((lane & 15) == 0) ss[(size_t)m * 16 + 4 * j + (lane >> 4)] = s;
            u32x2 o; o.x = pk2(v.x, v.y); o.y = pk2(v.z, v.w);
            *(u32x2*)(xb + (size_t)m * DM + 256 * j + 4 * lane) = o;
        }
    }
}

namespace pg8 {
#define PG8_LAS __attribute__((address_space(3)))
typedef short bf16x8 __attribute__((ext_vector_type(8)));
constexpr int BM = 256, BK = 64, HALF = 128, HTB = HALF * BK * 2  , STAGE_BYTES = 8 * HTB, NXCD = 8, WGM = 8;
__host__ __device__ __forceinline__ int lds_byte(int r, int c) { const int st = (r >> 4) * 2 + (c >> 5), rr = r & 15, cc = c & 31, ob = rr * 64 + cc * 2; return st * 1024 + (ob ^ (((ob >> 9) & 1) << 5)); }
__host__ __device__ __forceinline__ void stage_rc(int b, int& R, int& C) { const int st = b / 1024, sb = b % 1024, swz = sb ^ (((sb >> 9) & 1) << 5); R = (st >> 1) * 16 + swz / 64; C = (st & 1) * 32 + (swz % 64) / 2; }
__host__ __device__ __forceinline__ int perm32(int rho) { const int n = rho >> 4, i = rho & 15; return 8 * (i >> 2) + 4 * n + (i & 3); }
struct Unit { int pm, pn; };
struct Gemm { const bf16_t* A; const bf16_t* Bt; int M, N, K; };
struct StaticOrder {
    int nM, nN, nwg, G, c;
    __host__ __device__ void init(int M_, int N_, int G_, int c_) { nM = M_ / BM; nN = N_ / BM; nwg = nM * nN; G = G_; c = c_; }
    __host__ __device__ bool next(int i, Unit& u) const {
        const long L = (long)i * G + c; if (L >= nwg) return false;
        int wgid = (int)L; { const int q = nwg / NXCD, r = nwg % NXCD, xcd = wgid % NXCD, off = wgid / NXCD; wgid = (xcd < r ? xcd * (q + 1) : r * (q + 1) + (xcd - r) * q) + off; }
        const int nig = WGM * nN, gid = wgid / nig, fm = gid * WGM, gsz = (nM - fm) < WGM ? (nM - fm) : WGM;
        u.pm = fm + ((wgid % nig) % gsz); u.pn = (wgid % nig) / gsz; return true;
    }
    __device__ __forceinline__ void a_ready(const Unit&) const {}
    __device__ __forceinline__ void done(const Unit&) const {}
};
__device__ __forceinline__ unsigned cvt_pk_bf16(float lo, float hi) { unsigned r; asm volatile("v_cvt_pk_bf16_f32 %0, %1, %2" : "=v"(r) : "v"(lo), "v"(hi)); return r; }

__device__ __forceinline__ float row_rstd(const float* ss, int row, int fq) {
    const f32x4 pq = *(const f32x4*)(ss + (size_t)row * 16 + 4 * fq);
    float s = (pq.x + pq.y) + (pq.z + pq.w);
    s += __shfl_xor(s, 16); s += __shfl_xor(s, 32);
    return rsqrtf(s * (1.f / DM) + EPS);
}
struct EpiInT {
    static constexpr bool PERM = true, AFTER_DRAIN = false;
    const float* ss; const float* bias; bf16_t* proj; float* gates;
    __device__ __forceinline__ void operator()(const f32x4 (&acc)[2][2][4][2], const Unit& u, int wr, int wc, int fr, int fq) const {
        const int row0 = u.pm * BM + wr * 64 + fr, col0 = u.pn * BM + wc * 32 + 8 * fq;
        f32x4 bv[2][2];
#pragma unroll
        for (int bj = 0; bj < 2; ++bj)
#pragma unroll
            for (int n = 0; n < 2; ++n) bv[bj][n] = *(const f32x4*)(bias + col0 + bj * HALF + 4 * n);
#pragma unroll
        for (int ai = 0; ai < 2; ++ai)
#pragma unroll
            for (int m = 0; m < 4; ++m) {
                const int row = row0 + ai * HALF + m * 16;
                const float r = row_rstd(ss, row, fq);
                if (u.pn < 13) {
                    bf16_t* rowp = proj + (size_t)row * NPROJ + col0;
#pragma unroll
                    for (int bj = 0; bj < 2; ++bj) {
                        const f32x4 v0 = acc[ai][bj][m][0] * r + bv[bj][0], v1 = acc[ai][bj][m][1] * r + bv[bj][1];
                        u32x4 w; w.x = cvt_pk_bf16(v0[0], v0[1]); w.y = cvt_pk_bf16(v0[2], v0[3]); w.z = cvt_pk_bf16(v1[0], v1[1]); w.w = cvt_pk_bf16(v1[2], v1[3]);
                        *(u32x4*)(rowp + bj * HALF) = w;
                    }
                } else if (wc == 0) {
                    const f32x4 v0 = acc[ai][0][m][0] * r + bv[0][0], v1 = acc[ai][0][m][1] * r + bv[0][1];
                    float* gp = gates + (size_t)row * 32 + 8 * fq;
                    *(f32x4*)gp = v0; *(f32x4*)(gp + 4) = v1;
                }
            }
    }
};
struct EpiResT {
    static constexpr bool PERM = true, AFTER_DRAIN = false;
    const float* base; float* out; bf16_t* xb; float* ss;
    __device__ __forceinline__ void operator()(const f32x4 (&acc)[2][2][4][2], const Unit& u, int wr, int wc, int fr, int fq) const {
        const int row0 = u.pm * BM + wr * 64 + fr, col0 = u.pn * BM + wc * 32 + 8 * fq;
#pragma unroll
        for (int ai = 0; ai < 2; ++ai)
#pragma unroll
            for (int m = 0; m < 4; ++m) {
                const int row = row0 + ai * HALF + m * 16;
                const size_t off = (size_t)row * DM + col0;
                float sq = 0.f;
#pragma unroll
                for (int bj = 0; bj < 2; ++bj) {
                    const f32x4 x0 = *(const f32x4*)(base + off + bj * HALF) + acc[ai][bj][m][0];
                    const f32x4 x1 = *(const f32x4*)(base + off + bj * HALF + 4) + acc[ai][bj][m][1];
                    *(f32x4*)(out + off + bj * HALF) = x0; *(f32x4*)(out + off + bj * HALF + 4) = x1;
                    u32x4 w; w.x = cvt_pk_bf16(x0[0], x0[1]); w.y = cvt_pk_bf16(x0[2], x0[3]); w.z = cvt_pk_bf16(x1[0], x1[1]); w.w = cvt_pk_bf16(x1[2], x1[3]);
                    *(u32x4*)(xb + off + bj * HALF) = w;
                    sq += (x0[0] * x0[0] + x0[1] * x0[1]) + (x0[2] * x0[2] + x0[3] * x0[3]) + (x1[0] * x1[0] + x1[1] * x1[1]) + (x1[2] * x1[2] + x1[3] * x1[3]);
                }
                sq += __shfl_xor(sq, 16); sq += __shfl_xor(sq, 32);
                if (fq == 0) ss[(size_t)row * 16 + u.pn * 4 + wc] = sq;
                asm volatile("" ::: "memory");
            }
    }
};
struct EpiGUT {
    static constexpr bool PERM = true, AFTER_DRAIN = false;
    const float* ss; bf16_t* act;
    __device__ __forceinline__ void operator()(const f32x4 (&acc)[2][2][4][2], const Unit& u, int wr, int wc, int fr, int fq) const {
        const int row0 = u.pm * BM + wr * 64 + fr, hid0 = u.pn * HALF + wc * 32 + 8 * fq;
#pragma unroll
        for (int ai = 0; ai < 2; ++ai)
#pragma unroll
            for (int m = 0; m < 4; ++m) {
                const int row = row0 + ai * HALF + m * 16;
                const float r = row_rstd(ss, row, fq);
                float a[8];
#pragma unroll
                for (int n = 0; n < 2; ++n)
#pragma unroll
                    for (int j = 0; j < 4; ++j) {
                        const float g = acc[ai][0][m][n][j] * r, up = acc[ai][1][m][n][j] * r;
                        a[4 * n + j] = g * __builtin_amdgcn_rcpf(1.f + __builtin_amdgcn_exp2f(-1.4426950408889634f * g)) * up;
                    }
                u32x4 w; w.x = cvt_pk_bf16(a[0], a[1]); w.y = cvt_pk_bf16(a[2], a[3]); w.z = cvt_pk_bf16(a[4], a[5]); w.w = cvt_pk_bf16(a[6], a[7]);
                *(u32x4*)(act + (size_t)row * FF + hid0) = w;
            }
    }
};

template <class Epi, class Sched, bool ALIGN_EPI = false, bool SP2 = false>
__device__ __forceinline__ void gemm_phase(PG8_LAS unsigned char* lds, const Gemm g, const Sched& S, const Epi& E) {
    const int tid = my_tid(), wid = __builtin_amdgcn_readfirstlane(tid >> 6), lane = tid & 63, wr = wid >> 2, wc = wid & 3, fr = lane & 15, fq = lane >> 4;
    const int K = g.K, nt = K / BK;
    unsigned voffA[2], voffB[2];
#pragma unroll
    for (int i = 0; i < 2; ++i) { int R, C; stage_rc(tid * 16 + i * 8192, R, C); const int Rb = Epi::PERM ? ((R & ~31) + perm32(R & 31)) : R;
        voffA[i] = (unsigned)(R * K + C) * 2u; voffB[i] = (unsigned)(Rb * K + C) * 2u; }
    const size_t kstep = (size_t)(BK * 2);
    const size_t hstep = (size_t)HALF * K * 2;
    const size_t tstep = 2 * hstep;
    const unsigned ldsw = (unsigned)wid * 1024u;
    const int aoff = lds_byte(wr * 64 + fr, fq * 8), boff = lds_byte(wc * 32 + fr, fq * 8);
#define PG8_SA(b, h) (((b) * 2 + (h)) * HTB)
#define PG8_SB(b, h) ((4 + (b) * 2 + (h)) * HTB)
#define PG8_STAGE(bufoff, gbase, voff) do { _Pragma("unroll") for (int _i = 0; _i < 2; ++_i) \
        __builtin_amdgcn_global_load_lds((const unsigned*)((const char*)(gbase) + (voff)[_i]), (PG8_LAS unsigned*)(lds + (bufoff) + ldsw + _i * 8192), 16, 0, 0); } while (0)
#define PG8_LDA(dst, b, h) do { _Pragma("unroll") for (int m = 0; m < 4; ++m) _Pragma("unroll") for (int k = 0; k < 2; ++k) dst[m][k] = *(const PG8_LAS bf16x8*)(lds + PG8_SA(b, h) + aoff + m * 2048 + k * 1024); } while (0)
#define PG8_LDB(dst, b, h) do { _Pragma("unroll") for (int n = 0; n < 2; ++n) _Pragma("unroll") for (int k = 0; k < 2; ++k) dst[n][k] = *(const PG8_LAS bf16x8*)(lds + PG8_SB(b, h) + boff + n * 2048 + k * 1024); } while (0)
#define PG8_MMA(ai, bj, At, Bt) do { __builtin_amdgcn_s_setprio(1); _Pragma("unroll") for (int m = 0; m < 4; ++m) _Pragma("unroll") for (int n = 0; n < 2; ++n) _Pragma("unroll") for (int k = 0; k < 2; ++k) \
        acc[ai][bj][m][n] = __builtin_amdgcn_mfma_f32_16x16x32_bf16(Bt[n][k], At[m][k], acc[ai][bj][m][n], 0, 0, 0); __builtin_amdgcn_s_setprio(0); } while (0)
#define PG8_WAIT_V(n) asm volatile("s_waitcnt vmcnt(" #n ")" ::: "memory")
#define PG8_WAIT_L(n) asm volatile("s_waitcnt lgkmcnt(" #n ")" ::: "memory")
#define PG8_BAR __builtin_amdgcn_s_barrier()
#define PG8_SCHED __builtin_amdgcn_sched_barrier(0)
    Unit cur, nxt; int ui = 0;
    if (!S.next(0, cur)) return;
    f32x4 acc[2][2][4][2];
#pragma unroll
    for (int a = 0; a < 2; ++a)
#pragma unroll
        for (int b = 0; b < 2; ++b)
#pragma unroll
            for (int m = 0; m < 4; ++m)
#pragma unroll
                for (int n = 0; n < 2; ++n) acc[a][b][m][n] = (f32x4){0.f, 0.f, 0.f, 0.f};
    bf16x8 At[4][2], B0[2][2], B1[2][2];
    const char* cA = (const char*)g.A + (size_t)cur.pm * tstep; const char* cB = (const char*)g.Bt + (size_t)cur.pn * tstep;
    S.a_ready(cur);
    if constexpr (SP2) {
        PG8_STAGE(PG8_SB(0, 0), cB, voffB); PG8_STAGE(PG8_SB(0, 1), cB + hstep, voffB); PG8_STAGE(PG8_SA(0, 0), cA, voffA); PG8_STAGE(PG8_SA(0, 1), cA + hstep, voffA);
        if (wr == 1) PG8_BAR;
        PG8_WAIT_V(2); PG8_BAR;
        PG8_STAGE(PG8_SB(1, 0), cB + kstep, voffB); PG8_STAGE(PG8_SA(1, 0), cA + kstep, voffA); PG8_STAGE(PG8_SB(1, 1), cB + hstep + kstep, voffB);
        PG8_WAIT_V(6); PG8_BAR;
    } else {
        PG8_STAGE(PG8_SB(0, 0), cB, voffB); PG8_STAGE(PG8_SA(0, 0), cA, voffA); PG8_STAGE(PG8_SB(0, 1), cB + hstep, voffB); PG8_STAGE(PG8_SA(0, 1), cA + hstep, voffA);
        if (wr == 1) PG8_BAR;
        PG8_WAIT_V(4); PG8_BAR;
        PG8_STAGE(PG8_SB(1, 0), cB + kstep, voffB); PG8_STAGE(PG8_SA(1, 0), cA + kstep, voffA); PG8_STAGE(PG8_SB(1, 1), cB + hstep + kstep, voffB);
        PG8_WAIT_V(6); PG8_BAR;
    }
    for (;;) {
        const bool has_next = S.next(ui + 1, nxt);
        const char* nA = has_next ? (const char*)g.A + (size_t)nxt.pm * tstep : cA; const char* nB = has_next ? (const char*)g.Bt + (size_t)nxt.pn * tstep : cB;
        for (int t = 0; t < nt; t += 2) {
            const bool last = (t == nt - 2);
            const char* a1 = cA + (size_t)(t + 1) * kstep;
            const char* a2 = last ? nA : cA + (size_t)(t + 2) * kstep; const char* b2 = last ? nB : cB + (size_t)(t + 2) * kstep;
            const char* a3 = a2 + kstep; const char* b3 = b2 + kstep;
            if (last && has_next) S.a_ready(nxt);
            if constexpr (SP2) {
            PG8_LDB(B0, 0, 0); PG8_LDB(B1, 0, 1); PG8_SCHED; PG8_LDA(At, 0, 0); PG8_STAGE(PG8_SA(1, 1), a1 + hstep, voffA);
            PG8_WAIT_V(8); PG8_WAIT_L(0); PG8_BAR; PG8_MMA(0, 0, At, B0); PG8_MMA(0, 1, At, B1); PG8_BAR; PG8_SCHED;
            PG8_LDA(At, 0, 1); PG8_STAGE(PG8_SB(0, 0), b2, voffB); PG8_STAGE(PG8_SB(0, 1), b2 + hstep, voffB); PG8_STAGE(PG8_SA(0, 0), a2, voffA);
            PG8_WAIT_V(8); PG8_WAIT_L(0); PG8_BAR; PG8_MMA(1, 0, At, B0); PG8_MMA(1, 1, At, B1); PG8_BAR; PG8_SCHED;
            PG8_LDB(B0, 1, 0); PG8_LDB(B1, 1, 1); PG8_SCHED; PG8_LDA(At, 1, 0); PG8_STAGE(PG8_SA(0, 1), a2 + hstep, voffA);
            PG8_WAIT_V(8); PG8_WAIT_L(0); PG8_BAR; PG8_MMA(0, 0, At, B0); PG8_MMA(0, 1, At, B1); PG8_BAR; PG8_SCHED;
            PG8_LDA(At, 1, 1); PG8_STAGE(PG8_SB(1, 0), b3, voffB); PG8_STAGE(PG8_SB(1, 1), b3 + hstep, voffB); PG8_STAGE(PG8_SA(1, 0), a3, voffA);
            PG8_WAIT_V(8); PG8_WAIT_L(0); PG8_BAR; PG8_MMA(1, 0, At, B0); PG8_MMA(1, 1, At, B1); PG8_BAR; PG8_SCHED;
            } else {
            PG8_LDB(B0, 0, 0); PG8_SCHED; PG8_LDA(At, 0, 0); PG8_STAGE(PG8_SA(1, 1), a1 + hstep, voffA);
            PG8_WAIT_L(8); PG8_BAR; PG8_WAIT_L(0); PG8_MMA(0, 0, At, B0); PG8_BAR; PG8_SCHED;
            PG8_LDB(B1, 0, 1); PG8_STAGE(PG8_SB(0, 0), b2, voffB);
            PG8_BAR; PG8_WAIT_L(0); PG8_MMA(0, 1, At, B1); PG8_BAR;
            PG8_LDA(At, 0, 1); PG8_STAGE(PG8_SA(0, 0), a2, voffA);
            PG8_BAR; PG8_WAIT_L(0); PG8_MMA(1, 0, At, B0); PG8_BAR; PG8_SCHED;
            PG8_STAGE(PG8_SB(0, 1), b2 + hstep, voffB);
            PG8_WAIT_V(6); PG8_BAR; PG8_MMA(1, 1, At, B1); PG8_BAR;
            PG8_LDB(B0, 1, 0); PG8_SCHED; PG8_LDA(At, 1, 0); PG8_STAGE(PG8_SA(0, 1), a2 + hstep, voffA);
            PG8_WAIT_L(8); PG8_BAR; PG8_WAIT_L(0); PG8_MMA(0, 0, At, B0); PG8_BAR; PG8_SCHED;
            PG8_LDB(B1, 1, 1); PG8_STAGE(PG8_SB(1, 0), b3, voffB);
            PG8_BAR; PG8_WAIT_L(0); PG8_MMA(0, 1, At, B1); PG8_BAR;
            PG8_LDA(At, 1, 1); PG8_STAGE(PG8_SA(1, 0), a3, voffA);
            PG8_BAR; PG8_WAIT_L(0); PG8_MMA(1, 0, At, B0); PG8_BAR; PG8_SCHED;
            PG8_STAGE(PG8_SB(1, 1), b3 + hstep, voffB);
            PG8_WAIT_V(6); PG8_BAR; PG8_MMA(1, 1, At, B1); PG8_BAR;
            }
        }
        if constexpr (ALIGN_EPI) { if (wr == 0) PG8_BAR; }
        if constexpr (!Epi::AFTER_DRAIN) { E(acc, cur, wr, wc, fr, fq); S.done(cur); }
        if (!has_next) break;
#pragma unroll
        for (int a = 0; a < 2; ++a)
#pragma unroll
            for (int b = 0; b < 2; ++b)
#pragma unroll
                for (int m = 0; m < 4; ++m)
#pragma unroll
                    for (int n = 0; n < 2; ++n) acc[a][b][m][n] = (f32x4){0.f, 0.f, 0.f, 0.f};
        cur = nxt; cA = nA; cB = nB; ++ui;
        if constexpr (ALIGN_EPI) { if (wr == 1) PG8_BAR; }
    }
    PG8_WAIT_V(0);
    if constexpr (!ALIGN_EPI) { if (wr == 0) PG8_BAR; }
    PG8_BAR;
#undef PG8_SA
#undef PG8_SB
#undef PG8_STAGE
#undef PG8_LDA
#undef PG8_LDB
#undef PG8_MMA
#undef PG8_WAIT_V
#undef PG8_WAIT_L
#undef PG8_BAR
#undef PG8_SCHED
}
}

__device__ void phase_rowpass(const Params& p, int l) {
    unsigned char* ws = p.ws;
    bf16_t* proj = (bf16_t*)(ws + WS_PROJ); bf16_t* qkc = (bf16_t*)(ws + WS_XB);
    const float* qg = p.in[I_QG] + l * 64; const float* kg = p.in[I_KG] + l * 192;
    const float* cw = p.in[I_CW] + l * 4096; const float* cb = p.in[I_CB] + l * 1024;
    const int tid = my_tid(), lane = tid & 63, wave = tid >> 6;
    for (int m = my_bid() * 8 + wave; m < M; m += gridDim.x * 8) {
        const int t = m % SEQ;
        bf16_t* row = proj + (size_t)m * NPROJ;
        {
            const u32x4 raw = *(const u32x4*)(row + C_QA + lane * 8); float f[8]; unpack8(raw, f);
            float s = 0.f;
#pragma unroll
            for (int j = 0; j < 8; ++j) s += f[j] * f[j];
            s += __shfl_xor(s, 1); s += __shfl_xor(s, 2); s += __shfl_xor(s, 4);
            const float r = rsqrtf(s * (1.f / 64.f) + EPS);
            const int d0 = (lane & 7) * 8;
            u32x4 o; o.x = pk2(f[0] * r * qg[d0], f[1] * r * qg[d0 + 1]); o.y = pk2(f[2] * r * qg[d0 + 2], f[3] * r * qg[d0 + 3]);
            o.z = pk2(f[4] * r * qg[d0 + 4], f[5] * r * qg[d0 + 5]); o.w = pk2(f[6] * r * qg[d0 + 6], f[7] * r * qg[d0 + 7]);
            *(u32x4*)(row + C_QA + lane * 8) = o;
        }
        {
            const int which = lane >> 5, w4 = (lane & 31) * 4;
            bf16_t* pp = row + (which ? C_KW : C_KS) + w4;
            const u32x2 raw = *(const u32x2*)pp;
            float f[4] = {lo16(raw.x), hi16(raw.x), lo16(raw.y), hi16(raw.y)};
            float s = (f[0] * f[0] + f[1] * f[1]) + (f[2] * f[2] + f[3] * f[3]);
            s += __shfl_xor(s, 1); s += __shfl_xor(s, 2); s += __shfl_xor(s, 4); s += __shfl_xor(s, 8);
            const float r = rsqrtf(s * (1.f / 64.f) + EPS);
            const float* g = kg + (1 + which) * 64 + (w4 & 63);
            u32x2 o; o.x = pk2(f[0] * r * g[0], f[1] * r * g[1]); o.y = pk2(f[2] * r * g[2], f[3] * r * g[3]);
            *(u32x2*)pp = o;
        }
#pragma unroll
        for (int part = 0; part < 2; ++part) {
            const int c0 = part * 512 + lane * 8;
            float acc[8];
#pragma unroll
            for (int j = 0; j < 8; ++j) acc[j] = cb[c0 + j];
#pragma unroll
            for (int w = 0; w < 4; ++w) {
                if (t - 3 + w >= 0) {
                    const u32x4 raw = *(const u32x4*)(proj + (size_t)(m - 3 + w) * NPROJ + C_QB + c0); float f[8]; unpack8(raw, f);
#pragma unroll
                    for (int j = 0; j < 8; ++j) acc[j] += f[j] * cw[w * 1024 + c0 + j];
                }
            }
            const float sc = part ? 0.08838834764831845f : 1.f;
            float y[8];
#pragma unroll
            for (int j = 0; j < 8; ++j) y[j] = silu_f(acc[j]) * sc;
            u32x4 o; o.x = pk2(y[0], y[1]); o.y = pk2(y[2], y[3]); o.z = pk2(y[4], y[5]); o.w = pk2(y[6], y[7]);
            *(u32x4*)(qkc + (size_t)m * 1024 + c0) = o;
        }
    }
}

__device__ void phase_compress(const Params& p, int l, float* lds) {
    unsigned char* ws = p.ws;
    const bf16_t* proj = (const bf16_t*)(ws + WS_PROJ);
    const float* pe = p.in[I_PE] + (size_t)l * 2 * 2048; const float* w1 = p.in[I_W1] + (size_t)l * 2 * 2048 * 128; const float* w2 = p.in[I_W2] + (size_t)l * 2 * 128 * 64;
    const float* kg0 = p.in[I_KG] + l * 192;
    float* tok = lds;
    float* red = lds + 144 * 64;
    float* hidb = red + 4 * 8 * 128;
    const int tid = my_tid(), lane = tid & 63;
    for (int u = my_bid(); u < BATCH * 2 * 2 * 32; u += gridDim.x) {
        const int ib = u & 31, kv = (u >> 5) & 1, g = (u >> 6) & 1, b = u >> 7;
        const int i0 = ib * 8, ni = (NCMP - i0) < 8 ? (NCMP - i0) : 8;
        const int ntok = 16 * ni + 16;
        const int col = (kv ? C_VC : C_KC) + g * 64;
        __syncthreads();
        for (int e = tid; e < 144 * 64; e += NT) {
            const int tt = e >> 6, d = e & 63;
            tok[e] = tt < ntok ? bf2f(proj[(size_t)(b * SEQ + 16 * i0 + tt) * NPROJ + col + d]) : 0.f;
        }
        __syncthreads();
        {
            const int hid = tid & 127, part = tid >> 7;
            float acc[8], accP = 0.f;
#pragma unroll
            for (int ii = 0; ii < 8; ++ii) acc[ii] = 0.f;
            const float* w1p = w1 + (size_t)kv * 2048 * 128 + hid; const float* pep = pe + kv * 2048;
#pragma unroll 2
            for (int f = part * 512; f < part * 512 + 512; ++f) {
                const float w = w1p[(size_t)f * 128];
                accP += w * pep[f];
#pragma unroll
                for (int ii = 0; ii < 8; ++ii) acc[ii] += w * tok[16 * 64 * ii + f];
            }
#pragma unroll
            for (int ii = 0; ii < 8; ++ii) red[(part * 8 + ii) * 128 + hid] = acc[ii] + accP;
        }
        __syncthreads();
        for (int e = tid; e < 8 * 128; e += NT) {
            const float s = (red[e] + red[1024 + e]) + (red[2048 + e] + red[3072 + e]);
            hidb[e] = silu_f(s);
        }
        __syncthreads();
        {
            const int ii = tid >> 6, d = lane;
            float o = 0.f;
            const float* w2p = w2 + (size_t)kv * 128 * 64 + d;
            for (int h = 0; h < 128; ++h) o += hidb[ii * 128 + h] * w2p[h * 64];
            if (kv == 0) { const float s = wave_sum(o * o); o = o * rsqrtf(s * (1.f / 64.f) + EPS) * kg0[d]; }
            bf16_t* dst = (bf16_t*)(ws + (kv ? WS_VCMP : WS_KCMP));
            if (ii < ni) dst[(size_t)((b * 2 + g) * NCMPP + i0 + ii) * 64 + d] = f2bf(o);
        }
    }
    __syncthreads();
}

__device__ __forceinline__ float log_sigmoid_f(float x) { return fminf(x, 0.f) - log1pf(__expf(-fabsf(x))); }
__device__ void mlstm_gates(const float* gates, const float* fb, int m0, int h, float* bcum, float* ig) {
    const int tid = my_tid();
    __syncthreads();
    if (tid < 64) {
        const float lf = log_sigmoid_f(gates[(size_t)(m0 + tid) * 32 + 28 + h] + fb[h]);
        ig[tid] = gates[(size_t)(m0 + tid) * 32 + 24 + h];
        float v = lf;
#pragma unroll
        for (int o = 1; o < 64; o <<= 1) { const float t = __shfl_up(v, o); if (tid >= o) v += t; }
        bcum[tid] = v;
    }
    __syncthreads();
}

__device__ void phase_chunkstate(const Params& p, int l, float* lds) {
    unsigned char* ws = p.ws;
    const bf16_t* proj = (const bf16_t*)(ws + WS_PROJ); const float* gates = (const float*)(ws + WS_GATES);
    const float* cw = p.in[I_CW] + l * 4096; const float* cb = p.in[I_CB] + l * 1024; const float* fb = p.in[I_FB] + l * 4;
    bf16_t* ST = (bf16_t*)(ws + WS_ST); float* STN = (float*)(ws + WS_STN); float* STM = (float*)(ws + WS_STM);
    float* kw = lds;
    float* vv = lds + 8192;
    float* bcum = lds + 16384; float* ig = bcum + 64; float* wsc = ig + 64; float* misc = wsc + 64;
    const int tid = my_tid();
    for (int u = my_bid(); u < BATCH * 4 * 64; u += gridDim.x) {
        const int c = u & 63, h = (u >> 6) & 3, b = u >> 8;
        const int m0 = b * SEQ + c * 64, bh = b * 4 + h;
        mlstm_gates(gates, fb, m0, h, bcum, ig);
        if (tid < 64) {
            const float gv = bcum[63] - bcum[tid] + ig[tid];
            const float mx = wave_max(gv);
            wsc[tid] = __expf(gv - mx);
            if (tid == 0) { misc[0] = mx; STM[bh * 64 + c] = mx; STM[2048 + bh * 64 + c] = bcum[63]; }
        }
        __syncthreads();
        for (int e = tid; e < 64 * 16; e += NT) {
            const int s = e >> 4, d0 = (e & 15) * 8;
            const int t = c * 64 + s, ch = 512 + h * 128 + d0;
            float acc[8];
#pragma unroll
            for (int j = 0; j < 8; ++j) acc[j] = cb[ch + j];
#pragma unroll
            for (int w = 0; w < 4; ++w) {
                if (t - 3 + w >= 0) {
                    const u32x4 raw = *(const u32x4*)(proj + (size_t)(m0 + s - 3 + w) * NPROJ + C_QB + ch); float f[8]; unpack8(raw, f);
#pragma unroll
                    for (int j = 0; j < 8; ++j) acc[j] += f[j] * cw[w * 1024 + ch + j];
                }
            }
            const float sc = 0.08838834764831845f * wsc[s];
#pragma unroll
            for (int j = 0; j < 8; ++j) kw[s * 128 + d0 + j] = silu_f(acc[j]) * sc;
            const u32x4 rv = *(const u32x4*)(proj + (size_t)(m0 + s) * NPROJ + C_VB + h * 128 + d0); float fv[8]; unpack8(rv, fv);
#pragma unroll
            for (int j = 0; j < 8; ++j) vv[s * 128 + d0 + j] = fv[j];
        }
        __syncthreads();
        {
            const int e0 = (tid >> 4) * 4, d0 = (tid & 15) * 8;
            float acc[4][8];
#pragma unroll
            for (int i = 0; i < 4; ++i)
#pragma unroll
                for (int j = 0; j < 8; ++j) acc[i][j] = 0.f;
#pragma unroll 2
            for (int s = 0; s < 64; ++s) {
                const f32x4 ve = *(const f32x4*)(vv + s * 128 + e0);
                const f32x4 k0 = *(const f32x4*)(kw + s * 128 + d0), k1 = *(const f32x4*)(kw + s * 128 + d0 + 4);
                const float va[4] = {ve.x, ve.y, ve.z, ve.w}; const float ka[8] = {k0.x, k0.y, k0.z, k0.w, k1.x, k1.y, k1.z, k1.w};
#pragma unroll
                for (int i = 0; i < 4; ++i)
#pragma unroll
                    for (int j = 0; j < 8; ++j) acc[i][j] += va[i] * ka[j];
            }
#pragma unroll
            for (int i = 0; i < 4; ++i) {
                u32x4 o; o.x = pk2(acc[i][0], acc[i][1]); o.y = pk2(acc[i][2], acc[i][3]); o.z = pk2(acc[i][4], acc[i][5]); o.w = pk2(acc[i][6], acc[i][7]);
                *(u32x4*)(ST + ((size_t)(bh * 64 + c) * 128 + e0 + i) * 128 + d0) = o;
            }
        }
        if (tid < 128) {
            float s = 0.f;
            for (int q = 0; q < 64; ++q) s += kw[q * 128 + tid];
            STN[(size_t)(bh * 64 + c) * 128 + tid] = s;
        }
    }
    __syncthreads();
}

__device__ void phase_scan(const Params& p) {
    unsigned char* ws = p.ws;
    bf16_t* ST = (bf16_t*)(ws + WS_ST); float* STN = (float*)(ws + WS_STN); float* STM = (float*)(ws + WS_STM);
    const int tid = my_tid();
    for (int u = my_bid(); u < 128; u += gridDim.x) {
        const int bh = u >> 2, idx = ((u & 3) * NT + tid) * 8;
        float C[8];
#pragma unroll
        for (int j = 0; j < 8; ++j) C[j] = 0.f;
        float nval = 0.f; const bool do_n = (u & 3) == 0 && tid < 128;
        float m = 0.f;
        for (int c = 0; c < 64; ++c) {
            const float mloc = STM[bh * 64 + c], bl = STM[2048 + bh * 64 + c];
            const float mnew = fmaxf(bl + m, mloc);
            const float decay = __expf(bl + m - mnew), scale = __expf(mloc - mnew);
            bf16_t* sp = ST + (size_t)(bh * 64 + c) * 16384 + idx;
            const u32x4 raw = *(const u32x4*)sp; float f[8]; unpack8(raw, f);
            u32x4 o; o.x = pk2(C[0], C[1]); o.y = pk2(C[2], C[3]); o.z = pk2(C[4], C[5]); o.w = pk2(C[6], C[7]);
            *(u32x4*)sp = o;
#pragma unroll
            for (int j = 0; j < 8; ++j) C[j] = decay * C[j] + scale * f[j];
            if (do_n) {
                float* np = STN + (size_t)(bh * 64 + c) * 128 + tid;
                const float dn = *np; *np = nval; nval = decay * nval + scale * dn;
            }
            if ((u & 3) == 0 && tid == 0) STM[4096 + bh * 64 + c] = m;
            m = mnew;
        }
    }
}

__device__ void phase_attn_naive(const Params& p, int l, float* lds) {
    unsigned char* ws = p.ws;
    const bf16_t* proj = (const bf16_t*)(ws + WS_PROJ); const float* gates = (const float*)(ws + WS_GATES);
    const bf16_t* kcmp = (const bf16_t*)(ws + WS_KCMP); const bf16_t* vcmp = (const bf16_t*)(ws + WS_VCMP);
    bf16_t* Y = (bf16_t*)(ws + WS_Y);
    const float* oga = p.in[I_OGA] + l * 512;
    const int tid = my_tid(), lane = tid & 63, wave = tid >> 6;
    float* qs = lds + wave * (256 + 1024);
    float* pb = qs + 256;
    for (int u = my_bid(); u < BATCH * 2 * (SEQ / 8); u += gridDim.x) {
        const int tb = u % (SEQ / 8), g = (u / (SEQ / 8)) & 1, b = u / (SEQ / 4);
        const int t = tb * 8 + wave; const int m = b * SEQ + t;
        const bf16_t* prow = proj + (size_t)m * NPROJ;
#pragma unroll
        for (int hg = 0; hg < 4; ++hg) qs[hg * 64 + lane] = bf2f(prow[C_QA + g * 256 + hg * 64 + lane]);
        float otot[4] = {0.f, 0.f, 0.f, 0.f};
        const float* gt = gates + (size_t)m * 32 + g * 12;
        const int nval = t >= 31 ? ((t - 31) >> 4) + 1 : 0;
        float sc[4][4];
        float mx[4] = {-INFINITY, -INFINITY, -INFINITY, -INFINITY};
        const bf16_t* kc = kcmp + (size_t)(b * 2 + g) * NCMPP * 64; const bf16_t* vc = vcmp + (size_t)(b * 2 + g) * NCMPP * 64;
#pragma unroll
        for (int it = 0; it < 4; ++it) {
            asm volatile("" ::: "memory");
            const int i = it * 64 + lane;
            float a[4] = {0.f, 0.f, 0.f, 0.f};
            if (i < nval) {
#pragma unroll 1
                for (int d8 = 0; d8 < 8; ++d8) {
                    const u32x4 raw = *(const u32x4*)(kc + (size_t)i * 64 + d8 * 8); float f[8]; unpack8(raw, f);
#pragma unroll
                    for (int j = 0; j < 8; ++j)
#pragma unroll
                        for (int hg = 0; hg < 4; ++hg) a[hg] += qs[hg * 64 + d8 * 8 + j] * f[j];
                }
            }
#pragma unroll
            for (int hg = 0; hg < 4; ++hg) { sc[it][hg] = i < nval ? a[hg] * 0.125f : -INFINITY; mx[hg] = fmaxf(mx[hg], sc[it][hg]); }
        }
        float sm[4];
#pragma unroll
        for (int hg = 0; hg < 4; ++hg) {
            mx[hg] = wave_max(mx[hg]);
            float s = 0.f;
#pragma unroll
            for (int it = 0; it < 4; ++it) { const float e = (it * 64 + lane) < nval ? __expf(sc[it][hg] - mx[hg]) : 0.f; sc[it][hg] = e; s += e; }
            sm[hg] = wave_sum(s);
        }
#pragma unroll
        for (int it = 0; it < 4; ++it)
#pragma unroll
            for (int hg = 0; hg < 4; ++hg) pb[hg * 256 + it * 64 + lane] = nval > 0 ? sc[it][hg] / sm[hg] : 0.f;
        {
            float o[4] = {0.f, 0.f, 0.f, 0.f};
            for (int i = 0; i < nval; ++i) {
                const float v = bf2f(vc[(size_t)i * 64 + lane]);
#pragma unroll
                for (int hg = 0; hg < 4; ++hg) o[hg] += pb[hg * 256 + i] * v;
            }
#pragma unroll
            for (int hg = 0; hg < 4; ++hg) otot[hg] += sigmoid_f(gt[hg * 3 + 0]) * o[hg];
        }
        const int cur = t >> 6;
        float imp = 0.f;
#pragma unroll
        for (int k = -1; k < 4; ++k) {
            const int i = 4 * lane + k;
            if (i >= 0 && i < nval) imp += (pb[i] + pb[256 + i]) + (pb[512 + i] + pb[768 + i]);
        }
        const bool valid = lane <= cur;
        const bool forced = (lane == 0) || (lane == cur) || (lane == cur - 1);
        const float score = valid ? imp + (forced ? 1e4f : 0.f) : -1e30f;
        int rank = 0;
        for (int k = 0; k < 64; ++k) {
            const float sk = __shfl(score, k);
            rank += (sk > score || (sk == score && k < lane)) ? 1 : 0;
        }
        const unsigned long long selmask = __ballot(rank < 16 && valid);
#pragma unroll 1
        for (int br = 0; br < 2; ++br) {
            const int kcol = (br ? C_KW : C_KS) + g * 64, vcol = (br ? C_VW : C_VS) + g * 64;
            float mr[4] = {-INFINITY, -INFINITY, -INFINITY, -INFINITY}, lr[4] = {0.f, 0.f, 0.f, 0.f}, o[4] = {0.f, 0.f, 0.f, 0.f};
            const int jlo = br ? (cur >= 8 ? cur - 8 : 0) : 0;
            for (int j = jlo; j <= cur; ++j) {
                if (br == 0 && !((selmask >> j) & 1ull)) continue;
                asm volatile("" ::: "memory");
                const int pos = j * 64 + lane;
                const bool ok = pos <= t && (br == 0 || pos > t - 512);
                float a[4] = {0.f, 0.f, 0.f, 0.f};
                const bf16_t* kr = proj + (size_t)(b * SEQ + pos) * NPROJ + kcol;
#pragma unroll 1
                for (int d8 = 0; d8 < 8; ++d8) {
                    const u32x4 raw = *(const u32x4*)(kr + d8 * 8); float f[8]; unpack8(raw, f);
#pragma unroll
                    for (int jj = 0; jj < 8; ++jj)
#pragma unroll
                        for (int hg = 0; hg < 4; ++hg) a[hg] += qs[hg * 64 + d8 * 8 + jj] * f[jj];
                }
                float alpha[4];
#pragma unroll
                for (int hg = 0; hg < 4; ++hg) {
                    const float s = ok ? a[hg] * 0.125f : -INFINITY;
                    const float bm = wave_max(s);
                    const float mn = fmaxf(mr[hg], bm);
                    alpha[hg] = (mn == -INFINITY) ? 1.f : __expf(mr[hg] - mn);
                    const float e = (ok && mn > -INFINITY) ? __expf(s - mn) : 0.f;
                    lr[hg] = lr[hg] * alpha[hg] + wave_sum(e);
                    mr[hg] = mn;
                    pb[hg * 256 + lane] = e;
                    o[hg] *= alpha[hg];
                }
                const bf16_t* vr = proj + (size_t)(b * SEQ + j * 64) * NPROJ + vcol + lane;
                for (int k = 0; k < 64; ++k) {
                    const float v = bf2f(vr[(size_t)k * NPROJ]);
#pragma unroll
                    for (int hg = 0; hg < 4; ++hg) o[hg] += pb[hg * 256 + k] * v;
                }
            }
#pragma unroll
            for (int hg = 0; hg < 4; ++hg) otot[hg] += sigmoid_f(gt[hg * 3 + 1 + br]) * (lr[hg] > 0.f ? o[hg] / lr[hg] : 0.f);
        }
#pragma unroll
        for (int hg = 0; hg < 4; ++hg) {
            const float s = wave_sum(otot[hg] * otot[hg]);
            const float y = otot[hg] * rsqrtf(s * (1.f / 64.f) + EPS) * oga[(g * 4 + hg) * 64 + lane];
            Y[(size_t)m * 1024 + (g * 4 + hg) * 64 + lane] = f2bf(y);
        }
    }
}

namespace att {
typedef short bf16x8 __attribute__((ext_vector_type(8)));
typedef short s16x4 __attribute__((ext_vector_type(4)));
typedef float f32x16 __attribute__((ext_vector_type(16)));
#define ATT_LAS __attribute__((address_space(3)))
constexpr int L_K = 0, L_V = 16384, L_IMP = 32768, IMP_STRIDE = 65, L_SEL = L_IMP + 4 * 64 * IMP_STRIDE * 4, L_INV = L_SEL + 512, L_WS = L_INV + 1024, L_OST = L_WS + 8 * 256, L_END = L_OST + 8 * 4096;
static_assert(L_END <= LDS_BYTES, "attention LDS map");
constexpr float LOG2E = 1.4426950408889634f;
__device__ __forceinline__ int crow(int r, int hi) { return (r & 3) + 8 * (r >> 2) + 4 * hi; }
__device__ __forceinline__ unsigned cvtpk(float lo, float hi) { unsigned r; asm("v_cvt_pk_bf16_f32 %0, %1, %2" : "=v"(r) : "v"(lo), "v"(hi)); return r; }
__device__ __forceinline__ s16x4 vtr(ATT_LAS const unsigned char* p) { return __builtin_bit_cast(s16x4, __builtin_amdgcn_ds_read_tr16_b64_v4i16((ATT_LAS s16x4*)p)); }

struct Ctx {
    ATT_LAS unsigned char* lds;
    int lane, wave, r32, hi;
    u32x4 kreg, vreg;
};
__device__ __forceinline__ void tile_load(Ctx& C, const bf16_t* kbase, const bf16_t* vbase, int pitch) {
    C.kreg = *(const u32x4*)(kbase + (size_t)C.lane * pitch + C.wave * 8);
    C.vreg = *(const u32x4*)(vbase + (size_t)(16 * (C.wave & 3) + (C.lane >> 2)) * pitch + (C.wave >> 2) * 32 + (C.lane & 3) * 8);
}
__device__ __forceinline__ void tile_store(Ctx& C, int buf) {
    *(ATT_LAS u32x4*)(C.lds + L_K + buf * 8192 + C.wave * 1024 + C.lane * 16) = C.kreg;
    *(ATT_LAS u32x4*)(C.lds + L_V + buf * 8192 + C.wave * 1024 + C.lane * 16) = C.vreg;
}
__device__ __forceinline__ void qkt(const Ctx& C, int buf, const bf16x8 (&qr)[4], f32x16& p0, f32x16& p1) {
    ATT_LAS const unsigned char* kb = C.lds + L_K + buf * 8192 + C.hi * 1024 + C.r32 * 16;
    p0 = (f32x16){0.f, 0.f, 0.f, 0.f, 0.f, 0.f, 0.f, 0.f, 0.f, 0.f, 0.f, 0.f, 0.f, 0.f, 0.f, 0.f}; p1 = p0;
#pragma unroll
    for (int d0 = 0; d0 < 4; ++d0) {
        const bf16x8 b0 = *(ATT_LAS const bf16x8*)(kb + d0 * 2048);
        const bf16x8 b1 = *(ATT_LAS const bf16x8*)(kb + d0 * 2048 + 512);
        p0 = __builtin_amdgcn_mfma_f32_32x32x16_bf16(b0, qr[d0], p0, 0, 0, 0);
        p1 = __builtin_amdgcn_mfma_f32_32x32x16_bf16(b1, qr[d0], p1, 0, 0, 0);
    }
}
__device__ __forceinline__ void pv(const Ctx& C, int buf, const f32x16& p0, const f32x16& p1, f32x16 (&o)[2]) {
    ATT_LAS const unsigned char* vp = C.lds + L_V + buf * 8192 + ((C.lane >> 4) & 1) * 32 + (C.lane & 3) * 8 + (4 * C.hi + ((C.lane & 15) >> 2)) * 64;
    bf16x8 pa[4];
#pragma unroll
    for (int s2 = 0; s2 < 2; ++s2) {
        u32x4 w0, w1;
        w0.x = cvtpk(p0[8 * s2 + 0], p0[8 * s2 + 1]); w0.y = cvtpk(p0[8 * s2 + 2], p0[8 * s2 + 3]); w0.z = cvtpk(p0[8 * s2 + 4], p0[8 * s2 + 5]); w0.w = cvtpk(p0[8 * s2 + 6], p0[8 * s2 + 7]);
        w1.x = cvtpk(p1[8 * s2 + 0], p1[8 * s2 + 1]); w1.y = cvtpk(p1[8 * s2 + 2], p1[8 * s2 + 3]); w1.z = cvtpk(p1[8 * s2 + 4], p1[8 * s2 + 5]); w1.w = cvtpk(p1[8 * s2 + 6], p1[8 * s2 + 7]);
        pa[s2] = __builtin_bit_cast(bf16x8, w0); pa[2 + s2] = __builtin_bit_cast(bf16x8, w1);
    }
#pragma unroll
    for (int d0 = 0; d0 < 2; ++d0)
#pragma unroll
        for (int ks = 0; ks < 4; ++ks) {
            const s16x4 lo = vtr(vp + d0 * 4096 + ks * 1024), hh = vtr(vp + d0 * 4096 + ks * 1024 + 512);
            const bf16x8 vf = (bf16x8){lo[0], lo[1], lo[2], lo[3], hh[0], hh[1], hh[2], hh[3]};
            o[d0] = __builtin_amdgcn_mfma_f32_32x32x16_bf16(pa[ks], vf, o[d0], 0, 0, 0);
        }
}
__device__ __forceinline__ float sum16(const f32x16& p) {
    return ((p[0] + p[1]) + (p[2] + p[3])) + ((p[4] + p[5]) + (p[6] + p[7])) + (((p[8] + p[9]) + (p[10] + p[11])) + ((p[12] + p[13]) + (p[14] + p[15])));
}
__device__ __forceinline__ void accum_scaled(const Ctx& C, f32x16 (&otot)[2], const f32x16 (&o)[2], float fac) {
    ATT_LAS float* wsf = (ATT_LAS float*)(C.lds + L_WS) + C.wave * 64;
    asm volatile("s_waitcnt lgkmcnt(0)" ::: "memory");
    if (C.hi == 0) wsf[C.r32] = fac;
    asm volatile("s_waitcnt lgkmcnt(0)" ::: "memory");
#pragma unroll
    for (int r = 0; r < 16; ++r) { const float f = wsf[crow(r, C.hi)]; otot[0][r] += o[0][r] * f; otot[1][r] += o[1][r] * f; }
    asm volatile("s_waitcnt lgkmcnt(0)" : "+v"(otot[0]), "+v"(otot[1]) :: "memory");
}

__device__ void unit(const Params& p, int l, int b, int g, int c, ATT_LAS unsigned char* lds) {
    unsigned char* ws = p.ws;
    const bf16_t* proj = (const bf16_t*)(ws + WS_PROJ); const float* gates = (const float*)(ws + WS_GATES);
    const bf16_t* kcmp = (const bf16_t*)(ws + WS_KCMP) + (size_t)(b * 2 + g) * NCMPP * 64; const bf16_t* vcmp = (const bf16_t*)(ws + WS_VCMP) + (size_t)(b * 2 + g) * NCMPP * 64;
    bf16_t* Y = (bf16_t*)(ws + WS_Y);
    const float* kg = p.in[I_KG] + l * 192; const float* oga = p.in[I_OGA] + l * 512;
    Ctx C; C.lds = lds;
    const int tid = my_tid(); C.lane = tid & 63; C.wave = __builtin_amdgcn_readfirstlane(tid >> 6); C.r32 = C.lane & 31; C.hi = C.lane >> 5;
    const int lane = C.lane, wave = C.wave, r32 = C.r32, hi = C.hi, hg = wave >> 1, th = wave & 1;
    const int t = 64 * c + 32 * th + r32; const size_t m = (size_t)b * SEQ + t;
    const bf16_t* prow0 = proj + (size_t)b * SEQ * NPROJ;
    bf16x8 qr[4]; float qsq = 0.f;
#pragma unroll
    for (int d0 = 0; d0 < 4; ++d0) {
        const u32x4 raw = *(const u32x4*)(proj + m * NPROJ + C_QA + g * 256 + hg * 64 + 16 * d0 + 8 * hi);
        qr[d0] = __builtin_bit_cast(bf16x8, raw);
        float f[8]; unpack8(raw, f);
#pragma unroll
        for (int j = 0; j < 8; ++j) qsq += f[j] * f[j];
    }
    qsq += __shfl_xor(qsq, 32);
    const float qn = sqrtf(qsq) * 1.01f * LOG2E;
    const float off_c = qn * wave_max(fabsf(kg[lane])), off_s = qn * wave_max(fabsf(kg[64 + lane])), off_w = qn * wave_max(fabsf(kg[128 + lane]));
    const float* gt = gates + m * 32 + (g * 4 + hg) * 3;
    const float gq0 = sigmoid_f(gt[0]), gq1 = sigmoid_f(gt[1]), gq2 = sigmoid_f(gt[2]);
    constexpr float C2 = 0.125f * LOG2E;
    f32x16 otot[2]; otot[0] = (f32x16){0.f, 0.f, 0.f, 0.f, 0.f, 0.f, 0.f, 0.f, 0.f, 0.f, 0.f, 0.f, 0.f, 0.f, 0.f, 0.f}; otot[1] = otot[0];
    const f32x16 zero16 = otot[0];
    {
        const int nval = t >= 31 ? ((t - 31) >> 4) + 1 : 0;
        const int ntc = (4 * c + 3 + 63) >> 6;
        f32x16 o[2]; o[0] = zero16; o[1] = zero16;
        float lsum = 0.f, yprev = 0.f;
        ATT_LAS float* imp = (ATT_LAS float*)(lds + L_IMP) + (hg * 64 + 32 * th + r32) * IMP_STRIDE;
        tile_load(C, kcmp, vcmp, 64); tile_store(C, 0); __syncthreads();
#pragma unroll
        for (int jt = 0; jt < 4; ++jt) {
            if (jt < ntc) {
                if (jt + 1 < ntc) tile_load(C, kcmp + (size_t)(jt + 1) * 64 * 64, vcmp + (size_t)(jt + 1) * 64 * 64, 64);
                f32x16 p0, p1; qkt(C, jt & 1, qr, p0, p1);
#pragma unroll
                for (int r = 0; r < 16; ++r) {
                    const int i0 = 64 * jt + crow(r, hi);
                    p0[r] = i0 < nval ? __builtin_amdgcn_exp2f(p0[r] * C2 - off_c) : 0.f;
                    p1[r] = i0 + 32 < nval ? __builtin_amdgcn_exp2f(p1[r] * C2 - off_c) : 0.f;
                }
                lsum += sum16(p0) + sum16(p1);
#pragma unroll
                for (int H = 0; H < 2; ++H)
#pragma unroll
                    for (int rr = 0; rr < 4; ++rr) {
                        const f32x16& pp = H ? p1 : p0;
                        const float L = pp[4 * rr + 3], S4 = (pp[4 * rr] + pp[4 * rr + 1]) + (pp[4 * rr + 2] + L);
                        const float y = __shfl_xor(L, 32);
                        imp[2 * ((jt * 2 + H) * 4 + rr) + hi] = S4 + (hi ? y : yprev);
                        yprev = y;
                    }
                pv(C, jt & 1, p0, p1, o);
                if (jt + 1 < ntc) tile_store(C, (jt + 1) & 1);
                __syncthreads();
            }
        }
        lsum += __shfl_xor(lsum, 32);
        const float inv = lsum > 0.f ? 1.f / lsum : 0.f;
        if (hi == 0) ((ATT_LAS float*)(lds + L_INV))[hg * 64 + 32 * th + r32] = inv;
        accum_scaled(C, otot, o, gq0 * inv);
    }
    __syncthreads();
    {
        ATT_LAS unsigned long long* selm = (ATT_LAS unsigned long long*)(lds + L_SEL);
        const ATT_LAS float* impb = (const ATT_LAS float*)(lds + L_IMP);
        for (int i = 0; i < 8; ++i) {
            const int q = wave * 8 + i;
            unsigned long long msk;
            if (c < 16) msk = (2ull << c) - 1ull;
            else {
                const bool valid = lane <= c;
                float sc = -1e30f;
                if (valid) {
                    const ATT_LAS float* invb = (const ATT_LAS float*)(lds + L_INV);
                    sc = (impb[(0 * 64 + q) * IMP_STRIDE + lane] * invb[q] + impb[(1 * 64 + q) * IMP_STRIDE + lane] * invb[64 + q]) + (impb[(2 * 64 + q) * IMP_STRIDE + lane] * invb[128 + q] + impb[(3 * 64 + q) * IMP_STRIDE + lane] * invb[192 + q]);
                    if (lane == 0 || lane == c || lane == c - 1) sc += 1e4f;
                }
                int rank = 0;
                for (int k = 0; k <= c; ++k) { const float sk = __shfl(sc, k); rank += (sk > sc || (sk == sc && k < lane)) ? 1 : 0; }
                msk = __ballot(valid && rank < 16);
            }
            if (lane == 0) selm[q] = msk;
        }
    }
    __syncthreads();
    const unsigned long long mysel = ((ATT_LAS const unsigned long long*)(lds + L_SEL))[32 * th + r32];
    unsigned long long blkmask;
    {
        unsigned long long v = ((ATT_LAS const unsigned long long*)(lds + L_SEL))[lane];
#pragma unroll
        for (int o2 = 1; o2 < 64; o2 <<= 1) v |= __shfl_xor(v, o2);
        blkmask = ((unsigned long long)__builtin_amdgcn_readfirstlane((unsigned)(v >> 32)) << 32) | (unsigned)__builtin_amdgcn_readfirstlane((unsigned)v);
    }
    {
        f32x16 o[2]; o[0] = zero16; o[1] = zero16; float lsum = 0.f;
        const bf16_t* kb = prow0 + C_KS + g * 64; const bf16_t* vb = prow0 + C_VS + g * 64;
        unsigned long long rem = blkmask;
        int j = __builtin_ctzll(rem); rem &= rem - 1ull;
        tile_load(C, kb + (size_t)j * 64 * NPROJ, vb + (size_t)j * 64 * NPROJ, NPROJ); tile_store(C, 0); __syncthreads();
        int buf = 0;
        for (;;) {
            const int jn = rem ? __builtin_ctzll(rem) : -1;
            if (jn >= 0) { rem &= rem - 1ull; tile_load(C, kb + (size_t)jn * 64 * NPROJ, vb + (size_t)jn * 64 * NPROJ, NPROJ); }
            f32x16 p0, p1; qkt(C, buf, qr, p0, p1);
            const bool sel = (mysel >> j) & 1ull;
            const int lim = t - 64 * j;
#pragma unroll
            for (int r = 0; r < 16; ++r) {
                const int kk = crow(r, hi);
                p0[r] = (sel && kk <= lim) ? __builtin_amdgcn_exp2f(p0[r] * C2 - off_s) : 0.f;
                p1[r] = (sel && kk + 32 <= lim) ? __builtin_amdgcn_exp2f(p1[r] * C2 - off_s) : 0.f;
            }
            lsum += sum16(p0) + sum16(p1);
            pv(C, buf, p0, p1, o);
            if (jn >= 0) tile_store(C, buf ^ 1);
            __syncthreads();
            if (jn < 0) break;
            j = jn; buf ^= 1;
        }
        lsum += __shfl_xor(lsum, 32);
        accum_scaled(C, otot, o, gq1 / lsum);
    }
    {
        f32x16 o[2]; o[0] = zero16; o[1] = zero16; float lsum = 0.f;
        const bf16_t* kb = prow0 + C_KW + g * 64; const bf16_t* vb = prow0 + C_VW + g * 64;
        const int jlo = c >= 8 ? c - 8 : 0;
        tile_load(C, kb + (size_t)jlo * 64 * NPROJ, vb + (size_t)jlo * 64 * NPROJ, NPROJ); tile_store(C, 0); __syncthreads();
        int buf = 0;
        for (int j = jlo; j <= c; ++j) {
            if (j < c) tile_load(C, kb + (size_t)(j + 1) * 64 * NPROJ, vb + (size_t)(j + 1) * 64 * NPROJ, NPROJ);
            f32x16 p0, p1; qkt(C, buf, qr, p0, p1);
            const int lim = t - 64 * j;
#pragma unroll
            for (int r = 0; r < 16; ++r) {
                const int kk = crow(r, hi);
                p0[r] = (kk <= lim && kk > lim - 512) ? __builtin_amdgcn_exp2f(p0[r] * C2 - off_w) : 0.f;
                p1[r] = (kk + 32 <= lim && kk + 32 > lim - 512) ? __builtin_amdgcn_exp2f(p1[r] * C2 - off_w) : 0.f;
            }
            lsum += sum16(p0) + sum16(p1);
            pv(C, buf, p0, p1, o);
            if (j < c) tile_store(C, buf ^ 1);
            __syncthreads();
            buf ^= 1;
        }
        lsum += __shfl_xor(lsum, 32);
        accum_scaled(C, otot, o, gq2 / lsum);
    }
    {
        ATT_LAS bf16_t* stg = (ATT_LAS bf16_t*)(lds + L_OST) + wave * 2048;
        const float g0 = oga[(g * 4 + hg) * 64 + r32], g1 = oga[(g * 4 + hg) * 64 + 32 + r32];
#pragma unroll
        for (int r = 0; r < 16; ++r) {
            float sq = otot[0][r] * otot[0][r] + otot[1][r] * otot[1][r];
            sq += __shfl_xor(sq, 1); sq += __shfl_xor(sq, 2); sq += __shfl_xor(sq, 4); sq += __shfl_xor(sq, 8); sq += __shfl_xor(sq, 16);
            const float rs = rsqrtf(sq * (1.f / 64.f) + EPS);
            const int q = crow(r, hi);
            stg[q * 64 + r32] = f2bf(otot[0][r] * rs * g0);
            stg[q * 64 + 32 + r32] = f2bf(otot[1][r] * rs * g1);
        }
        asm volatile("s_waitcnt lgkmcnt(0)" ::: "memory");
        bf16_t* yb = Y + ((size_t)b * SEQ + 64 * c + 32 * th) * 1024 + (g * 4 + hg) * 64;
#pragma unroll
        for (int i = 0; i < 4; ++i) {
            const int row = i * 8 + (lane >> 3), ch = lane & 7;
            const u32x4 v = *(ATT_LAS const u32x4*)(stg + row * 64 + ch * 8);
            *(u32x4*)(yb + (size_t)row * 1024 + ch * 8) = v;
        }
    }
    __syncthreads();
}
}

__device__ void phase_attn_mfma(const Params& p, int l, unsigned char* lds_raw) {
    for (int v = my_bid(); v < 1024; v += gridDim.x) {
        const int r = v >> 8, x = (v >> 4) & 15, bg = v & 15;
        const int c = r == 0 ? 63 - x : (r == 1 ? 32 + x : (r == 2 ? 31 - x : x));
        att::unit(p, l, bg >> 1, bg & 1, c, (ATT_LAS unsigned char*)lds_raw);
    }
}

__device__ void phase_mlstm_out(const Params& p, int l, float* lds) {
    unsigned char* ws = p.ws;
    const bf16_t* proj = (const bf16_t*)(ws + WS_PROJ); const float* gates = (const float*)(ws + WS_GATES);
    const bf16_t* qkc = (const bf16_t*)(ws + WS_XB);
    const bf16_t* ST = (const bf16_t*)(ws + WS_ST); const float* STN = (const float*)(ws + WS_STN); const float* STM = (const float*)(ws + WS_STM);
    const float* fb = p.in[I_FB] + l * 4; const float* ogm = p.in[I_OGM] + l * 512;
    bf16_t* Y = (bf16_t*)(ws + WS_Y);
    float* qq = lds;
    float* kk = lds + 8192;
    float* Cs = lds + 16384;
    float* Ws = lds + 32768;
    float* bcum = Ws + 64 * 65; float* ig = bcum + 64; float* mt = ig + 64; float* wint = mt + 64; float* den = wint + 64; float* npv = den + 64;
    const int tid = my_tid(), lane = tid & 63, wave = tid >> 6;
    for (int u = my_bid(); u < BATCH * 4 * 64; u += gridDim.x) {
        const int c = u & 63, h = (u >> 6) & 3, b = u >> 8;
        const int m0 = b * SEQ + c * 64, bh = b * 4 + h;
        mlstm_gates(gates, fb, m0, h, bcum, ig);
        const float mprev = STM[4096 + bh * 64 + c];
        for (int e = tid; e < 64 * 16; e += NT) {
            const int s = e >> 4, d0 = (e & 15) * 8;
            const u32x4 rq = *(const u32x4*)(qkc + (size_t)(m0 + s) * 1024 + h * 128 + d0); float f[8]; unpack8(rq, f);
            const u32x4 rk = *(const u32x4*)(qkc + (size_t)(m0 + s) * 1024 + 512 + h * 128 + d0); float fk[8]; unpack8(rk, fk);
#pragma unroll
            for (int j = 0; j < 8; ++j) { qq[s * 128 + d0 + j] = f[j]; kk[s * 128 + d0 + j] = fk[j]; }
        }
        if (tid < 128) npv[tid] = STN[(size_t)(bh * 64 + c) * 128 + tid];
        for (int e8 = tid; e8 < 128 * 16; e8 += NT) {
            const int e = e8 >> 4, d0 = (e8 & 15) * 8;
            const u32x4 rc = *(const u32x4*)(ST + ((size_t)(bh * 64 + c) * 128 + e) * 128 + d0); float f[8]; unpack8(rc, f);
#pragma unroll
            for (int j = 0; j < 8; ++j) Cs[(d0 + j) * 128 + e] = f[j];
        }
        __syncthreads();
        {
            const int t = tid >> 3, s0 = (tid & 7) * 8;
            float a[8] = {0.f, 0.f, 0.f, 0.f, 0.f, 0.f, 0.f, 0.f};
#pragma unroll 2
            for (int d = 0; d < 128; ++d) {
                const float qv = qq[t * 128 + d];
#pragma unroll
                for (int j = 0; j < 8; ++j) a[j] += qv * kk[(s0 + j) * 128 + d];
            }
#pragma unroll
            for (int j = 0; j < 8; ++j) Ws[t * 65 + s0 + j] = a[j];
        }
        __syncthreads();
        for (int r = 0; r < 8; ++r) {
            const int t = wave * 8 + r;
            const float dv = lane <= t ? bcum[t] - bcum[lane] + ig[lane] : -INFINITY;
            const float a = bcum[t] + mprev;
            const float m_t = fmaxf(a, wave_max(dv));
            const float w = lane <= t ? __expf(dv - m_t) * Ws[t * 65 + lane] : 0.f;
            Ws[t * 65 + lane] = w;
            const float wi = __expf(a - m_t);
            const float qn = wave_sum(qq[t * 128 + lane] * npv[lane] + qq[t * 128 + 64 + lane] * npv[64 + lane]);
            const float dsum = wave_sum(w);
            if (lane == 0) { mt[t] = m_t; wint[t] = wi; den[t] = wi * qn + dsum; }
        }
        __syncthreads();
        for (int e = tid; e < 64 * 16; e += NT) {
            const int s = e >> 4, d0 = (e & 15) * 8;
            const u32x4 rv = *(const u32x4*)(proj + (size_t)(m0 + s) * NPROJ + C_VB + h * 128 + d0); float f[8]; unpack8(rv, f);
#pragma unroll
            for (int j = 0; j < 8; ++j) kk[s * 128 + d0 + j] = f[j];
        }
        __syncthreads();
        float hv[16];
        {
            const int e = tid & 127, t0 = (tid >> 7) * 16;
            float a1[16], a2[16];
#pragma unroll
            for (int i = 0; i < 16; ++i) { a1[i] = 0.f; a2[i] = 0.f; }
#pragma unroll 2
            for (int d = 0; d < 128; ++d) {
                const float cv = Cs[d * 128 + e];
#pragma unroll
                for (int i = 0; i < 16; ++i) a1[i] += qq[(t0 + i) * 128 + d] * cv;
            }
#pragma unroll 2
            for (int s = 0; s < 64; ++s) {
                const float vv = kk[s * 128 + e];
#pragma unroll
                for (int i = 0; i < 16; ++i) a2[i] += Ws[(t0 + i) * 65 + s] * vv;
            }
#pragma unroll
            for (int i = 0; i < 16; ++i) {
                const int t = t0 + i;
                const float num = wint[t] * a1[i] + a2[i];
                hv[i] = num / fmaxf(fabsf(den[t]), __expf(-mt[t]));
            }
        }
        __syncthreads();
        {
            const int e = tid & 127, t0 = (tid >> 7) * 16;
#pragma unroll
            for (int i = 0; i < 16; ++i) Cs[(t0 + i) * 128 + e] = hv[i];
        }
        __syncthreads();
        for (int r = 0; r < 8; ++r) {
            const int t = wave * 8 + r;
            const float h0 = Cs[t * 128 + lane], h1 = Cs[t * 128 + 64 + lane];
            const float s = wave_sum(h0 * h0 + h1 * h1);
            const float rr = rsqrtf(s * (1.f / 128.f) + EPS);
            const bf16_t* op = proj + (size_t)(m0 + t) * NPROJ + C_OB + h * 128;
            const float y0 = h0 * rr * ogm[h * 128 + lane] * sigmoid_f(bf2f(op[lane]));
            const float y1 = h1 * rr * ogm[h * 128 + 64 + lane] * sigmoid_f(bf2f(op[64 + lane]));
            Y[(size_t)(m0 + t) * 1024 + 512 + h * 128 + lane] = f2bf(y0);
            Y[(size_t)(m0 + t) * 1024 + 512 + h * 128 + 64 + lane] = f2bf(y1);
        }
        __syncthreads();
    }
}

constexpr int NPHASE = 1 + 7 * DEPTH;
template <bool COOP, int PMASK>
__global__ void __launch_bounds__(NT) mega(Params p) {
    extern __shared__ __attribute__((aligned(16))) unsigned char lds_raw[];
    float* lds = (float*)lds_raw;
    unsigned char* ws = p.ws;
    for (int ph = p.lo; ph < p.hi; ++ph) {
        if (ph == 0) {
            if (PMASK & 128) phase_prologue(p, lds);
        } else {
            const int l = (ph - 1) / 7, k = (ph - 1) % 7;
            if (k == 0 && (PMASK & 1)) {
                pg8::Gemm g{(const bf16_t*)(ws + WS_XB), (const bf16_t*)(ws + WS_WIN) + (size_t)l * NPAD * DM, M, NPAD, DM};
                pg8::StaticOrder S; S.init(M, NPAD, (int)gridDim.x, (int)blockIdx.x);
                pg8::EpiInT E{(const float*)(ws + WS_SS), (const float*)(ws + WS_BIAS) + l * NPAD, (bf16_t*)(ws + WS_PROJ), (float*)(ws + WS_GATES)};
                pg8::gemm_phase<pg8::EpiInT, pg8::StaticOrder, true, true>((PG8_LAS unsigned char*)lds_raw, g, S, E);
            } else if (k == 1 && (PMASK & 2)) {
                phase_rowpass(p, l);
                phase_compress(p, l, lds);
                phase_chunkstate(p, l, lds);
            } else if (k == 2 && (PMASK & 4)) {
                phase_scan(p);
                phase_attn_mfma(p, l, lds_raw);
            } else if (k == 3 && (PMASK & 8)) {
                phase_mlstm_out(p, l, lds);
            } else if (k == 4 && (PMASK & 16)) {
                pg8::Gemm g{(const bf16_t*)(ws + WS_Y), (const bf16_t*)(ws + WS_WOUT) + (size_t)l * DM * DM, M, DM, DM};
                pg8::StaticOrder S; S.init(M, DM, (int)gridDim.x, (int)blockIdx.x);
                pg8::EpiResT E{l == 0 ? p.in[I_X] : p.out, p.out, (bf16_t*)(ws + WS_XB), (float*)(ws + WS_SS)};
                pg8::gemm_phase<pg8::EpiResT, pg8::StaticOrder, true, true>((PG8_LAS unsigned char*)lds_raw, g, S, E);
            } else if (k == 5 && (PMASK & 32)) {
                pg8::Gemm g{(const bf16_t*)(ws + WS_XB), (const bf16_t*)(ws + WS_WGU) + (size_t)l * NGU * DM, M, NGU, DM};
                pg8::StaticOrder S; S.init(M, NGU, (int)gridDim.x, (int)blockIdx.x);
                pg8::EpiGUT E{(const float*)(ws + WS_SS), (bf16_t*)(ws + WS_PROJ)};
                pg8::gemm_phase<pg8::EpiGUT, pg8::StaticOrder, true, true>((PG8_LAS unsigned char*)lds_raw, g, S, E);
            } else if (k == 6 && (PMASK & 64)) {
                pg8::Gemm g{(const bf16_t*)(ws + WS_PROJ), (const bf16_t*)(ws + WS_WD) + (size_t)l * DM * FF, M, DM, FF};
                pg8::StaticOrder S; S.init(M, DM, (int)gridDim.x, (int)blockIdx.x);
                pg8::EpiResT E{p.out, p.out, (bf16_t*)(ws + WS_XB), (float*)(ws + WS_SS)};
                pg8::gemm_phase<pg8::EpiResT, pg8::StaticOrder, true, true>((PG8_LAS unsigned char*)lds_raw, g, S, E);
            }
        }
        if (COOP && ph + 1 < p.hi) { cg::this_grid().sync(); }
    }
}

extern "C" void kernel_launch(void* const* d_in, const int* in_sizes, int n_in, void* d_out, int out_size, void* d_ws, size_t ws_size, hipStream_t stream) {
    static int grid = 0;
    if (grid == 0) {
        if (n_in != 18 || ws_size < WS_END) { fprintf(stderr, "kernel_launch: unexpected n_in %d / ws_size %zu\n", n_in, ws_size); grid = -1; return; }
        int dev = 0, cus = 0, per_cu = 0;
        (void)hipGetDevice(&dev);
        (void)hipDeviceGetAttribute(&cus, hipDeviceAttributeMultiprocessorCount, dev);
        (void)hipFuncSetAttribute((const void*)mega<true, 0xff>, hipFuncAttributeMaxDynamicSharedMemorySize, LDS_BYTES);
        (void)hipOccupancyMaxActiveBlocksPerMultiprocessor(&per_cu, (const void*)mega<true, 0xff>, NT, LDS_BYTES);
        if (per_cu < 1) { fprintf(stderr, "kernel_launch: occupancy query reports %d blocks/CU\n", per_cu); grid = -1; return; }
        grid = (cus > 0 ? cus : 256) * 1;
        (void)hipGetLastError();
    }
    if (grid < 0) return;
    Params p{};
    for (int i = 0; i < 18; ++i) p.in[i] = (const float*)d_in[i];
    p.out = (float*)d_out; p.ws = (unsigned char*)d_ws;
    p.lo = 0; p.hi = NPHASE;
    void* args[] = {&p};
    hipError_t e = hipLaunchCooperativeKernel((const void*)mega<true, 0xff>, dim3(grid), dim3(NT), args, LDS_BYTES, stream);
    if (e != hipSuccess) fprintf(stderr, "cooperative launch failed: %s (grid %d)\n", hipGetErrorString(e), grid);
}
```

```cpp
#include <hip/hip_runtime.h>
#include <hip/hip_cooperative_groups.h>
#include <cstdint>
#include <cstdio>
namespace cg = cooperative_groups;

typedef unsigned short bf16_t;
typedef unsigned u32x4 __attribute__((ext_vector_type(4)));
typedef unsigned u32x2 __attribute__((ext_vector_type(2)));
typedef float f32x4 __attribute__((ext_vector_type(4)));

constexpr int BATCH = 8, SEQ = 4096, DM = 1024, M = BATCH * SEQ, DEPTH = 2;
constexpr int NIN = 3360, NPROJ = 3328, NPAD = 3584, FF = 2816, NGU = 2 * FF;
constexpr int NCMP = 255, NCMPP = 256;
constexpr float EPS = 1e-6f;
constexpr int NT = 512;
constexpr int LDS_BYTES = 152 * 1024;

constexpr int C_QA = 0, C_KC = 512, C_VC = 640, C_KS = 768, C_VS = 896, C_KW = 1024, C_VW = 1152, C_QB = 1280, C_KB = 1792, C_VB = 2304, C_OB = 2816;

constexpr size_t MiB = 1u << 20;
constexpr size_t WS_CTL = 0;
constexpr size_t WS_WIN = 1 * MiB;
constexpr size_t WS_WOUT = 15 * MiB;
constexpr size_t WS_WGU = 19 * MiB;
constexpr size_t WS_WD = 41 * MiB;
constexpr size_t WS_BIAS = 52 * MiB;
constexpr size_t WS_SS = 53 * MiB;
constexpr size_t WS_GATES = 55 * MiB;
constexpr size_t WS_KCMP = 59 * MiB;
constexpr size_t WS_VCMP = 59 * MiB + 512 * 1024;
constexpr size_t WS_STN = 60 * MiB;
constexpr size_t WS_STM = 61 * MiB;
constexpr size_t WS_XB = 64 * MiB;
constexpr size_t WS_Y = 128 * MiB;
constexpr size_t WS_ST = 192 * MiB;
constexpr size_t WS_PROJ = 256 * MiB;
constexpr size_t WS_END = 464 * MiB;

struct Params {
    const float* in[18];
    float* out;
    unsigned char* ws;
    int lo, hi;
};
enum { I_X = 0, I_LN1, I_WIN, I_BIN, I_QG, I_KG, I_PE, I_W1, I_W2, I_CW, I_CB, I_FB, I_OGA, I_OGM, I_WOUT, I_LN2, I_WGU, I_WD };

__device__ __forceinline__ float bf2f(bf16_t v) { return __uint_as_float(((unsigned)v) << 16); }
__device__ __forceinline__ bf16_t f2bf(float f) { unsigned u = __float_as_uint(f); return (bf16_t)((u + 0x7fffu + ((u >> 16) & 1u)) >> 16); }
__device__ __forceinline__ unsigned pk2(float lo, float hi) { return (unsigned)f2bf(lo) | ((unsigned)f2bf(hi) << 16); }
__device__ __forceinline__ float lo16(unsigned w) { return __uint_as_float(w << 16); }
__device__ __forceinline__ float hi16(unsigned w) { return __uint_as_float(w & 0xffff0000u); }
__device__ __forceinline__ float silu_f(float x) { return x / (1.f + __expf(-x)); }
__device__ __forceinline__ float sigmoid_f(float x) { return 1.f / (1.f + __expf(-x)); }
__device__ __forceinline__ float wave_sum(float v) {
#pragma unroll
    for (int o = 1; o < 64; o <<= 1) v += __shfl_xor(v, o);
    return v;
}
__device__ __forceinline__ float wave_max(float v) {
#pragma unroll
    for (int o = 1; o < 64; o <<= 1) v = fmaxf(v, __shfl_xor(v, o));
    return v;
}
__device__ __forceinline__ int my_tid() { int t = threadIdx.x; asm volatile("" : "+v"(t)); return t; }
__device__ __forceinline__ int my_bid() { int b = blockIdx.x; asm volatile("" : "+s"(b)); return b; }
__device__ __forceinline__ void unpack8(u32x4 w, float* f) {
    f[0] = lo16(w.x); f[1] = hi16(w.x); f[2] = lo16(w.y); f[3] = hi16(w.y);
    f[4] = lo16(w.z); f[5] = hi16(w.z); f[6] = lo16(w.w); f[7] = hi16(w.w);
}

__device__ __forceinline__ int in_srccol(int n) {
    if (n < 1280) return n;
    if (n < 2816) return n + 24;
    if (n < 3328) return n + 32;
    if (n < 3352) return n - 3328 + 1280;
    if (n < 3360) return n - 3352 + 2840;
    return -1;
}
__device__ __forceinline__ int gu_srccol(int n) {
    const int t = n >> 8, w = n & 255;
    return (w < 128) ? (t * 128 + w) : (FF + t * 128 + (w - 128));
}

template <int MODE>
__device__ void conv_job(const float* W, int K, int Nsrc, bf16_t* WT, int Nout, const float* kscale, float* tile) {
    const int tid = my_tid();
    const int nk = K / 64, nn = Nout / 64;
    for (int u = my_bid(); u < nk * nn; u += gridDim.x) {
        const int k0 = (u % nk) * 64, n0 = (u / nk) * 64;
#pragma unroll
        for (int i = 0; i < 8; ++i) {
            const int r = (tid >> 6) + 8 * i, c = tid & 63;
            const int n = n0 + c;
            const int sc = MODE == 0 ? n : (MODE == 1 ? in_srccol(n) : gu_srccol(n));
            float v = 0.f;
            if (sc >= 0) v = W[(size_t)(k0 + r) * Nsrc + sc] * (kscale ? kscale[k0 + r] : 1.f);
            tile[r * 65 + c] = v;
        }
        __syncthreads();
#pragma unroll
        for (int i = 0; i < 8; ++i) {
            const int r = (tid >> 6) + 8 * i, c = tid & 63;
            WT[(size_t)(n0 + r) * K + k0 + c] = f2bf(tile[c * 65 + r]);
        }
        __syncthreads();
    }
}

__device__ void phase_prologue(const Params& p, float* lds) {
    unsigned char* ws = p.ws;
    const int tid = my_tid(), lane = tid & 63, wave = tid >> 6;
    for (int l = 0; l < DEPTH; ++l) {
        conv_job<1>(p.in[I_WIN] + (size_t)l * DM * NIN, DM, NIN, (bf16_t*)(ws + WS_WIN) + (size_t)l * NPAD * DM, NPAD, p.in[I_LN1] + l * DM, lds);
        conv_job<0>(p.in[I_WOUT] + (size_t)l * DM * DM, DM, DM, (bf16_t*)(ws + WS_WOUT) + (size_t)l * DM * DM, DM, nullptr, lds);
        conv_job<2>(p.in[I_WGU] + (size_t)l * DM * NGU, DM, NGU, (bf16_t*)(ws + WS_WGU) + (size_t)l * NGU * DM, NGU, p.in[I_LN2] + l * DM, lds);
        conv_job<0>(p.in[I_WD] + (size_t)l * FF * DM, FF, DM, (bf16_t*)(ws + WS_WD) + (size_t)l * DM * FF, DM, nullptr, lds);
    }
    float* biasP = (float*)(ws + WS_BIAS);
    for (int i = my_bid() * NT + tid; i < DEPTH * NPAD; i += gridDim.x * NT) {
        const int l = i / NPAD, n = i % NPAD; const int sc = in_srccol(n);
        biasP[i] = sc >= 0 ? p.in[I_BIN][l * NIN + sc] : 0.f;
    }
    const float* x = p.in[I_X]; bf16_t* xb = (bf16_t*)(ws + WS_XB); float* ss = (float*)(ws + WS_SS);
    for (int m = my_bid() * 8 + wave; m < M; m += gridDim.x * 8) {
        const f32x4* xr = (const f32x4*)(x + (size_t)m * DM) + lane;
#pragma unroll
        for (int j = 0; j < 4; ++j) {
            const f32x4 v = xr[64 * j];
            float s = (v.x * v.x + v.y * v.y) + (v.z * v.z + v.w * v.w);
            s += __shfl_xor(s, 1); s += __shfl_xor(s, 2); s += __shfl_xor(s, 4); s += __shfl_xor(s, 8);
            if ((lane & 15) == 0) ss[(size_t)m * 16 + 4 * j + (lane >> 4)] = s;
            u32x2 o; o.x = pk2(v.x, v.y); o.y = pk2(v.z, v.w);
            *(u32x2*)(xb + (size_t)m * DM + 256 * j + 4 * lane) = o;
        }
    }
}

namespace pg8 {
#define PG8_LAS __attribute__((address_space(3)))
typedef short bf16x8 __attribute__((ext_vector_type(8)));
constexpr int BM = 256, BK = 64, HALF = 128, HTB = HALF * BK * 2  , STAGE_BYTES = 8 * HTB, NXCD = 8, WGM = 8;
__host__ __device__ __forceinline__ int lds_byte(int r, int c) { const int st = (r >> 4) * 2 + (c >> 5), rr = r & 15, cc = c & 31, ob = rr * 64 + cc * 2; return st * 1024 + (ob ^ (((ob >> 9) & 1) << 5)); }
__host__ __device__ __forceinline__ void stage_rc(int b, int& R, int& C) { const int st = b / 1024, sb = b % 1024, swz = sb ^ (((sb >> 9) & 1) << 5); R = (st >> 1) * 16 + swz / 64; C = (st & 1) * 32 + (swz % 64) / 2; }
__host__ __device__ __forceinline__ int perm32(int rho) { const int n = rho >> 4, i = rho & 15; return 8 * (i >> 2) + 4 * n + (i & 3); }
struct Unit { int pm, pn; };
struct Gemm { const bf16_t* A; const bf16_t* Bt; int M, N, K; };
struct StaticOrder {
    int nM, nN, nwg, G, c;
    __host__ __device__ void init(int M_, int N_, int G_, int c_) { nM = M_ / BM; nN = N_ / BM; nwg = nM * nN; G = G_; c = c_; }
    __host__ __device__ bool next(int i, Unit& u) const {
        const long L = (long)i * G + c; if (L >= nwg) return false;
        int wgid = (int)L; { const int q = nwg / NXCD, r = nwg % NXCD, xcd = wgid % NXCD, off = wgid / NXCD; wgid = (xcd < r ? xcd * (q + 1) : r * (q + 1) + (xcd - r) * q) + off; }
        const int nig = WGM * nN, gid = wgid / nig, fm = gid * WGM, gsz = (nM - fm) < WGM ? (nM - fm) : WGM;
        u.pm = fm + ((wgid % nig) % gsz); u.pn = (wgid % nig) / gsz; return true;
    }
    __device__ __forceinline__ void a_ready(const Unit&) const {}
    __device__ __forceinline__ void done(const Unit&) const {}
};
__device__ __forceinline__ unsigned cvt_pk_bf16(float lo, float hi) { unsigned r; asm volatile("v_cvt_pk_bf16_f32 %0, %1, %2" : "=v"(r) : "v"(lo), "v"(hi)); return r; }

__device__ __forceinline__ float row_rstd(const float* ss, int row, int fq) {
    const f32x4 pq = *(const f32x4*)(ss + (size_t)row * 16 + 4 * fq);
    float s = (pq.x + pq.y) + (pq.z + pq.w);
    s += __shfl_xor(s, 16); s += __shfl_xor(s, 32);
    return rsqrtf(s * (1.f / DM) + EPS);
}
struct EpiInT {
    static constexpr bool PERM = true, AFTER_DRAIN = false;
    const float* ss; const float* bias; bf16_t* proj; float* gates;
    __device__ __forceinline__ void operator()(const f32x4 (&acc)[2][2][4][2], const Unit& u, int wr, int wc, int fr, int fq) const {
        const int row0 = u.pm * BM + wr * 64 + fr, col0 = u.pn * BM + wc * 32 + 8 * fq;
        f32x4 bv[2][2];
#pragma unroll
        for (int bj = 0; bj < 2; ++bj)
#pragma unroll
            for (int n = 0; n < 2; ++n) bv[bj][n] = *(const f32x4*)(bias + col0 + bj * HALF + 4 * n);
#pragma unroll
        for (int ai = 0; ai < 2; ++ai)
#pragma unroll
            for (int m = 0; m < 4; ++m) {
                const int row = row0 + ai * HALF + m * 16;
                const float r = row_rstd(ss, row, fq);
                if (u.pn < 13) {
                    bf16_t* rowp = proj + (size_t)row * NPROJ + col0;
#pragma unroll
                    for (int bj = 0; bj < 2; ++bj) {
                        const f32x4 v0 = acc[ai][bj][m][0] * r + bv[bj][0], v1 = acc[ai][bj][m][1] * r + bv[bj][1];
                        u32x4 w; w.x = cvt_pk_bf16(v0[0], v0[1]); w.y = cvt_pk_bf16(v0[2], v0[3]); w.z = cvt_pk_bf16(v1[0], v1[1]); w.w = cvt_pk_bf16(v1[2], v1[3]);
                        *(u32x4*)(rowp + bj * HALF) = w;
                    }
                } else if (wc == 0) {
                    const f32x4 v0 = acc[ai][0][m][0] * r + bv[0][0], v1 = acc[ai][0][m][1] * r + bv[0][1];
                    float* gp = gates + (size_t)row * 32 + 8 * fq;
                    *(f32x4*)gp = v0; *(f32x4*)(gp + 4) = v1;
                }
            }
    }
};
struct EpiResT {
    static constexpr bool PERM = true, AFTER_DRAIN = false;
    const float* base; float* out; bf16_t* xb; float* ss;
    __device__ __forceinline__ void operator()(const f32x4 (&acc)[2][2][4][2], const Unit& u, int wr, int wc, int fr, int fq) const {
        const int row0 = u.pm * BM + wr * 64 + fr, col0 = u.pn * BM + wc * 32 + 8 * fq;
#pragma unroll
        for (int ai = 0; ai < 2; ++ai)
#pragma unroll
            for (int m = 0; m < 4; ++m) {
                const int row = row0 + ai * HALF + m * 16;
                const size_t off = (size_t)row * DM + col0;
                float sq = 0.f;
#pragma unroll
                for (int bj = 0; bj < 2; ++bj) {
                    const f32x4 x0 = *(const f32x4*)(base + off + bj * HALF) + acc[ai][bj][m][0];
                    const f32x4 x1 = *(const f32x4*)(base + off + bj * HALF + 4) + acc[ai][bj][m][1];
                    *(f32x4*)(out + off + bj * HALF) = x0; *(f32x4*)(out + off + bj * HALF + 4) = x1;
                    u32x4 w; w.x = cvt_pk_bf16(x0[0], x0[1]); w.y = cvt_pk_bf16(x0[2], x0[3]); w.z = cvt_pk_bf16(x1[0], x1[1]); w.w = cvt_pk_bf16(x1[2], x1[3]);
                    *(u32x4*)(xb + off + bj * HALF) = w;
                    sq += (x0[0] * x0[0] + x0[1] * x0[1]) + (x0[2] * x0[2] + x0[3] * x0[3]) + (x1[0] * x1[0] + x1[1] * x1[1]) + (x1[2] * x1[2] + x1[3] * x1[3]);
                }
                sq += __shfl_xor(sq, 16); sq += __shfl_xor(sq, 32);
                if (fq == 0) ss[(size_t)row * 16 + u.pn * 4 + wc] = sq;
                asm volatile("" ::: "memory");
            }
    }
};
struct EpiGUT {
    static constexpr bool PERM = true, AFTER_DRAIN = false;
    const float* ss; bf16_t* act;
    __device__ __forceinline__ void operator()(const f32x4 (&acc)[2][2][4][2], const Unit& u, int wr, int wc, int fr, int fq) const {
        const int row0 = u.pm * BM + wr * 64 + fr, hid0 = u.pn * HALF + wc * 32 + 8 * fq;
#pragma unroll
        for (int ai = 0; ai < 2; ++ai)
#pragma unroll
            for (int m = 0; m < 4; ++m) {
                const int row = row0 + ai * HALF + m * 16;
                const float r = row_rstd(ss, row, fq);
                float a[8];
#pragma unroll
                for (int n = 0; n < 2; ++n)
#pragma unroll
                    for (int j = 0; j < 4; ++j) {
                        const float g = acc[ai][0][m][n][j] * r, up = acc[ai][1][m][n][j] * r;
                        a[4 * n + j] = g * __builtin_amdgcn_rcpf(1.f + __builtin_amdgcn_exp2f(-1.4426950408889634f * g)) * up;
                    }
                u32x4 w; w.x = cvt_pk_bf16(a[0], a[1]); w.y = cvt_pk_bf16(a[2], a[3]); w.z = cvt_pk_bf16(a[4], a[5]); w.w = cvt_pk_bf16(a[6], a[7]);
                *(u32x4*)(act + (size_t)row * FF + hid0) = w;
            }
    }
};

template <class Epi, class Sched, bool ALIGN_EPI = false, bool SP2 = false>
__device__ __forceinline__ void gemm_phase(PG8_LAS unsigned char* lds, const Gemm g, const Sched& S, const Epi& E) {
    const int tid = my_tid(), wid = __builtin_amdgcn_readfirstlane(tid >> 6), lane = tid & 63, wr = wid >> 2, wc = wid & 3, fr = lane & 15, fq = lane >> 4;
    const int K = g.K, nt = K / BK;
    unsigned voffA[2], voffB[2];
#pragma unroll
    for (int i = 0; i < 2; ++i) { int R, C; stage_rc(tid * 16 + i * 8192, R, C); const int Rb = Epi::PERM ? ((R & ~31) + perm32(R & 31)) : R;
        voffA[i] = (unsigned)(R * K + C) * 2u; voffB[i] = (unsigned)(Rb * K + C) * 2u; }
    const size_t kstep = (size_t)(BK * 2);
    const size_t hstep = (size_t)HALF * K * 2;
    const size_t tstep = 2 * hstep;
    const unsigned ldsw = (unsigned)wid * 1024u;
    const int aoff = lds_byte(wr * 64 + fr, fq * 8), boff = lds_byte(wc * 32 + fr, fq * 8);
#define PG8_SA(b, h) (((b) * 2 + (h)) * HTB)
#define PG8_SB(b, h) ((4 + (b) * 2 + (h)) * HTB)
#define PG8_STAGE(bufoff, gbase, voff) do { _Pragma("unroll") for (int _i = 0; _i < 2; ++_i) \
        __builtin_amdgcn_global_load_lds((const unsigned*)((const char*)(gbase) + (voff)[_i]), (PG8_LAS unsigned*)(lds + (bufoff) + ldsw + _i * 8192), 16, 0, 0); } while (0)
#define PG8_LDA(dst, b, h) do { _Pragma("unroll") for (int m = 0; m < 4; ++m) _Pragma("unroll") for (int k = 0; k < 2; ++k) dst[m][k] = *(const PG8_LAS bf16x8*)(lds + PG8_SA(b, h) + aoff + m * 2048 + k * 1024); } while (0)
#define PG8_LDB(dst, b, h) do { _Pragma("unroll") for (int n = 0; n < 2; ++n) _Pragma("unroll") for (int k = 0; k < 2; ++k) dst[n][k] = *(const PG8_LAS bf16x8*)(lds + PG8_SB(b, h) + boff + n * 2048 + k * 1024); } while (0)
#define PG8_MMA(ai, bj, At, Bt) do { __builtin_amdgcn_s_setprio(1); _Pragma("unroll") for (int m = 0; m < 4; ++m) _Pragma("unroll") for (int n = 0; n < 2; ++n) _Pragma("unroll") for (int k = 0; k < 2; ++k) \
        acc[ai][bj][m][n] = __builtin_amdgcn_mfma_f32_16x16x32_bf16(Bt[n][k], At[m][k], acc[ai][bj][m][n], 0, 0, 0); __builtin_amdgcn_s_setprio(0); } while (0)
#define PG8_WAIT_V(n) asm volatile("s_waitcnt vmcnt(" #n ")" ::: "memory")
#define PG8_WAIT_L(n) asm volatile("s_waitcnt lgkmcnt(" #n ")" ::: "memory")
#define PG8_BAR __builtin_amdgcn_s_barrier()
#define PG8_SCHED __builtin_amdgcn_sched_barrier(0)
    Unit cur, nxt; int ui = 0;
    if (!S.next(0, cur)) return;
    f32x4 acc[2][2][4][2];
#pragma unroll
    for (int a = 0; a < 2; ++a)
#pragma unroll
        for (int b = 0; b < 2; ++b)
#pragma unroll
            for (int m = 0; m < 4; ++m)
#pragma unroll
                for (int n = 0; n < 2; ++n) acc[a][b][m][n] = (f32x4){0.f, 0.f, 0.f, 0.f};
    bf16x8 At[4][2], B0[2][2], B1[2][2];
    const char* cA = (const char*)g.A + (size_t)cur.pm * tstep; const char* cB = (const char*)g.Bt + (size_t)cur.pn * tstep;
    S.a_ready(cur);
    if constexpr (SP2) {
        PG8_STAGE(PG8_SB(0, 0), cB, voffB); PG8_STAGE(PG8_SB(0, 1), cB + hstep, voffB); PG8_STAGE(PG8_SA(0, 0), cA, voffA); PG8_STAGE(PG8_SA(0, 1), cA + hstep, voffA);
        if (wr == 1) PG8_BAR;
        PG8_WAIT_V(2); PG8_BAR;
        PG8_STAGE(PG8_SB(1, 0), cB + kstep, voffB); PG8_STAGE(PG8_SA(1, 0), cA + kstep, voffA); PG8_STAGE(PG8_SB(1, 1), cB + hstep + kstep, voffB);
        PG8_WAIT_V(6); PG8_BAR;
    } else {
        PG8_STAGE(PG8_SB(0, 0), cB, voffB); PG8_STAGE(PG8_SA(0, 0), cA, voffA); PG8_STAGE(PG8_SB(0, 1), cB + hstep, voffB); PG8_STAGE(PG8_SA(0, 1), cA + hstep, voffA);
        if (wr == 1) PG8_BAR;
        PG8_WAIT_V(4); PG8_BAR;
        PG8_STAGE(PG8_SB(1, 0), cB + kstep, voffB); PG8_STAGE(PG8_SA(1, 0), cA + kstep, voffA); PG8_STAGE(PG8_SB(1, 1), cB + hstep + kstep, voffB);
        PG8_WAIT_V(6); PG8_BAR;
    }
    for (;;) {
        const bool has_next = S.next(ui + 1, nxt);
        const char* nA = has_next ? (const char*)g.A + (size_t)nxt.pm * tstep : cA; const char* nB = has_next ? (const char*)g.Bt + (size_t)nxt.pn * tstep : cB;
        for (int t = 0; t < nt; t += 2) {
            const bool last = (t == nt - 2);
            const char* a1 = cA + (size_t)(t + 1) * kstep;
            const char* a2 = last ? nA : cA + (size_t)(t + 2) * kstep; const char* b2 = last ? nB : cB + (size_t)(t + 2) * kstep;
            const char* a3 = a2 + kstep; const char* b3 = b2 + kstep;
            if (last && has_next) S.a_ready(nxt);
            if constexpr (SP2) {
            PG8_LDB(B0, 0, 0); PG8_LDB(B1, 0, 1); PG8_SCHED; PG8_LDA(At, 0, 0); PG8_STAGE(PG8_SA(1, 1), a1 + hstep, voffA);
            PG8_WAIT_V(8); PG8_WAIT_L(0); PG8_BAR; PG8_MMA(0, 0, At, B0); PG8_MMA(0, 1, At, B1); PG8_BAR; PG8_SCHED;
            PG8_LDA(At, 0, 1); PG8_STAGE(PG8_SB(0, 0), b2, voffB); PG8_STAGE(PG8_SB(0, 1), b2 + hstep, voffB); PG8_STAGE(PG8_SA(0, 0), a2, voffA);
            PG8_WAIT_V(8); PG8_WAIT_L(0); PG8_BAR; PG8_MMA(1, 0, At, B0); PG8_MMA(1, 1, At, B1); PG8_BAR; PG8_SCHED;
            PG8_LDB(B0, 1, 0); PG8_LDB(B1, 1, 1); PG8_SCHED; PG8_LDA(At, 1, 0); PG8_STAGE(PG8_SA(0, 1), a2 + hstep, voffA);
            PG8_WAIT_V(8); PG8_WAIT_L(0); PG8_BAR; PG8_MMA(0, 0, At, B0); PG8_MMA(0, 1, At, B1); PG8_BAR; PG8_SCHED;
            PG8_LDA(At, 1, 1); PG8_STAGE(PG8_SB(1, 0), b3, voffB); PG8_STAGE(PG8_SB(1, 1), b3 + hstep, voffB); PG8_STAGE(PG8_SA(1, 0), a3, voffA);
            PG8_WAIT_V(8); PG8_WAIT_L(0); PG8_BAR; PG8_MMA(1, 0, At, B0); PG8_MMA(1, 1, At, B1); PG8_BAR; PG8_SCHED;
            } else {
            PG8_LDB(B0, 0, 0); PG8_SCHED; PG8_LDA(At, 0, 0); PG8_STAGE(PG8_SA(1, 1), a1 + hstep, voffA);
            PG8_WAIT_L(8); PG8_BAR; PG8_WAIT_L(0); PG8_MMA(0, 0, At, B0); PG8_BAR; PG8_SCHED;
            PG8_LDB(B1, 0, 1); PG8_STAGE(PG8_SB(0, 0), b2, voffB);
            PG8_BAR; PG8_WAIT_L(0); PG8_MMA(0, 1, At, B1); PG8_BAR;
            PG8_LDA(At, 0, 1); PG8_STAGE(PG8_SA(0, 0), a2, voffA);
            PG8_BAR; PG8_WAIT_L(0); PG8_MMA(1, 0, At, B0); PG8_BAR; PG8_SCHED;
            PG8_STAGE(PG8_SB(0, 1), b2 + hstep, voffB);
            PG8_WAIT_V(6); PG8_BAR; PG8_MMA(1, 1, At, B1); PG8_BAR;
            PG8_LDB(B0, 1, 0); PG8_SCHED; PG8_LDA(At, 1, 0); PG8_STAGE(PG8_SA(0, 1), a2 + hstep, voffA);
            PG8_WAIT_L(8); PG8_BAR; PG8_WAIT_L(0); PG8_MMA(0, 0, At, B0); PG8_BAR; PG8_SCHED;
            PG8_LDB(B1, 1, 1); PG8_STAGE(PG8_SB(1, 0), b3, voffB);
            PG8_BAR; PG8_WAIT_L(0); PG8_MMA(0, 1, At, B1); PG8_BAR;
            PG8_LDA(At, 1, 1); PG8_STAGE(PG8_SA(1, 0), a3, voffA);
            PG8_BAR; PG8_WAIT_L(0); PG8_MMA(1, 0, At, B0); PG8_BAR; PG8_SCHED;
            PG8_STAGE(PG8_SB(1, 1), b3 + hstep, voffB);
            PG8_WAIT_V(6); PG8_BAR; PG8_MMA(1, 1, At, B1); PG8_BAR;
            }
        }
        if constexpr (ALIGN_EPI) { if (wr == 0) PG8_BAR; }
        if constexpr (!Epi::AFTER_DRAIN) { E(acc, cur, wr, wc, fr, fq); S.done(cur); }
        if (!has_next) break;
#pragma unroll
        for (int a = 0; a < 2; ++a)
#pragma unroll
            for (int b = 0; b < 2; ++b)
#pragma unroll
                for (int m = 0; m < 4; ++m)
#pragma unroll
                    for (int n = 0; n < 2; ++n) acc[a][b][m][n] = (f32x4){0.f, 0.f, 0.f, 0.f};
        cur = nxt; cA = nA; cB = nB; ++ui;
        if constexpr (ALIGN_EPI) { if (wr == 1) PG8_BAR; }
    }
    PG8_WAIT_V(0);
    if constexpr (!ALIGN_EPI) { if (wr == 0) PG8_BAR; }
    PG8_BAR;
#undef PG8_SA
#undef PG8_SB
#undef PG8_STAGE
#undef PG8_LDA
#undef PG8_LDB
#undef PG8_MMA
#undef PG8_WAIT_V
#undef PG8_WAIT_L
#undef PG8_BAR
#undef PG8_SCHED
}
}

__device__ void phase_rowpass(const Params& p, int l) {
    unsigned char* ws = p.ws;
    bf16_t* proj = (bf16_t*)(ws + WS_PROJ); bf16_t* qkc = (bf16_t*)(ws + WS_XB);
    const float* qg = p.in[I_QG] + l * 64; const float* kg = p.in[I_KG] + l * 192;
    const float* cw = p.in[I_CW] + l * 4096; const float* cb = p.in[I_CB] + l * 1024;
    const int tid = my_tid(), lane = tid & 63, wave = tid >> 6;
    for (int m = my_bid() * 8 + wave; m < M; m += gridDim.x * 8) {
        const int t = m % SEQ;
        bf16_t* row = proj + (size_t)m * NPROJ;
        {
            const u32x4 raw = *(const u32x4*)(row + C_QA + lane * 8); float f[8]; unpack8(raw, f);
            float s = 0.f;
#pragma unroll
            for (int j = 0; j < 8; ++j) s += f[j] * f[j];
            s += __shfl_xor(s, 1); s += __shfl_xor(s, 2); s += __shfl_xor(s, 4);
            const float r = rsqrtf(s * (1.f / 64.f) + EPS);
            const int d0 = (lane & 7) * 8;
            u32x4 o; o.x = pk2(f[0] * r * qg[d0], f[1] * r * qg[d0 + 1]); o.y = pk2(f[2] * r * qg[d0 + 2], f[3] * r * qg[d0 + 3]);
            o.z = pk2(f[4] * r * qg[d0 + 4], f[5] * r * qg[d0 + 5]); o.w = pk2(f[6] * r * qg[d0 + 6], f[7] * r * qg[d0 + 7]);
            *(u32x4*)(row + C_QA + lane * 8) = o;
        }
        {
            const int which = lane >> 5, w4 = (lane & 31) * 4;
            bf16_t* pp = row + (which ? C_KW : C_KS) + w4;
            const u32x2 raw = *(const u32x2*)pp;
            float f[4] = {lo16(raw.x), hi16(raw.x), lo16(raw.y), hi16(raw.y)};
            float s = (f[0] * f[0] + f[1] * f[1]) + (f[2] * f[2] + f[3] * f[3]);
            s += __shfl_xor(s, 1); s += __shfl_xor(s, 2); s += __shfl_xor(s, 4); s += __shfl_xor(s, 8);
            const float r = rsqrtf(s * (1.f / 64.f) + EPS);
            const float* g = kg + (1 + which) * 64 + (w4 & 63);
            u32x2 o; o.x = pk2(f[0] * r * g[0], f[1] * r * g[1]); o.y = pk2(f[2] * r * g[2], f[3] * r * g[3]);
            *(u32x2*)pp = o;
        }
#pragma unroll
        for (int part = 0; part < 2; ++part) {
            const int c0 = part * 512 + lane * 8;
            float acc[8];
#pragma unroll
            for (int j = 0; j < 8; ++j) acc[j] = cb[c0 + j];
#pragma unroll
            for (int w = 0; w < 4; ++w) {
                if (t - 3 + w >= 0) {
                    const u32x4 raw = *(const u32x4*)(proj + (size_t)(m - 3 + w) * NPROJ + C_QB + c0); float f[8]; unpack8(raw, f);
#pragma unroll
                    for (int j = 0; j < 8; ++j) acc[j] += f[j] * cw[w * 1024 + c0 + j];
                }
            }
            const float sc = part ? 0.08838834764831845f : 1.f;
            float y[8];
#pragma unroll
            for (int j = 0; j < 8; ++j) y[j] = silu_f(acc[j]) * sc;
            u32x4 o; o.x = pk2(y[0], y[1]); o.y = pk2(y[2], y[3]); o.z = pk2(y[4], y[5]); o.w = pk2(y[6], y[7]);
            *(u32x4*)(qkc + (size_t)m * 1024 + c0) = o;
        }
    }
}

__device__ void phase_compress(const Params& p, int l, float* lds) {
    unsigned char* ws = p.ws;
    const bf16_t* proj = (const bf16_t*)(ws + WS_PROJ);
    const float* pe = p.in[I_PE] + (size_t)l * 2 * 2048; const float* w1 = p.in[I_W1] + (size_t)l * 2 * 2048 * 128; const float* w2 = p.in[I_W2] + (size_t)l * 2 * 128 * 64;
    const float* kg0 = p.in[I_KG] + l * 192;
    float* tok = lds;
    float* red = lds + 144 * 64;
    float* hidb = red + 4 * 8 * 128;
    const int tid = my_tid(), lane = tid & 63;
    for (int u = my_bid(); u < BATCH * 2 * 2 * 32; u += gridDim.x) {
        const int ib = u & 31, kv = (u >> 5) & 1, g = (u >> 6) & 1, b = u >> 7;
        const int i0 = ib * 8, ni = (NCMP - i0) < 8 ? (NCMP - i0) : 8;
        const int ntok = 16 * ni + 16;
        const int col = (kv ? C_VC : C_KC) + g * 64;
        __syncthreads();
        for (int e = tid; e < 144 * 64; e += NT) {
            const int tt = e >> 6, d = e & 63;
            tok[e] = tt < ntok ? bf2f(proj[(size_t)(b * SEQ + 16 * i0 + tt) * NPROJ + col + d]) : 0.f;
        }
        __syncthreads();
        {
            const int hid = tid & 127, part = tid >> 7;
            float acc[8], accP = 0.f;
#pragma unroll
            for (int ii = 0; ii < 8; ++ii) acc[ii] = 0.f;
            const float* w1p = w1 + (size_t)kv * 2048 * 128 + hid; const float* pep = pe + kv * 2048;
#pragma unroll 2
            for (int f = part * 512; f < part * 512 + 512; ++f) {
                const float w = w1p[(size_t)f * 128];
                accP += w * pep[f];
#pragma unroll
                for (int ii = 0; ii < 8; ++ii) acc[ii] += w * tok[16 * 64 * ii + f];
            }
#pragma unroll
            for (int ii = 0; ii < 8; ++ii) red[(part * 8 + ii) * 128 + hid] = acc[ii] + accP;
        }
        __syncthreads();
        for (int e = tid; e < 8 * 128; e += NT) {
            const float s = (red[e] + red[1024 + e]) + (red[2048 + e] + red[3072 + e]);
            hidb[e] = silu_f(s);
        }
        __syncthreads();
        {
            const int ii = tid >> 6, d = lane;
            float o = 0.f;
            const float* w2p = w2 + (size_t)kv * 128 * 64 + d;
            for (int h = 0; h < 128; ++h) o += hidb[ii * 128 + h] * w2p[h * 64];
            if (kv == 0) { const float s = wave_sum(o * o); o = o * rsqrtf(s * (1.f / 64.f) + EPS) * kg0[d]; }
            bf16_t* dst = (bf16_t*)(ws + (kv ? WS_VCMP : WS_KCMP));
            if (ii < ni) dst[(size_t)((b * 2 + g) * NCMPP + i0 + ii) * 64 + d] = f2bf(o);
        }
    }
    __syncthreads();
}

__device__ __forceinline__ float log_sigmoid_f(float x) { return fminf(x, 0.f) - log1pf(__expf(-fabsf(x))); }
__device__ void mlstm_gates(const float* gates, const float* fb, int m0, int h, float* bcum, float* ig) {
    const int tid = my_tid();
    __syncthreads();
    if (tid < 64) {
        const float lf = log_sigmoid_f(gates[(size_t)(m0 + tid) * 32 + 28 + h] + fb[h]);
        ig[tid] = gates[(size_t)(m0 + tid) * 32 + 24 + h];
        float v = lf;
#pragma unroll
        for (int o = 1; o < 64; o <<= 1) { const float t = __shfl_up(v, o); if (tid >= o) v += t; }
        bcum[tid] = v;
    }
    __syncthreads();
}

__device__ void phase_chunkstate(const Params& p, int l, float* lds) {
    unsigned char* ws = p.ws;
    const bf16_t* proj = (const bf16_t*)(ws + WS_PROJ); const float* gates = (const float*)(ws + WS_GATES);
    const float* cw = p.in[I_CW] + l * 4096; const float* cb = p.in[I_CB] + l * 1024; const float* fb = p.in[I_FB] + l * 4;
    bf16_t* ST = (bf16_t*)(ws + WS_ST); float* STN = (float*)(ws + WS_STN); float* STM = (float*)(ws + WS_STM);
    float* kw = lds;
    float* vv = lds + 8192;
    float* bcum = lds + 16384; float* ig = bcum + 64; float* wsc = ig + 64; float* misc = wsc + 64;
    const int tid = my_tid();
    for (int u = my_bid(); u < BATCH * 4 * 64; u += gridDim.x) {
        const int c = u & 63, h = (u >> 6) & 3, b = u >> 8;
        const int m0 = b * SEQ + c * 64, bh = b * 4 + h;
        mlstm_gates(gates, fb, m0, h, bcum, ig);
        if (tid < 64) {
            const float gv = bcum[63] - bcum[tid] + ig[tid];
            const float mx = wave_max(gv);
            wsc[tid] = __expf(gv - mx);
            if (tid == 0) { misc[0] = mx; STM[bh * 64 + c] = mx; STM[2048 + bh * 64 + c] = bcum[63]; }
        }
        __syncthreads();
        for (int e = tid; e < 64 * 16; e += NT) {
            const int s = e >> 4, d0 = (e & 15) * 8;
            const int t = c * 64 + s, ch = 512 + h * 128 + d0;
            float acc[8];
#pragma unroll
            for (int j = 0; j < 8; ++j) acc[j] = cb[ch + j];
#pragma unroll
            for (int w = 0; w < 4; ++w) {
                if (t - 3 + w >= 0) {
                    const u32x4 raw = *(const u32x4*)(proj + (size_t)(m0 + s - 3 + w) * NPROJ + C_QB + ch); float f[8]; unpack8(raw, f);
#pragma unroll
                    for (int j = 0; j < 8; ++j) acc[j] += f[j] * cw[w * 1024 + ch + j];
                }
            }
            const float sc = 0.08838834764831845f * wsc[s];
#pragma unroll
            for (int j = 0; j < 8; ++j) kw[s * 128 + d0 + j] = silu_f(acc[j]) * sc;
            const u32x4 rv = *(const u32x4*)(proj + (size_t)(m0 + s) * NPROJ + C_VB + h * 128 + d0); float fv[8]; unpack8(rv, fv);
#pragma unroll
            for (int j = 0; j < 8; ++j) vv[s * 128 + d0 + j] = fv[j];
        }
        __syncthreads();
        {
            const int e0 = (tid >> 4) * 4, d0 = (tid & 15) * 8;
            float acc[4][8];
#pragma unroll
            for (int i = 0; i < 4; ++i)
#pragma unroll
                for (int j = 0; j < 8; ++j) acc[i][j] = 0.f;
#pragma unroll 2
            for (int s = 0; s < 64; ++s) {
                const f32x4 ve = *(const f32x4*)(vv + s * 128 + e0);
                const f32x4 k0 = *(const f32x4*)(kw + s * 128 + d0), k1 = *(const f32x4*)(kw + s * 128 + d0 + 4);
                const float va[4] = {ve.x, ve.y, ve.z, ve.w}; const float ka[8] = {k0.x, k0.y, k0.z, k0.w, k1.x, k1.y, k1.z, k1.w};
#pragma unroll
                for (int i = 0; i < 4; ++i)
#pragma unroll
                    for (int j = 0; j < 8; ++j) acc[i][j] += va[i] * ka[j];
            }
#pragma unroll
            for (int i = 0; i < 4; ++i) {
                u32x4 o; o.x = pk2(acc[i][0], acc[i][1]); o.y = pk2(acc[i][2], acc[i][3]); o.z = pk2(acc[i][4], acc[i][5]); o.w = pk2(acc[i][6], acc[i][7]);
                *(u32x4*)(ST + ((size_t)(bh * 64 + c) * 128 + e0 + i) * 128 + d0) = o;
            }
        }
        if (tid < 128) {
            float s = 0.f;
            for (int q = 0; q < 64; ++q) s += kw[q * 128 + tid];
            STN[(size_t)(bh * 64 + c) * 128 + tid] = s;
        }
    }
    __syncthreads();
}

__device__ void phase_scan(const Params& p) {
    unsigned char* ws = p.ws;
    bf16_t* ST = (bf16_t*)(ws + WS_ST); float* STN = (float*)(ws + WS_STN); float* STM = (float*)(ws + WS_STM);
    const int tid = my_tid();
    for (int u = my_bid(); u < 128; u += gridDim.x) {
        const int bh = u >> 2, idx = ((u & 3) * NT + tid) * 8;
        float C[8];
#pragma unroll
        for (int j = 0; j < 8; ++j) C[j] = 0.f;
        float nval = 0.f; const bool do_n = (u & 3) == 0 && tid < 128;
        float m = 0.f;
        for (int c = 0; c < 64; ++c) {
            const float mloc = STM[bh * 64 + c], bl = STM[2048 + bh * 64 + c];
            const float mnew = fmaxf(bl + m, mloc);
            const float decay = __expf(bl + m - mnew), scale = __expf(mloc - mnew);
            bf16_t* sp = ST + (size_t)(bh * 64 + c) * 16384 + idx;
            const u32x4 raw = *(const u32x4*)sp; float f[8]; unpack8(raw, f);
            u32x4 o; o.x = pk2(C[0], C[1]); o.y = pk2(C[2], C[3]); o.z = pk2(C[4], C[5]); o.w = pk2(C[6], C[7]);
            *(u32x4*)sp = o;
#pragma unroll
            for (int j = 0; j < 8; ++j) C[j] = decay * C[j] + scale * f[j];
            if (do_n) {
                float* np = STN + (size_t)(bh * 64 + c) * 128 + tid;
                const float dn = *np; *np = nval; nval = decay * nval + scale * dn;
            }
            if ((u & 3) == 0 && tid == 0) STM[4096 + bh * 64 + c] = m;
            m = mnew;
        }
    }
}

__device__ void phase_attn_naive(const Params& p, int l, float* lds) {
    unsigned char* ws = p.ws;
    const bf16_t* proj = (const bf16_t*)(ws + WS_PROJ); const float* gates = (const float*)(ws + WS_GATES);
    const bf16_t* kcmp = (const bf16_t*)(ws + WS_KCMP); const bf16_t* vcmp = (const bf16_t*)(ws + WS_VCMP);
    bf16_t* Y = (bf16_t*)(ws + WS_Y);
    const float* oga = p.in[I_OGA] + l * 512;
    const int tid = my_tid(), lane = tid & 63, wave = tid >> 6;
    float* qs = lds + wave * (256 + 1024);
    float* pb = qs + 256;
    for (int u = my_bid(); u < BATCH * 2 * (SEQ / 8); u += gridDim.x) {
        const int tb = u % (SEQ / 8), g = (u / (SEQ / 8)) & 1, b = u / (SEQ / 4);
        const int t = tb * 8 + wave; const int m = b * SEQ + t;
        const bf16_t* prow = proj + (size_t)m * NPROJ;
#pragma unroll
        for (int hg = 0; hg < 4; ++hg) qs[hg * 64 + lane] = bf2f(prow[C_QA + g * 256 + hg * 64 + lane]);
        float otot[4] = {0.f, 0.f, 0.f, 0.f};
        const float* gt = gates + (size_t)m * 32 + g * 12;
        const int nval = t >= 31 ? ((t - 31) >> 4) + 1 : 0;
        float sc[4][4];
        float mx[4] = {-INFINITY, -INFINITY, -INFINITY, -INFINITY};
        const bf16_t* kc = kcmp + (size_t)(b * 2 + g) * NCMPP * 64; const bf16_t* vc = vcmp + (size_t)(b * 2 + g) * NCMPP * 64;
#pragma unroll
        for (int it = 0; it < 4; ++it) {
            asm volatile("" ::: "memory");
            const int i = it * 64 + lane;
            float a[4] = {0.f, 0.f, 0.f, 0.f};
            if (i < nval) {
#pragma unroll 1
                for (int d8 = 0; d8 < 8; ++d8) {
                    const u32x4 raw = *(const u32x4*)(kc + (size_t)i * 64 + d8 * 8); float f[8]; unpack8(raw, f);
#pragma unroll
                    for (int j = 0; j < 8; ++j)
#pragma unroll
                        for (int hg = 0; hg < 4; ++hg) a[hg] += qs[hg * 64 + d8 * 8 + j] * f[j];
                }
            }
#pragma unroll
            for (int hg = 0; hg < 4; ++hg) { sc[it][hg] = i < nval ? a[hg] * 0.125f : -INFINITY; mx[hg] = fmaxf(mx[hg], sc[it][hg]); }
        }
        float sm[4];
#pragma unroll
        for (int hg = 0; hg < 4; ++hg) {
            mx[hg] = wave_max(mx[hg]);
            float s = 0.f;
#pragma unroll
            for (int it = 0; it < 4; ++it) { const float e = (it * 64 + lane) < nval ? __expf(sc[it][hg] - mx[hg]) : 0.f; sc[it][hg] = e; s += e; }
            sm[hg] = wave_sum(s);
        }
#pragma unroll
        for (int it = 0; it < 4; ++it)
#pragma unroll
            for (int hg = 0; hg < 4; ++hg) pb[hg * 256 + it * 64 + lane] = nval > 0 ? sc[it][hg] / sm[hg] : 0.f;
        {
            float o[4] = {0.f, 0.f, 0.f, 0.f};
            for (int i = 0; i < nval; ++i) {
                const float v = bf2f(vc[(size_t)i * 64 + lane]);
#pragma unroll
                for (int hg = 0; hg < 4; ++hg) o[hg] += pb[hg * 256 + i] * v;
            }
#pragma unroll
            for (int hg = 0; hg < 4; ++hg) otot[hg] += sigmoid_f(gt[hg * 3 + 0]) * o[hg];
        }
        const int cur = t >> 6;
        float imp = 0.f;
#pragma unroll
        for (int k = -1; k < 4; ++k) {
            const int i = 4 * lane + k;
            if (i >= 0 && i < nval) imp += (pb[i] + pb[256 + i]) + (pb[512 + i] + pb[768 + i]);
        }
        const bool valid = lane <= cur;
        const bool forced = (lane == 0) || (lane == cur) || (lane == cur - 1);
        const float score = valid ? imp + (forced ? 1e4f : 0.f) : -1e30f;
        int rank = 0;
        for (int k = 0; k < 64; ++k) {
            const float sk = __shfl(score, k);
            rank += (sk > score || (sk == score && k < lane)) ? 1 : 0;
        }
        const unsigned long long selmask = __ballot(rank < 16 && valid);
#pragma unroll 1
        for (int br = 0; br < 2; ++br) {
            const int kcol = (br ? C_KW : C_KS) + g * 64, vcol = (br ? C_VW : C_VS) + g * 64;
            float mr[4] = {-INFINITY, -INFINITY, -INFINITY, -INFINITY}, lr[4] = {0.f, 0.f, 0.f, 0.f}, o[4] = {0.f, 0.f, 0.f, 0.f};
            const int jlo = br ? (cur >= 8 ? cur - 8 : 0) : 0;
            for (int j = jlo; j <= cur; ++j) {
                if (br == 0 && !((selmask >> j) & 1ull)) continue;
                asm volatile("" ::: "memory");
                const int pos = j * 64 + lane;
                const bool ok = pos <= t && (br == 0 || pos > t - 512);
                float a[4] = {0.f, 0.f, 0.f, 0.f};
                const bf16_t* kr = proj + (size_t)(b * SEQ + pos) * NPROJ + kcol;
#pragma unroll 1
                for (int d8 = 0; d8 < 8; ++d8) {
                    const u32x4 raw = *(const u32x4*)(kr + d8 * 8); float f[8]; unpack8(raw, f);
#pragma unroll
                    for (int jj = 0; jj < 8; ++jj)
#pragma unroll
                        for (int hg = 0; hg < 4; ++hg) a[hg] += qs[hg * 64 + d8 * 8 + jj] * f[jj];
                }
                float alpha[4];
#pragma unroll
                for (int hg = 0; hg < 4; ++hg) {
                    const float s = ok ? a[hg] * 0.125f : -INFINITY;
                    const float bm = wave_max(s);
                    const float mn = fmaxf(mr[hg], bm);
                    alpha[hg] = (mn == -INFINITY) ? 1.f : __expf(mr[hg] - mn);
                    const float e = (ok && mn > -INFINITY) ? __expf(s - mn) : 0.f;
                    lr[hg] = lr[hg] * alpha[hg] + wave_sum(e);
                    mr[hg] = mn;
                    pb[hg * 256 + lane] = e;
                    o[hg] *= alpha[hg];
                }
                const bf16_t* vr = proj + (size_t)(b * SEQ + j * 64) * NPROJ + vcol + lane;
                for (int k = 0; k < 64; ++k) {
                    const float v = bf2f(vr[(size_t)k * NPROJ]);
#pragma unroll
                    for (int hg = 0; hg < 4; ++hg) o[hg] += pb[hg * 256 + k] * v;
                }
            }
#pragma unroll
            for (int hg = 0; hg < 4; ++hg) otot[hg] += sigmoid_f(gt[hg * 3 + 1 + br]) * (lr[hg] > 0.f ? o[hg] / lr[hg] : 0.f);
        }
#pragma unroll
        for (int hg = 0; hg < 4; ++hg) {
            const float s = wave_sum(otot[hg] * otot[hg]);
            const float y = otot[hg] * rsqrtf(s * (1.f / 64.f) + EPS) * oga[(g * 4 + hg) * 64 + lane];
            Y[(size_t)m * 1024 + (g * 4 + hg) * 64 + lane] = f2bf(y);
        }
    }
}

namespace att {
typedef short bf16x8 __attribute__((ext_vector_type(8)));
typedef short s16x4 __attribute__((ext_vector_type(4)));
typedef float f32x16 __attribute__((ext_vector_type(16)));
#define ATT_LAS __attribute__((address_space(3)))
constexpr int L_K = 0, L_V = 16384, L_IMP = 32768, IMP_STRIDE = 65, L_SEL = L_IMP + 4 * 64 * IMP_STRIDE * 4, L_INV = L_SEL + 512, L_WS = L_INV + 1024, L_OST = L_WS + 8 * 256, L_END = L_OST + 8 * 4096;
static_assert(L_END <= LDS_BYTES, "attention LDS map");
constexpr float LOG2E = 1.4426950408889634f;
__device__ __forceinline__ int crow(int r, int hi) { return (r & 3) + 8 * (r >> 2) + 4 * hi; }
__device__ __forceinline__ unsigned cvtpk(float lo, float hi) { unsigned r; asm("v_cvt_pk_bf16_f32 %0, %1, %2" : "=v"(r) : "v"(lo), "v"(hi)); return r; }
__device__ __forceinline__ s16x4 vtr(ATT_LAS const unsigned char* p) { return __builtin_bit_cast(s16x4, __builtin_amdgcn_ds_read_tr16_b64_v4i16((ATT_LAS s16x4*)p)); }

struct Ctx {
    ATT_LAS unsigned char* lds;
    int lane, wave, r32, hi;
    u32x4 kreg, vreg;
};
__device__ __forceinline__ void tile_load(Ctx& C, const bf16_t* kbase, const bf16_t* vbase, int pitch) {
    C.kreg = *(const u32x4*)(kbase + (size_t)C.lane * pitch + C.wave * 8);
    C.vreg = *(const u32x4*)(vbase + (size_t)(16 * (C.wave & 3) + (C.lane >> 2)) * pitch + (C.wave >> 2) * 32 + (C.lane & 3) * 8);
}
__device__ __forceinline__ void tile_store(Ctx& C, int buf) {
    *(ATT_LAS u32x4*)(C.lds + L_K + buf * 8192 + C.wave * 1024 + C.lane * 16) = C.kreg;
    *(ATT_LAS u32x4*)(C.lds + L_V + buf * 8192 + C.wave * 1024 + C.lane * 16) = C.vreg;
}
__device__ __forceinline__ void qkt(const Ctx& C, int buf, const bf16x8 (&qr)[4], f32x16& p0, f32x16& p1) {
    ATT_LAS const unsigned char* kb = C.lds + L_K + buf * 8192 + C.hi * 1024 + C.r32 * 16;
    p0 = (f32x16){0.f, 0.f, 0.f, 0.f, 0.f, 0.f, 0.f, 0.f, 0.f, 0.f, 0.f, 0.f, 0.f, 0.f, 0.f, 0.f}; p1 = p0;
#pragma unroll
    for (int d0 = 0; d0 < 4; ++d0) {
        const bf16x8 b0 = *(ATT_LAS const bf16x8*)(kb + d0 * 2048);
        const bf16x8 b1 = *(ATT_LAS const bf16x8*)(kb + d0 * 2048 + 512);
        p0 = __builtin_amdgcn_mfma_f32_32x32x16_bf16(b0, qr[d0], p0, 0, 0, 0);
        p1 = __builtin_amdgcn_mfma_f32_32x32x16_bf16(b1, qr[d0], p1, 0, 0, 0);
    }
}
__device__ __forceinline__ void pv(const Ctx& C, int buf, const f32x16& p0, const f32x16& p1, f32x16 (&o)[2]) {
    ATT_LAS const unsigned char* vp = C.lds + L_V + buf * 8192 + ((C.lane >> 4) & 1) * 32 + (C.lane & 3) * 8 + (4 * C.hi + ((C.lane & 15) >> 2)) * 64;
    bf16x8 pa[4];
#pragma unroll
    for (int s2 = 0; s2 < 2; ++s2) {
        u32x4 w0, w1;
        w0.x = cvtpk(p0[8 * s2 + 0], p0[8 * s2 + 1]); w0.y = cvtpk(p0[8 * s2 + 2], p0[8 * s2 + 3]); w0.z = cvtpk(p0[8 * s2 + 4], p0[8 * s2 + 5]); w0.w = cvtpk(p0[8 * s2 + 6], p0[8 * s2 + 7]);
        w1.x = cvtpk(p1[8 * s2 + 0], p1[8 * s2 + 1]); w1.y = cvtpk(p1[8 * s2 + 2], p1[8 * s2 + 3]); w1.z = cvtpk(p1[8 * s2 + 4], p1[8 * s2 + 5]); w1.w = cvtpk(p1[8 * s2 + 6], p1[8 * s2 + 7]);
        pa[s2] = __builtin_bit_cast(bf16x8, w0); pa[2 + s2] = __builtin_bit_cast(bf16x8, w1);
    }
#pragma unroll
    for (int d0 = 0; d0 < 2; ++d0)
#pragma unroll
        for (int ks = 0; ks < 4; ++ks) {
            const s16x4 lo = vtr(vp + d0 * 4096 + ks * 1024), hh = vtr(vp + d0 * 4096 + ks * 1024 + 512);
            const bf16x8 vf = (bf16x8){lo[0], lo[1], lo[2], lo[3], hh[0], hh[1], hh[2], hh[3]};
            o[d0] = __builtin_amdgcn_mfma_f32_32x32x16_bf16(pa[ks], vf, o[d0], 0, 0, 0);
        }
}
__device__ __forceinline__ float sum16(const f32x16& p) {
    return ((p[0] + p[1]) + (p[2] + p[3])) + ((p[4] + p[5]) + (p[6] + p[7])) + (((p[8] + p[9]) + (p[10] + p[11])) + ((p[12] + p[13]) + (p[14] + p[15])));
}
__device__ __forceinline__ void accum_scaled(const Ctx& C, f32x16 (&otot)[2], const f32x16 (&o)[2], float fac) {
    ATT_LAS float* wsf = (ATT_LAS float*)(C.lds + L_WS) + C.wave * 64;
    asm volatile("s_waitcnt lgkmcnt(0)" ::: "memory");
    if (C.hi == 0) wsf[C.r32] = fac;
    asm volatile("s_waitcnt lgkmcnt(0)" ::: "memory");
#pragma unroll
    for (int r = 0; r < 16; ++r) { const float f = wsf[crow(r, C.hi)]; otot[0][r] += o[0][r] * f; otot[1][r] += o[1][r] * f; }
    asm volatile("s_waitcnt lgkmcnt(0)" : "+v"(otot[0]), "+v"(otot[1]) :: "memory");
}

__device__ void unit(const Params& p, int l, int b, int g, int c, ATT_LAS unsigned char* lds) {
    unsigned char* ws = p.ws;
    const bf16_t* proj = (const bf16_t*)(ws + WS_PROJ); const float* gates = (const float*)(ws + WS_GATES);
    const bf16_t* kcmp = (const bf16_t*)(ws + WS_KCMP) + (size_t)(b * 2 + g) * NCMPP * 64; const bf16_t* vcmp = (const bf16_t*)(ws + WS_VCMP) + (size_t)(b * 2 + g) * NCMPP * 64;
    bf16_t* Y = (bf16_t*)(ws + WS_Y);
    const float* kg = p.in[I_KG] + l * 192; const float* oga = p.in[I_OGA] + l * 512;
    Ctx C; C.lds = lds;
    const int tid = my_tid(); C.lane = tid & 63; C.wave = __builtin_amdgcn_readfirstlane(tid >> 6); C.r32 = C.lane & 31; C.hi = C.lane >> 5;
    const int lane = C.lane, wave = C.wave, r32 = C.r32, hi = C.hi, hg = wave >> 1, th = wave & 1;
    const int t = 64 * c + 32 * th + r32; const size_t m = (size_t)b * SEQ + t;
    const bf16_t* prow0 = proj + (size_t)b * SEQ * NPROJ;
    bf16x8 qr[4]; float qsq = 0.f;
#pragma unroll
    for (int d0 = 0; d0 < 4; ++d0) {
        const u32x4 raw = *(const u32x4*)(proj + m * NPROJ + C_QA + g * 256 + hg * 64 + 16 * d0 + 8 * hi);
        qr[d0] = __builtin_bit_cast(bf16x8, raw);
        float f[8]; unpack8(raw, f);
#pragma unroll
        for (int j = 0; j < 8; ++j) qsq += f[j] * f[j];
    }
    qsq += __shfl_xor(qsq, 32);
    const float qn = sqrtf(qsq) * 1.01f * LOG2E;
    const float off_c = qn * wave_max(fabsf(kg[lane])), off_s = qn * wave_max(fabsf(kg[64 + lane])), off_w = qn * wave_max(fabsf(kg[128 + lane]));
    const float* gt = gates + m * 32 + (g * 4 + hg) * 3;
    const float gq0 = sigmoid_f(gt[0]), gq1 = sigmoid_f(gt[1]), gq2 = sigmoid_f(gt[2]);
    constexpr float C2 = 0.125f * LOG2E;
    f32x16 otot[2]; otot[0] = (f32x16){0.f, 0.f, 0.f, 0.f, 0.f, 0.f, 0.f, 0.f, 0.f, 0.f, 0.f, 0.f, 0.f, 0.f, 0.f, 0.f}; otot[1] = otot[0];
    const f32x16 zero16 = otot[0];
    {
        const int nval = t >= 31 ? ((t - 31) >> 4) + 1 : 0;
        const int ntc = (4 * c + 3 + 63) >> 6;
        f32x16 o[2]; o[0] = zero16; o[1] = zero16;
        float lsum = 0.f, yprev = 0.f;
        ATT_LAS float* imp = (ATT_LAS float*)(lds + L_IMP) + (hg * 64 + 32 * th + r32) * IMP_STRIDE;
        tile_load(C, kcmp, vcmp, 64); tile_store(C, 0); __syncthreads();
#pragma unroll
        for (int jt = 0; jt < 4; ++jt) {
            if (jt < ntc) {
                if (jt + 1 < ntc) tile_load(C, kcmp + (size_t)(jt + 1) * 64 * 64, vcmp + (size_t)(jt + 1) * 64 * 64, 64);
                f32x16 p0, p1; qkt(C, jt & 1, qr, p0, p1);
#pragma unroll
                for (int r = 0; r < 16; ++r) {
                    const int i0 = 64 * jt + crow(r, hi);
                    p0[r] = i0 < nval ? __builtin_amdgcn_exp2f(p0[r] * C2 - off_c) : 0.f;
                    p1[r] = i0 + 32 < nval ? __builtin_amdgcn_exp2f(p1[r] * C2 - off_c) : 0.f;
                }
                lsum += sum16(p0) + sum16(p1);
#pragma unroll
                for (int H = 0; H < 2; ++H)
#pragma unroll
                    for (int rr = 0; rr < 4; ++rr) {
                        const f32x16& pp = H ? p1 : p0;
                        const float L = pp[4 * rr + 3], S4 = (pp[4 * rr] + pp[4 * rr + 1]) + (pp[4 * rr + 2] + L);
                        const float y = __shfl_xor(L, 32);
                        imp[2 * ((jt * 2 + H) * 4 + rr) + hi] = S4 + (hi ? y : yprev);
                        yprev = y;
                    }
                pv(C, jt & 1, p0, p1, o);
                if (jt + 1 < ntc) tile_store(C, (jt + 1) & 1);
                __syncthreads();
            }
        }
        lsum += __shfl_xor(lsum, 32);
        const float inv = lsum > 0.f ? 1.f / lsum : 0.f;
        if (hi == 0) ((ATT_LAS float*)(lds + L_INV))[hg * 64 + 32 * th + r32] = inv;
        accum_scaled(C, otot, o, gq0 * inv);
    }
    __syncthreads();
    {
        ATT_LAS unsigned long long* selm = (ATT_LAS unsigned long long*)(lds + L_SEL);
        const ATT_LAS float* impb = (const ATT_LAS float*)(lds + L_IMP);
        for (int i = 0; i < 8; ++i) {
            const int q = wave * 8 + i;
            unsigned long long msk;
            if (c < 16) msk = (2ull << c) - 1ull;
            else {
                const bool valid = lane <= c;
                float sc = -1e30f;
                if (valid) {
                    const ATT_LAS float* invb = (const ATT_LAS float*)(lds + L_INV);
                    sc = (impb[(0 * 64 + q) * IMP_STRIDE + lane] * invb[q] + impb[(1 * 64 + q) * IMP_STRIDE + lane] * invb[64 + q]) + (impb[(2 * 64 + q) * IMP_STRIDE + lane] * invb[128 + q] + impb[(3 * 64 + q) * IMP_STRIDE + lane] * invb[192 + q]);
                    if (lane == 0 || lane == c || lane == c - 1) sc += 1e4f;
                }
                int rank = 0;
                for (int k = 0; k <= c; ++k) { const float sk = __shfl(sc, k); rank += (sk > sc || (sk == sc && k < lane)) ? 1 : 0; }
                msk = __ballot(valid && rank < 16);
            }
            if (lane == 0) selm[q] = msk;
        }
    }
    __syncthreads();
    const unsigned long long mysel = ((ATT_LAS const unsigned long long*)(lds + L_SEL))[32 * th + r32];
    unsigned long long blkmask;
    {
        unsigned long long v = ((ATT_LAS const unsigned long long*)(lds + L_SEL))[lane];
#pragma unroll
        for (int o2 = 1; o2 < 64; o2 <<= 1) v |= __shfl_xor(v, o2);
        blkmask = ((unsigned long long)__builtin_amdgcn_readfirstlane((unsigned)(v >> 32)) << 32) | (unsigned)__builtin_amdgcn_readfirstlane((unsigned)v);
    }
    {
        f32x16 o[2]; o[0] = zero16; o[1] = zero16; float lsum = 0.f;
        const bf16_t* kb = prow0 + C_KS + g * 64; const bf16_t* vb = prow0 + C_VS + g * 64;
        unsigned long long rem = blkmask;
        int j = __builtin_ctzll(rem); rem &= rem - 1ull;
        tile_load(C, kb + (size_t)j * 64 * NPROJ, vb + (size_t)j * 64 * NPROJ, NPROJ); tile_store(C, 0); __syncthreads();
        int buf = 0;
        for (;;) {
            const int jn = rem ? __builtin_ctzll(rem) : -1;
            if (jn >= 0) { rem &= rem - 1ull; tile_load(C, kb + (size_t)jn * 64 * NPROJ, vb + (size_t)jn * 64 * NPROJ, NPROJ); }
            f32x16 p0, p1; qkt(C, buf, qr, p0, p1);
            const bool sel = (mysel >> j) & 1ull;
            const int lim = t - 64 * j;
#pragma unroll
            for (int r = 0; r < 16; ++r) {
                const int kk = crow(r, hi);
                p0[r] = (sel && kk <= lim) ? __builtin_amdgcn_exp2f(p0[r] * C2 - off_s) : 0.f;
                p1[r] = (sel && kk + 32 <= lim) ? __builtin_amdgcn_exp2f(p1[r] * C2 - off_s) : 0.f;
            }
            lsum += sum16(p0) + sum16(p1);
            pv(C, buf, p0, p1, o);
            if (jn >= 0) tile_store(C, buf ^ 1);
            __syncthreads();
            if (jn < 0) break;
            j = jn; buf ^= 1;
        }
        lsum += __shfl_xor(lsum, 32);
        accum_scaled(C, otot, o, gq1 / lsum);
    }
    {
        f32x16 o[2]; o[0] = zero16; o[1] = zero16; float lsum = 0.f;
        const bf16_t* kb = prow0 + C_KW + g * 64; const bf16_t* vb = prow0 + C_VW + g * 64;
        const int jlo = c >= 8 ? c - 8 : 0;
        tile_load(C, kb + (size_t)jlo * 64 * NPROJ, vb + (size_t)jlo * 64 * NPROJ, NPROJ); tile_store(C, 0); __syncthreads();
        int buf = 0;
        for (int j = jlo; j <= c; ++j) {
            if (j < c) tile_load(C, kb + (size_t)(j + 1) * 64 * NPROJ, vb + (size_t)(j + 1) * 64 * NPROJ, NPROJ);
            f32x16 p0, p1; qkt(C, buf, qr, p0, p1);
            const int lim = t - 64 * j;
#pragma unroll
            for (int r = 0; r < 16; ++r) {
                const int kk = crow(r, hi);
                p0[r] = (kk <= lim && kk > lim - 512) ? __builtin_amdgcn_exp2f(p0[r] * C2 - off_w) : 0.f;
                p1[r] = (kk + 32 <= lim && kk + 32 > lim - 512) ? __builtin_amdgcn_exp2f(p1[r] * C2 - off_w) : 0.f;
            }
            lsum += sum16(p0) + sum16(p1);
            pv(C, buf, p0, p1, o);
            if (j < c) tile_store(C, buf ^ 1);
            __syncthreads();
            buf ^= 1;
        }
        lsum += __shfl_xor(lsum, 32);
        accum_scaled(C, otot, o, gq2 / lsum);
    }
    {
        ATT_LAS bf16_t* stg = (ATT_LAS bf16_t*)(lds + L_OST) + wave * 2048;
        const float g0 = oga[(g * 4 + hg) * 64 + r32], g1 = oga[(g * 4 + hg) * 64 + 32 + r32];
#pragma unroll
        for (int r = 0; r < 16; ++r) {
            float sq = otot[0][r] * otot[0][r] + otot[1][r] * otot[1][r];
            sq += __shfl_xor(sq, 1); sq += __shfl_xor(sq, 2); sq += __shfl_xor(sq, 4); sq += __shfl_xor(sq, 8); sq += __shfl_xor(sq, 16);
            const float rs = rsqrtf(sq * (1.f / 64.f) + EPS);
            const int q = crow(r, hi);
            stg[q * 64 + r32] = f2bf(otot[0][r] * rs * g0);
            stg[q * 64 + 32 + r32] = f2bf(otot[1][r] * rs * g1);
        }
        asm volatile("s_waitcnt lgkmcnt(0)" ::: "memory");
        bf16_t* yb = Y + ((size_t)b * SEQ + 64 * c + 32 * th) * 1024 + (g * 4 + hg) * 64;
#pragma unroll
        for (int i = 0; i < 4; ++i) {
            const int row = i * 8 + (lane >> 3), ch = lane & 7;
            const u32x4 v = *(ATT_LAS const u32x4*)(stg + row * 64 + ch * 8);
            *(u32x4*)(yb + (size_t)row * 1024 + ch * 8) = v;
        }
    }
    __syncthreads();
}
}

__device__ void phase_attn_mfma(const Params& p, int l, unsigned char* lds_raw) {
    for (int v = my_bid(); v < 1024; v += gridDim.x) {
        const int r = v >> 8, x = (v >> 4) & 15, bg = v & 15;
        const int c = r == 0 ? 63 - x : (r == 1 ? 32 + x : (r == 2 ? 31 - x : x));
        att::unit(p, l, bg >> 1, bg & 1, c, (ATT_LAS unsigned char*)lds_raw);
    }
}

__device__ void phase_mlstm_out(const Params& p, int l, float* lds) {
    unsigned char* ws = p.ws;
    const bf16_t* proj = (const bf16_t*)(ws + WS_PROJ); const float* gates = (const float*)(ws + WS_GATES);
    const bf16_t* qkc = (const bf16_t*)(ws + WS_XB);
    const bf16_t* ST = (const bf16_t*)(ws + WS_ST); const float* STN = (const float*)(ws + WS_STN); const float* STM = (const float*)(ws + WS_STM);
    const float* fb = p.in[I_FB] + l * 4; const float* ogm = p.in[I_OGM] + l * 512;
    bf16_t* Y = (bf16_t*)(ws + WS_Y);
    float* qq = lds;
    float* kk = lds + 8192;
    float* Cs = lds + 16384;
    float* Ws = lds + 32768;
    float* bcum = Ws + 64 * 65; float* ig = bcum + 64; float* mt = ig + 64; float* wint = mt + 64; float* den = wint + 64; float* npv = den + 64;
    const int tid = my_tid(), lane = tid & 63, wave = tid >> 6;
    for (int u = my_bid(); u < BATCH * 4 * 64; u += gridDim.x) {
        const int c = u & 63, h = (u >> 6) & 3, b = u >> 8;
        const int m0 = b * SEQ + c * 64, bh = b * 4 + h;
        mlstm_gates(gates, fb, m0, h, bcum, ig);
        const float mprev = STM[4096 + bh * 64 + c];
        for (int e = tid; e < 64 * 16; e += NT) {
            const int s = e >> 4, d0 = (e & 15) * 8;
            const u32x4 rq = *(const u32x4*)(qkc + (size_t)(m0 + s) * 1024 + h * 128 + d0); float f[8]; unpack8(rq, f);
            const u32x4 rk = *(const u32x4*)(qkc + (size_t)(m0 + s) * 1024 + 512 + h * 128 + d0); float fk[8]; unpack8(rk, fk);
#pragma unroll
            for (int j = 0; j < 8; ++j) { qq[s * 128 + d0 + j] = f[j]; kk[s * 128 + d0 + j] = fk[j]; }
        }
        if (tid < 128) npv[tid] = STN[(size_t)(bh * 64 + c) * 128 + tid];
        for (int e8 = tid; e8 < 128 * 16; e8 += NT) {
            const int e = e8 >> 4, d0 = (e8 & 15) * 8;
            const u32x4 rc = *(const u32x4*)(ST + ((size_t)(bh * 64 + c) * 128 + e) * 128 + d0); float f[8]; unpack8(rc, f);
#pragma unroll
            for (int j = 0; j < 8; ++j) Cs[(d0 + j) * 128 + e] = f[j];
        }
        __syncthreads();
        {
            const int t = tid >> 3, s0 = (tid & 7) * 8;
            float a[8] = {0.f, 0.f, 0.f, 0.f, 0.f, 0.f, 0.f, 0.f};
#pragma unroll 2
            for (int d = 0; d < 128; ++d) {
                const float qv = qq[t * 128 + d];
#pragma unroll
                for (int j = 0; j < 8; ++j) a[j] += qv * kk[(s0 + j) * 128 + d];
            }
#pragma unroll
            for (int j = 0; j < 8; ++j) Ws[t * 65 + s0 + j] = a[j];
        }
        __syncthreads();
        for (int r = 0; r < 8; ++r) {
            const int t = wave * 8 + r;
            const float dv = lane <= t ? bcum[t] - bcum[lane] + ig[lane] : -INFINITY;
            const float a = bcum[t] + mprev;
            const float m_t = fmaxf(a, wave_max(dv));
            const float w = lane <= t ? __expf(dv - m_t) * Ws[t * 65 + lane] : 0.f;
            Ws[t * 65 + lane] = w;
            const float wi = __expf(a - m_t);
            const float qn = wave_sum(qq[t * 128 + lane] * npv[lane] + qq[t * 128 + 64 + lane] * npv[64 + lane]);
            const float dsum = wave_sum(w);
            if (lane == 0) { mt[t] = m_t; wint[t] = wi; den[t] = wi * qn + dsum; }
        }
        __syncthreads();
        for (int e = tid; e < 64 * 16; e += NT) {
            const int s = e >> 4, d0 = (e & 15) * 8;
            const u32x4 rv = *(const u32x4*)(proj + (size_t)(m0 + s) * NPROJ + C_VB + h * 128 + d0); float f[8]; unpack8(rv, f);
#pragma unroll
            for (int j = 0; j < 8; ++j) kk[s * 128 + d0 + j] = f[j];
        }
        __syncthreads();
        float hv[16];
        {
            const int e = tid & 127, t0 = (tid >> 7) * 16;
            float a1[16], a2[16];
#pragma unroll
            for (int i = 0; i < 16; ++i) { a1[i] = 0.f; a2[i] = 0.f; }
#pragma unroll 2
            for (int d = 0; d < 128; ++d) {
                const float cv = Cs[d * 128 + e];
#pragma unroll
                for (int i = 0; i < 16; ++i) a1[i] += qq[(t0 + i) * 128 + d] * cv;
            }
#pragma unroll 2
            for (int s = 0; s < 64; ++s) {
                const float vv = kk[s * 128 + e];
#pragma unroll
                for (int i = 0; i < 16; ++i) a2[i] += Ws[(t0 + i) * 65 + s] * vv;
            }
#pragma unroll
            for (int i = 0; i < 16; ++i) {
                const int t = t0 + i;
                const float num = wint[t] * a1[i] + a2[i];
                hv[i] = num / fmaxf(fabsf(den[t]), __expf(-mt[t]));
            }
        }
        __syncthreads();
        {
            const int e = tid & 127, t0 = (tid >> 7) * 16;
#pragma unroll
            for (int i = 0; i < 16; ++i) Cs[(t0 + i) * 128 + e] = hv[i];
        }
        __syncthreads();
        for (int r = 0; r < 8; ++r) {
            const int t = wave * 8 + r;
            const float h0 = Cs[t * 128 + lane], h1 = Cs[t * 128 + 64 + lane];
            const float s = wave_sum(h0 * h0 + h1 * h1);
            const float rr = rsqrtf(s * (1.f / 128.f) + EPS);
            const bf16_t* op = proj + (size_t)(m0 + t) * NPROJ + C_OB + h * 128;
            const float y0 = h0 * rr * ogm[h * 128 + lane] * sigmoid_f(bf2f(op[lane]));
            const float y1 = h1 * rr * ogm[h * 128 + 64 + lane] * sigmoid_f(bf2f(op[64 + lane]));
            Y[(size_t)(m0 + t) * 1024 + 512 + h * 128 + lane] = f2bf(y0);
            Y[(size_t)(m0 + t) * 1024 + 512 + h * 128 + 64 + lane] = f2bf(y1);
        }
        __syncthreads();
    }
}

namespace mls {
typedef short bf16x8 __attribute__((ext_vector_type(8)));
typedef short s16x4 __attribute__((ext_vector_type(4)));
typedef float f32x16 __attribute__((ext_vector_type(16)));
#define MLS_LAS __attribute__((address_space(3)))
__device__ __forceinline__ s16x4 vtr(MLS_LAS const unsigned char* p) { return __builtin_bit_cast(s16x4, __builtin_amdgcn_ds_read_tr16_b64_v4i16((MLS_LAS s16x4*)p)); }
__device__ __forceinline__ bf16x8 trfrag(MLS_LAS const unsigned char* p) { const s16x4 lo = vtr(p), hh = vtr(p + 512); return (bf16x8){lo[0], lo[1], lo[2], lo[3], hh[0], hh[1], hh[2], hh[3]}; }
__device__ __forceinline__ float incl_scan64(float v, int lane) {
#pragma unroll
    for (int o = 1; o < 64; o <<= 1) { const float t = __shfl_up(v, o); if (lane >= o) v += t; }
    return v;
}
constexpr float KSCALE = 0.08838834764831845f;

__device__ void chunk_unit(const Params& p, int l, int b, int c, MLS_LAS unsigned char* lds) {
    unsigned char* ws = p.ws;
    const bf16_t* proj = (const bf16_t*)(ws + WS_PROJ); const float* gates = (const float*)(ws + WS_GATES);
    const float* cw = p.in[I_CW] + l * 4096; const float* cb = p.in[I_CB] + l * 1024; const float* fb = p.in[I_FB] + l * 4;
    bf16_t* ST = (bf16_t*)(ws + WS_ST); float* STN = (float*)(ws + WS_STN); float* STM = (float*)(ws + WS_STM);
    const int tid = my_tid(), lane = tid & 63, wave = __builtin_amdgcn_readfirstlane(tid >> 6), r32 = lane & 31, hi = lane >> 5, h = wave >> 1, half = wave & 1;
    const size_t m0 = (size_t)b * SEQ + 64 * c; const int bh = b * 4 + h;
    const float lf = log_sigmoid_f(gates[(m0 + lane) * 32 + 28 + h] + fb[h]);
    const float igv = gates[(m0 + lane) * 32 + 24 + h];
    const float bc = incl_scan64(lf, lane);
    const float blast = __shfl(bc, 63);
    const float gv = blast - bc + igv;
    const float mloc = wave_max(gv);
    const float wsc = __expf(gv - mloc);
    if (half == 0 && lane == 0) { STM[bh * 64 + c] = mloc; STM[2048 + bh * 64 + c] = blast; }
    MLS_LAS unsigned char* vimg = lds + h * 32768; MLS_LAS unsigned char* kimg = vimg + 16384;
    {
        const int pc = lane & 15, ch = 512 + h * 128 + pc * 8;
        float cwv[4][8], cbv[8];
#pragma unroll
        for (int j = 0; j < 8; ++j) { cbv[j] = cb[ch + j];
#pragma unroll
            for (int w = 0; w < 4; ++w) cwv[w][j] = cw[w * 1024 + ch + j]; }
#pragma unroll 2
        for (int it = 0; it < 8; ++it) {
            const int s = 32 * half + 4 * it + (lane >> 4);
            const u32x4 rv = *(const u32x4*)(proj + (m0 + s) * NPROJ + C_VB + h * 128 + pc * 8);
            *(MLS_LAS u32x4*)(vimg + (pc >> 2) * 4096 + s * 64 + (pc & 3) * 16) = rv;
            float acc[8];
#pragma unroll
            for (int j = 0; j < 8; ++j) acc[j] = cbv[j];
#pragma unroll
            for (int w = 0; w < 4; ++w) {
                if (64 * c + s - 3 + w >= 0) {
                    const u32x4 raw = *(const u32x4*)(proj + (m0 + s - 3 + w) * NPROJ + C_KB + h * 128 + pc * 8); float f[8]; unpack8(raw, f);
#pragma unroll
                    for (int j = 0; j < 8; ++j) acc[j] += f[j] * cwv[w][j];
                }
            }
            const float sc = KSCALE * __shfl(wsc, s);
            float y[8];
#pragma unroll
            for (int j = 0; j < 8; ++j) y[j] = silu_f(acc[j]) * sc;
            u32x4 o; o.x = pk2(y[0], y[1]); o.y = pk2(y[2], y[3]); o.z = pk2(y[4], y[5]); o.w = pk2(y[6], y[7]);
            *(MLS_LAS u32x4*)(kimg + (pc >> 2) * 4096 + s * 64 + (pc & 3) * 16) = o;
        }
    }
    __syncthreads();
    f32x16 acc[2][4];
#pragma unroll
    for (int e2 = 0; e2 < 2; ++e2)
#pragma unroll
        for (int db = 0; db < 4; ++db) acc[e2][db] = (f32x16){0.f, 0.f, 0.f, 0.f, 0.f, 0.f, 0.f, 0.f, 0.f, 0.f, 0.f, 0.f, 0.f, 0.f, 0.f, 0.f};
    {
        const int tro = ((lane >> 4) & 1) * 32 + (lane & 3) * 8 + (4 * hi + ((lane & 15) >> 2)) * 64;
#pragma unroll
        for (int ks = 0; ks < 4; ++ks) {
            const bf16x8 a0 = trfrag(vimg + tro + (2 * half) * 4096 + ks * 1024), a1 = trfrag(vimg + tro + (2 * half + 1) * 4096 + ks * 1024);
#pragma unroll
            for (int db = 0; db < 4; ++db) {
                const bf16x8 bfr = trfrag(kimg + tro + db * 4096 + ks * 1024);
                acc[0][db] = __builtin_amdgcn_mfma_f32_32x32x16_bf16(a0, bfr, acc[0][db], 0, 0, 0);
                acc[1][db] = __builtin_amdgcn_mfma_f32_32x32x16_bf16(a1, bfr, acc[1][db], 0, 0, 0);
            }
        }
    }
    {
        const int hh = tid >> 7, d = tid & 127;
        MLS_LAS const bf16_t* kp = (MLS_LAS const bf16_t*)(lds + hh * 32768 + 16384 + (d >> 5) * 4096) + (d & 31);
        float sm = 0.f;
#pragma unroll 8
        for (int s2 = 0; s2 < 64; ++s2) sm += bf2f(kp[s2 * 32]);
        STN[(size_t)((b * 4 + hh) * 64 + c) * 128 + d] = sm;
    }
    __syncthreads();
    {
        MLS_LAS bf16_t* stg = (MLS_LAS bf16_t*)(lds + h * 32768 + half * 16384);
#pragma unroll
        for (int e2 = 0; e2 < 2; ++e2)
#pragma unroll
            for (int db = 0; db < 4; ++db)
#pragma unroll
                for (int r = 0; r < 16; ++r) stg[(32 * e2 + att::crow(r, hi)) * 128 + 32 * db + r32] = f2bf(acc[e2][db][r]);
        asm volatile("s_waitcnt lgkmcnt(0)" ::: "memory");
        bf16_t* dst = ST + ((size_t)(bh * 64 + c) * 128 + 64 * half) * 128;
#pragma unroll 4
        for (int it = 0; it < 16; ++it) {
            const int idx = it * 64 + lane;
            *(u32x4*)(dst + (size_t)idx * 8) = *(MLS_LAS const u32x4*)(stg + idx * 8);
        }
    }
    __syncthreads();
}

constexpr int LO_V = 0, LO_STG = 65536, LO_G = 131072;
__device__ void out_unit(const Params& p, int l, int b, int c, MLS_LAS unsigned char* lds) {
    unsigned char* ws = p.ws;
    const bf16_t* proj = (const bf16_t*)(ws + WS_PROJ); const float* gates = (const float*)(ws + WS_GATES);
    const bf16_t* qkc = (const bf16_t*)(ws + WS_XB);
    const bf16_t* ST = (const bf16_t*)(ws + WS_ST); const float* STN = (const float*)(ws + WS_STN); const float* STM = (const float*)(ws + WS_STM);
    const float* fb = p.in[I_FB] + l * 4; const float* ogm = p.in[I_OGM] + l * 512;
    bf16_t* Y = (bf16_t*)(ws + WS_Y);
    const int tid = my_tid(), lane = tid & 63, wave = __builtin_amdgcn_readfirstlane(tid >> 6), r32 = lane & 31, hi = lane >> 5, h = wave >> 1, th = wave & 1;
    const size_t m0 = (size_t)b * SEQ + 64 * c; const int bh = b * 4 + h;
    MLS_LAS unsigned char* vimg = lds + LO_V + h * 16384;
    MLS_LAS float* garr = (MLS_LAS float*)(lds + LO_G + wave * 512);
#pragma unroll 4
    for (int it = 0; it < 8; ++it) {
        const int s = 32 * th + 4 * it + (lane >> 4), pc = lane & 15;
        const u32x4 rv = *(const u32x4*)(proj + (m0 + s) * NPROJ + C_VB + h * 128 + pc * 8);
        *(MLS_LAS u32x4*)(vimg + (pc >> 2) * 4096 + s * 64 + (pc & 3) * 16) = rv;
    }
    {
        const float lf = log_sigmoid_f(gates[(m0 + lane) * 32 + 28 + h] + fb[h]);
        garr[lane] = incl_scan64(lf, lane);
        garr[64 + lane] = gates[(m0 + lane) * 32 + 24 + h];
    }
    const float mprev = STM[4096 + bh * 64 + c];
    const int tl = 32 * th + r32;
    bf16x8 qf[8];
#pragma unroll
    for (int ks = 0; ks < 8; ++ks) qf[ks] = __builtin_bit_cast(bf16x8, *(const u32x4*)(qkc + (m0 + tl) * 1024 + h * 128 + 16 * ks + 8 * hi));
    f32x16 p0 = (f32x16){0.f, 0.f, 0.f, 0.f, 0.f, 0.f, 0.f, 0.f, 0.f, 0.f, 0.f, 0.f, 0.f, 0.f, 0.f, 0.f}, p1 = p0;
#pragma unroll
    for (int ks = 0; ks < 8; ++ks) {
        const bf16x8 k0 = __builtin_bit_cast(bf16x8, *(const u32x4*)(qkc + (m0 + r32) * 1024 + 512 + h * 128 + 16 * ks + 8 * hi));
        const bf16x8 k1 = __builtin_bit_cast(bf16x8, *(const u32x4*)(qkc + (m0 + 32 + r32) * 1024 + 512 + h * 128 + 16 * ks + 8 * hi));
        p0 = __builtin_amdgcn_mfma_f32_32x32x16_bf16(k0, qf[ks], p0, 0, 0, 0);
        p1 = __builtin_amdgcn_mfma_f32_32x32x16_bf16(k1, qf[ks], p1, 0, 0, 0);
    }
    float qn = 0.f;
    {
        const float* np = STN + (size_t)(bh * 64 + c) * 128;
#pragma unroll
        for (int ks = 0; ks < 8; ++ks) {
            const f32x4 n0 = *(const f32x4*)(np + 16 * ks + 8 * hi), n1 = *(const f32x4*)(np + 16 * ks + 8 * hi + 4);
            float f[8]; unpack8(__builtin_bit_cast(u32x4, qf[ks]), f);
            qn += (f[0] * n0.x + f[1] * n0.y) + (f[2] * n0.z + f[3] * n0.w) + (f[4] * n1.x + f[5] * n1.y) + (f[6] * n1.z + f[7] * n1.w);
        }
        qn += __shfl_xor(qn, 32);
    }
    asm volatile("s_waitcnt lgkmcnt(0)" ::: "memory");
    const float bt = garr[tl];
    float dv0[16], dv1[16]; float mx = -INFINITY;
#pragma unroll
    for (int r = 0; r < 16; ++r) {
        const int s0 = att::crow(r, hi);
        dv0[r] = s0 <= tl ? bt - garr[s0] + garr[64 + s0] : -INFINITY;
        dv1[r] = s0 + 32 <= tl ? bt - garr[s0 + 32] + garr[64 + s0 + 32] : -INFINITY;
        mx = fmaxf(mx, fmaxf(dv0[r], dv1[r]));
    }
    mx = fmaxf(mx, __shfl_xor(mx, 32));
    const float a_t = bt + mprev;
    const float m_t = fmaxf(a_t, mx);
    float dsum = 0.f;
#pragma unroll
    for (int r = 0; r < 16; ++r) {
        p0[r] = __expf(dv0[r] - m_t) * p0[r];
        p1[r] = __expf(dv1[r] - m_t) * p1[r];
        dsum += p0[r] + p1[r];
    }
    dsum += __shfl_xor(dsum, 32);
    const float winter = __expf(a_t - m_t);
    const float den = winter * qn + dsum;
    const float scl = 1.f / fmaxf(fabsf(den), __expf(-m_t));
    const float fq = winter * scl;
    bf16x8 pa[4];
#pragma unroll
    for (int s2 = 0; s2 < 2; ++s2) {
        u32x4 w0, w1;
        w0.x = att::cvtpk(p0[8 * s2 + 0] * scl, p0[8 * s2 + 1] * scl); w0.y = att::cvtpk(p0[8 * s2 + 2] * scl, p0[8 * s2 + 3] * scl); w0.z = att::cvtpk(p0[8 * s2 + 4] * scl, p0[8 * s2 + 5] * scl); w0.w = att::cvtpk(p0[8 * s2 + 6] * scl, p0[8 * s2 + 7] * scl);
        w1.x = att::cvtpk(p1[8 * s2 + 0] * scl, p1[8 * s2 + 1] * scl); w1.y = att::cvtpk(p1[8 * s2 + 2] * scl, p1[8 * s2 + 3] * scl); w1.z = att::cvtpk(p1[8 * s2 + 4] * scl, p1[8 * s2 + 5] * scl); w1.w = att::cvtpk(p1[8 * s2 + 6] * scl, p1[8 * s2 + 7] * scl);
        pa[s2] = __builtin_bit_cast(bf16x8, w0); pa[2 + s2] = __builtin_bit_cast(bf16x8, w1);
    }
#pragma unroll
    for (int ks = 0; ks < 8; ++ks) {
        float f[8]; unpack8(__builtin_bit_cast(u32x4, qf[ks]), f);
        u32x4 w; w.x = att::cvtpk(f[0] * fq, f[1] * fq); w.y = att::cvtpk(f[2] * fq, f[3] * fq); w.z = att::cvtpk(f[4] * fq, f[5] * fq); w.w = att::cvtpk(f[6] * fq, f[7] * fq);
        qf[ks] = __builtin_bit_cast(bf16x8, w);
    }
    f32x16 acc[4];
#pragma unroll
    for (int eb = 0; eb < 4; ++eb) acc[eb] = (f32x16){0.f, 0.f, 0.f, 0.f, 0.f, 0.f, 0.f, 0.f, 0.f, 0.f, 0.f, 0.f, 0.f, 0.f, 0.f, 0.f};
    {
        const bf16_t* cp = ST + (size_t)(bh * 64 + c) * 16384 + (size_t)r32 * 128 + 8 * hi;
#pragma unroll
        for (int eb = 0; eb < 4; ++eb)
#pragma unroll
            for (int ks = 0; ks < 8; ++ks) {
                const bf16x8 cf = __builtin_bit_cast(bf16x8, *(const u32x4*)(cp + eb * 32 * 128 + 16 * ks));
                acc[eb] = __builtin_amdgcn_mfma_f32_32x32x16_bf16(qf[ks], cf, acc[eb], 0, 0, 0);
            }
    }
    __syncthreads();
    {
        const int tro = ((lane >> 4) & 1) * 32 + (lane & 3) * 8 + (4 * hi + ((lane & 15) >> 2)) * 64;
#pragma unroll
        for (int eb = 0; eb < 4; ++eb)
#pragma unroll
            for (int ks = 0; ks < 4; ++ks) acc[eb] = __builtin_amdgcn_mfma_f32_32x32x16_bf16(pa[ks], trfrag(vimg + tro + eb * 4096 + ks * 1024), acc[eb], 0, 0, 0);
    }
    {
        MLS_LAS bf16_t* stg = (MLS_LAS bf16_t*)(lds + LO_STG + wave * 8192);
        float gn[4];
#pragma unroll
        for (int eb = 0; eb < 4; ++eb) gn[eb] = ogm[h * 128 + 32 * eb + r32];
#pragma unroll
        for (int r = 0; r < 16; ++r) {
            float sq = (acc[0][r] * acc[0][r] + acc[1][r] * acc[1][r]) + (acc[2][r] * acc[2][r] + acc[3][r] * acc[3][r]);
            sq += __shfl_xor(sq, 1); sq += __shfl_xor(sq, 2); sq += __shfl_xor(sq, 4); sq += __shfl_xor(sq, 8); sq += __shfl_xor(sq, 16);
            const float rs = rsqrtf(sq * (1.f / 128.f) + EPS);
            const int q = att::crow(r, hi);
#pragma unroll
            for (int eb = 0; eb < 4; ++eb) stg[q * 128 + 32 * eb + r32] = f2bf(acc[eb][r] * rs * gn[eb]);
        }
        asm volatile("s_waitcnt lgkmcnt(0)" ::: "memory");
#pragma unroll 2
        for (int it = 0; it < 8; ++it) {
            const int idx = it * 64 + lane, row = idx >> 4, pc = idx & 15;
            const u32x4 hv = *(MLS_LAS const u32x4*)(stg + row * 128 + pc * 8);
            const u32x4 ov = *(const u32x4*)(proj + (m0 + 32 * th + row) * NPROJ + C_OB + h * 128 + pc * 8);
            float fh[8], fo[8]; unpack8(hv, fh); unpack8(ov, fo);
            float y[8];
#pragma unroll
            for (int j = 0; j < 8; ++j) y[j] = fh[j] * sigmoid_f(fo[j]);
            u32x4 o; o.x = pk2(y[0], y[1]); o.y = pk2(y[2], y[3]); o.z = pk2(y[4], y[5]); o.w = pk2(y[6], y[7]);
            *(u32x4*)(Y + (m0 + 32 * th + row) * 1024 + 512 + h * 128 + pc * 8) = o;
        }
    }
    __syncthreads();
}
}

__device__ void phase_chunkstate_mfma(const Params& p, int l, unsigned char* lds_raw) {
    for (int u = my_bid(); u < BATCH * 64; u += gridDim.x) mls::chunk_unit(p, l, u >> 6, u & 63, (MLS_LAS unsigned char*)lds_raw);
}
__device__ void phase_mlstm_out_mfma(const Params& p, int l, unsigned char* lds_raw) {
    for (int u = my_bid(); u < BATCH * 64; u += gridDim.x) mls::out_unit(p, l, u >> 6, u & 63, (MLS_LAS unsigned char*)lds_raw);
}

constexpr int NPHASE = 1 + 7 * DEPTH;
template <bool COOP, int PMASK>
__global__ void __launch_bounds__(NT) mega(Params p) {
    extern __shared__ __attribute__((aligned(16))) unsigned char lds_raw[];
    float* lds = (float*)lds_raw;
    unsigned char* ws = p.ws;
    for (int ph = p.lo; ph < p.hi; ++ph) {
        if (ph == 0) {
            if (PMASK & 128) phase_prologue(p, lds);
        } else {
            const int l = (ph - 1) / 7, k = (ph - 1) % 7;
            if (k == 0 && (PMASK & 1)) {
                pg8::Gemm g{(const bf16_t*)(ws + WS_XB), (const bf16_t*)(ws + WS_WIN) + (size_t)l * NPAD * DM, M, NPAD, DM};
                pg8::StaticOrder S; S.init(M, NPAD, (int)gridDim.x, (int)blockIdx.x);
                pg8::EpiInT E{(const float*)(ws + WS_SS), (const float*)(ws + WS_BIAS) + l * NPAD, (bf16_t*)(ws + WS_PROJ), (float*)(ws + WS_GATES)};
                pg8::gemm_phase<pg8::EpiInT, pg8::StaticOrder, true, true>((PG8_LAS unsigned char*)lds_raw, g, S, E);
            } else if (k == 1 && (PMASK & 2)) {
                phase_rowpass(p, l);
                phase_compress(p, l, lds);
                phase_chunkstate_mfma(p, l, lds_raw);
            } else if (k == 2 && (PMASK & 4)) {
                phase_scan(p);
                phase_attn_mfma(p, l, lds_raw);
            } else if (k == 3 && (PMASK & 8)) {
                phase_mlstm_out_mfma(p, l, lds_raw);
            } else if (k == 4 && (PMASK & 16)) {
                pg8::Gemm g{(const bf16_t*)(ws + WS_Y), (const bf16_t*)(ws + WS_WOUT) + (size_t)l * DM * DM, M, DM, DM};
                pg8::StaticOrder S; S.init(M, DM, (int)gridDim.x, (int)blockIdx.x);
                pg8::EpiResT E{l == 0 ? p.in[I_X] : p.out, p.out, (bf16_t*)(ws + WS_XB), (float*)(ws + WS_SS)};
                pg8::gemm_phase<pg8::EpiResT, pg8::StaticOrder, true, true>((PG8_LAS unsigned char*)lds_raw, g, S, E);
            } else if (k == 5 && (PMASK & 32)) {
                pg8::Gemm g{(const bf16_t*)(ws + WS_XB), (const bf16_t*)(ws + WS_WGU) + (size_t)l * NGU * DM, M, NGU, DM};
                pg8::StaticOrder S; S.init(M, NGU, (int)gridDim.x, (int)blockIdx.x);
                pg8::EpiGUT E{(const float*)(ws + WS_SS), (bf16_t*)(ws + WS_PROJ)};
                pg8::gemm_phase<pg8::EpiGUT, pg8::StaticOrder, true, true>((PG8_LAS unsigned char*)lds_raw, g, S, E);
            } else if (k == 6 && (PMASK & 64)) {
                pg8::Gemm g{(const bf16_t*)(ws + WS_PROJ), (const bf16_t*)(ws + WS_WD) + (size_t)l * DM * FF, M, DM, FF};
                pg8::StaticOrder S; S.init(M, DM, (int)gridDim.x, (int)blockIdx.x);
                pg8::EpiResT E{p.out, p.out, (bf16_t*)(ws + WS_XB), (float*)(ws + WS_SS)};
                pg8::gemm_phase<pg8::EpiResT, pg8::StaticOrder, true, true>((PG8_LAS unsigned char*)lds_raw, g, S, E);
            }
        }
        if (COOP && ph + 1 < p.hi) { cg::this_grid().sync(); }
    }
}

extern "C" void kernel_launch(void* const* d_in, const int* in_sizes, int n_in, void* d_out, int out_size, void* d_ws, size_t ws_size, hipStream_t stream) {
    static int grid = 0;
    if (grid == 0) {
        if (n_in != 18 || ws_size < WS_END) { fprintf(stderr, "kernel_launch: unexpected n_in %d / ws_size %zu\n", n_in, ws_size); grid = -1; return; }
        int dev = 0, cus = 0, per_cu = 0;
        (void)hipGetDevice(&dev);
        (void)hipDeviceGetAttribute(&cus, hipDeviceAttributeMultiprocessorCount, dev);
        (void)hipFuncSetAttribute((const void*)mega<true, 0xff>, hipFuncAttributeMaxDynamicSharedMemorySize, LDS_BYTES);
        (void)hipOccupancyMaxActiveBlocksPerMultiprocessor(&per_cu, (const void*)mega<true, 0xff>, NT, LDS_BYTES);
        if (per_cu < 1) { fprintf(stderr, "kernel_launch: occupancy query reports %d blocks/CU\n", per_cu); grid = -1; return; }
        grid = (cus > 0 ? cus : 256) * 1;
        (void)hipGetLastError();
    }
    if (grid < 0) return;
    Params p{};
    for (int i = 0; i < 18; ++i) p.in[i] = (const float*)d_in[i];
    p.out = (float*)d_out; p.ws = (unsigned char*)d_ws;
    p.lo = 0; p.hi = NPHASE;
    void* args[] = {&p};
    hipError_t e = hipLaunchCooperativeKernel((const void*)mega<true, 0xff>, dim3(grid), dim3(NT), args, LDS_BYTES, stream);
    if (e != hipSuccess) fprintf(stderr, "cooperative launch failed: %s (grid %d)\n", hipGetErrorString(e), grid);
}
```

```cpp
#include <hip/hip_runtime.h>
#include <hip/hip_cooperative_groups.h>
#include <cstdint>
#include <cstdio>
namespace cg = cooperative_groups;

typedef unsigned short bf16_t;
typedef unsigned u32x4 __attribute__((ext_vector_type(4)));
typedef unsigned u32x2 __attribute__((ext_vector_type(2)));
typedef float f32x4 __attribute__((ext_vector_type(4)));

constexpr int BATCH = 8, SEQ = 4096, DM = 1024, M = BATCH * SEQ, DEPTH = 2;
constexpr int NIN = 3360, NPROJ = 3328, NPAD = 3584, FF = 2816, NGU = 2 * FF;
constexpr int NCMP = 255, NCMPP = 256;
constexpr float EPS = 1e-6f;
constexpr int NT = 512;
constexpr int LDS_BYTES = 152 * 1024;

constexpr int C_QA = 0, C_KC = 512, C_VC = 640, C_KS = 768, C_VS = 896, C_KW = 1024, C_VW = 1152, C_QB = 1280, C_KB = 1792, C_VB = 2304, C_OB = 2816;

constexpr size_t MiB = 1u << 20;
constexpr size_t WS_CTL = 0;
constexpr size_t WS_WIN = 1 * MiB;
constexpr size_t WS_WOUT = 15 * MiB;
constexpr size_t WS_WGU = 19 * MiB;
constexpr size_t WS_WD = 41 * MiB;
constexpr size_t WS_BIAS = 52 * MiB;
constexpr size_t WS_SS = 53 * MiB;
constexpr size_t WS_GATES = 55 * MiB;
constexpr size_t WS_KCMP = 59 * MiB;
constexpr size_t WS_VCMP = 59 * MiB + 512 * 1024;
constexpr size_t WS_STN = 60 * MiB;
constexpr size_t WS_STM = 61 * MiB;
constexpr size_t WS_W2T = 61 * MiB + 256 * 1024;
constexpr size_t WS_PEB = 61 * MiB + 512 * 1024;
constexpr size_t WS_CW1 = 62 * MiB;
constexpr size_t WS_XB = 64 * MiB;
constexpr size_t WS_Y = 128 * MiB;
constexpr size_t WS_ST = 192 * MiB;
constexpr size_t WS_PROJ = 256 * MiB;
constexpr size_t WS_END = 464 * MiB;

struct Params {
    const float* in[18];
    float* out;
    unsigned char* ws;
    int lo, hi;
};
enum { I_X = 0, I_LN1, I_WIN, I_BIN, I_QG, I_KG, I_PE, I_W1, I_W2, I_CW, I_CB, I_FB, I_OGA, I_OGM, I_WOUT, I_LN2, I_WGU, I_WD };

__device__ __forceinline__ float bf2f(bf16_t v) { return __uint_as_float(((unsigned)v) << 16); }
__device__ __forceinline__ bf16_t f2bf(float f) { unsigned u = __float_as_uint(f); return (bf16_t)((u + 0x7fffu + ((u >> 16) & 1u)) >> 16); }
__device__ __forceinline__ unsigned pk2(float lo, float hi) { return (unsigned)f2bf(lo) | ((unsigned)f2bf(hi) << 16); }
__device__ __forceinline__ float lo16(unsigned w) { return __uint_as_float(w << 16); }
__device__ __forceinline__ float hi16(unsigned w) { return __uint_as_float(w & 0xffff0000u); }
__device__ __forceinline__ float silu_f(float x) { return x / (1.f + __expf(-x)); }
__device__ __forceinline__ float sigmoid_f(float x) { return 1.f / (1.f + __expf(-x)); }
__device__ __forceinline__ float wave_sum(float v) {
#pragma unroll
    for (int o = 1; o < 64; o <<= 1) v += __shfl_xor(v, o);
    return v;
}
__device__ __forceinline__ float wave_max(float v) {
#pragma unroll
    for (int o = 1; o < 64; o <<= 1) v = fmaxf(v, __shfl_xor(v, o));
    return v;
}
__device__ __forceinline__ int my_tid() { int t = threadIdx.x; asm volatile("" : "+v"(t)); return t; }
__device__ __forceinline__ int my_bid() { int b = blockIdx.x; asm volatile("" : "+s"(b)); return b; }
__device__ __forceinline__ void unpack8(u32x4 w, float* f) {
    f[0] = lo16(w.x); f[1] = hi16(w.x); f[2] = lo16(w.y); f[3] = hi16(w.y);
    f[4] = lo16(w.z); f[5] = hi16(w.z); f[6] = lo16(w.w); f[7] = hi16(w.w);
}

__device__ __forceinline__ int in_srccol(int n) {
    if (n < 1280) return n;
    if (n < 2816) return n + 24;
    if (n < 3328) return n + 32;
    if (n < 3352) return n - 3328 + 1280;
    if (n < 3360) return n - 3352 + 2840;
    return -1;
}
__device__ __forceinline__ int gu_srccol(int n) {
    const int t = n >> 8, w = n & 255;
    return (w < 128) ? (t * 128 + w) : (FF + t * 128 + (w - 128));
}

template <int MODE>
__device__ void conv_job(const float* W, int K, int Nsrc, bf16_t* WT, int Nout, const float* kscale, float* tile) {
    const int tid = my_tid();
    const int nk = K / 64, nn = Nout / 64;
    for (int u = my_bid(); u < nk * nn; u += gridDim.x) {
        const int k0 = (u % nk) * 64, n0 = (u / nk) * 64;
#pragma unroll
        for (int i = 0; i < 8; ++i) {
            const int r = (tid >> 6) + 8 * i, c = tid & 63;
            const int n = n0 + c;
            const int sc = MODE == 0 ? n : (MODE == 1 ? in_srccol(n) : gu_srccol(n));
            float v = 0.f;
            if (sc >= 0) v = W[(size_t)(k0 + r) * Nsrc + sc] * (kscale ? kscale[k0 + r] : 1.f);
            tile[r * 65 + c] = v;
        }
        __syncthreads();
#pragma unroll
        for (int i = 0; i < 8; ++i) {
            const int r = (tid >> 6) + 8 * i, c = tid & 63;
            WT[(size_t)(n0 + r) * K + k0 + c] = f2bf(tile[c * 65 + r]);
        }
        __syncthreads();
    }
}

__device__ void phase_prologue(const Params& p, float* lds) {
    unsigned char* ws = p.ws;
    const int tid = my_tid(), lane = tid & 63, wave = tid >> 6;
    for (int l = 0; l < DEPTH; ++l) {
        conv_job<1>(p.in[I_WIN] + (size_t)l * DM * NIN, DM, NIN, (bf16_t*)(ws + WS_WIN) + (size_t)l * NPAD * DM, NPAD, p.in[I_LN1] + l * DM, lds);
        conv_job<0>(p.in[I_WOUT] + (size_t)l * DM * DM, DM, DM, (bf16_t*)(ws + WS_WOUT) + (size_t)l * DM * DM, DM, nullptr, lds);
        conv_job<2>(p.in[I_WGU] + (size_t)l * DM * NGU, DM, NGU, (bf16_t*)(ws + WS_WGU) + (size_t)l * NGU * DM, NGU, p.in[I_LN2] + l * DM, lds);
        conv_job<0>(p.in[I_WD] + (size_t)l * FF * DM, FF, DM, (bf16_t*)(ws + WS_WD) + (size_t)l * DM * FF, DM, nullptr, lds);
    }
    for (int lk = 0; lk < DEPTH * 2; ++lk) {
        conv_job<0>(p.in[I_W1] + (size_t)lk * 2048 * 128, 2048, 128, (bf16_t*)(ws + WS_CW1) + (size_t)lk * 128 * 2048, 128, nullptr, lds);
        conv_job<0>(p.in[I_W2] + (size_t)lk * 128 * 64, 128, 64, (bf16_t*)(ws + WS_W2T) + (size_t)lk * 64 * 128, 64, nullptr, lds);
    }
    {
        float* peb = (float*)(ws + WS_PEB);
        for (int o = my_bid() * 8 + wave; o < DEPTH * 2 * 128; o += gridDim.x * 8) {
            const int lk = o >> 7, hid = o & 127;
            const float* w1 = p.in[I_W1] + (size_t)lk * 2048 * 128 + hid; const float* pe = p.in[I_PE] + (size_t)lk * 2048;
            float sacc = 0.f;
            for (int f = lane; f < 2048; f += 64) sacc += w1[(size_t)f * 128] * pe[f];
            sacc = wave_sum(sacc);
            if (lane == 0) peb[o] = sacc;
        }
    }
    float* biasP = (float*)(ws + WS_BIAS);
    for (int i = my_bid() * NT + tid; i < DEPTH * NPAD; i += gridDim.x * NT) {
        const int l = i / NPAD, n = i % NPAD; const int sc = in_srccol(n);
        biasP[i] = sc >= 0 ? p.in[I_BIN][l * NIN + sc] : 0.f;
    }
    const float* x = p.in[I_X]; bf16_t* xb = (bf16_t*)(ws + WS_XB); float* ss = (float*)(ws + WS_SS);
    for (int m = my_bid() * 8 + wave; m < M; m += gridDim.x * 8) {
        const f32x4* xr = (const f32x4*)(x + (size_t)m * DM) + lane;
#pragma unroll
        for (int j = 0; j < 4; ++j) {
            const f32x4 v = xr[64 * j];
            float s = (v.x * v.x + v.y * v.y) + (v.z * v.z + v.w * v.w);
            s += __shfl_xor(s, 1); s += __shfl_xor(s, 2); s += __shfl_xor(s, 4); s += __shfl_xor(s, 8);
            if ((lane & 15) == 0) ss[(size_t)m * 16 + 4 * j + (lane >> 4)] = s;
            u32x2 o; o.x = pk2(v.x, v.y); o.y = pk2(v.z, v.w);
            *(u32x2*)(xb + (size_t)m * DM + 256 * j + 4 * lane) = o;
        }
    }
}

namespace pg8 {
#define PG8_LAS __attribute__((address_space(3)))
typedef short bf16x8 __attribute__((ext_vector_type(8)));
constexpr int BM = 256, BK = 64, HALF = 128, HTB = HALF * BK * 2  , STAGE_BYTES = 8 * HTB, NXCD = 8, WGM = 8;
__host__ __device__ __forceinline__ int lds_byte(int r, int c) { const int st = (r >> 4) * 2 + (c >> 5), rr = r & 15, cc = c & 31, ob = rr * 64 + cc * 2; return st * 1024 + (ob ^ (((ob >> 9) & 1) << 5)); }
__host__ __device__ __forceinline__ void stage_rc(int b, int& R, int& C) { const int st = b / 1024, sb = b % 1024, swz = sb ^ (((sb >> 9) & 1) << 5); R = (st >> 1) * 16 + swz / 64; C = (st & 1) * 32 + (swz % 64) / 2; }
__host__ __device__ __forceinline__ int perm32(int rho) { const int n = rho >> 4, i = rho & 15; return 8 * (i >> 2) + 4 * n + (i & 3); }
struct Unit { int pm, pn; };
struct Gemm { const bf16_t* A; const bf16_t* Bt; int M, N, K; };
struct StaticOrder {
    int nM, nN, nwg, G, c;
    __host__ __device__ void init(int M_, int N_, int G_, int c_) { nM = M_ / BM; nN = N_ / BM; nwg = nM * nN; G = G_; c = c_; }
    __host__ __device__ bool next(int i, Unit& u) const {
        const long L = (long)i * G + c; if (L >= nwg) return false;
        int wgid = (int)L; { const int q = nwg / NXCD, r = nwg % NXCD, xcd = wgid % NXCD, off = wgid / NXCD; wgid = (xcd < r ? xcd * (q + 1) : r * (q + 1) + (xcd - r) * q) + off; }
        const int nig = WGM * nN, gid = wgid / nig, fm = gid * WGM, gsz = (nM - fm) < WGM ? (nM - fm) : WGM;
        u.pm = fm + ((wgid % nig) % gsz); u.pn = (wgid % nig) / gsz; return true;
    }
    __device__ __forceinline__ void a_ready(const Unit&) const {}
    __device__ __forceinline__ void done(const Unit&) const {}
};
__device__ __forceinline__ unsigned cvt_pk_bf16(float lo, float hi) { unsigned r; asm volatile("v_cvt_pk_bf16_f32 %0, %1, %2" : "=v"(r) : "v"(lo), "v"(hi)); return r; }

__device__ __forceinline__ float row_rstd(const float* ss, int row, int fq) {
    const f32x4 pq = *(const f32x4*)(ss + (size_t)row * 16 + 4 * fq);
    float s = (pq.x + pq.y) + (pq.z + pq.w);
    s += __shfl_xor(s, 16); s += __shfl_xor(s, 32);
    return rsqrtf(s * (1.f / DM) + EPS);
}
struct EpiInT {
    static constexpr bool PERM = true, AFTER_DRAIN = false;
    const float* ss; const float* bias; bf16_t* proj; float* gates;
    __device__ __forceinline__ void operator()(const f32x4 (&acc)[2][2][4][2], const Unit& u, int wr, int wc, int fr, int fq) const {
        const int row0 = u.pm * BM + wr * 64 + fr, col0 = u.pn * BM + wc * 32 + 8 * fq;
        f32x4 bv[2][2];
#pragma unroll
        for (int bj = 0; bj < 2; ++bj)
#pragma unroll
            for (int n = 0; n < 2; ++n) bv[bj][n] = *(const f32x4*)(bias + col0 + bj * HALF + 4 * n);
#pragma unroll
        for (int ai = 0; ai < 2; ++ai)
#pragma unroll
            for (int m = 0; m < 4; ++m) {
                const int row = row0 + ai * HALF + m * 16;
                const float r = row_rstd(ss, row, fq);
                if (u.pn < 13) {
                    bf16_t* rowp = proj + (size_t)row * NPROJ + col0;
#pragma unroll
                    for (int bj = 0; bj < 2; ++bj) {
                        const f32x4 v0 = acc[ai][bj][m][0] * r + bv[bj][0], v1 = acc[ai][bj][m][1] * r + bv[bj][1];
                        u32x4 w; w.x = cvt_pk_bf16(v0[0], v0[1]); w.y = cvt_pk_bf16(v0[2], v0[3]); w.z = cvt_pk_bf16(v1[0], v1[1]); w.w = cvt_pk_bf16(v1[2], v1[3]);
                        *(u32x4*)(rowp + bj * HALF) = w;
                    }
                } else if (wc == 0) {
                    const f32x4 v0 = acc[ai][0][m][0] * r + bv[0][0], v1 = acc[ai][0][m][1] * r + bv[0][1];
                    float* gp = gates + (size_t)row * 32 + 8 * fq;
                    *(f32x4*)gp = v0; *(f32x4*)(gp + 4) = v1;
                }
            }
    }
};
struct EpiResT {
    static constexpr bool PERM = true, AFTER_DRAIN = false;
    const float* base; float* out; bf16_t* xb; float* ss;
    __device__ __forceinline__ void operator()(const f32x4 (&acc)[2][2][4][2], const Unit& u, int wr, int wc, int fr, int fq) const {
        const int row0 = u.pm * BM + wr * 64 + fr, col0 = u.pn * BM + wc * 32 + 8 * fq;
#pragma unroll
        for (int ai = 0; ai < 2; ++ai)
#pragma unroll
            for (int m = 0; m < 4; ++m) {
                const int row = row0 + ai * HALF + m * 16;
                const size_t off = (size_t)row * DM + col0;
                float sq = 0.f;
#pragma unroll
                for (int bj = 0; bj < 2; ++bj) {
                    const f32x4 x0 = *(const f32x4*)(base + off + bj * HALF) + acc[ai][bj][m][0];
                    const f32x4 x1 = *(const f32x4*)(base + off + bj * HALF + 4) + acc[ai][bj][m][1];
                    *(f32x4*)(out + off + bj * HALF) = x0; *(f32x4*)(out + off + bj * HALF + 4) = x1;
                    u32x4 w; w.x = cvt_pk_bf16(x0[0], x0[1]); w.y = cvt_pk_bf16(x0[2], x0[3]); w.z = cvt_pk_bf16(x1[0], x1[1]); w.w = cvt_pk_bf16(x1[2], x1[3]);
                    *(u32x4*)(xb + off + bj * HALF) = w;
                    sq += (x0[0] * x0[0] + x0[1] * x0[1]) + (x0[2] * x0[2] + x0[3] * x0[3]) + (x1[0] * x1[0] + x1[1] * x1[1]) + (x1[2] * x1[2] + x1[3] * x1[3]);
                }
                sq += __shfl_xor(sq, 16); sq += __shfl_xor(sq, 32);
                if (fq == 0) ss[(size_t)row * 16 + u.pn * 4 + wc] = sq;
                asm volatile("" ::: "memory");
            }
    }
};
struct EpiGUT {
    static constexpr bool PERM = true, AFTER_DRAIN = false;
    const float* ss; bf16_t* act;
    __device__ __forceinline__ void operator()(const f32x4 (&acc)[2][2][4][2], const Unit& u, int wr, int wc, int fr, int fq) const {
        const int row0 = u.pm * BM + wr * 64 + fr, hid0 = u.pn * HALF + wc * 32 + 8 * fq;
#pragma unroll
        for (int ai = 0; ai < 2; ++ai)
#pragma unroll
            for (int m = 0; m < 4; ++m) {
                const int row = row0 + ai * HALF + m * 16;
                const float r = row_rstd(ss, row, fq);
                float a[8];
#pragma unroll
                for (int n = 0; n < 2; ++n)
#pragma unroll
                    for (int j = 0; j < 4; ++j) {
                        const float g = acc[ai][0][m][n][j] * r, up = acc[ai][1][m][n][j] * r;
                        a[4 * n + j] = g * __builtin_amdgcn_rcpf(1.f + __builtin_amdgcn_exp2f(-1.4426950408889634f * g)) * up;
                    }
                u32x4 w; w.x = cvt_pk_bf16(a[0], a[1]); w.y = cvt_pk_bf16(a[2], a[3]); w.z = cvt_pk_bf16(a[4], a[5]); w.w = cvt_pk_bf16(a[6], a[7]);
                *(u32x4*)(act + (size_t)row * FF + hid0) = w;
            }
    }
};

template <class Epi, class Sched, bool ALIGN_EPI = false, bool SP2 = false>
__device__ __forceinline__ void gemm_phase(PG8_LAS unsigned char* lds, const Gemm g, const Sched& S, const Epi& E) {
    const int tid = my_tid(), wid = __builtin_amdgcn_readfirstlane(tid >> 6), lane = tid & 63, wr = wid >> 2, wc = wid & 3, fr = lane & 15, fq = lane >> 4;
    const int K = g.K, nt = K / BK;
    unsigned voffA[2], voffB[2];
#pragma unroll
    for (int i = 0; i < 2; ++i) { int R, C; stage_rc(tid * 16 + i * 8192, R, C); const int Rb = Epi::PERM ? ((R & ~31) + perm32(R & 31)) : R;
        voffA[i] = (unsigned)(R * K + C) * 2u; voffB[i] = (unsigned)(Rb * K + C) * 2u; }
    const size_t kstep = (size_t)(BK * 2);
    const size_t hstep = (size_t)HALF * K * 2;
    const size_t tstep = 2 * hstep;
    const unsigned ldsw = (unsigned)wid * 1024u;
    const int aoff = lds_byte(wr * 64 + fr, fq * 8), boff = lds_byte(wc * 32 + fr, fq * 8);
#define PG8_SA(b, h) (((b) * 2 + (h)) * HTB)
#define PG8_SB(b, h) ((4 + (b) * 2 + (h)) * HTB)
#define PG8_STAGE(bufoff, gbase, voff) do { _Pragma("unroll") for (int _i = 0; _i < 2; ++_i) \
        __builtin_amdgcn_global_load_lds((const unsigned*)((const char*)(gbase) + (voff)[_i]), (PG8_LAS unsigned*)(lds + (bufoff) + ldsw + _i * 8192), 16, 0, 0); } while (0)
#define PG8_LDA(dst, b, h) do { _Pragma("unroll") for (int m = 0; m < 4; ++m) _Pragma("unroll") for (int k = 0; k < 2; ++k) dst[m][k] = *(const PG8_LAS bf16x8*)(lds + PG8_SA(b, h) + aoff + m * 2048 + k * 1024); } while (0)
#define PG8_LDB(dst, b, h) do { _Pragma("unroll") for (int n = 0; n < 2; ++n) _Pragma("unroll") for (int k = 0; k < 2; ++k) dst[n][k] = *(const PG8_LAS bf16x8*)(lds + PG8_SB(b, h) + boff + n * 2048 + k * 1024); } while (0)
#define PG8_MMA(ai, bj, At, Bt) do { __builtin_amdgcn_s_setprio(1); _Pragma("unroll") for (int m = 0; m < 4; ++m) _Pragma("unroll") for (int n = 0; n < 2; ++n) _Pragma("unroll") for (int k = 0; k < 2; ++k) \
        acc[ai][bj][m][n] = __builtin_amdgcn_mfma_f32_16x16x32_bf16(Bt[n][k], At[m][k], acc[ai][bj][m][n], 0, 0, 0); __builtin_amdgcn_s_setprio(0); } while (0)
#define PG8_WAIT_V(n) asm volatile("s_waitcnt vmcnt(" #n ")" ::: "memory")
#define PG8_WAIT_L(n) asm volatile("s_waitcnt lgkmcnt(" #n ")" ::: "memory")
#define PG8_BAR __builtin_amdgcn_s_barrier()
#define PG8_SCHED __builtin_amdgcn_sched_barrier(0)
    Unit cur, nxt; int ui = 0;
    if (!S.next(0, cur)) return;
    f32x4 acc[2][2][4][2];
#pragma unroll
    for (int a = 0; a < 2; ++a)
#pragma unroll
        for (int b = 0; b < 2; ++b)
#pragma unroll
            for (int m = 0; m < 4; ++m)
#pragma unroll
                for (int n = 0; n < 2; ++n) acc[a][b][m][n] = (f32x4){0.f, 0.f, 0.f, 0.f};
    bf16x8 At[4][2], B0[2][2], B1[2][2];
    const char* cA = (const char*)g.A + (size_t)cur.pm * tstep; const char* cB = (const char*)g.Bt + (size_t)cur.pn * tstep;
    S.a_ready(cur);
    if constexpr (SP2) {
        PG8_STAGE(PG8_SB(0, 0), cB, voffB); PG8_STAGE(PG8_SB(0, 1), cB + hstep, voffB); PG8_STAGE(PG8_SA(0, 0), cA, voffA); PG8_STAGE(PG8_SA(0, 1), cA + hstep, voffA);
        if (wr == 1) PG8_BAR;
        PG8_WAIT_V(2); PG8_BAR;
        PG8_STAGE(PG8_SB(1, 0), cB + kstep, voffB); PG8_STAGE(PG8_SA(1, 0), cA + kstep, voffA); PG8_STAGE(PG8_SB(1, 1), cB + hstep + kstep, voffB);
        PG8_WAIT_V(6); PG8_BAR;
    } else {
        PG8_STAGE(PG8_SB(0, 0), cB, voffB); PG8_STAGE(PG8_SA(0, 0), cA, voffA); PG8_STAGE(PG8_SB(0, 1), cB + hstep, voffB); PG8_STAGE(PG8_SA(0, 1), cA + hstep, voffA);
        if (wr == 1) PG8_BAR;
        PG8_WAIT_V(4); PG8_BAR;
        PG8_STAGE(PG8_SB(1, 0), cB + kstep, voffB); PG8_STAGE(PG8_SA(1, 0), cA + kstep, voffA); PG8_STAGE(PG8_SB(1, 1), cB + hstep + kstep, voffB);
        PG8_WAIT_V(6); PG8_BAR;
    }
    for (;;) {
        const bool has_next = S.next(ui + 1, nxt);
        const char* nA = has_next ? (const char*)g.A + (size_t)nxt.pm * tstep : cA; const char* nB = has_next ? (const char*)g.Bt + (size_t)nxt.pn * tstep : cB;
        for (int t = 0; t < nt; t += 2) {
            const bool last = (t == nt - 2);
            const char* a1 = cA + (size_t)(t + 1) * kstep;
            const char* a2 = last ? nA : cA + (size_t)(t + 2) * kstep; const char* b2 = last ? nB : cB + (size_t)(t + 2) * kstep;
            const char* a3 = a2 + kstep; const char* b3 = b2 + kstep;
            if (last && has_next) S.a_ready(nxt);
            if constexpr (SP2) {
            PG8_LDB(B0, 0, 0); PG8_LDB(B1, 0, 1); PG8_SCHED; PG8_LDA(At, 0, 0); PG8_STAGE(PG8_SA(1, 1), a1 + hstep, voffA);
            PG8_WAIT_V(8); PG8_WAIT_L(0); PG8_BAR; PG8_MMA(0, 0, At, B0); PG8_MMA(0, 1, At, B1); PG8_BAR; PG8_SCHED;
            PG8_LDA(At, 0, 1); PG8_STAGE(PG8_SB(0, 0), b2, voffB); PG8_STAGE(PG8_SB(0, 1), b2 + hstep, voffB); PG8_STAGE(PG8_SA(0, 0), a2, voffA);
            PG8_WAIT_V(8); PG8_WAIT_L(0); PG8_BAR; PG8_MMA(1, 0, At, B0); PG8_MMA(1, 1, At, B1); PG8_BAR; PG8_SCHED;
            PG8_LDB(B0, 1, 0); PG8_LDB(B1, 1, 1); PG8_SCHED; PG8_LDA(At, 1, 0); PG8_STAGE(PG8_SA(0, 1), a2 + hstep, voffA);
            PG8_WAIT_V(8); PG8_WAIT_L(0); PG8_BAR; PG8_MMA(0, 0, At, B0); PG8_MMA(0, 1, At, B1); PG8_BAR; PG8_SCHED;
            PG8_LDA(At, 1, 1); PG8_STAGE(PG8_SB(1, 0), b3, voffB); PG8_STAGE(PG8_SB(1, 1), b3 + hstep, voffB); PG8_STAGE(PG8_SA(1, 0), a3, voffA);
            PG8_WAIT_V(8); PG8_WAIT_L(0); PG8_BAR; PG8_MMA(1, 0, At, B0); PG8_MMA(1, 1, At, B1); PG8_BAR; PG8_SCHED;
            } else {
            PG8_LDB(B0, 0, 0); PG8_SCHED; PG8_LDA(At, 0, 0); PG8_STAGE(PG8_SA(1, 1), a1 + hstep, voffA);
            PG8_WAIT_L(8); PG8_BAR; PG8_WAIT_L(0); PG8_MMA(0, 0, At, B0); PG8_BAR; PG8_SCHED;
            PG8_LDB(B1, 0, 1); PG8_STAGE(PG8_SB(0, 0), b2, voffB);
            PG8_BAR; PG8_WAIT_L(0); PG8_MMA(0, 1, At, B1); PG8_BAR;
            PG8_LDA(At, 0, 1); PG8_STAGE(PG8_SA(0, 0), a2, voffA);
            PG8_BAR; PG8_WAIT_L(0); PG8_MMA(1, 0, At, B0); PG8_BAR; PG8_SCHED;
            PG8_STAGE(PG8_SB(0, 1), b2 + hstep, voffB);
            PG8_WAIT_V(6); PG8_BAR; PG8_MMA(1, 1, At, B1); PG8_BAR;
            PG8_LDB(B0, 1, 0); PG8_SCHED; PG8_LDA(At, 1, 0); PG8_STAGE(PG8_SA(0, 1), a2 + hstep, voffA);
            PG8_WAIT_L(8); PG8_BAR; PG8_WAIT_L(0); PG8_MMA(0, 0, At, B0); PG8_BAR; PG8_SCHED;
            PG8_LDB(B1, 1, 1); PG8_STAGE(PG8_SB(1, 0), b3, voffB);
            PG8_BAR; PG8_WAIT_L(0); PG8_MMA(0, 1, At, B1); PG8_BAR;
            PG8_LDA(At, 1, 1); PG8_STAGE(PG8_SA(1, 0), a3, voffA);
            PG8_BAR; PG8_WAIT_L(0); PG8_MMA(1, 0, At, B0); PG8_BAR; PG8_SCHED;
            PG8_STAGE(PG8_SB(1, 1), b3 + hstep, voffB);
            PG8_WAIT_V(6); PG8_BAR; PG8_MMA(1, 1, At, B1); PG8_BAR;
            }
        }
        if constexpr (ALIGN_EPI) { if (wr == 0) PG8_BAR; }
        if constexpr (!Epi::AFTER_DRAIN) { E(acc, cur, wr, wc, fr, fq); S.done(cur); }
        if (!has_next) break;
#pragma unroll
        for (int a = 0; a < 2; ++a)
#pragma unroll
            for (int b = 0; b < 2; ++b)
#pragma unroll
                for (int m = 0; m < 4; ++m)
#pragma unroll
                    for (int n = 0; n < 2; ++n) acc[a][b][m][n] = (f32x4){0.f, 0.f, 0.f, 0.f};
        cur = nxt; cA = nA; cB = nB; ++ui;
        if constexpr (ALIGN_EPI) { if (wr == 1) PG8_BAR; }
    }
    PG8_WAIT_V(0);
    if constexpr (!ALIGN_EPI) { if (wr == 0) PG8_BAR; }
    PG8_BAR;
#undef PG8_SA
#undef PG8_SB
#undef PG8_STAGE
#undef PG8_LDA
#undef PG8_LDB
#undef PG8_MMA
#undef PG8_WAIT_V
#undef PG8_WAIT_L
#undef PG8_BAR
#undef PG8_SCHED
}
}

__device__ void phase_rowpass(const Params& p, int l) {
    unsigned char* ws = p.ws;
    bf16_t* proj = (bf16_t*)(ws + WS_PROJ); bf16_t* qkc = (bf16_t*)(ws + WS_XB);
    const float* qg = p.in[I_QG] + l * 64; const float* kg = p.in[I_KG] + l * 192;
    const float* cw = p.in[I_CW] + l * 4096; const float* cb = p.in[I_CB] + l * 1024;
    const int tid = my_tid(), lane = tid & 63, wave = tid >> 6;
    for (int m = my_bid() * 8 + wave; m < M; m += gridDim.x * 8) {
        const int t = m % SEQ;
        bf16_t* row = proj + (size_t)m * NPROJ;
        {
            const u32x4 raw = *(const u32x4*)(row + C_QA + lane * 8); float f[8]; unpack8(raw, f);
            float s = 0.f;
#pragma unroll
            for (int j = 0; j < 8; ++j) s += f[j] * f[j];
            s += __shfl_xor(s, 1); s += __shfl_xor(s, 2); s += __shfl_xor(s, 4);
            const float r = rsqrtf(s * (1.f / 64.f) + EPS);
            const int d0 = (lane & 7) * 8;
            u32x4 o; o.x = pk2(f[0] * r * qg[d0], f[1] * r * qg[d0 + 1]); o.y = pk2(f[2] * r * qg[d0 + 2], f[3] * r * qg[d0 + 3]);
            o.z = pk2(f[4] * r * qg[d0 + 4], f[5] * r * qg[d0 + 5]); o.w = pk2(f[6] * r * qg[d0 + 6], f[7] * r * qg[d0 + 7]);
            *(u32x4*)(row + C_QA + lane * 8) = o;
        }
        {
            const int which = lane >> 5, w4 = (lane & 31) * 4;
            bf16_t* pp = row + (which ? C_KW : C_KS) + w4;
            const u32x2 raw = *(const u32x2*)pp;
            float f[4] = {lo16(raw.x), hi16(raw.x), lo16(raw.y), hi16(raw.y)};
            float s = (f[0] * f[0] + f[1] * f[1]) + (f[2] * f[2] + f[3] * f[3]);
            s += __shfl_xor(s, 1); s += __shfl_xor(s, 2); s += __shfl_xor(s, 4); s += __shfl_xor(s, 8);
            const float r = rsqrtf(s * (1.f / 64.f) + EPS);
            const float* g = kg + (1 + which) * 64 + (w4 & 63);
            u32x2 o; o.x = pk2(f[0] * r * g[0], f[1] * r * g[1]); o.y = pk2(f[2] * r * g[2], f[3] * r * g[3]);
            *(u32x2*)pp = o;
        }
#pragma unroll
        for (int part = 0; part < 2; ++part) {
            const int c0 = part * 512 + lane * 8;
            float acc[8];
#pragma unroll
            for (int j = 0; j < 8; ++j) acc[j] = cb[c0 + j];
#pragma unroll
            for (int w = 0; w < 4; ++w) {
                if (t - 3 + w >= 0) {
                    const u32x4 raw = *(const u32x4*)(proj + (size_t)(m - 3 + w) * NPROJ + C_QB + c0); float f[8]; unpack8(raw, f);
#pragma unroll
                    for (int j = 0; j < 8; ++j) acc[j] += f[j] * cw[w * 1024 + c0 + j];
                }
            }
            const float sc = part ? 0.08838834764831845f : 1.f;
            float y[8];
#pragma unroll
            for (int j = 0; j < 8; ++j) y[j] = silu_f(acc[j]) * sc;
            u32x4 o; o.x = pk2(y[0], y[1]); o.y = pk2(y[2], y[3]); o.z = pk2(y[4], y[5]); o.w = pk2(y[6], y[7]);
            *(u32x4*)(qkc + (size_t)m * 1024 + c0) = o;
        }
    }
}

__device__ void phase_compress(const Params& p, int l, float* lds) {
    unsigned char* ws = p.ws;
    const bf16_t* proj = (const bf16_t*)(ws + WS_PROJ);
    const float* pe = p.in[I_PE] + (size_t)l * 2 * 2048; const float* w1 = p.in[I_W1] + (size_t)l * 2 * 2048 * 128; const float* w2 = p.in[I_W2] + (size_t)l * 2 * 128 * 64;
    const float* kg0 = p.in[I_KG] + l * 192;
    float* tok = lds;
    float* red = lds + 144 * 64;
    float* hidb = red + 4 * 8 * 128;
    const int tid = my_tid(), lane = tid & 63;
    for (int u = my_bid(); u < BATCH * 2 * 2 * 32; u += gridDim.x) {
        const int ib = u & 31, kv = (u >> 5) & 1, g = (u >> 6) & 1, b = u >> 7;
        const int i0 = ib * 8, ni = (NCMP - i0) < 8 ? (NCMP - i0) : 8;
        const int ntok = 16 * ni + 16;
        const int col = (kv ? C_VC : C_KC) + g * 64;
        __syncthreads();
        for (int e = tid; e < 144 * 64; e += NT) {
            const int tt = e >> 6, d = e & 63;
            tok[e] = tt < ntok ? bf2f(proj[(size_t)(b * SEQ + 16 * i0 + tt) * NPROJ + col + d]) : 0.f;
        }
        __syncthreads();
        {
            const int hid = tid & 127, part = tid >> 7;
            float acc[8], accP = 0.f;
#pragma unroll
            for (int ii = 0; ii < 8; ++ii) acc[ii] = 0.f;
            const float* w1p = w1 + (size_t)kv * 2048 * 128 + hid; const float* pep = pe + kv * 2048;
#pragma unroll 2
            for (int f = part * 512; f < part * 512 + 512; ++f) {
                const float w = w1p[(size_t)f * 128];
                accP += w * pep[f];
#pragma unroll
                for (int ii = 0; ii < 8; ++ii) acc[ii] += w * tok[16 * 64 * ii + f];
            }
#pragma unroll
            for (int ii = 0; ii < 8; ++ii) red[(part * 8 + ii) * 128 + hid] = acc[ii] + accP;
        }
        __syncthreads();
        for (int e = tid; e < 8 * 128; e += NT) {
            const float s = (red[e] + red[1024 + e]) + (red[2048 + e] + red[3072 + e]);
            hidb[e] = silu_f(s);
        }
        __syncthreads();
        {
            const int ii = tid >> 6, d = lane;
            float o = 0.f;
            const float* w2p = w2 + (size_t)kv * 128 * 64 + d;
            for (int h = 0; h < 128; ++h) o += hidb[ii * 128 + h] * w2p[h * 64];
            if (kv == 0) { const float s = wave_sum(o * o); o = o * rsqrtf(s * (1.f / 64.f) + EPS) * kg0[d]; }
            bf16_t* dst = (bf16_t*)(ws + (kv ? WS_VCMP : WS_KCMP));
            if (ii < ni) dst[(size_t)((b * 2 + g) * NCMPP + i0 + ii) * 64 + d] = f2bf(o);
        }
    }
    __syncthreads();
}

__device__ __forceinline__ float log_sigmoid_f(float x) { return fminf(x, 0.f) - log1pf(__expf(-fabsf(x))); }
__device__ void mlstm_gates(const float* gates, const float* fb, int m0, int h, float* bcum, float* ig) {
    const int tid = my_tid();
    __syncthreads();
    if (tid < 64) {
        const float lf = log_sigmoid_f(gates[(size_t)(m0 + tid) * 32 + 28 + h] + fb[h]);
        ig[tid] = gates[(size_t)(m0 + tid) * 32 + 24 + h];
        float v = lf;
#pragma unroll
        for (int o = 1; o < 64; o <<= 1) { const float t = __shfl_up(v, o); if (tid >= o) v += t; }
        bcum[tid] = v;
    }
    __syncthreads();
}

__device__ void phase_chunkstate(const Params& p, int l, float* lds) {
    unsigned char* ws = p.ws;
    const bf16_t* proj = (const bf16_t*)(ws + WS_PROJ); const float* gates = (const float*)(ws + WS_GATES);
    const float* cw = p.in[I_CW] + l * 4096; const float* cb = p.in[I_CB] + l * 1024; const float* fb = p.in[I_FB] + l * 4;
    bf16_t* ST = (bf16_t*)(ws + WS_ST); float* STN = (float*)(ws + WS_STN); float* STM = (float*)(ws + WS_STM);
    float* kw = lds;
    float* vv = lds + 8192;
    float* bcum = lds + 16384; float* ig = bcum + 64; float* wsc = ig + 64; float* misc = wsc + 64;
    const int tid = my_tid();
    for (int u = my_bid(); u < BATCH * 4 * 64; u += gridDim.x) {
        const int c = u & 63, h = (u >> 6) & 3, b = u >> 8;
        const int m0 = b * SEQ + c * 64, bh = b * 4 + h;
        mlstm_gates(gates, fb, m0, h, bcum, ig);
        if (tid < 64) {
            const float gv = bcum[63] - bcum[tid] + ig[tid];
            const float mx = wave_max(gv);
            wsc[tid] = __expf(gv - mx);
            if (tid == 0) { misc[0] = mx; STM[bh * 64 + c] = mx; STM[2048 + bh * 64 + c] = bcum[63]; }
        }
        __syncthreads();
        for (int e = tid; e < 64 * 16; e += NT) {
            const int s = e >> 4, d0 = (e & 15) * 8;
            const int t = c * 64 + s, ch = 512 + h * 128 + d0;
            float acc[8];
#pragma unroll
            for (int j = 0; j < 8; ++j) acc[j] = cb[ch + j];
#pragma unroll
            for (int w = 0; w < 4; ++w) {
                if (t - 3 + w >= 0) {
                    const u32x4 raw = *(const u32x4*)(proj + (size_t)(m0 + s - 3 + w) * NPROJ + C_QB + ch); float f[8]; unpack8(raw, f);
#pragma unroll
                    for (int j = 0; j < 8; ++j) acc[j] += f[j] * cw[w * 1024 + ch + j];
                }
            }
            const float sc = 0.08838834764831845f * wsc[s];
#pragma unroll
            for (int j = 0; j < 8; ++j) kw[s * 128 + d0 + j] = silu_f(acc[j]) * sc;
            const u32x4 rv = *(const u32x4*)(proj + (size_t)(m0 + s) * NPROJ + C_VB + h * 128 + d0); float fv[8]; unpack8(rv, fv);
#pragma unroll
            for (int j = 0; j < 8; ++j) vv[s * 128 + d0 + j] = fv[j];
        }
        __syncthreads();
        {
            const int e0 = (tid >> 4) * 4, d0 = (tid & 15) * 8;
            float acc[4][8];
#pragma unroll
            for (int i = 0; i < 4; ++i)
#pragma unroll
                for (int j = 0; j < 8; ++j) acc[i][j] = 0.f;
#pragma unroll 2
            for (int s = 0; s < 64; ++s) {
                const f32x4 ve = *(const f32x4*)(vv + s * 128 + e0);
                const f32x4 k0 = *(const f32x4*)(kw + s * 128 + d0), k1 = *(const f32x4*)(kw + s * 128 + d0 + 4);
                const float va[4] = {ve.x, ve.y, ve.z, ve.w}; const float ka[8] = {k0.x, k0.y, k0.z, k0.w, k1.x, k1.y, k1.z, k1.w};
#pragma unroll
                for (int i = 0; i < 4; ++i)
#pragma unroll
                    for (int j = 0; j < 8; ++j) acc[i][j] += va[i] * ka[j];
            }
#pragma unroll
            for (int i = 0; i < 4; ++i) {
                u32x4 o; o.x = pk2(acc[i][0], acc[i][1]); o.y = pk2(acc[i][2], acc[i][3]); o.z = pk2(acc[i][4], acc[i][5]); o.w = pk2(acc[i][6], acc[i][7]);
                *(u32x4*)(ST + ((size_t)(bh * 64 + c) * 128 + e0 + i) * 128 + d0) = o;
            }
        }
        if (tid < 128) {
            float s = 0.f;
            for (int q = 0; q < 64; ++q) s += kw[q * 128 + tid];
            STN[(size_t)(bh * 64 + c) * 128 + tid] = s;
        }
    }
    __syncthreads();
}

__device__ void phase_scan(const Params& p) {
    unsigned char* ws = p.ws;
    bf16_t* ST = (bf16_t*)(ws + WS_ST); float* STN = (float*)(ws + WS_STN); float* STM = (float*)(ws + WS_STM);
    const int tid = my_tid();
    for (int u = my_bid(); u < 128; u += gridDim.x) {
        const int bh = u >> 2, idx = ((u & 3) * NT + tid) * 8;
        float C[8];
#pragma unroll
        for (int j = 0; j < 8; ++j) C[j] = 0.f;
        float nval = 0.f; const bool do_n = (u & 3) == 0 && tid < 128;
        float m = 0.f;
        for (int c = 0; c < 64; ++c) {
            const float mloc = STM[bh * 64 + c], bl = STM[2048 + bh * 64 + c];
            const float mnew = fmaxf(bl + m, mloc);
            const float decay = __expf(bl + m - mnew), scale = __expf(mloc - mnew);
            bf16_t* sp = ST + (size_t)(bh * 64 + c) * 16384 + idx;
            const u32x4 raw = *(const u32x4*)sp; float f[8]; unpack8(raw, f);
            u32x4 o; o.x = pk2(C[0], C[1]); o.y = pk2(C[2], C[3]); o.z = pk2(C[4], C[5]); o.w = pk2(C[6], C[7]);
            *(u32x4*)sp = o;
#pragma unroll
            for (int j = 0; j < 8; ++j) C[j] = decay * C[j] + scale * f[j];
            if (do_n) {
                float* np = STN + (size_t)(bh * 64 + c) * 128 + tid;
                const float dn = *np; *np = nval; nval = decay * nval + scale * dn;
            }
            if ((u & 3) == 0 && tid == 0) STM[4096 + bh * 64 + c] = m;
            m = mnew;
        }
    }
}

__device__ void phase_attn_naive(const Params& p, int l, float* lds) {
    unsigned char* ws = p.ws;
    const bf16_t* proj = (const bf16_t*)(ws + WS_PROJ); const float* gates = (const float*)(ws + WS_GATES);
    const bf16_t* kcmp = (const bf16_t*)(ws + WS_KCMP); const bf16_t* vcmp = (const bf16_t*)(ws + WS_VCMP);
    bf16_t* Y = (bf16_t*)(ws + WS_Y);
    const float* oga = p.in[I_OGA] + l * 512;
    const int tid = my_tid(), lane = tid & 63, wave = tid >> 6;
    float* qs = lds + wave * (256 + 1024);
    float* pb = qs + 256;
    for (int u = my_bid(); u < BATCH * 2 * (SEQ / 8); u += gridDim.x) {
        const int tb = u % (SEQ / 8), g = (u / (SEQ / 8)) & 1, b = u / (SEQ / 4);
        const int t = tb * 8 + wave; const int m = b * SEQ + t;
        const bf16_t* prow = proj + (size_t)m * NPROJ;
#pragma unroll
        for (int hg = 0; hg < 4; ++hg) qs[hg * 64 + lane] = bf2f(prow[C_QA + g * 256 + hg * 64 + lane]);
        float otot[4] = {0.f, 0.f, 0.f, 0.f};
        const float* gt = gates + (size_t)m * 32 + g * 12;
        const int nval = t >= 31 ? ((t - 31) >> 4) + 1 : 0;
        float sc[4][4];
        float mx[4] = {-INFINITY, -INFINITY, -INFINITY, -INFINITY};
        const bf16_t* kc = kcmp + (size_t)(b * 2 + g) * NCMPP * 64; const bf16_t* vc = vcmp + (size_t)(b * 2 + g) * NCMPP * 64;
#pragma unroll
        for (int it = 0; it < 4; ++it) {
            asm volatile("" ::: "memory");
            const int i = it * 64 + lane;
            float a[4] = {0.f, 0.f, 0.f, 0.f};
            if (i < nval) {
#pragma unroll 1
                for (int d8 = 0; d8 < 8; ++d8) {
                    const u32x4 raw = *(const u32x4*)(kc + (size_t)i * 64 + d8 * 8); float f[8]; unpack8(raw, f);
#pragma unroll
                    for (int j = 0; j < 8; ++j)
#pragma unroll
                        for (int hg = 0; hg < 4; ++hg) a[hg] += qs[hg * 64 + d8 * 8 + j] * f[j];
                }
            }
#pragma unroll
            for (int hg = 0; hg < 4; ++hg) { sc[it][hg] = i < nval ? a[hg] * 0.125f : -INFINITY; mx[hg] = fmaxf(mx[hg], sc[it][hg]); }
        }
        float sm[4];
#pragma unroll
        for (int hg = 0; hg < 4; ++hg) {
            mx[hg] = wave_max(mx[hg]);
            float s = 0.f;
#pragma unroll
            for (int it = 0; it < 4; ++it) { const float e = (it * 64 + lane) < nval ? __expf(sc[it][hg] - mx[hg]) : 0.f; sc[it][hg] = e; s += e; }
            sm[hg] = wave_sum(s);
        }
#pragma unroll
        for (int it = 0; it < 4; ++it)
#pragma unroll
            for (int hg = 0; hg < 4; ++hg) pb[hg * 256 + it * 64 + lane] = nval > 0 ? sc[it][hg] / sm[hg] : 0.f;
        {
            float o[4] = {0.f, 0.f, 0.f, 0.f};
            for (int i = 0; i < nval; ++i) {
                const float v = bf2f(vc[(size_t)i * 64 + lane]);
#pragma unroll
                for (int hg = 0; hg < 4; ++hg) o[hg] += pb[hg * 256 + i] * v;
            }
#pragma unroll
            for (int hg = 0; hg < 4; ++hg) otot[hg] += sigmoid_f(gt[hg * 3 + 0]) * o[hg];
        }
        const int cur = t >> 6;
        float imp = 0.f;
#pragma unroll
        for (int k = -1; k < 4; ++k) {
            const int i = 4 * lane + k;
            if (i >= 0 && i < nval) imp += (pb[i] + pb[256 + i]) + (pb[512 + i] + pb[768 + i]);
        }
        const bool valid = lane <= cur;
        const bool forced = (lane == 0) || (lane == cur) || (lane == cur - 1);
        const float score = valid ? imp + (forced ? 1e4f : 0.f) : -1e30f;
        int rank = 0;
        for (int k = 0; k < 64; ++k) {
            const float sk = __shfl(score, k);
            rank += (sk > score || (sk == score && k < lane)) ? 1 : 0;
        }
        const unsigned long long selmask = __ballot(rank < 16 && valid);
#pragma unroll 1
        for (int br = 0; br < 2; ++br) {
            const int kcol = (br ? C_KW : C_KS) + g * 64, vcol = (br ? C_VW : C_VS) + g * 64;
            float mr[4] = {-INFINITY, -INFINITY, -INFINITY, -INFINITY}, lr[4] = {0.f, 0.f, 0.f, 0.f}, o[4] = {0.f, 0.f, 0.f, 0.f};
            const int jlo = br ? (cur >= 8 ? cur - 8 : 0) : 0;
            for (int j = jlo; j <= cur; ++j) {
                if (br == 0 && !((selmask >> j) & 1ull)) continue;
                asm volatile("" ::: "memory");
                const int pos = j * 64 + lane;
                const bool ok = pos <= t && (br == 0 || pos > t - 512);
                float a[4] = {0.f, 0.f, 0.f, 0.f};
                const bf16_t* kr = proj + (size_t)(b * SEQ + pos) * NPROJ + kcol;
#pragma unroll 1
                for (int d8 = 0; d8 < 8; ++d8) {
                    const u32x4 raw = *(const u32x4*)(kr + d8 * 8); float f[8]; unpack8(raw, f);
#pragma unroll
                    for (int jj = 0; jj < 8; ++jj)
#pragma unroll
                        for (int hg = 0; hg < 4; ++hg) a[hg] += qs[hg * 64 + d8 * 8 + jj] * f[jj];
                }
                float alpha[4];
#pragma unroll
                for (int hg = 0; hg < 4; ++hg) {
                    const float s = ok ? a[hg] * 0.125f : -INFINITY;
                    const float bm = wave_max(s);
                    const float mn = fmaxf(mr[hg], bm);
                    alpha[hg] = (mn == -INFINITY) ? 1.f : __expf(mr[hg] - mn);
                    const float e = (ok && mn > -INFINITY) ? __expf(s - mn) : 0.f;
                    lr[hg] = lr[hg] * alpha[hg] + wave_sum(e);
                    mr[hg] = mn;
                    pb[hg * 256 + lane] = e;
                    o[hg] *= alpha[hg];
                }
                const bf16_t* vr = proj + (size_t)(b * SEQ + j * 64) * NPROJ + vcol + lane;
                for (int k = 0; k < 64; ++k) {
                    const float v = bf2f(vr[(size_t)k * NPROJ]);
#pragma unroll
                    for (int hg = 0; hg < 4; ++hg) o[hg] += pb[hg * 256 + k] * v;
                }
            }
#pragma unroll
            for (int hg = 0; hg < 4; ++hg) otot[hg] += sigmoid_f(gt[hg * 3 + 1 + br]) * (lr[hg] > 0.f ? o[hg] / lr[hg] : 0.f);
        }
#pragma unroll
        for (int hg = 0; hg < 4; ++hg) {
            const float s = wave_sum(otot[hg] * otot[hg]);
            const float y = otot[hg] * rsqrtf(s * (1.f / 64.f) + EPS) * oga[(g * 4 + hg) * 64 + lane];
            Y[(size_t)m * 1024 + (g * 4 + hg) * 64 + lane] = f2bf(y);
        }
    }
}

namespace att {
typedef short bf16x8 __attribute__((ext_vector_type(8)));
typedef short s16x4 __attribute__((ext_vector_type(4)));
typedef float f32x16 __attribute__((ext_vector_type(16)));
#define ATT_LAS __attribute__((address_space(3)))
constexpr int L_K = 0, L_V = 16384, L_IMP = 32768, IMP_STRIDE = 65, L_SEL = L_IMP + 4 * 64 * IMP_STRIDE * 4, L_INV = L_SEL + 512, L_WS = L_INV + 1024, L_OST = L_WS + 8 * 256, L_END = L_OST + 8 * 4096;
static_assert(L_END <= LDS_BYTES, "attention LDS map");
constexpr float LOG2E = 1.4426950408889634f;
__device__ __forceinline__ int crow(int r, int hi) { return (r & 3) + 8 * (r >> 2) + 4 * hi; }
__device__ __forceinline__ unsigned cvtpk(float lo, float hi) { unsigned r; asm("v_cvt_pk_bf16_f32 %0, %1, %2" : "=v"(r) : "v"(lo), "v"(hi)); return r; }
__device__ __forceinline__ s16x4 vtr(ATT_LAS const unsigned char* p) { return __builtin_bit_cast(s16x4, __builtin_amdgcn_ds_read_tr16_b64_v4i16((ATT_LAS s16x4*)p)); }

struct Ctx {
    ATT_LAS unsigned char* lds;
    int lane, wave, r32, hi;
    u32x4 kreg, vreg;
};
__device__ __forceinline__ void tile_load(Ctx& C, const bf16_t* kbase, const bf16_t* vbase, int pitch) {
    C.kreg = *(const u32x4*)(kbase + (size_t)C.lane * pitch + C.wave * 8);
    C.vreg = *(const u32x4*)(vbase + (size_t)(16 * (C.wave & 3) + (C.lane >> 2)) * pitch + (C.wave >> 2) * 32 + (C.lane & 3) * 8);
}
__device__ __forceinline__ void tile_store(Ctx& C, int buf) {
    *(ATT_LAS u32x4*)(C.lds + L_K + buf * 8192 + C.wave * 1024 + C.lane * 16) = C.kreg;
    *(ATT_LAS u32x4*)(C.lds + L_V + buf * 8192 + C.wave * 1024 + C.lane * 16) = C.vreg;
}
__device__ __forceinline__ void qkt(const Ctx& C, int buf, const bf16x8 (&qr)[4], f32x16& p0, f32x16& p1) {
    ATT_LAS const unsigned char* kb = C.lds + L_K + buf * 8192 + C.hi * 1024 + C.r32 * 16;
    p0 = (f32x16){0.f, 0.f, 0.f, 0.f, 0.f, 0.f, 0.f, 0.f, 0.f, 0.f, 0.f, 0.f, 0.f, 0.f, 0.f, 0.f}; p1 = p0;
#pragma unroll
    for (int d0 = 0; d0 < 4; ++d0) {
        const bf16x8 b0 = *(ATT_LAS const bf16x8*)(kb + d0 * 2048);
        const bf16x8 b1 = *(ATT_LAS const bf16x8*)(kb + d0 * 2048 + 512);
        p0 = __builtin_amdgcn_mfma_f32_32x32x16_bf16(b0, qr[d0], p0, 0, 0, 0);
        p1 = __builtin_amdgcn_mfma_f32_32x32x16_bf16(b1, qr[d0], p1, 0, 0, 0);
    }
}
__device__ __forceinline__ void pv(const Ctx& C, int buf, const f32x16& p0, const f32x16& p1, f32x16 (&o)[2]) {
    ATT_LAS const unsigned char* vp = C.lds + L_V + buf * 8192 + ((C.lane >> 4) & 1) * 32 + (C.lane & 3) * 8 + (4 * C.hi + ((C.lane & 15) >> 2)) * 64;
    bf16x8 pa[4];
#pragma unroll
    for (int s2 = 0; s2 < 2; ++s2) {
        u32x4 w0, w1;
        w0.x = cvtpk(p0[8 * s2 + 0], p0[8 * s2 + 1]); w0.y = cvtpk(p0[8 * s2 + 2], p0[8 * s2 + 3]); w0.z = cvtpk(p0[8 * s2 + 4], p0[8 * s2 + 5]); w0.w = cvtpk(p0[8 * s2 + 6], p0[8 * s2 + 7]);
        w1.x = cvtpk(p1[8 * s2 + 0], p1[8 * s2 + 1]); w1.y = cvtpk(p1[8 * s2 + 2], p1[8 * s2 + 3]); w1.z = cvtpk(p1[8 * s2 + 4], p1[8 * s2 + 5]); w1.w = cvtpk(p1[8 * s2 + 6], p1[8 * s2 + 7]);
        pa[s2] = __builtin_bit_cast(bf16x8, w0); pa[2 + s2] = __builtin_bit_cast(bf16x8, w1);
    }
#pragma unroll
    for (int d0 = 0; d0 < 2; ++d0)
#pragma unroll
        for (int ks = 0; ks < 4; ++ks) {
            const s16x4 lo = vtr(vp + d0 * 4096 + ks * 1024), hh = vtr(vp + d0 * 4096 + ks * 1024 + 512);
            const bf16x8 vf = (bf16x8){lo[0], lo[1], lo[2], lo[3], hh[0], hh[1], hh[2], hh[3]};
            o[d0] = __builtin_amdgcn_mfma_f32_32x32x16_bf16(pa[ks], vf, o[d0], 0, 0, 0);
        }
}
__device__ __forceinline__ float sum16(const f32x16& p) {
    return ((p[0] + p[1]) + (p[2] + p[3])) + ((p[4] + p[5]) + (p[6] + p[7])) + (((p[8] + p[9]) + (p[10] + p[11])) + ((p[12] + p[13]) + (p[14] + p[15])));
}
__device__ __forceinline__ void accum_scaled(const Ctx& C, f32x16 (&otot)[2], const f32x16 (&o)[2], float fac) {
    ATT_LAS float* wsf = (ATT_LAS float*)(C.lds + L_WS) + C.wave * 64;
    asm volatile("s_waitcnt lgkmcnt(0)" ::: "memory");
    if (C.hi == 0) wsf[C.r32] = fac;
    asm volatile("s_waitcnt lgkmcnt(0)" ::: "memory");
#pragma unroll
    for (int r = 0; r < 16; ++r) { const float f = wsf[crow(r, C.hi)]; otot[0][r] += o[0][r] * f; otot[1][r] += o[1][r] * f; }
    asm volatile("s_waitcnt lgkmcnt(0)" : "+v"(otot[0]), "+v"(otot[1]) :: "memory");
}

__device__ void unit(const Params& p, int l, int b, int g, int c, ATT_LAS unsigned char* lds) {
    unsigned char* ws = p.ws;
    const bf16_t* proj = (const bf16_t*)(ws + WS_PROJ); const float* gates = (const float*)(ws + WS_GATES);
    const bf16_t* kcmp = (const bf16_t*)(ws + WS_KCMP) + (size_t)(b * 2 + g) * NCMPP * 64; const bf16_t* vcmp = (const bf16_t*)(ws + WS_VCMP) + (size_t)(b * 2 + g) * NCMPP * 64;
    bf16_t* Y = (bf16_t*)(ws + WS_Y);
    const float* kg = p.in[I_KG] + l * 192; const float* oga = p.in[I_OGA] + l * 512;
    Ctx C; C.lds = lds;
    const int tid = my_tid(); C.lane = tid & 63; C.wave = __builtin_amdgcn_readfirstlane(tid >> 6); C.r32 = C.lane & 31; C.hi = C.lane >> 5;
    const int lane = C.lane, wave = C.wave, r32 = C.r32, hi = C.hi, hg = wave >> 1, th = wave & 1;
    const int t = 64 * c + 32 * th + r32; const size_t m = (size_t)b * SEQ + t;
    const bf16_t* prow0 = proj + (size_t)b * SEQ * NPROJ;
    bf16x8 qr[4]; float qsq = 0.f;
#pragma unroll
    for (int d0 = 0; d0 < 4; ++d0) {
        const u32x4 raw = *(const u32x4*)(proj + m * NPROJ + C_QA + g * 256 + hg * 64 + 16 * d0 + 8 * hi);
        qr[d0] = __builtin_bit_cast(bf16x8, raw);
        float f[8]; unpack8(raw, f);
#pragma unroll
        for (int j = 0; j < 8; ++j) qsq += f[j] * f[j];
    }
    qsq += __shfl_xor(qsq, 32);
    const float qn = sqrtf(qsq) * 1.01f * LOG2E;
    const float off_c = qn * wave_max(fabsf(kg[lane])), off_s = qn * wave_max(fabsf(kg[64 + lane])), off_w = qn * wave_max(fabsf(kg[128 + lane]));
    const float* gt = gates + m * 32 + (g * 4 + hg) * 3;
    const float gq0 = sigmoid_f(gt[0]), gq1 = sigmoid_f(gt[1]), gq2 = sigmoid_f(gt[2]);
    constexpr float C2 = 0.125f * LOG2E;
    f32x16 otot[2]; otot[0] = (f32x16){0.f, 0.f, 0.f, 0.f, 0.f, 0.f, 0.f, 0.f, 0.f, 0.f, 0.f, 0.f, 0.f, 0.f, 0.f, 0.f}; otot[1] = otot[0];
    const f32x16 zero16 = otot[0];
    {
        const int nval = t >= 31 ? ((t - 31) >> 4) + 1 : 0;
        const int ntc = (4 * c + 3 + 63) >> 6;
        f32x16 o[2]; o[0] = zero16; o[1] = zero16;
        float lsum = 0.f, yprev = 0.f;
        ATT_LAS float* imp = (ATT_LAS float*)(lds + L_IMP) + (hg * 64 + 32 * th + r32) * IMP_STRIDE;
        tile_load(C, kcmp, vcmp, 64); tile_store(C, 0); __syncthreads();
#pragma unroll
        for (int jt = 0; jt < 4; ++jt) {
            if (jt < ntc) {
                if (jt + 1 < ntc) tile_load(C, kcmp + (size_t)(jt + 1) * 64 * 64, vcmp + (size_t)(jt + 1) * 64 * 64, 64);
                f32x16 p0, p1; qkt(C, jt & 1, qr, p0, p1);
#pragma unroll
                for (int r = 0; r < 16; ++r) {
                    const int i0 = 64 * jt + crow(r, hi);
                    p0[r] = i0 < nval ? __builtin_amdgcn_exp2f(p0[r] * C2 - off_c) : 0.f;
                    p1[r] = i0 + 32 < nval ? __builtin_amdgcn_exp2f(p1[r] * C2 - off_c) : 0.f;
                }
                lsum += sum16(p0) + sum16(p1);
#pragma unroll
                for (int H = 0; H < 2; ++H)
#pragma unroll
                    for (int rr = 0; rr < 4; ++rr) {
                        const f32x16& pp = H ? p1 : p0;
                        const float L = pp[4 * rr + 3], S4 = (pp[4 * rr] + pp[4 * rr + 1]) + (pp[4 * rr + 2] + L);
                        const float y = __shfl_xor(L, 32);
                        imp[2 * ((jt * 2 + H) * 4 + rr) + hi] = S4 + (hi ? y : yprev);
                        yprev = y;
                    }
                pv(C, jt & 1, p0, p1, o);
                if (jt + 1 < ntc) tile_store(C, (jt + 1) & 1);
                __syncthreads();
            }
        }
        lsum += __shfl_xor(lsum, 32);
        const float inv = lsum > 0.f ? 1.f / lsum : 0.f;
        if (hi == 0) ((ATT_LAS float*)(lds + L_INV))[hg * 64 + 32 * th + r32] = inv;
        accum_scaled(C, otot, o, gq0 * inv);
    }
    __syncthreads();
    {
        ATT_LAS unsigned long long* selm = (ATT_LAS unsigned long long*)(lds + L_SEL);
        const ATT_LAS float* impb = (const ATT_LAS float*)(lds + L_IMP);
        for (int i = 0; i < 8; ++i) {
            const int q = wave * 8 + i;
            unsigned long long msk;
            if (c < 16) msk = (2ull << c) - 1ull;
            else {
                const bool valid = lane <= c;
                float sc = -1e30f;
                if (valid) {
                    const ATT_LAS float* invb = (const ATT_LAS float*)(lds + L_INV);
                    sc = (impb[(0 * 64 + q) * IMP_STRIDE + lane] * invb[q] + impb[(1 * 64 + q) * IMP_STRIDE + lane] * invb[64 + q]) + (impb[(2 * 64 + q) * IMP_STRIDE + lane] * invb[128 + q] + impb[(3 * 64 + q) * IMP_STRIDE + lane] * invb[192 + q]);
                    if (lane == 0 || lane == c || lane == c - 1) sc += 1e4f;
                }
                int rank = 0;
                for (int k = 0; k <= c; ++k) { const float sk = __shfl(sc, k); rank += (sk > sc || (sk == sc && k < lane)) ? 1 : 0; }
                msk = __ballot(valid && rank < 16);
            }
            if (lane == 0) selm[q] = msk;
        }
    }
    __syncthreads();
    const unsigned long long mysel = ((ATT_LAS const unsigned long long*)(lds + L_SEL))[32 * th + r32];
    unsigned long long blkmask;
    {
        unsigned long long v = ((ATT_LAS const unsigned long long*)(lds + L_SEL))[lane];
#pragma unroll
        for (int o2 = 1; o2 < 64; o2 <<= 1) v |= __shfl_xor(v, o2);
        blkmask = ((unsigned long long)__builtin_amdgcn_readfirstlane((unsigned)(v >> 32)) << 32) | (unsigned)__builtin_amdgcn_readfirstlane((unsigned)v);
    }
    {
        f32x16 o[2]; o[0] = zero16; o[1] = zero16; float lsum = 0.f;
        const bf16_t* kb = prow0 + C_KS + g * 64; const bf16_t* vb = prow0 + C_VS + g * 64;
        unsigned long long rem = blkmask;
        int j = __builtin_ctzll(rem); rem &= rem - 1ull;
        tile_load(C, kb + (size_t)j * 64 * NPROJ, vb + (size_t)j * 64 * NPROJ, NPROJ); tile_store(C, 0); __syncthreads();
        int buf = 0;
        for (;;) {
            const int jn = rem ? __builtin_ctzll(rem) : -1;
            if (jn >= 0) { rem &= rem - 1ull; tile_load(C, kb + (size_t)jn * 64 * NPROJ, vb + (size_t)jn * 64 * NPROJ, NPROJ); }
            f32x16 p0, p1; qkt(C, buf, qr, p0, p1);
            const bool sel = (mysel >> j) & 1ull;
            const int lim = t - 64 * j;
#pragma unroll
            for (int r = 0; r < 16; ++r) {
                const int kk = crow(r, hi);
                p0[r] = (sel && kk <= lim) ? __builtin_amdgcn_exp2f(p0[r] * C2 - off_s) : 0.f;
                p1[r] = (sel && kk + 32 <= lim) ? __builtin_amdgcn_exp2f(p1[r] * C2 - off_s) : 0.f;
            }
            lsum += sum16(p0) + sum16(p1);
            pv(C, buf, p0, p1, o);
            if (jn >= 0) tile_store(C, buf ^ 1);
            __syncthreads();
            if (jn < 0) break;
            j = jn; buf ^= 1;
        }
        lsum += __shfl_xor(lsum, 32);
        accum_scaled(C, otot, o, gq1 / lsum);
    }
    {
        f32x16 o[2]; o[0] = zero16; o[1] = zero16; float lsum = 0.f;
        const bf16_t* kb = prow0 + C_KW + g * 64; const bf16_t* vb = prow0 + C_VW + g * 64;
        const int jlo = c >= 8 ? c - 8 : 0;
        tile_load(C, kb + (size_t)jlo * 64 * NPROJ, vb + (size_t)jlo * 64 * NPROJ, NPROJ); tile_store(C, 0); __syncthreads();
        int buf = 0;
        for (int j = jlo; j <= c; ++j) {
            if (j < c) tile_load(C, kb + (size_t)(j + 1) * 64 * NPROJ, vb + (size_t)(j + 1) * 64 * NPROJ, NPROJ);
            f32x16 p0, p1; qkt(C, buf, qr, p0, p1);
            const int lim = t - 64 * j;
#pragma unroll
            for (int r = 0; r < 16; ++r) {
                const int kk = crow(r, hi);
                p0[r] = (kk <= lim && kk > lim - 512) ? __builtin_amdgcn_exp2f(p0[r] * C2 - off_w) : 0.f;
                p1[r] = (kk + 32 <= lim && kk + 32 > lim - 512) ? __builtin_amdgcn_exp2f(p1[r] * C2 - off_w) : 0.f;
            }
            lsum += sum16(p0) + sum16(p1);
            pv(C, buf, p0, p1, o);
            if (j < c) tile_store(C, buf ^ 1);
            __syncthreads();
            buf ^= 1;
        }
        lsum += __shfl_xor(lsum, 32);
        accum_scaled(C, otot, o, gq2 / lsum);
    }
    {
        ATT_LAS bf16_t* stg = (ATT_LAS bf16_t*)(lds + L_OST) + wave * 2048;
        const float g0 = oga[(g * 4 + hg) * 64 + r32], g1 = oga[(g * 4 + hg) * 64 + 32 + r32];
#pragma unroll
        for (int r = 0; r < 16; ++r) {
            float sq = otot[0][r] * otot[0][r] + otot[1][r] * otot[1][r];
            sq += __shfl_xor(sq, 1); sq += __shfl_xor(sq, 2); sq += __shfl_xor(sq, 4); sq += __shfl_xor(sq, 8); sq += __shfl_xor(sq, 16);
            const float rs = rsqrtf(sq * (1.f / 64.f) + EPS);
            const int q = crow(r, hi);
            stg[q * 64 + r32] = f2bf(otot[0][r] * rs * g0);
            stg[q * 64 + 32 + r32] = f2bf(otot[1][r] * rs * g1);
        }
        asm volatile("s_waitcnt lgkmcnt(0)" ::: "memory");
        bf16_t* yb = Y + ((size_t)b * SEQ + 64 * c + 32 * th) * 1024 + (g * 4 + hg) * 64;
#pragma unroll
        for (int i = 0; i < 4; ++i) {
            const int row = i * 8 + (lane >> 3), ch = lane & 7;
            const u32x4 v = *(ATT_LAS const u32x4*)(stg + row * 64 + ch * 8);
            *(u32x4*)(yb + (size_t)row * 1024 + ch * 8) = v;
        }
    }
    __syncthreads();
}
}

__device__ void phase_attn_mfma(const Params& p, int l, unsigned char* lds_raw) {
    for (int v = my_bid(); v < 1024; v += gridDim.x) {
        const int r = v >> 8, x = (v >> 4) & 15, bg = v & 15;
        const int c = r == 0 ? 63 - x : (r == 1 ? 32 + x : (r == 2 ? 31 - x : x));
        att::unit(p, l, bg >> 1, bg & 1, c, (ATT_LAS unsigned char*)lds_raw);
    }
}

__device__ void phase_mlstm_out(const Params& p, int l, float* lds) {
    unsigned char* ws = p.ws;
    const bf16_t* proj = (const bf16_t*)(ws + WS_PROJ); const float* gates = (const float*)(ws + WS_GATES);
    const bf16_t* qkc = (const bf16_t*)(ws + WS_XB);
    const bf16_t* ST = (const bf16_t*)(ws + WS_ST); const float* STN = (const float*)(ws + WS_STN); const float* STM = (const float*)(ws + WS_STM);
    const float* fb = p.in[I_FB] + l * 4; const float* ogm = p.in[I_OGM] + l * 512;
    bf16_t* Y = (bf16_t*)(ws + WS_Y);
    float* qq = lds;
    float* kk = lds + 8192;
    float* Cs = lds + 16384;
    float* Ws = lds + 32768;
    float* bcum = Ws + 64 * 65; float* ig = bcum + 64; float* mt = ig + 64; float* wint = mt + 64; float* den = wint + 64; float* npv = den + 64;
    const int tid = my_tid(), lane = tid & 63, wave = tid >> 6;
    for (int u = my_bid(); u < BATCH * 4 * 64; u += gridDim.x) {
        const int c = u & 63, h = (u >> 6) & 3, b = u >> 8;
        const int m0 = b * SEQ + c * 64, bh = b * 4 + h;
        mlstm_gates(gates, fb, m0, h, bcum, ig);
        const float mprev = STM[4096 + bh * 64 + c];
        for (int e = tid; e < 64 * 16; e += NT) {
            const int s = e >> 4, d0 = (e & 15) * 8;
            const u32x4 rq = *(const u32x4*)(qkc + (size_t)(m0 + s) * 1024 + h * 128 + d0); float f[8]; unpack8(rq, f);
            const u32x4 rk = *(const u32x4*)(qkc + (size_t)(m0 + s) * 1024 + 512 + h * 128 + d0); float fk[8]; unpack8(rk, fk);
#pragma unroll
            for (int j = 0; j < 8; ++j) { qq[s * 128 + d0 + j] = f[j]; kk[s * 128 + d0 + j] = fk[j]; }
        }
        if (tid < 128) npv[tid] = STN[(size_t)(bh * 64 + c) * 128 + tid];
        for (int e8 = tid; e8 < 128 * 16; e8 += NT) {
            const int e = e8 >> 4, d0 = (e8 & 15) * 8;
            const u32x4 rc = *(const u32x4*)(ST + ((size_t)(bh * 64 + c) * 128 + e) * 128 + d0); float f[8]; unpack8(rc, f);
#pragma unroll
            for (int j = 0; j < 8; ++j) Cs[(d0 + j) * 128 + e] = f[j];
        }
        __syncthreads();
        {
            const int t = tid >> 3, s0 = (tid & 7) * 8;
            float a[8] = {0.f, 0.f, 0.f, 0.f, 0.f, 0.f, 0.f, 0.f};
#pragma unroll 2
            for (int d = 0; d < 128; ++d) {
                const float qv = qq[t * 128 + d];
#pragma unroll
                for (int j = 0; j < 8; ++j) a[j] += qv * kk[(s0 + j) * 128 + d];
            }
#pragma unroll
            for (int j = 0; j < 8; ++j) Ws[t * 65 + s0 + j] = a[j];
        }
        __syncthreads();
        for (int r = 0; r < 8; ++r) {
            const int t = wave * 8 + r;
            const float dv = lane <= t ? bcum[t] - bcum[lane] + ig[lane] : -INFINITY;
            const float a = bcum[t] + mprev;
            const float m_t = fmaxf(a, wave_max(dv));
            const float w = lane <= t ? __expf(dv - m_t) * Ws[t * 65 + lane] : 0.f;
            Ws[t * 65 + lane] = w;
            const float wi = __expf(a - m_t);
            const float qn = wave_sum(qq[t * 128 + lane] * npv[lane] + qq[t * 128 + 64 + lane] * npv[64 + lane]);
            const float dsum = wave_sum(w);
            if (lane == 0) { mt[t] = m_t; wint[t] = wi; den[t] = wi * qn + dsum; }
        }
        __syncthreads();
        for (int e = tid; e < 64 * 16; e += NT) {
            const int s = e >> 4, d0 = (e & 15) * 8;
            const u32x4 rv = *(const u32x4*)(proj + (size_t)(m0 + s) * NPROJ + C_VB + h * 128 + d0); float f[8]; unpack8(rv, f);
#pragma unroll
            for (int j = 0; j < 8; ++j) kk[s * 128 + d0 + j] = f[j];
        }
        __syncthreads();
        float hv[16];
        {
            const int e = tid & 127, t0 = (tid >> 7) * 16;
            float a1[16], a2[16];
#pragma unroll
            for (int i = 0; i < 16; ++i) { a1[i] = 0.f; a2[i] = 0.f; }
#pragma unroll 2
            for (int d = 0; d < 128; ++d) {
                const float cv = Cs[d * 128 + e];
#pragma unroll
                for (int i = 0; i < 16; ++i) a1[i] += qq[(t0 + i) * 128 + d] * cv;
            }
#pragma unroll 2
            for (int s = 0; s < 64; ++s) {
                const float vv = kk[s * 128 + e];
#pragma unroll
                for (int i = 0; i < 16; ++i) a2[i] += Ws[(t0 + i) * 65 + s] * vv;
            }
#pragma unroll
            for (int i = 0; i < 16; ++i) {
                const int t = t0 + i;
                const float num = wint[t] * a1[i] + a2[i];
                hv[i] = num / fmaxf(fabsf(den[t]), __expf(-mt[t]));
            }
        }
        __syncthreads();
        {
            const int e = tid & 127, t0 = (tid >> 7) * 16;
#pragma unroll
            for (int i = 0; i < 16; ++i) Cs[(t0 + i) * 128 + e] = hv[i];
        }
        __syncthreads();
        for (int r = 0; r < 8; ++r) {
            const int t = wave * 8 + r;
            const float h0 = Cs[t * 128 + lane], h1 = Cs[t * 128 + 64 + lane];
            const float s = wave_sum(h0 * h0 + h1 * h1);
            const float rr = rsqrtf(s * (1.f / 128.f) + EPS);
            const bf16_t* op = proj + (size_t)(m0 + t) * NPROJ + C_OB + h * 128;
            const float y0 = h0 * rr * ogm[h * 128 + lane] * sigmoid_f(bf2f(op[lane]));
            const float y1 = h1 * rr * ogm[h * 128 + 64 + lane] * sigmoid_f(bf2f(op[64 + lane]));
            Y[(size_t)(m0 + t) * 1024 + 512 + h * 128 + lane] = f2bf(y0);
            Y[(size_t)(m0 + t) * 1024 + 512 + h * 128 + 64 + lane] = f2bf(y1);
        }
        __syncthreads();
    }
}

namespace mls {
typedef short bf16x8 __attribute__((ext_vector_type(8)));
typedef short s16x4 __attribute__((ext_vector_type(4)));
typedef float f32x16 __attribute__((ext_vector_type(16)));
#define MLS_LAS __attribute__((address_space(3)))
__device__ __forceinline__ s16x4 vtr(MLS_LAS const unsigned char* p) { return __builtin_bit_cast(s16x4, __builtin_amdgcn_ds_read_tr16_b64_v4i16((MLS_LAS s16x4*)p)); }
__device__ __forceinline__ bf16x8 trfrag(MLS_LAS const unsigned char* p) { const s16x4 lo = vtr(p), hh = vtr(p + 512); return (bf16x8){lo[0], lo[1], lo[2], lo[3], hh[0], hh[1], hh[2], hh[3]}; }
__device__ __forceinline__ float incl_scan64(float v, int lane) {
#pragma unroll
    for (int o = 1; o < 64; o <<= 1) { const float t = __shfl_up(v, o); if (lane >= o) v += t; }
    return v;
}
constexpr float KSCALE = 0.08838834764831845f;

__device__ void chunk_unit(const Params& p, int l, int b, int c, MLS_LAS unsigned char* lds) {
    unsigned char* ws = p.ws;
    const bf16_t* proj = (const bf16_t*)(ws + WS_PROJ); const float* gates = (const float*)(ws + WS_GATES);
    const float* cw = p.in[I_CW] + l * 4096; const float* cb = p.in[I_CB] + l * 1024; const float* fb = p.in[I_FB] + l * 4;
    bf16_t* ST = (bf16_t*)(ws + WS_ST); float* STN = (float*)(ws + WS_STN); float* STM = (float*)(ws + WS_STM);
    const int tid = my_tid(), lane = tid & 63, wave = __builtin_amdgcn_readfirstlane(tid >> 6), r32 = lane & 31, hi = lane >> 5, h = wave >> 1, half = wave & 1;
    const size_t m0 = (size_t)b * SEQ + 64 * c; const int bh = b * 4 + h;
    const float lf = log_sigmoid_f(gates[(m0 + lane) * 32 + 28 + h] + fb[h]);
    const float igv = gates[(m0 + lane) * 32 + 24 + h];
    const float bc = incl_scan64(lf, lane);
    const float blast = __shfl(bc, 63);
    const float gv = blast - bc + igv;
    const float mloc = wave_max(gv);
    const float wsc = __expf(gv - mloc);
    if (half == 0 && lane == 0) { STM[bh * 64 + c] = mloc; STM[2048 + bh * 64 + c] = blast; }
    MLS_LAS unsigned char* vimg = lds + h * 32768; MLS_LAS unsigned char* kimg = vimg + 16384;
    {
        const int pc = lane & 15, ch = 512 + h * 128 + pc * 8;
        float cwv[4][8], cbv[8];
#pragma unroll
        for (int j = 0; j < 8; ++j) { cbv[j] = cb[ch + j];
#pragma unroll
            for (int w = 0; w < 4; ++w) cwv[w][j] = cw[w * 1024 + ch + j]; }
#pragma unroll 2
        for (int it = 0; it < 8; ++it) {
            const int s = 32 * half + 4 * it + (lane >> 4);
            const u32x4 rv = *(const u32x4*)(proj + (m0 + s) * NPROJ + C_VB + h * 128 + pc * 8);
            *(MLS_LAS u32x4*)(vimg + (pc >> 2) * 4096 + s * 64 + (pc & 3) * 16) = rv;
            float acc[8];
#pragma unroll
            for (int j = 0; j < 8; ++j) acc[j] = cbv[j];
#pragma unroll
            for (int w = 0; w < 4; ++w) {
                if (64 * c + s - 3 + w >= 0) {
                    const u32x4 raw = *(const u32x4*)(proj + (m0 + s - 3 + w) * NPROJ + C_KB + h * 128 + pc * 8); float f[8]; unpack8(raw, f);
#pragma unroll
                    for (int j = 0; j < 8; ++j) acc[j] += f[j] * cwv[w][j];
                }
            }
            const float sc = KSCALE * __shfl(wsc, s);
            float y[8];
#pragma unroll
            for (int j = 0; j < 8; ++j) y[j] = silu_f(acc[j]) * sc;
            u32x4 o; o.x = pk2(y[0], y[1]); o.y = pk2(y[2], y[3]); o.z = pk2(y[4], y[5]); o.w = pk2(y[6], y[7]);
            *(MLS_LAS u32x4*)(kimg + (pc >> 2) * 4096 + s * 64 + (pc & 3) * 16) = o;
        }
    }
    __syncthreads();
    f32x16 acc[2][4];
#pragma unroll
    for (int e2 = 0; e2 < 2; ++e2)
#pragma unroll
        for (int db = 0; db < 4; ++db) acc[e2][db] = (f32x16){0.f, 0.f, 0.f, 0.f, 0.f, 0.f, 0.f, 0.f, 0.f, 0.f, 0.f, 0.f, 0.f, 0.f, 0.f, 0.f};
    {
        const int tro = ((lane >> 4) & 1) * 32 + (lane & 3) * 8 + (4 * hi + ((lane & 15) >> 2)) * 64;
#pragma unroll
        for (int ks = 0; ks < 4; ++ks) {
            const bf16x8 a0 = trfrag(vimg + tro + (2 * half) * 4096 + ks * 1024), a1 = trfrag(vimg + tro + (2 * half + 1) * 4096 + ks * 1024);
#pragma unroll
            for (int db = 0; db < 4; ++db) {
                const bf16x8 bfr = trfrag(kimg + tro + db * 4096 + ks * 1024);
                acc[0][db] = __builtin_amdgcn_mfma_f32_32x32x16_bf16(a0, bfr, acc[0][db], 0, 0, 0);
                acc[1][db] = __builtin_amdgcn_mfma_f32_32x32x16_bf16(a1, bfr, acc[1][db], 0, 0, 0);
            }
        }
    }
    {
        const int hh = tid >> 7, d = tid & 127;
        MLS_LAS const bf16_t* kp = (MLS_LAS const bf16_t*)(lds + hh * 32768 + 16384 + (d >> 5) * 4096) + (d & 31);
        float sm = 0.f;
#pragma unroll 8
        for (int s2 = 0; s2 < 64; ++s2) sm += bf2f(kp[s2 * 32]);
        STN[(size_t)((b * 4 + hh) * 64 + c) * 128 + d] = sm;
    }
    __syncthreads();
    {
        MLS_LAS bf16_t* stg = (MLS_LAS bf16_t*)(lds + h * 32768 + half * 16384);
#pragma unroll
        for (int e2 = 0; e2 < 2; ++e2)
#pragma unroll
            for (int db = 0; db < 4; ++db)
#pragma unroll
                for (int r = 0; r < 16; ++r) stg[(32 * e2 + att::crow(r, hi)) * 128 + 32 * db + r32] = f2bf(acc[e2][db][r]);
        asm volatile("s_waitcnt lgkmcnt(0)" ::: "memory");
        bf16_t* dst = ST + ((size_t)(bh * 64 + c) * 128 + 64 * half) * 128;
#pragma unroll 4
        for (int it = 0; it < 16; ++it) {
            const int idx = it * 64 + lane;
            *(u32x4*)(dst + (size_t)idx * 8) = *(MLS_LAS const u32x4*)(stg + idx * 8);
        }
    }
    __syncthreads();
}

constexpr int LO_V = 0, LO_STG = 65536, LO_G = 131072;
__device__ void out_unit(const Params& p, int l, int b, int c, MLS_LAS unsigned char* lds) {
    unsigned char* ws = p.ws;
    const bf16_t* proj = (const bf16_t*)(ws + WS_PROJ); const float* gates = (const float*)(ws + WS_GATES);
    const bf16_t* qkc = (const bf16_t*)(ws + WS_XB);
    const bf16_t* ST = (const bf16_t*)(ws + WS_ST); const float* STN = (const float*)(ws + WS_STN); const float* STM = (const float*)(ws + WS_STM);
    const float* fb = p.in[I_FB] + l * 4; const float* ogm = p.in[I_OGM] + l * 512;
    bf16_t* Y = (bf16_t*)(ws + WS_Y);
    const int tid = my_tid(), lane = tid & 63, wave = __builtin_amdgcn_readfirstlane(tid >> 6), r32 = lane & 31, hi = lane >> 5, h = wave >> 1, th = wave & 1;
    const size_t m0 = (size_t)b * SEQ + 64 * c; const int bh = b * 4 + h;
    MLS_LAS unsigned char* vimg = lds + LO_V + h * 16384;
    MLS_LAS float* garr = (MLS_LAS float*)(lds + LO_G + wave * 512);
#pragma unroll 4
    for (int it = 0; it < 8; ++it) {
        const int s = 32 * th + 4 * it + (lane >> 4), pc = lane & 15;
        const u32x4 rv = *(const u32x4*)(proj + (m0 + s) * NPROJ + C_VB + h * 128 + pc * 8);
        *(MLS_LAS u32x4*)(vimg + (pc >> 2) * 4096 + s * 64 + (pc & 3) * 16) = rv;
    }
    {
        const float lf = log_sigmoid_f(gates[(m0 + lane) * 32 + 28 + h] + fb[h]);
        garr[lane] = incl_scan64(lf, lane);
        garr[64 + lane] = gates[(m0 + lane) * 32 + 24 + h];
    }
    const float mprev = STM[4096 + bh * 64 + c];
    const int tl = 32 * th + r32;
    bf16x8 qf[8];
#pragma unroll
    for (int ks = 0; ks < 8; ++ks) qf[ks] = __builtin_bit_cast(bf16x8, *(const u32x4*)(qkc + (m0 + tl) * 1024 + h * 128 + 16 * ks + 8 * hi));
    f32x16 p0 = (f32x16){0.f, 0.f, 0.f, 0.f, 0.f, 0.f, 0.f, 0.f, 0.f, 0.f, 0.f, 0.f, 0.f, 0.f, 0.f, 0.f}, p1 = p0;
#pragma unroll
    for (int ks = 0; ks < 8; ++ks) {
        const bf16x8 k0 = __builtin_bit_cast(bf16x8, *(const u32x4*)(qkc + (m0 + r32) * 1024 + 512 + h * 128 + 16 * ks + 8 * hi));
        const bf16x8 k1 = __builtin_bit_cast(bf16x8, *(const u32x4*)(qkc + (m0 + 32 + r32) * 1024 + 512 + h * 128 + 16 * ks + 8 * hi));
        p0 = __builtin_amdgcn_mfma_f32_32x32x16_bf16(k0, qf[ks], p0, 0, 0, 0);
        p1 = __builtin_amdgcn_mfma_f32_32x32x16_bf16(k1, qf[ks], p1, 0, 0, 0);
    }
    float qn = 0.f;
    {
        const float* np = STN + (size_t)(bh * 64 + c) * 128;
#pragma unroll
        for (int ks = 0; ks < 8; ++ks) {
            const f32x4 n0 = *(const f32x4*)(np + 16 * ks + 8 * hi), n1 = *(const f32x4*)(np + 16 * ks + 8 * hi + 4);
            float f[8]; unpack8(__builtin_bit_cast(u32x4, qf[ks]), f);
            qn += (f[0] * n0.x + f[1] * n0.y) + (f[2] * n0.z + f[3] * n0.w) + (f[4] * n1.x + f[5] * n1.y) + (f[6] * n1.z + f[7] * n1.w);
        }
        qn += __shfl_xor(qn, 32);
    }
    asm volatile("s_waitcnt lgkmcnt(0)" ::: "memory");
    const float bt = garr[tl];
    float dv0[16], dv1[16]; float mx = -INFINITY;
#pragma unroll
    for (int r = 0; r < 16; ++r) {
        const int s0 = att::crow(r, hi);
        dv0[r] = s0 <= tl ? bt - garr[s0] + garr[64 + s0] : -INFINITY;
        dv1[r] = s0 + 32 <= tl ? bt - garr[s0 + 32] + garr[64 + s0 + 32] : -INFINITY;
        mx = fmaxf(mx, fmaxf(dv0[r], dv1[r]));
    }
    mx = fmaxf(mx, __shfl_xor(mx, 32));
    const float a_t = bt + mprev;
    const float m_t = fmaxf(a_t, mx);
    float dsum = 0.f;
#pragma unroll
    for (int r = 0; r < 16; ++r) {
        p0[r] = __expf(dv0[r] - m_t) * p0[r];
        p1[r] = __expf(dv1[r] - m_t) * p1[r];
        dsum += p0[r] + p1[r];
    }
    dsum += __shfl_xor(dsum, 32);
    const float winter = __expf(a_t - m_t);
    const float den = winter * qn + dsum;
    const float scl = 1.f / fmaxf(fabsf(den), __expf(-m_t));
    const float fq = winter * scl;
    bf16x8 pa[4];
#pragma unroll
    for (int s2 = 0; s2 < 2; ++s2) {
        u32x4 w0, w1;
        w0.x = att::cvtpk(p0[8 * s2 + 0] * scl, p0[8 * s2 + 1] * scl); w0.y = att::cvtpk(p0[8 * s2 + 2] * scl, p0[8 * s2 + 3] * scl); w0.z = att::cvtpk(p0[8 * s2 + 4] * scl, p0[8 * s2 + 5] * scl); w0.w = att::cvtpk(p0[8 * s2 + 6] * scl, p0[8 * s2 + 7] * scl);
        w1.x = att::cvtpk(p1[8 * s2 + 0] * scl, p1[8 * s2 + 1] * scl); w1.y = att::cvtpk(p1[8 * s2 + 2] * scl, p1[8 * s2 + 3] * scl); w1.z = att::cvtpk(p1[8 * s2 + 4] * scl, p1[8 * s2 + 5] * scl); w1.w = att::cvtpk(p1[8 * s2 + 6] * scl, p1[8 * s2 + 7] * scl);
        pa[s2] = __builtin_bit_cast(bf16x8, w0); pa[2 + s2] = __builtin_bit_cast(bf16x8, w1);
    }
#pragma unroll
    for (int ks = 0; ks < 8; ++ks) {
        float f[8]; unpack8(__builtin_bit_cast(u32x4, qf[ks]), f);
        u32x4 w; w.x = att::cvtpk(f[0] * fq, f[1] * fq); w.y = att::cvtpk(f[2] * fq, f[3] * fq); w.z = att::cvtpk(f[4] * fq, f[5] * fq); w.w = att::cvtpk(f[6] * fq, f[7] * fq);
        qf[ks] = __builtin_bit_cast(bf16x8, w);
    }
    f32x16 acc[4];
#pragma unroll
    for (int eb = 0; eb < 4; ++eb) acc[eb] = (f32x16){0.f, 0.f, 0.f, 0.f, 0.f, 0.f, 0.f, 0.f, 0.f, 0.f, 0.f, 0.f, 0.f, 0.f, 0.f, 0.f};
    {
        const bf16_t* cp = ST + (size_t)(bh * 64 + c) * 16384 + (size_t)r32 * 128 + 8 * hi;
#pragma unroll
        for (int eb = 0; eb < 4; ++eb)
#pragma unroll
            for (int ks = 0; ks < 8; ++ks) {
                const bf16x8 cf = __builtin_bit_cast(bf16x8, *(const u32x4*)(cp + eb * 32 * 128 + 16 * ks));
                acc[eb] = __builtin_amdgcn_mfma_f32_32x32x16_bf16(qf[ks], cf, acc[eb], 0, 0, 0);
            }
    }
    __syncthreads();
    {
        const int tro = ((lane >> 4) & 1) * 32 + (lane & 3) * 8 + (4 * hi + ((lane & 15) >> 2)) * 64;
#pragma unroll
        for (int eb = 0; eb < 4; ++eb)
#pragma unroll
            for (int ks = 0; ks < 4; ++ks) acc[eb] = __builtin_amdgcn_mfma_f32_32x32x16_bf16(pa[ks], trfrag(vimg + tro + eb * 4096 + ks * 1024), acc[eb], 0, 0, 0);
    }
    {
        MLS_LAS bf16_t* stg = (MLS_LAS bf16_t*)(lds + LO_STG + wave * 8192);
        float gn[4];
#pragma unroll
        for (int eb = 0; eb < 4; ++eb) gn[eb] = ogm[h * 128 + 32 * eb + r32];
#pragma unroll
        for (int r = 0; r < 16; ++r) {
            float sq = (acc[0][r] * acc[0][r] + acc[1][r] * acc[1][r]) + (acc[2][r] * acc[2][r] + acc[3][r] * acc[3][r]);
            sq += __shfl_xor(sq, 1); sq += __shfl_xor(sq, 2); sq += __shfl_xor(sq, 4); sq += __shfl_xor(sq, 8); sq += __shfl_xor(sq, 16);
            const float rs = rsqrtf(sq * (1.f / 128.f) + EPS);
            const int q = att::crow(r, hi);
#pragma unroll
            for (int eb = 0; eb < 4; ++eb) stg[q * 128 + 32 * eb + r32] = f2bf(acc[eb][r] * rs * gn[eb]);
        }
        asm volatile("s_waitcnt lgkmcnt(0)" ::: "memory");
#pragma unroll 2
        for (int it = 0; it < 8; ++it) {
            const int idx = it * 64 + lane, row = idx >> 4, pc = idx & 15;
            const u32x4 hv = *(MLS_LAS const u32x4*)(stg + row * 128 + pc * 8);
            const u32x4 ov = *(const u32x4*)(proj + (m0 + 32 * th + row) * NPROJ + C_OB + h * 128 + pc * 8);
            float fh[8], fo[8]; unpack8(hv, fh); unpack8(ov, fo);
            float y[8];
#pragma unroll
            for (int j = 0; j < 8; ++j) y[j] = fh[j] * sigmoid_f(fo[j]);
            u32x4 o; o.x = pk2(y[0], y[1]); o.y = pk2(y[2], y[3]); o.z = pk2(y[4], y[5]); o.w = pk2(y[6], y[7]);
            *(u32x4*)(Y + (m0 + 32 * th + row) * 1024 + 512 + h * 128 + pc * 8) = o;
        }
    }
    __syncthreads();
}
}

__device__ void phase_chunkstate_mfma(const Params& p, int l, unsigned char* lds_raw) {
    for (int u = my_bid(); u < BATCH * 64; u += gridDim.x) mls::chunk_unit(p, l, u >> 6, u & 63, (MLS_LAS unsigned char*)lds_raw);
}
__device__ void phase_mlstm_out_mfma(const Params& p, int l, unsigned char* lds_raw) {
    for (int u = my_bid(); u < BATCH * 64; u += gridDim.x) mls::out_unit(p, l, u >> 6, u & 63, (MLS_LAS unsigned char*)lds_raw);
}

namespace cmpx {
typedef short bf16x8 __attribute__((ext_vector_type(8)));
typedef float f32x16 __attribute__((ext_vector_type(16)));
#define CMP_LAS __attribute__((address_space(3)))
constexpr int LC_PART = 0  , LC_HID = 32768  ;
__device__ void unit(const Params& p, int l, int b, int g, int kv, int ib, CMP_LAS unsigned char* lds) {
    unsigned char* ws = p.ws;
    const bf16_t* proj = (const bf16_t*)(ws + WS_PROJ);
    const bf16_t* w1t = (const bf16_t*)(ws + WS_CW1) + (size_t)(l * 2 + kv) * 128 * 2048;
    const bf16_t* w2t = (const bf16_t*)(ws + WS_W2T) + (size_t)(l * 2 + kv) * 64 * 128;
    const float* peb = (const float*)(ws + WS_PEB) + (l * 2 + kv) * 128;
    const float* kg0 = p.in[I_KG] + l * 192;
    const int tid = my_tid(), lane = tid & 63, wave = __builtin_amdgcn_readfirstlane(tid >> 6), r32 = lane & 31, hi = lane >> 5, hb = wave & 3, kh = wave >> 2;
    const int col = (kv ? C_VC : C_KC) + g * 64;
    const int i = 32 * ib + r32;
    const f32x16 zero16 = (f32x16){0.f, 0.f, 0.f, 0.f, 0.f, 0.f, 0.f, 0.f, 0.f, 0.f, 0.f, 0.f, 0.f, 0.f, 0.f, 0.f};
    {
        f32x16 acc = zero16;
        const bf16_t* bp = w1t + (size_t)(32 * hb + r32) * 2048 + 1024 * kh + 8 * hi;
        const int tok0 = 16 * i + 16 * kh;
#pragma unroll 8
        for (int ks = 0; ks < 64; ++ks) {
            int tok = tok0 + (ks >> 2); tok = tok < SEQ ? tok : SEQ - 1;
            const bf16x8 af = __builtin_bit_cast(bf16x8, *(const u32x4*)(proj + ((size_t)b * SEQ + tok) * NPROJ + col + 16 * (ks & 3) + 8 * hi));
            const bf16x8 bf = __builtin_bit_cast(bf16x8, *(const u32x4*)(bp + 16 * ks));
            acc = __builtin_amdgcn_mfma_f32_32x32x16_bf16(af, bf, acc, 0, 0, 0);
        }
        CMP_LAS float* part = (CMP_LAS float*)(lds + LC_PART) + kh * 32 * 128;
#pragma unroll
        for (int r = 0; r < 16; ++r) part[att::crow(r, hi) * 128 + 32 * hb + r32] = acc[r];
    }
    __syncthreads();
    {
        const CMP_LAS float* part = (const CMP_LAS float*)(lds + LC_PART);
        CMP_LAS bf16_t* hbuf = (CMP_LAS bf16_t*)(lds + LC_HID);
#pragma unroll
        for (int e = 0; e < 8; ++e) {
            const int idx = e * NT + tid, row = idx >> 7, hid = idx & 127;
            hbuf[row * 136 + hid] = f2bf(silu_f(part[idx] + part[4096 + idx] + peb[hid]));
        }
    }
    __syncthreads();
    if (wave == 0) {
        const CMP_LAS bf16_t* hbuf = (const CMP_LAS bf16_t*)(lds + LC_HID);
        f32x16 o0 = zero16, o1 = zero16;
#pragma unroll
        for (int ks = 0; ks < 8; ++ks) {
            const bf16x8 af = *(const CMP_LAS bf16x8*)(hbuf + r32 * 136 + 16 * ks + 8 * hi);
            const bf16x8 b0 = __builtin_bit_cast(bf16x8, *(const u32x4*)(w2t + (size_t)r32 * 128 + 16 * ks + 8 * hi));
            const bf16x8 b1 = __builtin_bit_cast(bf16x8, *(const u32x4*)(w2t + (size_t)(32 + r32) * 128 + 16 * ks + 8 * hi));
            o0 = __builtin_amdgcn_mfma_f32_32x32x16_bf16(af, b0, o0, 0, 0, 0);
            o1 = __builtin_amdgcn_mfma_f32_32x32x16_bf16(af, b1, o1, 0, 0, 0);
        }
        bf16_t* dst = (bf16_t*)(ws + (kv ? WS_VCMP : WS_KCMP)) + (size_t)(b * 2 + g) * NCMPP * 64;
        const float g0 = kv ? 1.f : kg0[r32], g1 = kv ? 1.f : kg0[32 + r32];
#pragma unroll
        for (int r = 0; r < 16; ++r) {
            float rs = 1.f;
            if (kv == 0) {
                float sq = o0[r] * o0[r] + o1[r] * o1[r];
                sq += __shfl_xor(sq, 1); sq += __shfl_xor(sq, 2); sq += __shfl_xor(sq, 4); sq += __shfl_xor(sq, 8); sq += __shfl_xor(sq, 16);
                rs = rsqrtf(sq * (1.f / 64.f) + EPS);
            }
            const int row = 32 * ib + att::crow(r, hi);
            const bool ok = row < NCMP;
            dst[(size_t)row * 64 + r32] = ok ? f2bf(o0[r] * rs * g0) : (bf16_t)0;
            dst[(size_t)row * 64 + 32 + r32] = ok ? f2bf(o1[r] * rs * g1) : (bf16_t)0;
        }
    }
    __syncthreads();
}
}
__device__ void phase_compress_mfma(const Params& p, int l, unsigned char* lds_raw) {
    for (int u = my_bid(); u < BATCH * 2 * 2 * 8; u += gridDim.x) cmpx::unit(p, l, u >> 5, (u >> 4) & 1, (u >> 3) & 1, u & 7, (CMP_LAS unsigned char*)lds_raw);
}

#ifndef DUP
#define DUP 0
#endif
#define REP(bit) for (int rep_ = 0; rep_ < ((DUP & (bit)) ? 2 : 1); ++rep_)
constexpr int NPHASE = 1 + 7 * DEPTH;
template <bool COOP, int PMASK>
__global__ void __launch_bounds__(NT) mega(Params p) {
    extern __shared__ __attribute__((aligned(16))) unsigned char lds_raw[];
    float* lds = (float*)lds_raw;
    unsigned char* ws = p.ws;
    for (int ph = p.lo; ph < p.hi; ++ph) {
        if (ph == 0) {
            if (PMASK & 128) phase_prologue(p, lds);
        } else {
            const int l = (ph - 1) / 7, k = (ph - 1) % 7;
            if (k == 0 && (PMASK & 1)) {
                pg8::Gemm g{(const bf16_t*)(ws + WS_XB), (const bf16_t*)(ws + WS_WIN) + (size_t)l * NPAD * DM, M, NPAD, DM};
                pg8::StaticOrder S; S.init(M, NPAD, (int)gridDim.x, (int)blockIdx.x);
                pg8::EpiInT E{(const float*)(ws + WS_SS), (const float*)(ws + WS_BIAS) + l * NPAD, (bf16_t*)(ws + WS_PROJ), (float*)(ws + WS_GATES)};
                REP(1) pg8::gemm_phase<pg8::EpiInT, pg8::StaticOrder, true, true>((PG8_LAS unsigned char*)lds_raw, g, S, E);
            } else if (k == 1 && (PMASK & 2)) {
                phase_rowpass(p, l);
                REP(2) phase_compress_mfma(p, l, lds_raw);
                REP(4) phase_chunkstate_mfma(p, l, lds_raw);
            } else if (k == 2 && (PMASK & 4)) {
                phase_scan(p);
                REP(8) phase_attn_mfma(p, l, lds_raw);
            } else if (k == 3 && (PMASK & 8)) {
                REP(16) phase_mlstm_out_mfma(p, l, lds_raw);
            } else if (k == 4 && (PMASK & 16)) {
                pg8::Gemm g{(const bf16_t*)(ws + WS_Y), (const bf16_t*)(ws + WS_WOUT) + (size_t)l * DM * DM, M, DM, DM};
                pg8::StaticOrder S; S.init(M, DM, (int)gridDim.x, (int)blockIdx.x);
                pg8::EpiResT E{l == 0 ? p.in[I_X] : p.out, p.out, (bf16_t*)(ws + WS_XB), (float*)(ws + WS_SS)};
                pg8::gemm_phase<pg8::EpiResT, pg8::StaticOrder, true, true>((PG8_LAS unsigned char*)lds_raw, g, S, E);
            } else if (k == 5 && (PMASK & 32)) {
                pg8::Gemm g{(const bf16_t*)(ws + WS_XB), (const bf16_t*)(ws + WS_WGU) + (size_t)l * NGU * DM, M, NGU, DM};
                pg8::StaticOrder S; S.init(M, NGU, (int)gridDim.x, (int)blockIdx.x);
                pg8::EpiGUT E{(const float*)(ws + WS_SS), (bf16_t*)(ws + WS_PROJ)};
                REP(32) pg8::gemm_phase<pg8::EpiGUT, pg8::StaticOrder, true, true>((PG8_LAS unsigned char*)lds_raw, g, S, E);
            } else if (k == 6 && (PMASK & 64)) {
                pg8::Gemm g{(const bf16_t*)(ws + WS_PROJ), (const bf16_t*)(ws + WS_WD) + (size_t)l * DM * FF, M, DM, FF};
                pg8::StaticOrder S; S.init(M, DM, (int)gridDim.x, (int)blockIdx.x);
                pg8::EpiResT E{p.out, p.out, (bf16_t*)(ws + WS_XB), (float*)(ws + WS_SS)};
                pg8::gemm_phase<pg8::EpiResT, pg8::StaticOrder, true, true>((PG8_LAS unsigned char*)lds_raw, g, S, E);
            }
        }
        if (COOP && ph + 1 < p.hi) { cg::this_grid().sync(); }
    }
}

extern "C" void kernel_launch(void* const* d_in, const int* in_sizes, int n_in, void* d_out, int out_size, void* d_ws, size_t ws_size, hipStream_t stream) {
    static int grid = 0;
    if (grid == 0) {
        if (n_in != 18 || ws_size < WS_END) { fprintf(stderr, "kernel_launch: unexpected n_in %d / ws_size %zu\n", n_in, ws_size); grid = -1; return; }
        int dev = 0, cus = 0, per_cu = 0;
        (void)hipGetDevice(&dev);
        (void)hipDeviceGetAttribute(&cus, hipDeviceAttributeMultiprocessorCount, dev);
        (void)hipFuncSetAttribute((const void*)mega<true, 0xff>, hipFuncAttributeMaxDynamicSharedMemorySize, LDS_BYTES);
        (void)hipOccupancyMaxActiveBlocksPerMultiprocessor(&per_cu, (const void*)mega<true, 0xff>, NT, LDS_BYTES);
        if (per_cu < 1) { fprintf(stderr, "kernel_launch: occupancy query reports %d blocks/CU\n", per_cu); grid = -1; return; }
        grid = (cus > 0 ? cus : 256) * 1;
        (void)hipGetLastError();
    }
    if (grid < 0) return;
    Params p{};
    for (int i = 0; i < 18; ++i) p.in[i] = (const float*)d_in[i];
    p.out = (float*)d_out; p.ws = (unsigned char*)d_ws;
    p.lo = 0; p.hi = NPHASE;
    void* args[] = {&p};
    hipError_t e = hipLaunchCooperativeKernel((const void*)mega<true, 0xff>, dim3(grid), dim3(NT), args, LDS_BYTES, stream);
    if (e != hipSuccess) fprintf(stderr, "cooperative launch failed: %s (grid %d)\n", hipGetErrorString(e), grid);
}
```

```cpp
#include <hip/hip_runtime.h>
#include <hip/hip_cooperative_groups.h>
#include <cstdint>
#include <cstdio>
namespace cg = cooperative_groups;

typedef unsigned short bf16_t;
typedef unsigned u32x4 __attribute__((ext_vector_type(4)));
typedef unsigned u32x2 __attribute__((ext_vector_type(2)));
typedef float f32x4 __attribute__((ext_vector_type(4)));

constexpr int BATCH = 8, SEQ = 4096, DM = 1024, M = BATCH * SEQ, DEPTH = 2;
constexpr int NIN = 3360, NPROJ = 3328, NPAD = 3584, FF = 2816, NGU = 2 * FF;
constexpr int NCMP = 255, NCMPP = 256;
constexpr float EPS = 1e-6f;
constexpr int NT = 512;
constexpr int LDS_BYTES = 152 * 1024;

constexpr int C_QA = 0, C_KC = 512, C_VC = 640, C_KS = 768, C_VS = 896, C_KW = 1024, C_VW = 1152, C_QB = 1280, C_KB = 1792, C_VB = 2304, C_OB = 2816;

constexpr size_t MiB = 1u << 20;
constexpr size_t WS_CTL = 0;
constexpr size_t WS_WIN = 1 * MiB;
constexpr size_t WS_WOUT = 15 * MiB;
constexpr size_t WS_WGU = 19 * MiB;
constexpr size_t WS_WD = 41 * MiB;
constexpr size_t WS_BIAS = 52 * MiB;
constexpr size_t WS_SS = 53 * MiB;
constexpr size_t WS_GATES = 55 * MiB;
constexpr size_t WS_KCMP = 59 * MiB;
constexpr size_t WS_VCMP = 59 * MiB + 512 * 1024;
constexpr size_t WS_STN = 60 * MiB;
constexpr size_t WS_STM = 61 * MiB;
constexpr size_t WS_W2T = 61 * MiB + 256 * 1024;
constexpr size_t WS_PEB = 61 * MiB + 512 * 1024;
constexpr size_t WS_CW1 = 62 * MiB;
constexpr size_t WS_XB = 64 * MiB;
constexpr size_t WS_Y = 128 * MiB;
constexpr size_t WS_ST = 192 * MiB;
constexpr size_t WS_PROJ = 256 * MiB;
constexpr size_t WS_END = 464 * MiB;

struct Params {
    const float* in[18];
    float* out;
    unsigned char* ws;
    int lo, hi;
};
enum { I_X = 0, I_LN1, I_WIN, I_BIN, I_QG, I_KG, I_PE, I_W1, I_W2, I_CW, I_CB, I_FB, I_OGA, I_OGM, I_WOUT, I_LN2, I_WGU, I_WD };

__device__ __forceinline__ float bf2f(bf16_t v) { return __uint_as_float(((unsigned)v) << 16); }
__device__ __forceinline__ bf16_t f2bf(float f) { unsigned u = __float_as_uint(f); return (bf16_t)((u + 0x7fffu + ((u >> 16) & 1u)) >> 16); }
__device__ __forceinline__ unsigned pk2(float lo, float hi) { return (unsigned)f2bf(lo) | ((unsigned)f2bf(hi) << 16); }
__device__ __forceinline__ float lo16(unsigned w) { return __uint_as_float(w << 16); }
__device__ __forceinline__ float hi16(unsigned w) { return __uint_as_float(w & 0xffff0000u); }
__device__ __forceinline__ float silu_f(float x) { return x / (1.f + __expf(-x)); }
__device__ __forceinline__ float sigmoid_f(float x) { return 1.f / (1.f + __expf(-x)); }
__device__ __forceinline__ float wave_sum(float v) {
#pragma unroll
    for (int o = 1; o < 64; o <<= 1) v += __shfl_xor(v, o);
    return v;
}
__device__ __forceinline__ float wave_max(float v) {
#pragma unroll
    for (int o = 1; o < 64; o <<= 1) v = fmaxf(v, __shfl_xor(v, o));
    return v;
}
__device__ __forceinline__ int my_tid() { int t = threadIdx.x; asm volatile("" : "+v"(t)); return t; }
__device__ __forceinline__ int my_bid() { int b = blockIdx.x; asm volatile("" : "+s"(b)); return b; }
__device__ __forceinline__ void unpack8(u32x4 w, float* f) {
    f[0] = lo16(w.x); f[1] = hi16(w.x); f[2] = lo16(w.y); f[3] = hi16(w.y);
    f[4] = lo16(w.z); f[5] = hi16(w.z); f[6] = lo16(w.w); f[7] = hi16(w.w);
}

__device__ __forceinline__ int in_srccol(int n) {
    if (n < 1280) return n;
    if (n < 2816) return n + 24;
    if (n < 3328) return n + 32;
    if (n < 3352) return n - 3328 + 1280;
    if (n < 3360) return n - 3352 + 2840;
    return -1;
}
__device__ __forceinline__ int gu_srccol(int n) {
    const int t = n >> 8, w = n & 255;
    return (w < 128) ? (t * 128 + w) : (FF + t * 128 + (w - 128));
}

template <int MODE>
__device__ void conv_job(const float* W, int K, int Nsrc, bf16_t* WT, int Nout, const float* kscale, float* tile) {
    const int tid = my_tid();
    const int nk = K / 64, nn = Nout / 64;
    for (int u = my_bid(); u < nk * nn; u += gridDim.x) {
        const int k0 = (u % nk) * 64, n0 = (u / nk) * 64;
#pragma unroll
        for (int i = 0; i < 8; ++i) {
            const int r = (tid >> 6) + 8 * i, c = tid & 63;
            const int n = n0 + c;
            const int sc = MODE == 0 ? n : (MODE == 1 ? in_srccol(n) : gu_srccol(n));
            float v = 0.f;
            if (sc >= 0) v = W[(size_t)(k0 + r) * Nsrc + sc] * (kscale ? kscale[k0 + r] : 1.f);
            tile[r * 65 + c] = v;
        }
        __syncthreads();
#pragma unroll
        for (int i = 0; i < 8; ++i) {
            const int r = (tid >> 6) + 8 * i, c = tid & 63;
            WT[(size_t)(n0 + r) * K + k0 + c] = f2bf(tile[c * 65 + r]);
        }
        __syncthreads();
    }
}

__device__ void phase_prologue(const Params& p, float* lds) {
    unsigned char* ws = p.ws;
    const int tid = my_tid(), lane = tid & 63, wave = tid >> 6;
    for (int l = 0; l < DEPTH; ++l) {
        conv_job<1>(p.in[I_WIN] + (size_t)l * DM * NIN, DM, NIN, (bf16_t*)(ws + WS_WIN) + (size_t)l * NPAD * DM, NPAD, p.in[I_LN1] + l * DM, lds);
        conv_job<0>(p.in[I_WOUT] + (size_t)l * DM * DM, DM, DM, (bf16_t*)(ws + WS_WOUT) + (size_t)l * DM * DM, DM, nullptr, lds);
        conv_job<2>(p.in[I_WGU] + (size_t)l * DM * NGU, DM, NGU, (bf16_t*)(ws + WS_WGU) + (size_t)l * NGU * DM, NGU, p.in[I_LN2] + l * DM, lds);
        conv_job<0>(p.in[I_WD] + (size_t)l * FF * DM, FF, DM, (bf16_t*)(ws + WS_WD) + (size_t)l * DM * FF, DM, nullptr, lds);
    }
    for (int lk = 0; lk < DEPTH * 2; ++lk) {
        conv_job<0>(p.in[I_W1] + (size_t)lk * 2048 * 128, 2048, 128, (bf16_t*)(ws + WS_CW1) + (size_t)lk * 128 * 2048, 128, nullptr, lds);
        conv_job<0>(p.in[I_W2] + (size_t)lk * 128 * 64, 128, 64, (bf16_t*)(ws + WS_W2T) + (size_t)lk * 64 * 128, 64, nullptr, lds);
    }
    {
        float* peb = (float*)(ws + WS_PEB);
        for (int o = my_bid() * 8 + wave; o < DEPTH * 2 * 128; o += gridDim.x * 8) {
            const int lk = o >> 7, hid = o & 127;
            const float* w1 = p.in[I_W1] + (size_t)lk * 2048 * 128 + hid; const float* pe = p.in[I_PE] + (size_t)lk * 2048;
            float sacc = 0.f;
            for (int f = lane; f < 2048; f += 64) sacc += w1[(size_t)f * 128] * pe[f];
            sacc = wave_sum(sacc);
            if (lane == 0) peb[o] = sacc;
        }
    }
    float* biasP = (float*)(ws + WS_BIAS);
    for (int i = my_bid() * NT + tid; i < DEPTH * NPAD; i += gridDim.x * NT) {
        const int l = i / NPAD, n = i % NPAD; const int sc = in_srccol(n);
        biasP[i] = sc >= 0 ? p.in[I_BIN][l * NIN + sc] : 0.f;
    }
    const float* x = p.in[I_X]; bf16_t* xb = (bf16_t*)(ws + WS_XB); float* ss = (float*)(ws + WS_SS);
    for (int m = my_bid() * 8 + wave; m < M; m += gridDim.x * 8) {
        const f32x4* xr = (const f32x4*)(x + (size_t)m * DM) + lane;
#pragma unroll
        for (int j = 0; j < 4; ++j) {
            const f32x4 v = xr[64 * j];
            float s = (v.x * v.x + v.y * v.y) + (v.z * v.z + v.w * v.w);
            s += __shfl_xor(s, 1); s += __shfl_xor(s, 2); s += __shfl_xor(s, 4); s += __shfl_xor(s, 8);
            if ((lane & 15) == 0) ss[(size_t)m * 16 + 4 * j + (lane >> 4)] = s;
            u32x2 o; o.x = pk2(v.x, v.y); o.y = pk2(v.z, v.w);
            *(u32x2*)(xb + (size_t)m * DM + 256 * j + 4 * lane) = o;
        }
    }
}

namespace pg8 {
#define PG8_LAS __attribute__((address_space(3)))
typedef short bf16x8 __attribute__((ext_vector_type(8)));
constexpr int BM = 256, BK = 64, HALF = 128, HTB = HALF * BK * 2  , STAGE_BYTES = 8 * HTB, NXCD = 8, WGM = 8;
__host__ __device__ __forceinline__ int lds_byte(int r, int c) { const int st = (r >> 4) * 2 + (c >> 5), rr = r & 15, cc = c & 31, ob = rr * 64 + cc * 2; return st * 1024 + (ob ^ (((ob >> 9) & 1) << 5)); }
__host__ __device__ __forceinline__ void stage_rc(int b, int& R, int& C) { const int st = b / 1024, sb = b % 1024, swz = sb ^ (((sb >> 9) & 1) << 5); R = (st >> 1) * 16 + swz / 64; C = (st & 1) * 32 + (swz % 64) / 2; }
__host__ __device__ __forceinline__ int perm32(int rho) { const int n = rho >> 4, i = rho & 15; return 8 * (i >> 2) + 4 * n + (i & 3); }
struct Unit { int pm, pn; };
struct Gemm { const bf16_t* A; const bf16_t* Bt; int M, N, K; };
struct StaticOrder {
    int nM, nN, nwg, G, c;
    __host__ __device__ void init(int M_, int N_, int G_, int c_) { nM = M_ / BM; nN = N_ / BM; nwg = nM * nN; G = G_; c = c_; }
    __host__ __device__ bool next(int i, Unit& u) const {
        const long L = (long)i * G + c; if (L >= nwg) return false;
        int wgid = (int)L; { const int q = nwg / NXCD, r = nwg % NXCD, xcd = wgid % NXCD, off = wgid / NXCD; wgid = (xcd < r ? xcd * (q + 1) : r * (q + 1) + (xcd - r) * q) + off; }
        const int nig = WGM * nN, gid = wgid / nig, fm = gid * WGM, gsz = (nM - fm) < WGM ? (nM - fm) : WGM;
        u.pm = fm + ((wgid % nig) % gsz); u.pn = (wgid % nig) / gsz; return true;
    }
    __device__ __forceinline__ void a_ready(const Unit&) const {}
    __device__ __forceinline__ void done(const Unit&) const {}
};
__device__ __forceinline__ unsigned cvt_pk_bf16(float lo, float hi) { unsigned r; asm volatile("v_cvt_pk_bf16_f32 %0, %1, %2" : "=v"(r) : "v"(lo), "v"(hi)); return r; }

__device__ __forceinline__ float row_rstd(const float* ss, int row, int fq) {
    const f32x4 pq = *(const f32x4*)(ss + (size_t)row * 16 + 4 * fq);
    float s = (pq.x + pq.y) + (pq.z + pq.w);
    s += __shfl_xor(s, 16); s += __shfl_xor(s, 32);
    return rsqrtf(s * (1.f / DM) + EPS);
}
struct EpiInT {
    static constexpr bool PERM = true, AFTER_DRAIN = false;
    const float* ss; const float* bias; bf16_t* proj; float* gates;
    __device__ __forceinline__ void operator()(const f32x4 (&acc)[2][2][4][2], const Unit& u, int wr, int wc, int fr, int fq) const {
        const int row0 = u.pm * BM + wr * 64 + fr, col0 = u.pn * BM + wc * 32 + 8 * fq;
        f32x4 bv[2][2];
#pragma unroll
        for (int bj = 0; bj < 2; ++bj)
#pragma unroll
            for (int n = 0; n < 2; ++n) bv[bj][n] = *(const f32x4*)(bias + col0 + bj * HALF + 4 * n);
#pragma unroll
        for (int ai = 0; ai < 2; ++ai)
#pragma unroll
            for (int m = 0; m < 4; ++m) {
                const int row = row0 + ai * HALF + m * 16;
                const float r = row_rstd(ss, row, fq);
                if (u.pn < 13) {
                    bf16_t* rowp = proj + (size_t)row * NPROJ + col0;
#pragma unroll
                    for (int bj = 0; bj < 2; ++bj) {
                        const f32x4 v0 = acc[ai][bj][m][0] * r + bv[bj][0], v1 = acc[ai][bj][m][1] * r + bv[bj][1];
                        u32x4 w; w.x = cvt_pk_bf16(v0[0], v0[1]); w.y = cvt_pk_bf16(v0[2], v0[3]); w.z = cvt_pk_bf16(v1[0], v1[1]); w.w = cvt_pk_bf16(v1[2], v1[3]);
                        *(u32x4*)(rowp + bj * HALF) = w;
                    }
                } else if (wc == 0) {
                    const f32x4 v0 = acc[ai][0][m][0] * r + bv[0][0], v1 = acc[ai][0][m][1] * r + bv[0][1];
                    float* gp = gates + (size_t)row * 32 + 8 * fq;
                    *(f32x4*)gp = v0; *(f32x4*)(gp + 4) = v1;
                }
            }
    }
};
struct EpiResT {
    static constexpr bool PERM = true, AFTER_DRAIN = false;
    const float* base; float* out; bf16_t* xb; float* ss;
    __device__ __forceinline__ void operator()(const f32x4 (&acc)[2][2][4][2], const Unit& u, int wr, int wc, int fr, int fq) const {
        const int row0 = u.pm * BM + wr * 64 + fr, col0 = u.pn * BM + wc * 32 + 8 * fq;
#pragma unroll
        for (int ai = 0; ai < 2; ++ai)
#pragma unroll
            for (int m = 0; m < 4; ++m) {
                const int row = row0 + ai * HALF + m * 16;
                const size_t off = (size_t)row * DM + col0;
                float sq = 0.f;
#pragma unroll
                for (int bj = 0; bj < 2; ++bj) {
                    const f32x4 x0 = *(const f32x4*)(base + off + bj * HALF) + acc[ai][bj][m][0];
                    const f32x4 x1 = *(const f32x4*)(base + off + bj * HALF + 4) + acc[ai][bj][m][1];
                    *(f32x4*)(out + off + bj * HALF) = x0; *(f32x4*)(out + off + bj * HALF + 4) = x1;
                    u32x4 w; w.x = cvt_pk_bf16(x0[0], x0[1]); w.y = cvt_pk_bf16(x0[2], x0[3]); w.z = cvt_pk_bf16(x1[0], x1[1]); w.w = cvt_pk_bf16(x1[2], x1[3]);
                    *(u32x4*)(xb + off + bj * HALF) = w;
                    sq += (x0[0] * x0[0] + x0[1] * x0[1]) + (x0[2] * x0[2] + x0[3] * x0[3]) + (x1[0] * x1[0] + x1[1] * x1[1]) + (x1[2] * x1[2] + x1[3] * x1[3]);
                }
                sq += __shfl_xor(sq, 16); sq += __shfl_xor(sq, 32);
                if (fq == 0) ss[(size_t)row * 16 + u.pn * 4 + wc] = sq;
                asm volatile("" ::: "memory");
            }
    }
};
struct EpiGUT {
    static constexpr bool PERM = true, AFTER_DRAIN = false;
    const float* ss; bf16_t* act;
    __device__ __forceinline__ void operator()(const f32x4 (&acc)[2][2][4][2], const Unit& u, int wr, int wc, int fr, int fq) const {
        const int row0 = u.pm * BM + wr * 64 + fr, hid0 = u.pn * HALF + wc * 32 + 8 * fq;
#pragma unroll
        for (int ai = 0; ai < 2; ++ai)
#pragma unroll
            for (int m = 0; m < 4; ++m) {
                const int row = row0 + ai * HALF + m * 16;
                const float r = row_rstd(ss, row, fq);
                float a[8];
#pragma unroll
                for (int n = 0; n < 2; ++n)
#pragma unroll
                    for (int j = 0; j < 4; ++j) {
                        const float g = acc[ai][0][m][n][j] * r, up = acc[ai][1][m][n][j] * r;
                        a[4 * n + j] = g * __builtin_amdgcn_rcpf(1.f + __builtin_amdgcn_exp2f(-1.4426950408889634f * g)) * up;
                    }
                u32x4 w; w.x = cvt_pk_bf16(a[0], a[1]); w.y = cvt_pk_bf16(a[2], a[3]); w.z = cvt_pk_bf16(a[4], a[5]); w.w = cvt_pk_bf16(a[6], a[7]);
                *(u32x4*)(act + (size_t)row * FF + hid0) = w;
            }
    }
};

template <class Epi, class Sched, bool ALIGN_EPI = false, bool SP2 = false>
__device__ __forceinline__ void gemm_phase(PG8_LAS unsigned char* lds, const Gemm g, const Sched& S, const Epi& E) {
    const int tid = my_tid(), wid = __builtin_amdgcn_readfirstlane(tid >> 6), lane = tid & 63, wr = wid >> 2, wc = wid & 3, fr = lane & 15, fq = lane >> 4;
    const int K = g.K, nt = K / BK;
    unsigned voffA[2], voffB[2];
#pragma unroll
    for (int i = 0; i < 2; ++i) { int R, C; stage_rc(tid * 16 + i * 8192, R, C); const int Rb = Epi::PERM ? ((R & ~31) + perm32(R & 31)) : R;
        voffA[i] = (unsigned)(R * K + C) * 2u; voffB[i] = (unsigned)(Rb * K + C) * 2u; }
    const size_t kstep = (size_t)(BK * 2);
    const size_t hstep = (size_t)HALF * K * 2;
    const size_t tstep = 2 * hstep;
    const unsigned ldsw = (unsigned)wid * 1024u;
    const int aoff = lds_byte(wr * 64 + fr, fq * 8), boff = lds_byte(wc * 32 + fr, fq * 8);
#define PG8_SA(b, h) (((b) * 2 + (h)) * HTB)
#define PG8_SB(b, h) ((4 + (b) * 2 + (h)) * HTB)
#define PG8_STAGE(bufoff, gbase, voff) do { _Pragma("unroll") for (int _i = 0; _i < 2; ++_i) \
        __builtin_amdgcn_global_load_lds((const unsigned*)((const char*)(gbase) + (voff)[_i]), (PG8_LAS unsigned*)(lds + (bufoff) + ldsw + _i * 8192), 16, 0, 0); } while (0)
#define PG8_LDA(dst, b, h) do { _Pragma("unroll") for (int m = 0; m < 4; ++m) _Pragma("unroll") for (int k = 0; k < 2; ++k) dst[m][k] = *(const PG8_LAS bf16x8*)(lds + PG8_SA(b, h) + aoff + m * 2048 + k * 1024); } while (0)
#define PG8_LDB(dst, b, h) do { _Pragma("unroll") for (int n = 0; n < 2; ++n) _Pragma("unroll") for (int k = 0; k < 2; ++k) dst[n][k] = *(const PG8_LAS bf16x8*)(lds + PG8_SB(b, h) + boff + n * 2048 + k * 1024); } while (0)
#define PG8_MMA(ai, bj, At, Bt) do { __builtin_amdgcn_s_setprio(1); _Pragma("unroll") for (int m = 0; m < 4; ++m) _Pragma("unroll") for (int n = 0; n < 2; ++n) _Pragma("unroll") for (int k = 0; k < 2; ++k) \
        acc[ai][bj][m][n] = __builtin_amdgcn_mfma_f32_16x16x32_bf16(Bt[n][k], At[m][k], acc[ai][bj][m][n], 0, 0, 0); __builtin_amdgcn_s_setprio(0); } while (0)
#define PG8_WAIT_V(n) asm volatile("s_waitcnt vmcnt(" #n ")" ::: "memory")
#define PG8_WAIT_L(n) asm volatile("s_waitcnt lgkmcnt(" #n ")" ::: "memory")
#define PG8_BAR __builtin_amdgcn_s_barrier()
#define PG8_SCHED __builtin_amdgcn_sched_barrier(0)
    Unit cur, nxt; int ui = 0;
    if (!S.next(0, cur)) return;
    f32x4 acc[2][2][4][2];
#pragma unroll
    for (int a = 0; a < 2; ++a)
#pragma unroll
        for (int b = 0; b < 2; ++b)
#pragma unroll
            for (int m = 0; m < 4; ++m)
#pragma unroll
                for (int n = 0; n < 2; ++n) acc[a][b][m][n] = (f32x4){0.f, 0.f, 0.f, 0.f};
    bf16x8 At[4][2], B0[2][2], B1[2][2];
    const char* cA = (const char*)g.A + (size_t)cur.pm * tstep; const char* cB = (const char*)g.Bt + (size_t)cur.pn * tstep;
    S.a_ready(cur);
    if constexpr (SP2) {
        PG8_STAGE(PG8_SB(0, 0), cB, voffB); PG8_STAGE(PG8_SB(0, 1), cB + hstep, voffB); PG8_STAGE(PG8_SA(0, 0), cA, voffA); PG8_STAGE(PG8_SA(0, 1), cA + hstep, voffA);
        if (wr == 1) PG8_BAR;
        PG8_WAIT_V(2); PG8_BAR;
        PG8_STAGE(PG8_SB(1, 0), cB + kstep, voffB); PG8_STAGE(PG8_SA(1, 0), cA + kstep, voffA); PG8_STAGE(PG8_SB(1, 1), cB + hstep + kstep, voffB);
        PG8_WAIT_V(6); PG8_BAR;
    } else {
        PG8_STAGE(PG8_SB(0, 0), cB, voffB); PG8_STAGE(PG8_SA(0, 0), cA, voffA); PG8_STAGE(PG8_SB(0, 1), cB + hstep, voffB); PG8_STAGE(PG8_SA(0, 1), cA + hstep, voffA);
        if (wr == 1) PG8_BAR;
        PG8_WAIT_V(4); PG8_BAR;
        PG8_STAGE(PG8_SB(1, 0), cB + kstep, voffB); PG8_STAGE(PG8_SA(1, 0), cA + kstep, voffA); PG8_STAGE(PG8_SB(1, 1), cB + hstep + kstep, voffB);
        PG8_WAIT_V(6); PG8_BAR;
    }
    for (;;) {
        const bool has_next = S.next(ui + 1, nxt);
        const char* nA = has_next ? (const char*)g.A + (size_t)nxt.pm * tstep : cA; const char* nB = has_next ? (const char*)g.Bt + (size_t)nxt.pn * tstep : cB;
        for (int t = 0; t < nt; t += 2) {
            const bool last = (t == nt - 2);
            const char* a1 = cA + (size_t)(t + 1) * kstep;
            const char* a2 = last ? nA : cA + (size_t)(t + 2) * kstep; const char* b2 = last ? nB : cB + (size_t)(t + 2) * kstep;
            const char* a3 = a2 + kstep; const char* b3 = b2 + kstep;
            if (last && has_next) S.a_ready(nxt);
            if constexpr (SP2) {
            PG8_LDB(B0, 0, 0); PG8_LDB(B1, 0, 1); PG8_SCHED; PG8_LDA(At, 0, 0); PG8_STAGE(PG8_SA(1, 1), a1 + hstep, voffA);
            PG8_WAIT_V(8); PG8_WAIT_L(0); PG8_BAR; PG8_MMA(0, 0, At, B0); PG8_MMA(0, 1, At, B1); PG8_BAR; PG8_SCHED;
            PG8_LDA(At, 0, 1); PG8_STAGE(PG8_SB(0, 0), b2, voffB); PG8_STAGE(PG8_SB(0, 1), b2 + hstep, voffB); PG8_STAGE(PG8_SA(0, 0), a2, voffA);
            PG8_WAIT_V(8); PG8_WAIT_L(0); PG8_BAR; PG8_MMA(1, 0, At, B0); PG8_MMA(1, 1, At, B1); PG8_BAR; PG8_SCHED;
            PG8_LDB(B0, 1, 0); PG8_LDB(B1, 1, 1); PG8_SCHED; PG8_LDA(At, 1, 0); PG8_STAGE(PG8_SA(0, 1), a2 + hstep, voffA);
            PG8_WAIT_V(8); PG8_WAIT_L(0); PG8_BAR; PG8_MMA(0, 0, At, B0); PG8_MMA(0, 1, At, B1); PG8_BAR; PG8_SCHED;
            PG8_LDA(At, 1, 1); PG8_STAGE(PG8_SB(1, 0), b3, voffB); PG8_STAGE(PG8_SB(1, 1), b3 + hstep, voffB); PG8_STAGE(PG8_SA(1, 0), a3, voffA);
            PG8_WAIT_V(8); PG8_WAIT_L(0); PG8_BAR; PG8_MMA(1, 0, At, B0); PG8_MMA(1, 1, At, B1); PG8_BAR; PG8_SCHED;
            } else {
            PG8_LDB(B0, 0, 0); PG8_SCHED; PG8_LDA(At, 0, 0); PG8_STAGE(PG8_SA(1, 1), a1 + hstep, voffA);
            PG8_WAIT_L(8); PG8_BAR; PG8_WAIT_L(0); PG8_MMA(0, 0, At, B0); PG8_BAR; PG8_SCHED;
            PG8_LDB(B1, 0, 1); PG8_STAGE(PG8_SB(0, 0), b2, voffB);
            PG8_BAR; PG8_WAIT_L(0); PG8_MMA(0, 1, At, B1); PG8_BAR;
            PG8_LDA(At, 0, 1); PG8_STAGE(PG8_SA(0, 0), a2, voffA);
            PG8_BAR; PG8_WAIT_L(0); PG8_MMA(1, 0, At, B0); PG8_BAR; PG8_SCHED;
            PG8_STAGE(PG8_SB(0, 1), b2 + hstep, voffB);
            PG8_WAIT_V(6); PG8_BAR; PG8_MMA(1, 1, At, B1); PG8_BAR;
            PG8_LDB(B0, 1, 0); PG8_SCHED; PG8_LDA(At, 1, 0); PG8_STAGE(PG8_SA(0, 1), a2 + hstep, voffA);
            PG8_WAIT_L(8); PG8_BAR; PG8_WAIT_L(0); PG8_MMA(0, 0, At, B0); PG8_BAR; PG8_SCHED;
            PG8_LDB(B1, 1, 1); PG8_STAGE(PG8_SB(1, 0), b3, voffB);
            PG8_BAR; PG8_WAIT_L(0); PG8_MMA(0, 1, At, B1); PG8_BAR;
            PG8_LDA(At, 1, 1); PG8_STAGE(PG8_SA(1, 0), a3, voffA);
            PG8_BAR; PG8_WAIT_L(0); PG8_MMA(1, 0, At, B0); PG8_BAR; PG8_SCHED;
            PG8_STAGE(PG8_SB(1, 1), b3 + hstep, voffB);
            PG8_WAIT_V(6); PG8_BAR; PG8_MMA(1, 1, At, B1); PG8_BAR;
            }
        }
        if constexpr (ALIGN_EPI) { if (wr == 0) PG8_BAR; }
        if constexpr (!Epi::AFTER_DRAIN) { E(acc, cur, wr, wc, fr, fq); S.done(cur); }
        if (!has_next) break;
#pragma unroll
        for (int a = 0; a < 2; ++a)
#pragma unroll
            for (int b = 0; b < 2; ++b)
#pragma unroll
                for (int m = 0; m < 4; ++m)
#pragma unroll
                    for (int n = 0; n < 2; ++n) acc[a][b][m][n] = (f32x4){0.f, 0.f, 0.f, 0.f};
        cur = nxt; cA = nA; cB = nB; ++ui;
        if constexpr (ALIGN_EPI) { if (wr == 1) PG8_BAR; }
    }
    PG8_WAIT_V(0);
    if constexpr (!ALIGN_EPI) { if (wr == 0) PG8_BAR; }
    PG8_BAR;
#undef PG8_SA
#undef PG8_SB
#undef PG8_STAGE
#undef PG8_LDA
#undef PG8_LDB
#undef PG8_MMA
#undef PG8_WAIT_V
#undef PG8_WAIT_L
#undef PG8_BAR
#undef PG8_SCHED
}
}

__device__ void phase_rowpass(const Params& p, int l) {
    unsigned char* ws = p.ws;
    bf16_t* proj = (bf16_t*)(ws + WS_PROJ); bf16_t* qkc = (bf16_t*)(ws + WS_XB);
    const float* qg = p.in[I_QG] + l * 64; const float* kg = p.in[I_KG] + l * 192;
    const float* cw = p.in[I_CW] + l * 4096; const float* cb = p.in[I_CB] + l * 1024;
    const int tid = my_tid(), lane = tid & 63, wave = tid >> 6;
    for (int m = my_bid() * 8 + wave; m < M; m += gridDim.x * 8) {
        const int t = m % SEQ;
        bf16_t* row = proj + (size_t)m * NPROJ;
        {
            const u32x4 raw = *(const u32x4*)(row + C_QA + lane * 8); float f[8]; unpack8(raw, f);
            float s = 0.f;
#pragma unroll
            for (int j = 0; j < 8; ++j) s += f[j] * f[j];
            s += __shfl_xor(s, 1); s += __shfl_xor(s, 2); s += __shfl_xor(s, 4);
            const float r = rsqrtf(s * (1.f / 64.f) + EPS);
            const int d0 = (lane & 7) * 8;
            u32x4 o; o.x = pk2(f[0] * r * qg[d0], f[1] * r * qg[d0 + 1]); o.y = pk2(f[2] * r * qg[d0 + 2], f[3] * r * qg[d0 + 3]);
            o.z = pk2(f[4] * r * qg[d0 + 4], f[5] * r * qg[d0 + 5]); o.w = pk2(f[6] * r * qg[d0 + 6], f[7] * r * qg[d0 + 7]);
            *(u32x4*)(row + C_QA + lane * 8) = o;
        }
        {
            const int which = lane >> 5, w4 = (lane & 31) * 4;
            bf16_t* pp = row + (which ? C_KW : C_KS) + w4;
            const u32x2 raw = *(const u32x2*)pp;
            float f[4] = {lo16(raw.x), hi16(raw.x), lo16(raw.y), hi16(raw.y)};
            float s = (f[0] * f[0] + f[1] * f[1]) + (f[2] * f[2] + f[3] * f[3]);
            s += __shfl_xor(s, 1); s += __shfl_xor(s, 2); s += __shfl_xor(s, 4); s += __shfl_xor(s, 8);
            const float r = rsqrtf(s * (1.f / 64.f) + EPS);
            const float* g = kg + (1 + which) * 64 + (w4 & 63);
            u32x2 o; o.x = pk2(f[0] * r * g[0], f[1] * r * g[1]); o.y = pk2(f[2] * r * g[2], f[3] * r * g[3]);
            *(u32x2*)pp = o;
        }
#pragma unroll
        for (int part = 0; part < 2; ++part) {
            const int c0 = part * 512 + lane * 8;
            float acc[8];
#pragma unroll
            for (int j = 0; j < 8; ++j) acc[j] = cb[c0 + j];
#pragma unroll
            for (int w = 0; w < 4; ++w) {
                if (t - 3 + w >= 0) {
                    const u32x4 raw = *(const u32x4*)(proj + (size_t)(m - 3 + w) * NPROJ + C_QB + c0); float f[8]; unpack8(raw, f);
#pragma unroll
                    for (int j = 0; j < 8; ++j) acc[j] += f[j] * cw[w * 1024 + c0 + j];
                }
            }
            const float sc = part ? 0.08838834764831845f : 1.f;
            float y[8];
#pragma unroll
            for (int j = 0; j < 8; ++j) y[j] = silu_f(acc[j]) * sc;
            u32x4 o; o.x = pk2(y[0], y[1]); o.y = pk2(y[2], y[3]); o.z = pk2(y[4], y[5]); o.w = pk2(y[6], y[7]);
            *(u32x4*)(qkc + (size_t)m * 1024 + c0) = o;
        }
    }
}

__device__ void phase_compress(const Params& p, int l, float* lds) {
    unsigned char* ws = p.ws;
    const bf16_t* proj = (const bf16_t*)(ws + WS_PROJ);
    const float* pe = p.in[I_PE] + (size_t)l * 2 * 2048; const float* w1 = p.in[I_W1] + (size_t)l * 2 * 2048 * 128; const float* w2 = p.in[I_W2] + (size_t)l * 2 * 128 * 64;
    const float* kg0 = p.in[I_KG] + l * 192;
    float* tok = lds;
    float* red = lds + 144 * 64;
    float* hidb = red + 4 * 8 * 128;
    const int tid = my_tid(), lane = tid & 63;
    for (int u = my_bid(); u < BATCH * 2 * 2 * 32; u += gridDim.x) {
        const int ib = u & 31, kv = (u >> 5) & 1, g = (u >> 6) & 1, b = u >> 7;
        const int i0 = ib * 8, ni = (NCMP - i0) < 8 ? (NCMP - i0) : 8;
        const int ntok = 16 * ni + 16;
        const int col = (kv ? C_VC : C_KC) + g * 64;
        __syncthreads();
        for (int e = tid; e < 144 * 64; e += NT) {
            const int tt = e >> 6, d = e & 63;
            tok[e] = tt < ntok ? bf2f(proj[(size_t)(b * SEQ + 16 * i0 + tt) * NPROJ + col + d]) : 0.f;
        }
        __syncthreads();
        {
            const int hid = tid & 127, part = tid >> 7;
            float acc[8], accP = 0.f;
#pragma unroll
            for (int ii = 0; ii < 8; ++ii) acc[ii] = 0.f;
            const float* w1p = w1 + (size_t)kv * 2048 * 128 + hid; const float* pep = pe + kv * 2048;
#pragma unroll 2
            for (int f = part * 512; f < part * 512 + 512; ++f) {
                const float w = w1p[(size_t)f * 128];
                accP += w * pep[f];
#pragma unroll
                for (int ii = 0; ii < 8; ++ii) acc[ii] += w * tok[16 * 64 * ii + f];
            }
#pragma unroll
            for (int ii = 0; ii < 8; ++ii) red[(part * 8 + ii) * 128 + hid] = acc[ii] + accP;
        }
        __syncthreads();
        for (int e = tid; e < 8 * 128; e += NT) {
            const float s = (red[e] + red[1024 + e]) + (red[2048 + e] + red[3072 + e]);
            hidb[e] = silu_f(s);
        }
        __syncthreads();
        {
            const int ii = tid >> 6, d = lane;
            float o = 0.f;
            const float* w2p = w2 + (size_t)kv * 128 * 64 + d;
            for (int h = 0; h < 128; ++h) o += hidb[ii * 128 + h] * w2p[h * 64];
            if (kv == 0) { const float s = wave_sum(o * o); o = o * rsqrtf(s * (1.f / 64.f) + EPS) * kg0[d]; }
            bf16_t* dst = (bf16_t*)(ws + (kv ? WS_VCMP : WS_KCMP));
            if (ii < ni) dst[(size_t)((b * 2 + g) * NCMPP + i0 + ii) * 64 + d] = f2bf(o);
        }
    }
    __syncthreads();
}

__device__ __forceinline__ float log_sigmoid_f(float x) { return fminf(x, 0.f) - log1pf(__expf(-fabsf(x))); }
__device__ void mlstm_gates(const float* gates, const float* fb, int m0, int h, float* bcum, float* ig) {
    const int tid = my_tid();
    __syncthreads();
    if (tid < 64) {
        const float lf = log_sigmoid_f(gates[(size_t)(m0 + tid) * 32 + 28 + h] + fb[h]);
        ig[tid] = gates[(size_t)(m0 + tid) * 32 + 24 + h];
        float v = lf;
#pragma unroll
        for (int o = 1; o < 64; o <<= 1) { const float t = __shfl_up(v, o); if (tid >= o) v += t; }
        bcum[tid] = v;
    }
    __syncthreads();
}

__device__ void phase_chunkstate(const Params& p, int l, float* lds) {
    unsigned char* ws = p.ws;
    const bf16_t* proj = (const bf16_t*)(ws + WS_PROJ); const float* gates = (const float*)(ws + WS_GATES);
    const float* cw = p.in[I_CW] + l * 4096; const float* cb = p.in[I_CB] + l * 1024; const float* fb = p.in[I_FB] + l * 4;
    bf16_t* ST = (bf16_t*)(ws + WS_ST); float* STN = (float*)(ws + WS_STN); float* STM = (float*)(ws + WS_STM);
    float* kw = lds;
    float* vv = lds + 8192;
    float* bcum = lds + 16384; float* ig = bcum + 64; float* wsc = ig + 64; float* misc = wsc + 64;
    const int tid = my_tid();
    for (int u = my_bid(); u < BATCH * 4 * 64; u += gridDim.x) {
        const int c = u & 63, h = (u >> 6) & 3, b = u >> 8;
        const int m0 = b * SEQ + c * 64, bh = b * 4 + h;
        mlstm_gates(gates, fb, m0, h, bcum, ig);
        if (tid < 64) {
            const float gv = bcum[63] - bcum[tid] + ig[tid];
            const float mx = wave_max(gv);
            wsc[tid] = __expf(gv - mx);
            if (tid == 0) { misc[0] = mx; STM[bh * 64 + c] = mx; STM[2048 + bh * 64 + c] = bcum[63]; }
        }
        __syncthreads();
        for (int e = tid; e < 64 * 16; e += NT) {
            const int s = e >> 4, d0 = (e & 15) * 8;
            const int t = c * 64 + s, ch = 512 + h * 128 + d0;
            float acc[8];
#pragma unroll
            for (int j = 0; j < 8; ++j) acc[j] = cb[ch + j];
#pragma unroll
            for (int w = 0; w < 4; ++w) {
                if (t - 3 + w >= 0) {
                    const u32x4 raw = *(const u32x4*)(proj + (size_t)(m0 + s - 3 + w) * NPROJ + C_QB + ch); float f[8]; unpack8(raw, f);
#pragma unroll
                    for (int j = 0; j < 8; ++j) acc[j] += f[j] * cw[w * 1024 + ch + j];
                }
            }
            const float sc = 0.08838834764831845f * wsc[s];
#pragma unroll
            for (int j = 0; j < 8; ++j) kw[s * 128 + d0 + j] = silu_f(acc[j]) * sc;
            const u32x4 rv = *(const u32x4*)(proj + (size_t)(m0 + s) * NPROJ + C_VB + h * 128 + d0); float fv[8]; unpack8(rv, fv);
#pragma unroll
            for (int j = 0; j < 8; ++j) vv[s * 128 + d0 + j] = fv[j];
        }
        __syncthreads();
        {
            const int e0 = (tid >> 4) * 4, d0 = (tid & 15) * 8;
            float acc[4][8];
#pragma unroll
            for (int i = 0; i < 4; ++i)
#pragma unroll
                for (int j = 0; j < 8; ++j) acc[i][j] = 0.f;
#pragma unroll 2
            for (int s = 0; s < 64; ++s) {
                const f32x4 ve = *(const f32x4*)(vv + s * 128 + e0);
                const f32x4 k0 = *(const f32x4*)(kw + s * 128 + d0), k1 = *(const f32x4*)(kw + s * 128 + d0 + 4);
                const float va[4] = {ve.x, ve.y, ve.z, ve.w}; const float ka[8] = {k0.x, k0.y, k0.z, k0.w, k1.x, k1.y, k1.z, k1.w};
#pragma unroll
                for (int i = 0; i < 4; ++i)
#pragma unroll
                    for (int j = 0; j < 8; ++j) acc[i][j] += va[i] * ka[j];
            }
#pragma unroll
            for (int i = 0; i < 4; ++i) {
                u32x4 o; o.x = pk2(acc[i][0], acc[i][1]); o.y = pk2(acc[i][2], acc[i][3]); o.z = pk2(acc[i][4], acc[i][5]); o.w = pk2(acc[i][6], acc[i][7]);
                *(u32x4*)(ST + ((size_t)(bh * 64 + c) * 128 + e0 + i) * 128 + d0) = o;
            }
        }
        if (tid < 128) {
            float s = 0.f;
            for (int q = 0; q < 64; ++q) s += kw[q * 128 + tid];
            STN[(size_t)(bh * 64 + c) * 128 + tid] = s;
        }
    }
    __syncthreads();
}

__device__ void phase_scan(const Params& p) {
    unsigned char* ws = p.ws;
    bf16_t* ST = (bf16_t*)(ws + WS_ST); float* STN = (float*)(ws + WS_STN); float* STM = (float*)(ws + WS_STM);
    const int tid = my_tid();
    for (int u = my_bid(); u < 256; u += gridDim.x) {
        const int bh = u >> 3, idx = ((u & 7) * NT + tid) * 4;
        float C[4] = {0.f, 0.f, 0.f, 0.f};
        float nval = 0.f; const bool do_n = (u & 7) == 0 && tid < 128;
        float m = 0.f;
        for (int c0 = 0; c0 < 64; c0 += 8) {
            u32x2 raw[8]; float dn[8], dec[8], scl[8];
#pragma unroll
            for (int k = 0; k < 8; ++k) {
                raw[k] = *(const u32x2*)(ST + (size_t)(bh * 64 + c0 + k) * 16384 + idx);
                dn[k] = do_n ? STN[(size_t)(bh * 64 + c0 + k) * 128 + tid] : 0.f;
            }
#pragma unroll
            for (int k = 0; k < 8; ++k) {
                const float mloc = STM[bh * 64 + c0 + k], bl = STM[2048 + bh * 64 + c0 + k];
                const float mnew = fmaxf(bl + m, mloc);
                dec[k] = __expf(bl + m - mnew); scl[k] = __expf(mloc - mnew);
                if ((u & 7) == 0 && tid == 0) STM[4096 + bh * 64 + c0 + k] = m;
                m = mnew;
            }
#pragma unroll
            for (int k = 0; k < 8; ++k) {
                u32x2 o; o.x = pk2(C[0], C[1]); o.y = pk2(C[2], C[3]);
                *(u32x2*)(ST + (size_t)(bh * 64 + c0 + k) * 16384 + idx) = o;
                const float f[4] = {lo16(raw[k].x), hi16(raw[k].x), lo16(raw[k].y), hi16(raw[k].y)};
#pragma unroll
                for (int j = 0; j < 4; ++j) C[j] = dec[k] * C[j] + scl[k] * f[j];
                if (do_n) { STN[(size_t)(bh * 64 + c0 + k) * 128 + tid] = nval; nval = dec[k] * nval + scl[k] * dn[k]; }
            }
        }
    }
}

__device__ void phase_attn_naive(const Params& p, int l, float* lds) {
    unsigned char* ws = p.ws;
    const bf16_t* proj = (const bf16_t*)(ws + WS_PROJ); const float* gates = (const float*)(ws + WS_GATES);
    const bf16_t* kcmp = (const bf16_t*)(ws + WS_KCMP); const bf16_t* vcmp = (const bf16_t*)(ws + WS_VCMP);
    bf16_t* Y = (bf16_t*)(ws + WS_Y);
    const float* oga = p.in[I_OGA] + l * 512;
    const int tid = my_tid(), lane = tid & 63, wave = tid >> 6;
    float* qs = lds + wave * (256 + 1024);
    float* pb = qs + 256;
    for (int u = my_bid(); u < BATCH * 2 * (SEQ / 8); u += gridDim.x) {
        const int tb = u % (SEQ / 8), g = (u / (SEQ / 8)) & 1, b = u / (SEQ / 4);
        const int t = tb * 8 + wave; const int m = b * SEQ + t;
        const bf16_t* prow = proj + (size_t)m * NPROJ;
#pragma unroll
        for (int hg = 0; hg < 4; ++hg) qs[hg * 64 + lane] = bf2f(prow[C_QA + g * 256 + hg * 64 + lane]);
        float otot[4] = {0.f, 0.f, 0.f, 0.f};
        const float* gt = gates + (size_t)m * 32 + g * 12;
        const int nval = t >= 31 ? ((t - 31) >> 4) + 1 : 0;
        float sc[4][4];
        float mx[4] = {-INFINITY, -INFINITY, -INFINITY, -INFINITY};
        const bf16_t* kc = kcmp + (size_t)(b * 2 + g) * NCMPP * 64; const bf16_t* vc = vcmp + (size_t)(b * 2 + g) * NCMPP * 64;
#pragma unroll
        for (int it = 0; it < 4; ++it) {
            asm volatile("" ::: "memory");
            const int i = it * 64 + lane;
            float a[4] = {0.f, 0.f, 0.f, 0.f};
            if (i < nval) {
#pragma unroll 1
                for (int d8 = 0; d8 < 8; ++d8) {
                    const u32x4 raw = *(const u32x4*)(kc + (size_t)i * 64 + d8 * 8); float f[8]; unpack8(raw, f);
#pragma unroll
                    for (int j = 0; j < 8; ++j)
#pragma unroll
                        for (int hg = 0; hg < 4; ++hg) a[hg] += qs[hg * 64 + d8 * 8 + j] * f[j];
                }
            }
#pragma unroll
            for (int hg = 0; hg < 4; ++hg) { sc[it][hg] = i < nval ? a[hg] * 0.125f : -INFINITY; mx[hg] = fmaxf(mx[hg], sc[it][hg]); }
        }
        float sm[4];
#pragma unroll
        for (int hg = 0; hg < 4; ++hg) {
            mx[hg] = wave_max(mx[hg]);
            float s = 0.f;
#pragma unroll
            for (int it = 0; it < 4; ++it) { const float e = (it * 64 + lane) < nval ? __expf(sc[it][hg] - mx[hg]) : 0.f; sc[it][hg] = e; s += e; }
            sm[hg] = wave_sum(s);
        }
#pragma unroll
        for (int it = 0; it < 4; ++it)
#pragma unroll
            for (int hg = 0; hg < 4; ++hg) pb[hg * 256 + it * 64 + lane] = nval > 0 ? sc[it][hg] / sm[hg] : 0.f;
        {
            float o[4] = {0.f, 0.f, 0.f, 0.f};
            for (int i = 0; i < nval; ++i) {
                const float v = bf2f(vc[(size_t)i * 64 + lane]);
#pragma unroll
                for (int hg = 0; hg < 4; ++hg) o[hg] += pb[hg * 256 + i] * v;
            }
#pragma unroll
            for (int hg = 0; hg < 4; ++hg) otot[hg] += sigmoid_f(gt[hg * 3 + 0]) * o[hg];
        }
        const int cur = t >> 6;
        float imp = 0.f;
#pragma unroll
        for (int k = -1; k < 4; ++k) {
            const int i = 4 * lane + k;
            if (i >= 0 && i < nval) imp += (pb[i] + pb[256 + i]) + (pb[512 + i] + pb[768 + i]);
        }
        const bool valid = lane <= cur;
        const bool forced = (lane == 0) || (lane == cur) || (lane == cur - 1);
        const float score = valid ? imp + (forced ? 1e4f : 0.f) : -1e30f;
        int rank = 0;
        for (int k = 0; k < 64; ++k) {
            const float sk = __shfl(score, k);
            rank += (sk > score || (sk == score && k < lane)) ? 1 : 0;
        }
        const unsigned long long selmask = __ballot(rank < 16 && valid);
#pragma unroll 1
        for (int br = 0; br < 2; ++br) {
            const int kcol = (br ? C_KW : C_KS) + g * 64, vcol = (br ? C_VW : C_VS) + g * 64;
            float mr[4] = {-INFINITY, -INFINITY, -INFINITY, -INFINITY}, lr[4] = {0.f, 0.f, 0.f, 0.f}, o[4] = {0.f, 0.f, 0.f, 0.f};
            const int jlo = br ? (cur >= 8 ? cur - 8 : 0) : 0;
            for (int j = jlo; j <= cur; ++j) {
                if (br == 0 && !((selmask >> j) & 1ull)) continue;
                asm volatile("" ::: "memory");
                const int pos = j * 64 + lane;
                const bool ok = pos <= t && (br == 0 || pos > t - 512);
                float a[4] = {0.f, 0.f, 0.f, 0.f};
                const bf16_t* kr = proj + (size_t)(b * SEQ + pos) * NPROJ + kcol;
#pragma unroll 1
                for (int d8 = 0; d8 < 8; ++d8) {
                    const u32x4 raw = *(const u32x4*)(kr + d8 * 8); float f[8]; unpack8(raw, f);
#pragma unroll
                    for (int jj = 0; jj < 8; ++jj)
#pragma unroll
                        for (int hg = 0; hg < 4; ++hg) a[hg] += qs[hg * 64 + d8 * 8 + jj] * f[jj];
                }
                float alpha[4];
#pragma unroll
                for (int hg = 0; hg < 4; ++hg) {
                    const float s = ok ? a[hg] * 0.125f : -INFINITY;
                    const float bm = wave_max(s);
                    const float mn = fmaxf(mr[hg], bm);
                    alpha[hg] = (mn == -INFINITY) ? 1.f : __expf(mr[hg] - mn);
                    const float e = (ok && mn > -INFINITY) ? __expf(s - mn) : 0.f;
                    lr[hg] = lr[hg] * alpha[hg] + wave_sum(e);
                    mr[hg] = mn;
                    pb[hg * 256 + lane] = e;
                    o[hg] *= alpha[hg];
                }
                const bf16_t* vr = proj + (size_t)(b * SEQ + j * 64) * NPROJ + vcol + lane;
                for (int k = 0; k < 64; ++k) {
                    const float v = bf2f(vr[(size_t)k * NPROJ]);
#pragma unroll
                    for (int hg = 0; hg < 4; ++hg) o[hg] += pb[hg * 256 + k] * v;
                }
            }
#pragma unroll
            for (int hg = 0; hg < 4; ++hg) otot[hg] += sigmoid_f(gt[hg * 3 + 1 + br]) * (lr[hg] > 0.f ? o[hg] / lr[hg] : 0.f);
        }
#pragma unroll
        for (int hg = 0; hg < 4; ++hg) {
            const float s = wave_sum(otot[hg] * otot[hg]);
            const float y = otot[hg] * rsqrtf(s * (1.f / 64.f) + EPS) * oga[(g * 4 + hg) * 64 + lane];
            Y[(size_t)m * 1024 + (g * 4 + hg) * 64 + lane] = f2bf(y);
        }
    }
}

namespace att {
typedef short bf16x8 __attribute__((ext_vector_type(8)));
typedef short s16x4 __attribute__((ext_vector_type(4)));
typedef float f32x16 __attribute__((ext_vector_type(16)));
#define ATT_LAS __attribute__((address_space(3)))
constexpr int L_K = 0, L_V = 16384, L_IMP = 32768, IMP_STRIDE = 65, L_SEL = L_IMP + 4 * 64 * IMP_STRIDE * 4, L_INV = L_SEL + 512, L_WS = L_INV + 1024, L_OST = L_WS + 8 * 256, L_END = L_OST + 8 * 4096;
static_assert(L_END <= LDS_BYTES, "attention LDS map");
constexpr float LOG2E = 1.4426950408889634f;
__device__ __forceinline__ int crow(int r, int hi) { return (r & 3) + 8 * (r >> 2) + 4 * hi; }
__device__ __forceinline__ unsigned cvtpk(float lo, float hi) { unsigned r; asm("v_cvt_pk_bf16_f32 %0, %1, %2" : "=v"(r) : "v"(lo), "v"(hi)); return r; }
__device__ __forceinline__ s16x4 vtr(ATT_LAS const unsigned char* p) { return __builtin_bit_cast(s16x4, __builtin_amdgcn_ds_read_tr16_b64_v4i16((ATT_LAS s16x4*)p)); }

struct Ctx {
    ATT_LAS unsigned char* lds;
    int lane, wave, r32, hi;
    u32x4 kreg, vreg;
};
__device__ __forceinline__ void tile_load(Ctx& C, const bf16_t* kbase, const bf16_t* vbase, int pitch) {
    C.kreg = *(const u32x4*)(kbase + (size_t)C.lane * pitch + C.wave * 8);
    C.vreg = *(const u32x4*)(vbase + (size_t)(16 * (C.wave & 3) + (C.lane >> 2)) * pitch + (C.wave >> 2) * 32 + (C.lane & 3) * 8);
}
__device__ __forceinline__ void tile_store(Ctx& C, int buf) {
    *(ATT_LAS u32x4*)(C.lds + L_K + buf * 8192 + C.wave * 1024 + C.lane * 16) = C.kreg;
    *(ATT_LAS u32x4*)(C.lds + L_V + buf * 8192 + C.wave * 1024 + C.lane * 16) = C.vreg;
}
__device__ __forceinline__ void qkt(const Ctx& C, int buf, const bf16x8 (&qr)[4], f32x16& p0, f32x16& p1) {
    ATT_LAS const unsigned char* kb = C.lds + L_K + buf * 8192 + C.hi * 1024 + C.r32 * 16;
    p0 = (f32x16){0.f, 0.f, 0.f, 0.f, 0.f, 0.f, 0.f, 0.f, 0.f, 0.f, 0.f, 0.f, 0.f, 0.f, 0.f, 0.f}; p1 = p0;
#pragma unroll
    for (int d0 = 0; d0 < 4; ++d0) {
        const bf16x8 b0 = *(ATT_LAS const bf16x8*)(kb + d0 * 2048);
        const bf16x8 b1 = *(ATT_LAS const bf16x8*)(kb + d0 * 2048 + 512);
        p0 = __builtin_amdgcn_mfma_f32_32x32x16_bf16(b0, qr[d0], p0, 0, 0, 0);
        p1 = __builtin_amdgcn_mfma_f32_32x32x16_bf16(b1, qr[d0], p1, 0, 0, 0);
    }
}
__device__ __forceinline__ void pv(const Ctx& C, int buf, const f32x16& p0, const f32x16& p1, f32x16 (&o)[2]) {
    ATT_LAS const unsigned char* vp = C.lds + L_V + buf * 8192 + ((C.lane >> 4) & 1) * 32 + (C.lane & 3) * 8 + (4 * C.hi + ((C.lane & 15) >> 2)) * 64;
    bf16x8 pa[4];
#pragma unroll
    for (int s2 = 0; s2 < 2; ++s2) {
        u32x4 w0, w1;
        w0.x = cvtpk(p0[8 * s2 + 0], p0[8 * s2 + 1]); w0.y = cvtpk(p0[8 * s2 + 2], p0[8 * s2 + 3]); w0.z = cvtpk(p0[8 * s2 + 4], p0[8 * s2 + 5]); w0.w = cvtpk(p0[8 * s2 + 6], p0[8 * s2 + 7]);
        w1.x = cvtpk(p1[8 * s2 + 0], p1[8 * s2 + 1]); w1.y = cvtpk(p1[8 * s2 + 2], p1[8 * s2 + 3]); w1.z = cvtpk(p1[8 * s2 + 4], p1[8 * s2 + 5]); w1.w = cvtpk(p1[8 * s2 + 6], p1[8 * s2 + 7]);
        pa[s2] = __builtin_bit_cast(bf16x8, w0); pa[2 + s2] = __builtin_bit_cast(bf16x8, w1);
    }
#pragma unroll
    for (int d0 = 0; d0 < 2; ++d0)
#pragma unroll
        for (int ks = 0; ks < 4; ++ks) {
            const s16x4 lo = vtr(vp + d0 * 4096 + ks * 1024), hh = vtr(vp + d0 * 4096 + ks * 1024 + 512);
            const bf16x8 vf = (bf16x8){lo[0], lo[1], lo[2], lo[3], hh[0], hh[1], hh[2], hh[3]};
            o[d0] = __builtin_amdgcn_mfma_f32_32x32x16_bf16(pa[ks], vf, o[d0], 0, 0, 0);
        }
}
__device__ __forceinline__ float sum16(const f32x16& p) {
    return ((p[0] + p[1]) + (p[2] + p[3])) + ((p[4] + p[5]) + (p[6] + p[7])) + (((p[8] + p[9]) + (p[10] + p[11])) + ((p[12] + p[13]) + (p[14] + p[15])));
}
__device__ __forceinline__ void accum_scaled(const Ctx& C, f32x16 (&otot)[2], const f32x16 (&o)[2], float fac) {
    ATT_LAS float* wsf = (ATT_LAS float*)(C.lds + L_WS) + C.wave * 64;
    asm volatile("s_waitcnt lgkmcnt(0)" ::: "memory");
    if (C.hi == 0) wsf[C.r32] = fac;
    asm volatile("s_waitcnt lgkmcnt(0)" ::: "memory");
#pragma unroll
    for (int r = 0; r < 16; ++r) { const float f = wsf[crow(r, C.hi)]; otot[0][r] += o[0][r] * f; otot[1][r] += o[1][r] * f; }
    asm volatile("s_waitcnt lgkmcnt(0)" : "+v"(otot[0]), "+v"(otot[1]) :: "memory");
}

__device__ void unit(const Params& p, int l, int b, int g, int c, ATT_LAS unsigned char* lds) {
    unsigned char* ws = p.ws;
    const bf16_t* proj = (const bf16_t*)(ws + WS_PROJ); const float* gates = (const float*)(ws + WS_GATES);
    const bf16_t* kcmp = (const bf16_t*)(ws + WS_KCMP) + (size_t)(b * 2 + g) * NCMPP * 64; const bf16_t* vcmp = (const bf16_t*)(ws + WS_VCMP) + (size_t)(b * 2 + g) * NCMPP * 64;
    bf16_t* Y = (bf16_t*)(ws + WS_Y);
    const float* kg = p.in[I_KG] + l * 192; const float* oga = p.in[I_OGA] + l * 512;
    Ctx C; C.lds = lds;
    const int tid = my_tid(); C.lane = tid & 63; C.wave = __builtin_amdgcn_readfirstlane(tid >> 6); C.r32 = C.lane & 31; C.hi = C.lane >> 5;
    const int lane = C.lane, wave = C.wave, r32 = C.r32, hi = C.hi, hg = wave >> 1, th = wave & 1;
    const int t = 64 * c + 32 * th + r32; const size_t m = (size_t)b * SEQ + t;
    const bf16_t* prow0 = proj + (size_t)b * SEQ * NPROJ;
    bf16x8 qr[4]; float qsq = 0.f;
#pragma unroll
    for (int d0 = 0; d0 < 4; ++d0) {
        const u32x4 raw = *(const u32x4*)(proj + m * NPROJ + C_QA + g * 256 + hg * 64 + 16 * d0 + 8 * hi);
        qr[d0] = __builtin_bit_cast(bf16x8, raw);
        float f[8]; unpack8(raw, f);
#pragma unroll
        for (int j = 0; j < 8; ++j) qsq += f[j] * f[j];
    }
    qsq += __shfl_xor(qsq, 32);
    const float qn = sqrtf(qsq) * 1.01f * LOG2E;
    const float off_c = qn * wave_max(fabsf(kg[lane])), off_s = qn * wave_max(fabsf(kg[64 + lane])), off_w = qn * wave_max(fabsf(kg[128 + lane]));
    const float* gt = gates + m * 32 + (g * 4 + hg) * 3;
    const float gq0 = sigmoid_f(gt[0]), gq1 = sigmoid_f(gt[1]), gq2 = sigmoid_f(gt[2]);
    constexpr float C2 = 0.125f * LOG2E;
    f32x16 otot[2]; otot[0] = (f32x16){0.f, 0.f, 0.f, 0.f, 0.f, 0.f, 0.f, 0.f, 0.f, 0.f, 0.f, 0.f, 0.f, 0.f, 0.f, 0.f}; otot[1] = otot[0];
    const f32x16 zero16 = otot[0];
    {
        const int nval = t >= 31 ? ((t - 31) >> 4) + 1 : 0;
        const int ntc = (4 * c + 3 + 63) >> 6;
        f32x16 o[2]; o[0] = zero16; o[1] = zero16;
        float lsum = 0.f, yprev = 0.f;
        ATT_LAS float* imp = (ATT_LAS float*)(lds + L_IMP) + (hg * 64 + 32 * th + r32) * IMP_STRIDE;
        tile_load(C, kcmp, vcmp, 64); tile_store(C, 0); __syncthreads();
#pragma unroll
        for (int jt = 0; jt < 4; ++jt) {
            if (jt < ntc) {
                if (jt + 1 < ntc) tile_load(C, kcmp + (size_t)(jt + 1) * 64 * 64, vcmp + (size_t)(jt + 1) * 64 * 64, 64);
                f32x16 p0, p1; qkt(C, jt & 1, qr, p0, p1);
#pragma unroll
                for (int r = 0; r < 16; ++r) {
                    const int i0 = 64 * jt + crow(r, hi);
                    p0[r] = i0 < nval ? __builtin_amdgcn_exp2f(p0[r] * C2 - off_c) : 0.f;
                    p1[r] = i0 + 32 < nval ? __builtin_amdgcn_exp2f(p1[r] * C2 - off_c) : 0.f;
                }
                lsum += sum16(p0) + sum16(p1);
#pragma unroll
                for (int H = 0; H < 2; ++H)
#pragma unroll
                    for (int rr = 0; rr < 4; ++rr) {
                        const f32x16& pp = H ? p1 : p0;
                        const float L = pp[4 * rr + 3], S4 = (pp[4 * rr] + pp[4 * rr + 1]) + (pp[4 * rr + 2] + L);
                        const float y = __shfl_xor(L, 32);
                        imp[2 * ((jt * 2 + H) * 4 + rr) + hi] = S4 + (hi ? y : yprev);
                        yprev = y;
                    }
                pv(C, jt & 1, p0, p1, o);
                if (jt + 1 < ntc) tile_store(C, (jt + 1) & 1);
                __syncthreads();
            }
        }
        lsum += __shfl_xor(lsum, 32);
        const float inv = lsum > 0.f ? 1.f / lsum : 0.f;
        if (hi == 0) ((ATT_LAS float*)(lds + L_INV))[hg * 64 + 32 * th + r32] = inv;
        accum_scaled(C, otot, o, gq0 * inv);
    }
    __syncthreads();
    {
        ATT_LAS unsigned long long* selm = (ATT_LAS unsigned long long*)(lds + L_SEL);
        const ATT_LAS float* impb = (const ATT_LAS float*)(lds + L_IMP);
        for (int i = 0; i < 8; ++i) {
            const int q = wave * 8 + i;
            unsigned long long msk;
            if (c < 16) msk = (2ull << c) - 1ull;
            else {
                const bool valid = lane <= c;
                float sc = -1e30f;
                if (valid) {
                    const ATT_LAS float* invb = (const ATT_LAS float*)(lds + L_INV);
                    sc = (impb[(0 * 64 + q) * IMP_STRIDE + lane] * invb[q] + impb[(1 * 64 + q) * IMP_STRIDE + lane] * invb[64 + q]) + (impb[(2 * 64 + q) * IMP_STRIDE + lane] * invb[128 + q] + impb[(3 * 64 + q) * IMP_STRIDE + lane] * invb[192 + q]);
                    if (lane == 0 || lane == c || lane == c - 1) sc += 1e4f;
                }
                int rank = 0;
                for (int k = 0; k <= c; ++k) { const float sk = __shfl(sc, k); rank += (sk > sc || (sk == sc && k < lane)) ? 1 : 0; }
                msk = __ballot(valid && rank < 16);
            }
            if (lane == 0) selm[q] = msk;
        }
    }
    __syncthreads();
    const unsigned long long mysel = ((ATT_LAS const unsigned long long*)(lds + L_SEL))[32 * th + r32];
    unsigned long long blkmask;
    {
        unsigned long long v = ((ATT_LAS const unsigned long long*)(lds + L_SEL))[lane];
#pragma unroll
        for (int o2 = 1; o2 < 64; o2 <<= 1) v |= __shfl_xor(v, o2);
        blkmask = ((unsigned long long)__builtin_amdgcn_readfirstlane((unsigned)(v >> 32)) << 32) | (unsigned)__builtin_amdgcn_readfirstlane((unsigned)v);
    }
    {
        f32x16 o[2]; o[0] = zero16; o[1] = zero16; float lsum = 0.f;
        const bf16_t* kb = prow0 + C_KS + g * 64; const bf16_t* vb = prow0 + C_VS + g * 64;
        unsigned long long rem = blkmask;
        int j = __builtin_ctzll(rem); rem &= rem - 1ull;
        tile_load(C, kb + (size_t)j * 64 * NPROJ, vb + (size_t)j * 64 * NPROJ, NPROJ); tile_store(C, 0); __syncthreads();
        int buf = 0;
        for (;;) {
            const int jn = rem ? __builtin_ctzll(rem) : -1;
            if (jn >= 0) { rem &= rem - 1ull; tile_load(C, kb + (size_t)jn * 64 * NPROJ, vb + (size_t)jn * 64 * NPROJ, NPROJ); }
            f32x16 p0, p1; qkt(C, buf, qr, p0, p1);
            const bool sel = (mysel >> j) & 1ull;
            const int lim = t - 64 * j;
#pragma unroll
            for (int r = 0; r < 16; ++r) {
                const int kk = crow(r, hi);
                p0[r] = (sel && kk <= lim) ? __builtin_amdgcn_exp2f(p0[r] * C2 - off_s) : 0.f;
                p1[r] = (sel && kk + 32 <= lim) ? __builtin_amdgcn_exp2f(p1[r] * C2 - off_s) : 0.f;
            }
            lsum += sum16(p0) + sum16(p1);
            pv(C, buf, p0, p1, o);
            if (jn >= 0) tile_store(C, buf ^ 1);
            __syncthreads();
            if (jn < 0) break;
            j = jn; buf ^= 1;
        }
        lsum += __shfl_xor(lsum, 32);
        accum_scaled(C, otot, o, gq1 / lsum);
    }
    {
        f32x16 o[2]; o[0] = zero16; o[1] = zero16; float lsum = 0.f;
        const bf16_t* kb = prow0 + C_KW + g * 64; const bf16_t* vb = prow0 + C_VW + g * 64;
        const int jlo = c >= 8 ? c - 8 : 0;
        tile_load(C, kb + (size_t)jlo * 64 * NPROJ, vb + (size_t)jlo * 64 * NPROJ, NPROJ); tile_store(C, 0); __syncthreads();
        int buf = 0;
        for (int j = jlo; j <= c; ++j) {
            if (j < c) tile_load(C, kb + (size_t)(j + 1) * 64 * NPROJ, vb + (size_t)(j + 1) * 64 * NPROJ, NPROJ);
            f32x16 p0, p1; qkt(C, buf, qr, p0, p1);
            const int lim = t - 64 * j;
#pragma unroll
            for (int r = 0; r < 16; ++r) {
                const int kk = crow(r, hi);
                p0[r] = (kk <= lim && kk > lim - 512) ? __builtin_amdgcn_exp2f(p0[r] * C2 - off_w) : 0.f;
                p1[r] = (kk + 32 <= lim && kk + 32 > lim - 512) ? __builtin_amdgcn_exp2f(p1[r] * C2 - off_w) : 0.f;
            }
            lsum += sum16(p0) + sum16(p1);
            pv(C, buf, p0, p1, o);
            if (j < c) tile_store(C, buf ^ 1);
            __syncthreads();
            buf ^= 1;
        }
        lsum += __shfl_xor(lsum, 32);
        accum_scaled(C, otot, o, gq2 / lsum);
    }
    {
        ATT_LAS bf16_t* stg = (ATT_LAS bf16_t*)(lds + L_OST) + wave * 2048;
        const float g0 = oga[(g * 4 + hg) * 64 + r32], g1 = oga[(g * 4 + hg) * 64 + 32 + r32];
#pragma unroll
        for (int r = 0; r < 16; ++r) {
            float sq = otot[0][r] * otot[0][r] + otot[1][r] * otot[1][r];
            sq += __shfl_xor(sq, 1); sq += __shfl_xor(sq, 2); sq += __shfl_xor(sq, 4); sq += __shfl_xor(sq, 8); sq += __shfl_xor(sq, 16);
            const float rs = rsqrtf(sq * (1.f / 64.f) + EPS);
            const int q = crow(r, hi);
            stg[q * 64 + r32] = f2bf(otot[0][r] * rs * g0);
            stg[q * 64 + 32 + r32] = f2bf(otot[1][r] * rs * g1);
        }
        asm volatile("s_waitcnt lgkmcnt(0)" ::: "memory");
        bf16_t* yb = Y + ((size_t)b * SEQ + 64 * c + 32 * th) * 1024 + (g * 4 + hg) * 64;
#pragma unroll
        for (int i = 0; i < 4; ++i) {
            const int row = i * 8 + (lane >> 3), ch = lane & 7;
            const u32x4 v = *(ATT_LAS const u32x4*)(stg + row * 64 + ch * 8);
            *(u32x4*)(yb + (size_t)row * 1024 + ch * 8) = v;
        }
    }
    __syncthreads();
}
}

__device__ void phase_attn_mfma(const Params& p, int l, unsigned char* lds_raw) {
    for (int v = my_bid(); v < 1024; v += gridDim.x) {
        const int r = v >> 8, x = (v >> 4) & 15, bg = v & 15;
        const int c = r == 0 ? 63 - x : (r == 1 ? 32 + x : (r == 2 ? 31 - x : x));
        att::unit(p, l, bg >> 1, bg & 1, c, (ATT_LAS unsigned char*)lds_raw);
    }
}

__device__ void phase_mlstm_out(const Params& p, int l, float* lds) {
    unsigned char* ws = p.ws;
    const bf16_t* proj = (const bf16_t*)(ws + WS_PROJ); const float* gates = (const float*)(ws + WS_GATES);
    const bf16_t* qkc = (const bf16_t*)(ws + WS_XB);
    const bf16_t* ST = (const bf16_t*)(ws + WS_ST); const float* STN = (const float*)(ws + WS_STN); const float* STM = (const float*)(ws + WS_STM);
    const float* fb = p.in[I_FB] + l * 4; const float* ogm = p.in[I_OGM] + l * 512;
    bf16_t* Y = (bf16_t*)(ws + WS_Y);
    float* qq = lds;
    float* kk = lds + 8192;
    float* Cs = lds + 16384;
    float* Ws = lds + 32768;
    float* bcum = Ws + 64 * 65; float* ig = bcum + 64; float* mt = ig + 64; float* wint = mt + 64; float* den = wint + 64; float* npv = den + 64;
    const int tid = my_tid(), lane = tid & 63, wave = tid >> 6;
    for (int u = my_bid(); u < BATCH * 4 * 64; u += gridDim.x) {
        const int c = u & 63, h = (u >> 6) & 3, b = u >> 8;
        const int m0 = b * SEQ + c * 64, bh = b * 4 + h;
        mlstm_gates(gates, fb, m0, h, bcum, ig);
        const float mprev = STM[4096 + bh * 64 + c];
        for (int e = tid; e < 64 * 16; e += NT) {
            const int s = e >> 4, d0 = (e & 15) * 8;
            const u32x4 rq = *(const u32x4*)(qkc + (size_t)(m0 + s) * 1024 + h * 128 + d0); float f[8]; unpack8(rq, f);
            const u32x4 rk = *(const u32x4*)(qkc + (size_t)(m0 + s) * 1024 + 512 + h * 128 + d0); float fk[8]; unpack8(rk, fk);
#pragma unroll
            for (int j = 0; j < 8; ++j) { qq[s * 128 + d0 + j] = f[j]; kk[s * 128 + d0 + j] = fk[j]; }
        }
        if (tid < 128) npv[tid] = STN[(size_t)(bh * 64 + c) * 128 + tid];
        for (int e8 = tid; e8 < 128 * 16; e8 += NT) {
            const int e = e8 >> 4, d0 = (e8 & 15) * 8;
            const u32x4 rc = *(const u32x4*)(ST + ((size_t)(bh * 64 + c) * 128 + e) * 128 + d0); float f[8]; unpack8(rc, f);
#pragma unroll
            for (int j = 0; j < 8; ++j) Cs[(d0 + j) * 128 + e] = f[j];
        }
        __syncthreads();
        {
            const int t = tid >> 3, s0 = (tid & 7) * 8;
            float a[8] = {0.f, 0.f, 0.f, 0.f, 0.f, 0.f, 0.f, 0.f};
#pragma unroll 2
            for (int d = 0; d < 128; ++d) {
                const float qv = qq[t * 128 + d];
#pragma unroll
                for (int j = 0; j < 8; ++j) a[j] += qv * kk[(s0 + j) * 128 + d];
            }
#pragma unroll
            for (int j = 0; j < 8; ++j) Ws[t * 65 + s0 + j] = a[j];
        }
        __syncthreads();
        for (int r = 0; r < 8; ++r) {
            const int t = wave * 8 + r;
            const float dv = lane <= t ? bcum[t] - bcum[lane] + ig[lane] : -INFINITY;
            const float a = bcum[t] + mprev;
            const float m_t = fmaxf(a, wave_max(dv));
            const float w = lane <= t ? __expf(dv - m_t) * Ws[t * 65 + lane] : 0.f;
            Ws[t * 65 + lane] = w;
            const float wi = __expf(a - m_t);
            const float qn = wave_sum(qq[t * 128 + lane] * npv[lane] + qq[t * 128 + 64 + lane] * npv[64 + lane]);
            const float dsum = wave_sum(w);
            if (lane == 0) { mt[t] = m_t; wint[t] = wi; den[t] = wi * qn + dsum; }
        }
        __syncthreads();
        for (int e = tid; e < 64 * 16; e += NT) {
            const int s = e >> 4, d0 = (e & 15) * 8;
            const u32x4 rv = *(const u32x4*)(proj + (size_t)(m0 + s) * NPROJ + C_VB + h * 128 + d0); float f[8]; unpack8(rv, f);
#pragma unroll
            for (int j = 0; j < 8; ++j) kk[s * 128 + d0 + j] = f[j];
        }
        __syncthreads();
        float hv[16];
        {
            const int e = tid & 127, t0 = (tid >> 7) * 16;
            float a1[16], a2[16];
#pragma unroll
            for (int i = 0; i < 16; ++i) { a1[i] = 0.f; a2[i] = 0.f; }
#pragma unroll 2
            for (int d = 0; d < 128; ++d) {
                const float cv = Cs[d * 128 + e];
#pragma unroll
                for (int i = 0; i < 16; ++i) a1[i] += qq[(t0 + i) * 128 + d] * cv;
            }
#pragma unroll 2
            for (int s = 0; s < 64; ++s) {
                const float vv = kk[s * 128 + e];
#pragma unroll
                for (int i = 0; i < 16; ++i) a2[i] += Ws[(t0 + i) * 65 + s] * vv;
            }
#pragma unroll
            for (int i = 0; i < 16; ++i) {
                const int t = t0 + i;
                const float num = wint[t] * a1[i] + a2[i];
                hv[i] = num / fmaxf(fabsf(den[t]), __expf(-mt[t]));
            }
        }
        __syncthreads();
        {
            const int e = tid & 127, t0 = (tid >> 7) * 16;
#pragma unroll
            for (int i = 0; i < 16; ++i) Cs[(t0 + i) * 128 + e] = hv[i];
        }
        __syncthreads();
        for (int r = 0; r < 8; ++r) {
            const int t = wave * 8 + r;
            const float h0 = Cs[t * 128 + lane], h1 = Cs[t * 128 + 64 + lane];
            const float s = wave_sum(h0 * h0 + h1 * h1);
            const float rr = rsqrtf(s * (1.f / 128.f) + EPS);
            const bf16_t* op = proj + (size_t)(m0 + t) * NPROJ + C_OB + h * 128;
            const float y0 = h0 * rr * ogm[h * 128 + lane] * sigmoid_f(bf2f(op[lane]));
            const float y1 = h1 * rr * ogm[h * 128 + 64 + lane] * sigmoid_f(bf2f(op[64 + lane]));
            Y[(size_t)(m0 + t) * 1024 + 512 + h * 128 + lane] = f2bf(y0);
            Y[(size_t)(m0 + t) * 1024 + 512 + h * 128 + 64 + lane] = f2bf(y1);
        }
        __syncthreads();
    }
}

namespace mls {
typedef short bf16x8 __attribute__((ext_vector_type(8)));
typedef short s16x4 __attribute__((ext_vector_type(4)));
typedef float f32x16 __attribute__((ext_vector_type(16)));
#define MLS_LAS __attribute__((address_space(3)))
__device__ __forceinline__ s16x4 vtr(MLS_LAS const unsigned char* p) { return __builtin_bit_cast(s16x4, __builtin_amdgcn_ds_read_tr16_b64_v4i16((MLS_LAS s16x4*)p)); }
__device__ __forceinline__ bf16x8 trfrag(MLS_LAS const unsigned char* p) { const s16x4 lo = vtr(p), hh = vtr(p + 512); return (bf16x8){lo[0], lo[1], lo[2], lo[3], hh[0], hh[1], hh[2], hh[3]}; }
__device__ __forceinline__ float incl_scan64(float v, int lane) {
#pragma unroll
    for (int o = 1; o < 64; o <<= 1) { const float t = __shfl_up(v, o); if (lane >= o) v += t; }
    return v;
}
constexpr float KSCALE = 0.08838834764831845f;

__device__ void chunk_unit(const Params& p, int l, int b, int c, MLS_LAS unsigned char* lds) {
    unsigned char* ws = p.ws;
    const bf16_t* proj = (const bf16_t*)(ws + WS_PROJ); const float* gates = (const float*)(ws + WS_GATES);
    const float* cw = p.in[I_CW] + l * 4096; const float* cb = p.in[I_CB] + l * 1024; const float* fb = p.in[I_FB] + l * 4;
    bf16_t* ST = (bf16_t*)(ws + WS_ST); float* STN = (float*)(ws + WS_STN); float* STM = (float*)(ws + WS_STM);
    const int tid = my_tid(), lane = tid & 63, wave = __builtin_amdgcn_readfirstlane(tid >> 6), r32 = lane & 31, hi = lane >> 5, h = wave >> 1, half = wave & 1;
    const size_t m0 = (size_t)b * SEQ + 64 * c; const int bh = b * 4 + h;
    const float lf = log_sigmoid_f(gates[(m0 + lane) * 32 + 28 + h] + fb[h]);
    const float igv = gates[(m0 + lane) * 32 + 24 + h];
    const float bc = incl_scan64(lf, lane);
    const float blast = __shfl(bc, 63);
    const float gv = blast - bc + igv;
    const float mloc = wave_max(gv);
    const float wsc = __expf(gv - mloc);
    if (half == 0 && lane == 0) { STM[bh * 64 + c] = mloc; STM[2048 + bh * 64 + c] = blast; }
    MLS_LAS unsigned char* vimg = lds + h * 32768; MLS_LAS unsigned char* kimg = vimg + 16384;
    {
        const int pc = lane & 15, ch = 512 + h * 128 + pc * 8;
        float cwv[4][8], cbv[8];
#pragma unroll
        for (int j = 0; j < 8; ++j) { cbv[j] = cb[ch + j];
#pragma unroll
            for (int w = 0; w < 4; ++w) cwv[w][j] = cw[w * 1024 + ch + j]; }
#pragma unroll 2
        for (int it = 0; it < 8; ++it) {
            const int s = 32 * half + 4 * it + (lane >> 4);
            const u32x4 rv = *(const u32x4*)(proj + (m0 + s) * NPROJ + C_VB + h * 128 + pc * 8);
            *(MLS_LAS u32x4*)(vimg + (pc >> 2) * 4096 + s * 64 + (pc & 3) * 16) = rv;
            float acc[8];
#pragma unroll
            for (int j = 0; j < 8; ++j) acc[j] = cbv[j];
#pragma unroll
            for (int w = 0; w < 4; ++w) {
                if (64 * c + s - 3 + w >= 0) {
                    const u32x4 raw = *(const u32x4*)(proj + (m0 + s - 3 + w) * NPROJ + C_KB + h * 128 + pc * 8); float f[8]; unpack8(raw, f);
#pragma unroll
                    for (int j = 0; j < 8; ++j) acc[j] += f[j] * cwv[w][j];
                }
            }
            const float sc = KSCALE * __shfl(wsc, s);
            float y[8];
#pragma unroll
            for (int j = 0; j < 8; ++j) y[j] = silu_f(acc[j]) * sc;
            u32x4 o; o.x = pk2(y[0], y[1]); o.y = pk2(y[2], y[3]); o.z = pk2(y[4], y[5]); o.w = pk2(y[6], y[7]);
            *(MLS_LAS u32x4*)(kimg + (pc >> 2) * 4096 + s * 64 + (pc & 3) * 16) = o;
        }
    }
    __syncthreads();
    f32x16 acc[2][4];
#pragma unroll
    for (int e2 = 0; e2 < 2; ++e2)
#pragma unroll
        for (int db = 0; db < 4; ++db) acc[e2][db] = (f32x16){0.f, 0.f, 0.f, 0.f, 0.f, 0.f, 0.f, 0.f, 0.f, 0.f, 0.f, 0.f, 0.f, 0.f, 0.f, 0.f};
    {
        const int tro = ((lane >> 4) & 1) * 32 + (lane & 3) * 8 + (4 * hi + ((lane & 15) >> 2)) * 64;
#pragma unroll
        for (int ks = 0; ks < 4; ++ks) {
            const bf16x8 a0 = trfrag(vimg + tro + (2 * half) * 4096 + ks * 1024), a1 = trfrag(vimg + tro + (2 * half + 1) * 4096 + ks * 1024);
#pragma unroll
            for (int db = 0; db < 4; ++db) {
                const bf16x8 bfr = trfrag(kimg + tro + db * 4096 + ks * 1024);
                acc[0][db] = __builtin_amdgcn_mfma_f32_32x32x16_bf16(a0, bfr, acc[0][db], 0, 0, 0);
                acc[1][db] = __builtin_amdgcn_mfma_f32_32x32x16_bf16(a1, bfr, acc[1][db], 0, 0, 0);
            }
        }
    }
    {
        const int hh = tid >> 7, d = tid & 127;
        MLS_LAS const bf16_t* kp = (MLS_LAS const bf16_t*)(lds + hh * 32768 + 16384 + (d >> 5) * 4096) + (d & 31);
        float sm = 0.f;
#pragma unroll 8
        for (int s2 = 0; s2 < 64; ++s2) sm += bf2f(kp[s2 * 32]);
        STN[(size_t)((b * 4 + hh) * 64 + c) * 128 + d] = sm;
    }
    __syncthreads();
    {
        MLS_LAS bf16_t* stg = (MLS_LAS bf16_t*)(lds + h * 32768 + half * 16384);
#pragma unroll
        for (int e2 = 0; e2 < 2; ++e2)
#pragma unroll
            for (int db = 0; db < 4; ++db)
#pragma unroll
                for (int r = 0; r < 16; ++r) stg[(32 * e2 + att::crow(r, hi)) * 128 + 32 * db + r32] = f2bf(acc[e2][db][r]);
        asm volatile("s_waitcnt lgkmcnt(0)" ::: "memory");
        bf16_t* dst = ST + ((size_t)(bh * 64 + c) * 128 + 64 * half) * 128;
#pragma unroll 4
        for (int it = 0; it < 16; ++it) {
            const int idx = it * 64 + lane;
            *(u32x4*)(dst + (size_t)idx * 8) = *(MLS_LAS const u32x4*)(stg + idx * 8);
        }
    }
    __syncthreads();
}

constexpr int LO_V = 0, LO_STG = 65536, LO_G = 131072;
__device__ void out_unit(const Params& p, int l, int b, int c, MLS_LAS unsigned char* lds) {
    unsigned char* ws = p.ws;
    const bf16_t* proj = (const bf16_t*)(ws + WS_PROJ); const float* gates = (const float*)(ws + WS_GATES);
    const bf16_t* qkc = (const bf16_t*)(ws + WS_XB);
    const bf16_t* ST = (const bf16_t*)(ws + WS_ST); const float* STN = (const float*)(ws + WS_STN); const float* STM = (const float*)(ws + WS_STM);
    const float* fb = p.in[I_FB] + l * 4; const float* ogm = p.in[I_OGM] + l * 512;
    bf16_t* Y = (bf16_t*)(ws + WS_Y);
    const int tid = my_tid(), lane = tid & 63, wave = __builtin_amdgcn_readfirstlane(tid >> 6), r32 = lane & 31, hi = lane >> 5, h = wave >> 1, th = wave & 1;
    const size_t m0 = (size_t)b * SEQ + 64 * c; const int bh = b * 4 + h;
    MLS_LAS unsigned char* vimg = lds + LO_V + h * 16384;
    MLS_LAS float* garr = (MLS_LAS float*)(lds + LO_G + wave * 512);
#pragma unroll 4
    for (int it = 0; it < 8; ++it) {
        const int s = 32 * th + 4 * it + (lane >> 4), pc = lane & 15;
        const u32x4 rv = *(const u32x4*)(proj + (m0 + s) * NPROJ + C_VB + h * 128 + pc * 8);
        *(MLS_LAS u32x4*)(vimg + (pc >> 2) * 4096 + s * 64 + (pc & 3) * 16) = rv;
    }
    {
        const float lf = log_sigmoid_f(gates[(m0 + lane) * 32 + 28 + h] + fb[h]);
        garr[lane] = incl_scan64(lf, lane);
        garr[64 + lane] = gates[(m0 + lane) * 32 + 24 + h];
    }
    const float mprev = STM[4096 + bh * 64 + c];
    const int tl = 32 * th + r32;
    bf16x8 qf[8];
#pragma unroll
    for (int ks = 0; ks < 8; ++ks) qf[ks] = __builtin_bit_cast(bf16x8, *(const u32x4*)(qkc + (m0 + tl) * 1024 + h * 128 + 16 * ks + 8 * hi));
    f32x16 p0 = (f32x16){0.f, 0.f, 0.f, 0.f, 0.f, 0.f, 0.f, 0.f, 0.f, 0.f, 0.f, 0.f, 0.f, 0.f, 0.f, 0.f}, p1 = p0;
#pragma unroll
    for (int ks = 0; ks < 8; ++ks) {
        const bf16x8 k0 = __builtin_bit_cast(bf16x8, *(const u32x4*)(qkc + (m0 + r32) * 1024 + 512 + h * 128 + 16 * ks + 8 * hi));
        const bf16x8 k1 = __builtin_bit_cast(bf16x8, *(const u32x4*)(qkc + (m0 + 32 + r32) * 1024 + 512 + h * 128 + 16 * ks + 8 * hi));
        p0 = __builtin_amdgcn_mfma_f32_32x32x16_bf16(k0, qf[ks], p0, 0, 0, 0);
        p1 = __builtin_amdgcn_mfma_f32_32x32x16_bf16(k1, qf[ks], p1, 0, 0, 0);
    }
    float qn = 0.f;
    {
        const float* np = STN + (size_t)(bh * 64 + c) * 128;
#pragma unroll
        for (int ks = 0; ks < 8; ++ks) {
            const f32x4 n0 = *(const f32x4*)(np + 16 * ks + 8 * hi), n1 = *(const f32x4*)(np + 16 * ks + 8 * hi + 4);
            float f[8]; unpack8(__builtin_bit_cast(u32x4, qf[ks]), f);
            qn += (f[0] * n0.x + f[1] * n0.y) + (f[2] * n0.z + f[3] * n0.w) + (f[4] * n1.x + f[5] * n1.y) + (f[6] * n1.z + f[7] * n1.w);
        }
        qn += __shfl_xor(qn, 32);
    }
    asm volatile("s_waitcnt lgkmcnt(0)" ::: "memory");
    const float bt = garr[tl];
    float dv0[16], dv1[16]; float mx = -INFINITY;
#pragma unroll
    for (int r = 0; r < 16; ++r) {
        const int s0 = att::crow(r, hi);
        dv0[r] = s0 <= tl ? bt - garr[s0] + garr[64 + s0] : -INFINITY;
        dv1[r] = s0 + 32 <= tl ? bt - garr[s0 + 32] + garr[64 + s0 + 32] : -INFINITY;
        mx = fmaxf(mx, fmaxf(dv0[r], dv1[r]));
    }
    mx = fmaxf(mx, __shfl_xor(mx, 32));
    const float a_t = bt + mprev;
    const float m_t = fmaxf(a_t, mx);
    float dsum = 0.f;
#pragma unroll
    for (int r = 0; r < 16; ++r) {
        p0[r] = __expf(dv0[r] - m_t) * p0[r];
        p1[r] = __expf(dv1[r] - m_t) * p1[r];
        dsum += p0[r] + p1[r];
    }
    dsum += __shfl_xor(dsum, 32);
    const float winter = __expf(a_t - m_t);
    const float den = winter * qn + dsum;
    const float scl = 1.f / fmaxf(fabsf(den), __expf(-m_t));
    const float fq = winter * scl;
    bf16x8 pa[4];
#pragma unroll
    for (int s2 = 0; s2 < 2; ++s2) {
        u32x4 w0, w1;
        w0.x = att::cvtpk(p0[8 * s2 + 0] * scl, p0[8 * s2 + 1] * scl); w0.y = att::cvtpk(p0[8 * s2 + 2] * scl, p0[8 * s2 + 3] * scl); w0.z = att::cvtpk(p0[8 * s2 + 4] * scl, p0[8 * s2 + 5] * scl); w0.w = att::cvtpk(p0[8 * s2 + 6] * scl, p0[8 * s2 + 7] * scl);
        w1.x = att::cvtpk(p1[8 * s2 + 0] * scl, p1[8 * s2 + 1] * scl); w1.y = att::cvtpk(p1[8 * s2 + 2] * scl, p1[8 * s2 + 3] * scl); w1.z = att::cvtpk(p1[8 * s2 + 4] * scl, p1[8 * s2 + 5] * scl); w1.w = att::cvtpk(p1[8 * s2 + 6] * scl, p1[8 * s2 + 7] * scl);
        pa[s2] = __builtin_bit_cast(bf16x8, w0); pa[2 + s2] = __builtin_bit_cast(bf16x8, w1);
    }
#pragma unroll
    for (int ks = 0; ks < 8; ++ks) {
        float f[8]; unpack8(__builtin_bit_cast(u32x4, qf[ks]), f);
        u32x4 w; w.x = att::cvtpk(f[0] * fq, f[1] * fq); w.y = att::cvtpk(f[2] * fq, f[3] * fq); w.z = att::cvtpk(f[4] * fq, f[5] * fq); w.w = att::cvtpk(f[6] * fq, f[7] * fq);
        qf[ks] = __builtin_bit_cast(bf16x8, w);
    }
    f32x16 acc[4];
#pragma unroll
    for (int eb = 0; eb < 4; ++eb) acc[eb] = (f32x16){0.f, 0.f, 0.f, 0.f, 0.f, 0.f, 0.f, 0.f, 0.f, 0.f, 0.f, 0.f, 0.f, 0.f, 0.f, 0.f};
    {
        const bf16_t* cp = ST + (size_t)(bh * 64 + c) * 16384 + (size_t)r32 * 128 + 8 * hi;
#pragma unroll
        for (int eb = 0; eb < 4; ++eb)
#pragma unroll
            for (int ks = 0; ks < 8; ++ks) {
                const bf16x8 cf = __builtin_bit_cast(bf16x8, *(const u32x4*)(cp + eb * 32 * 128 + 16 * ks));
                acc[eb] = __builtin_amdgcn_mfma_f32_32x32x16_bf16(qf[ks], cf, acc[eb], 0, 0, 0);
            }
    }
    __syncthreads();
    {
        const int tro = ((lane >> 4) & 1) * 32 + (lane & 3) * 8 + (4 * hi + ((lane & 15) >> 2)) * 64;
#pragma unroll
        for (int eb = 0; eb < 4; ++eb)
#pragma unroll
            for (int ks = 0; ks < 4; ++ks) acc[eb] = __builtin_amdgcn_mfma_f32_32x32x16_bf16(pa[ks], trfrag(vimg + tro + eb * 4096 + ks * 1024), acc[eb], 0, 0, 0);
    }
    {
        MLS_LAS bf16_t* stg = (MLS_LAS bf16_t*)(lds + LO_STG + wave * 8192);
        float gn[4];
#pragma unroll
        for (int eb = 0; eb < 4; ++eb) gn[eb] = ogm[h * 128 + 32 * eb + r32];
#pragma unroll
        for (int r = 0; r < 16; ++r) {
            float sq = (acc[0][r] * acc[0][r] + acc[1][r] * acc[1][r]) + (acc[2][r] * acc[2][r] + acc[3][r] * acc[3][r]);
            sq += __shfl_xor(sq, 1); sq += __shfl_xor(sq, 2); sq += __shfl_xor(sq, 4); sq += __shfl_xor(sq, 8); sq += __shfl_xor(sq, 16);
            const float rs = rsqrtf(sq * (1.f / 128.f) + EPS);
            const int q = att::crow(r, hi);
#pragma unroll
            for (int eb = 0; eb < 4; ++eb) stg[q * 128 + 32 * eb + r32] = f2bf(acc[eb][r] * rs * gn[eb]);
        }
        asm volatile("s_waitcnt lgkmcnt(0)" ::: "memory");
#pragma unroll 2
        for (int it = 0; it < 8; ++it) {
            const int idx = it * 64 + lane, row = idx >> 4, pc = idx & 15;
            const u32x4 hv = *(MLS_LAS const u32x4*)(stg + row * 128 + pc * 8);
            const u32x4 ov = *(const u32x4*)(proj + (m0 + 32 * th + row) * NPROJ + C_OB + h * 128 + pc * 8);
            float fh[8], fo[8]; unpack8(hv, fh); unpack8(ov, fo);
            float y[8];
#pragma unroll
            for (int j = 0; j < 8; ++j) y[j] = fh[j] * sigmoid_f(fo[j]);
            u32x4 o; o.x = pk2(y[0], y[1]); o.y = pk2(y[2], y[3]); o.z = pk2(y[4], y[5]); o.w = pk2(y[6], y[7]);
            *(u32x4*)(Y + (m0 + 32 * th + row) * 1024 + 512 + h * 128 + pc * 8) = o;
        }
    }
    __syncthreads();
}
}

__device__ void phase_chunkstate_mfma(const Params& p, int l, unsigned char* lds_raw) {
    for (int u = my_bid(); u < BATCH * 64; u += gridDim.x) mls::chunk_unit(p, l, u >> 6, u & 63, (MLS_LAS unsigned char*)lds_raw);
}
__device__ void phase_mlstm_out_mfma(const Params& p, int l, unsigned char* lds_raw) {
    for (int u = my_bid(); u < BATCH * 64; u += gridDim.x) mls::out_unit(p, l, u >> 6, u & 63, (MLS_LAS unsigned char*)lds_raw);
}

namespace cmpx {
typedef short bf16x8 __attribute__((ext_vector_type(8)));
typedef float f32x16 __attribute__((ext_vector_type(16)));
#define CMP_LAS __attribute__((address_space(3)))
constexpr int LC_PART = 0  , LC_HID = 32768  ;
__device__ void unit(const Params& p, int l, int b, int g, int kv, int ib, CMP_LAS unsigned char* lds) {
    unsigned char* ws = p.ws;
    const bf16_t* proj = (const bf16_t*)(ws + WS_PROJ);
    const bf16_t* w1t = (const bf16_t*)(ws + WS_CW1) + (size_t)(l * 2 + kv) * 128 * 2048;
    const bf16_t* w2t = (const bf16_t*)(ws + WS_W2T) + (size_t)(l * 2 + kv) * 64 * 128;
    const float* peb = (const float*)(ws + WS_PEB) + (l * 2 + kv) * 128;
    const float* kg0 = p.in[I_KG] + l * 192;
    const int tid = my_tid(), lane = tid & 63, wave = __builtin_amdgcn_readfirstlane(tid >> 6), r32 = lane & 31, hi = lane >> 5, hb = wave & 3, kh = wave >> 2;
    const int col = (kv ? C_VC : C_KC) + g * 64;
    const int i = 32 * ib + r32;
    const f32x16 zero16 = (f32x16){0.f, 0.f, 0.f, 0.f, 0.f, 0.f, 0.f, 0.f, 0.f, 0.f, 0.f, 0.f, 0.f, 0.f, 0.f, 0.f};
    {
        f32x16 acc = zero16;
        const bf16_t* bp = w1t + (size_t)(32 * hb + r32) * 2048 + 1024 * kh + 8 * hi;
        const int tok0 = 16 * i + 16 * kh;
#pragma unroll 8
        for (int ks = 0; ks < 64; ++ks) {
            int tok = tok0 + (ks >> 2); tok = tok < SEQ ? tok : SEQ - 1;
            const bf16x8 af = __builtin_bit_cast(bf16x8, *(const u32x4*)(proj + ((size_t)b * SEQ + tok) * NPROJ + col + 16 * (ks & 3) + 8 * hi));
            const bf16x8 bf = __builtin_bit_cast(bf16x8, *(const u32x4*)(bp + 16 * ks));
            acc = __builtin_amdgcn_mfma_f32_32x32x16_bf16(af, bf, acc, 0, 0, 0);
        }
        CMP_LAS float* part = (CMP_LAS float*)(lds + LC_PART) + kh * 32 * 128;
#pragma unroll
        for (int r = 0; r < 16; ++r) part[att::crow(r, hi) * 128 + 32 * hb + r32] = acc[r];
    }
    __syncthreads();
    {
        const CMP_LAS float* part = (const CMP_LAS float*)(lds + LC_PART);
        CMP_LAS bf16_t* hbuf = (CMP_LAS bf16_t*)(lds + LC_HID);
#pragma unroll
        for (int e = 0; e < 8; ++e) {
            const int idx = e * NT + tid, row = idx >> 7, hid = idx & 127;
            hbuf[row * 136 + hid] = f2bf(silu_f(part[idx] + part[4096 + idx] + peb[hid]));
        }
    }
    __syncthreads();
    if (wave == 0) {
        const CMP_LAS bf16_t* hbuf = (const CMP_LAS bf16_t*)(lds + LC_HID);
        f32x16 o0 = zero16, o1 = zero16;
#pragma unroll
        for (int ks = 0; ks < 8; ++ks) {
            const bf16x8 af = *(const CMP_LAS bf16x8*)(hbuf + r32 * 136 + 16 * ks + 8 * hi);
            const bf16x8 b0 = __builtin_bit_cast(bf16x8, *(const u32x4*)(w2t + (size_t)r32 * 128 + 16 * ks + 8 * hi));
            const bf16x8 b1 = __builtin_bit_cast(bf16x8, *(const u32x4*)(w2t + (size_t)(32 + r32) * 128 + 16 * ks + 8 * hi));
            o0 = __builtin_amdgcn_mfma_f32_32x32x16_bf16(af, b0, o0, 0, 0, 0);
            o1 = __builtin_amdgcn_mfma_f32_32x32x16_bf16(af, b1, o1, 0, 0, 0);
        }
        bf16_t* dst = (bf16_t*)(ws + (kv ? WS_VCMP : WS_KCMP)) + (size_t)(b * 2 + g) * NCMPP * 64;
        const float g0 = kv ? 1.f : kg0[r32], g1 = kv ? 1.f : kg0[32 + r32];
#pragma unroll
        for (int r = 0; r < 16; ++r) {
            float rs = 1.f;
            if (kv == 0) {
                float sq = o0[r] * o0[r] + o1[r] * o1[r];
                sq += __shfl_xor(sq, 1); sq += __shfl_xor(sq, 2); sq += __shfl_xor(sq, 4); sq += __shfl_xor(sq, 8); sq += __shfl_xor(sq, 16);
                rs = rsqrtf(sq * (1.f / 64.f) + EPS);
            }
            const int row = 32 * ib + att::crow(r, hi);
            const bool ok = row < NCMP;
            dst[(size_t)row * 64 + r32] = ok ? f2bf(o0[r] * rs * g0) : (bf16_t)0;
            dst[(size_t)row * 64 + 32 + r32] = ok ? f2bf(o1[r] * rs * g1) : (bf16_t)0;
        }
    }
    __syncthreads();
}
}
__device__ void phase_compress_mfma(const Params& p, int l, unsigned char* lds_raw) {
    for (int u = my_bid(); u < BATCH * 2 * 2 * 8; u += gridDim.x) cmpx::unit(p, l, u >> 5, (u >> 4) & 1, (u >> 3) & 1, u & 7, (CMP_LAS unsigned char*)lds_raw);
}

#define XB_TMO      128
#define XB_XCNT(j)  (256  + 64 * (j))
#define XB_XSUB(j)  (1280 + 64 * (j))
#define XB_XGEN(j)  (2304 + 64 * (j))
#define XB_TOP      3328
#define XB_TOPGEN   3392
#define XCD_BAR_WORDS 3456
#define XB_SPIN_CAP (1u << 18)
#define XLAS __attribute__((address_space(3)))
__device__ __forceinline__ unsigned xb_ld(unsigned* p)              { return __hip_atomic_load(p, __ATOMIC_RELAXED, __HIP_MEMORY_SCOPE_AGENT); }
__device__ __forceinline__ unsigned xb_add(unsigned* p, unsigned v) { return __hip_atomic_fetch_add(p, v, __ATOMIC_RELAXED, __HIP_MEMORY_SCOPE_AGENT); }
__device__ __forceinline__ unsigned xb_xcc_id() { return (unsigned)__builtin_amdgcn_s_getreg((3 << 11) | 20) & 0xFu; }
#define XB_SPIN(cond, bar) do { unsigned _sp = 0; while (cond) { __builtin_amdgcn_s_sleep(1); \
    if ((++_sp & 255u) == 0u) { if (xb_ld(&(bar)[XB_TMO])) break; if (_sp > XB_SPIN_CAP) { atomicAdd(&(bar)[XB_TMO], 1u); break; } } } } while (0)
struct XcdBarrier { unsigned* bar; unsigned x; volatile XLAS unsigned* st; };
__device__ __forceinline__ XcdBarrier xcd_barrier_post(unsigned* bar, volatile XLAS unsigned* st) {
    XcdBarrier b; b.bar = bar; b.x = xb_xcc_id(); b.st = st;
    if (threadIdx.x == 0) (void)xb_add(&bar[XB_XCNT(b.x)], 1u);
    return b;
}
__device__ __forceinline__ void xcd_barrier_complete(unsigned* bar, unsigned x, unsigned& nloc, unsigned& nx) {
    const unsigned G = gridDim.x * gridDim.y * gridDim.z;
    unsigned sum, cnt, mine, sp = 0u;
    for (;;) {
        sum = 0u; cnt = 0u; mine = 0u;
#pragma unroll
        for (unsigned j = 0; j < 16; ++j) { const unsigned c = xb_ld(&bar[XB_XCNT(j)]); sum += c; cnt += (c > 0u) ? 1u : 0u; mine = (j == x) ? c : mine; }
        if (sum == G) break;
        __builtin_amdgcn_s_sleep(1);
        if ((++sp & 255u) == 0u) { if (xb_ld(&bar[XB_TMO])) break; if (sp > XB_SPIN_CAP) { atomicAdd(&bar[XB_TMO], 1u); break; } }
    }
    nloc = mine > 0u ? mine : 1u; nx = cnt > 0u ? cnt : 1u;
}
__device__ __forceinline__ void xcd_barrier(const XcdBarrier& b) {
    asm volatile("s_waitcnt vmcnt(0)" ::: "memory");
    __syncthreads();
    if (threadIdx.x == 0) {
        unsigned* bar = b.bar;
        __builtin_amdgcn_s_waitcnt(0);
        unsigned nloc = b.st[0], nx = b.st[1];
        if (nloc == 0u) { xcd_barrier_complete(bar, b.x, nloc, nx); b.st[0] = nloc; b.st[1] = nx; }
        const unsigned old = xb_add(&bar[XB_XSUB(b.x)], 1u);
        const unsigned gen = old / nloc;
        if (old + 1u == (gen + 1u) * nloc) {
            __builtin_amdgcn_fence(__ATOMIC_RELEASE, "agent");
            asm volatile("s_waitcnt vmcnt(0)" ::: "memory");
            const unsigned og = xb_add(&bar[XB_TOP], 1u);
            const unsigned tg = og / nx;
            if (og + 1u == (tg + 1u) * nx) xb_add(&bar[XB_TOPGEN], 1u);
            else XB_SPIN(xb_ld(&bar[XB_TOPGEN]) == tg, bar);
            __builtin_amdgcn_fence(__ATOMIC_ACQUIRE, "agent");
            xb_add(&bar[XB_XGEN(b.x)], 1u);
            asm volatile("s_waitcnt vmcnt(0)" ::: "memory");
        } else {
            XB_SPIN(xb_ld(&bar[XB_XGEN(b.x)]) == gen, bar);
            __builtin_amdgcn_fence(__ATOMIC_ACQUIRE, "agent");
            asm volatile("s_waitcnt vmcnt(0)" ::: "memory");
        }
    }
    __syncthreads();
}

#ifndef DUP
#define DUP 0
#endif
#define REP(bit) for (int rep_ = 0; rep_ < ((DUP & (bit)) ? 2 : 1); ++rep_)
constexpr int NPHASE = 1 + 7 * DEPTH;
template <bool COOP, int PMASK>
__global__ void __launch_bounds__(NT) mega(Params p) {
    extern __shared__ __attribute__((aligned(16))) unsigned char lds_raw[];
    float* lds = (float*)lds_raw;
    unsigned char* ws = p.ws;
    volatile XLAS unsigned* bst = (volatile XLAS unsigned*)((XLAS unsigned char*)lds_raw + LDS_BYTES - 16);
    if (threadIdx.x < 4) bst[threadIdx.x] = 0u;
    __syncthreads();
    XcdBarrier gbar = xcd_barrier_post((unsigned*)(ws + WS_CTL), bst);
    for (int ph = p.lo; ph < p.hi; ++ph) {
        if (ph == 0) {
            if (PMASK & 128) phase_prologue(p, lds);
        } else {
            const int l = (ph - 1) / 7, k = (ph - 1) % 7;
            if (k == 0 && (PMASK & 1)) {
                pg8::Gemm g{(const bf16_t*)(ws + WS_XB), (const bf16_t*)(ws + WS_WIN) + (size_t)l * NPAD * DM, M, NPAD, DM};
                pg8::StaticOrder S; S.init(M, NPAD, (int)gridDim.x, (int)blockIdx.x);
                pg8::EpiInT E{(const float*)(ws + WS_SS), (const float*)(ws + WS_BIAS) + l * NPAD, (bf16_t*)(ws + WS_PROJ), (float*)(ws + WS_GATES)};
                REP(1) pg8::gemm_phase<pg8::EpiInT, pg8::StaticOrder, true, true>((PG8_LAS unsigned char*)lds_raw, g, S, E);
            } else if (k == 1 && (PMASK & 2)) {
                phase_rowpass(p, l);
                REP(2) phase_compress_mfma(p, l, lds_raw);
                REP(4) phase_chunkstate_mfma(p, l, lds_raw);
            } else if (k == 2 && (PMASK & 4)) {
                phase_scan(p);
                REP(8) phase_attn_mfma(p, l, lds_raw);
            } else if (k == 3 && (PMASK & 8)) {
                REP(16) phase_mlstm_out_mfma(p, l, lds_raw);
            } else if (k == 4 && (PMASK & 16)) {
                pg8::Gemm g{(const bf16_t*)(ws + WS_Y), (const bf16_t*)(ws + WS_WOUT) + (size_t)l * DM * DM, M, DM, DM};
                pg8::StaticOrder S; S.init(M, DM, (int)gridDim.x, (int)blockIdx.x);
                pg8::EpiResT E{l == 0 ? p.in[I_X] : p.out, p.out, (bf16_t*)(ws + WS_XB), (float*)(ws + WS_SS)};
                pg8::gemm_phase<pg8::EpiResT, pg8::StaticOrder, true, true>((PG8_LAS unsigned char*)lds_raw, g, S, E);
            } else if (k == 5 && (PMASK & 32)) {
                pg8::Gemm g{(const bf16_t*)(ws + WS_XB), (const bf16_t*)(ws + WS_WGU) + (size_t)l * NGU * DM, M, NGU, DM};
                pg8::StaticOrder S; S.init(M, NGU, (int)gridDim.x, (int)blockIdx.x);
                pg8::EpiGUT E{(const float*)(ws + WS_SS), (bf16_t*)(ws + WS_PROJ)};
                REP(32) pg8::gemm_phase<pg8::EpiGUT, pg8::StaticOrder, true, true>((PG8_LAS unsigned char*)lds_raw, g, S, E);
            } else if (k == 6 && (PMASK & 64)) {
                pg8::Gemm g{(const bf16_t*)(ws + WS_PROJ), (const bf16_t*)(ws + WS_WD) + (size_t)l * DM * FF, M, DM, FF};
                pg8::StaticOrder S; S.init(M, DM, (int)gridDim.x, (int)blockIdx.x);
                pg8::EpiResT E{p.out, p.out, (bf16_t*)(ws + WS_XB), (float*)(ws + WS_SS)};
                pg8::gemm_phase<pg8::EpiResT, pg8::StaticOrder, true, true>((PG8_LAS unsigned char*)lds_raw, g, S, E);
            }
        }
        if (COOP && ph + 1 < p.hi) {
            if (ph == 0) cg::this_grid().sync();
            else xcd_barrier(gbar);
        }
    }
}

extern "C" void kernel_launch(void* const* d_in, const int* in_sizes, int n_in, void* d_out, int out_size, void* d_ws, size_t ws_size, hipStream_t stream) {
    static int grid = 0;
    if (grid == 0) {
        if (n_in != 18 || ws_size < WS_END) { fprintf(stderr, "kernel_launch: unexpected n_in %d / ws_size %zu\n", n_in, ws_size); grid = -1; return; }
        int dev = 0, cus = 0, per_cu = 0;
        (void)hipGetDevice(&dev);
        (void)hipDeviceGetAttribute(&cus, hipDeviceAttributeMultiprocessorCount, dev);
        (void)hipFuncSetAttribute((const void*)mega<true, 0xff>, hipFuncAttributeMaxDynamicSharedMemorySize, LDS_BYTES);
        (void)hipOccupancyMaxActiveBlocksPerMultiprocessor(&per_cu, (const void*)mega<true, 0xff>, NT, LDS_BYTES);
        if (per_cu < 1) { fprintf(stderr, "kernel_launch: occupancy query reports %d blocks/CU\n", per_cu); grid = -1; return; }
        grid = (cus > 0 ? cus : 256) * 1;
        (void)hipGetLastError();
    }
    if (grid < 0) return;
    Params p{};
    for (int i = 0; i < 18; ++i) p.in[i] = (const float*)d_in[i];
    p.out = (float*)d_out; p.ws = (unsigned char*)d_ws;
    p.lo = 0; p.hi = NPHASE;
    (void)hipMemsetAsync((unsigned char*)d_ws + WS_CTL, 0, 16384, stream);
    void* args[] = {&p};
    hipError_t e = hipLaunchCooperativeKernel((const void*)mega<true, 0xff>, dim3(grid), dim3(NT), args, LDS_BYTES, stream);
    if (e != hipSuccess) fprintf(stderr, "cooperative launch failed: %s (grid %d)\n", hipGetErrorString(e), grid);
}
```

```cpp
#include <hip/hip_runtime.h>
#include <hip/hip_cooperative_groups.h>
#include <cstdint>
#include <cstdio>
namespace cg = cooperative_groups;

typedef unsigned short bf16_t;
typedef unsigned u32x4 __attribute__((ext_vector_type(4)));
typedef unsigned u32x2 __attribute__((ext_vector_type(2)));
typedef float f32x4 __attribute__((ext_vector_type(4)));

constexpr int BATCH = 8, SEQ = 4096, DM = 1024, M = BATCH * SEQ, DEPTH = 2;
constexpr int NIN = 3360, NPROJ = 3328, NPAD = 3584, FF = 2816, NGU = 2 * FF;
constexpr int NCMP = 255, NCMPP = 256;
constexpr float EPS = 1e-6f;
constexpr int NT = 512;
constexpr int LDS_BYTES = 152 * 1024;

constexpr int C_QA = 0, C_KC = 512, C_VC = 640, C_KS = 768, C_VS = 896, C_KW = 1024, C_VW = 1152, C_QB = 1280, C_KB = 1792, C_VB = 2304, C_OB = 2816;

constexpr size_t MiB = 1u << 20;
constexpr size_t WS_CTL = 0;
constexpr size_t WS_WIN = 1 * MiB;
constexpr size_t WS_WOUT = 15 * MiB;
constexpr size_t WS_WGU = 19 * MiB;
constexpr size_t WS_WD = 41 * MiB;
constexpr size_t WS_BIAS = 52 * MiB;
constexpr size_t WS_SS = 53 * MiB;
constexpr size_t WS_GATES = 55 * MiB;
constexpr size_t WS_KCMP = 59 * MiB;
constexpr size_t WS_VCMP = 59 * MiB + 512 * 1024;
constexpr size_t WS_STN = 60 * MiB;
constexpr size_t WS_STM = 61 * MiB;
constexpr size_t WS_W2T = 61 * MiB + 256 * 1024;
constexpr size_t WS_PEB = 61 * MiB + 512 * 1024;
constexpr size_t WS_CW1 = 62 * MiB;
constexpr size_t WS_XB = 64 * MiB;
constexpr size_t WS_Y = 128 * MiB;
constexpr size_t WS_ST = 192 * MiB;
constexpr size_t WS_PROJ = 256 * MiB;
constexpr size_t WS_END = 464 * MiB;

struct Params {
    const float* in[18];
    float* out;
    unsigned char* ws;
    int lo, hi;
};
enum { I_X = 0, I_LN1, I_WIN, I_BIN, I_QG, I_KG, I_PE, I_W1, I_W2, I_CW, I_CB, I_FB, I_OGA, I_OGM, I_WOUT, I_LN2, I_WGU, I_WD };

__device__ __forceinline__ float bf2f(bf16_t v) { return __uint_as_float(((unsigned)v) << 16); }
__device__ __forceinline__ bf16_t f2bf(float f) { unsigned u = __float_as_uint(f); return (bf16_t)((u + 0x7fffu + ((u >> 16) & 1u)) >> 16); }
__device__ __forceinline__ unsigned pk2(float lo, float hi) { return (unsigned)f2bf(lo) | ((unsigned)f2bf(hi) << 16); }
__device__ __forceinline__ float lo16(unsigned w) { return __uint_as_float(w << 16); }
__device__ __forceinline__ float hi16(unsigned w) { return __uint_as_float(w & 0xffff0000u); }
__device__ __forceinline__ float silu_f(float x) { return x / (1.f + __expf(-x)); }
__device__ __forceinline__ float sigmoid_f(float x) { return 1.f / (1.f + __expf(-x)); }
__device__ __forceinline__ float wave_sum(float v) {
#pragma unroll
    for (int o = 1; o < 64; o <<= 1) v += __shfl_xor(v, o);
    return v;
}
__device__ __forceinline__ float wave_max(float v) {
#pragma unroll
    for (int o = 1; o < 64; o <<= 1) v = fmaxf(v, __shfl_xor(v, o));
    return v;
}
__device__ __forceinline__ int my_tid() { int t = threadIdx.x; asm volatile("" : "+v"(t)); return t; }
__device__ __forceinline__ int my_bid() { int b = blockIdx.x; asm volatile("" : "+s"(b)); return b; }
__device__ __forceinline__ void unpack8(u32x4 w, float* f) {
    f[0] = lo16(w.x); f[1] = hi16(w.x); f[2] = lo16(w.y); f[3] = hi16(w.y);
    f[4] = lo16(w.z); f[5] = hi16(w.z); f[6] = lo16(w.w); f[7] = hi16(w.w);
}

__device__ __forceinline__ int in_srccol(int n) {
    if (n < 1280) return n;
    if (n < 2816) return n + 24;
    if (n < 3328) return n + 32;
    if (n < 3352) return n - 3328 + 1280;
    if (n < 3360) return n - 3352 + 2840;
    return -1;
}
__device__ __forceinline__ int gu_srccol(int n) {
    const int t = n >> 8, w = n & 255;
    return (w < 128) ? (t * 128 + w) : (FF + t * 128 + (w - 128));
}

struct ConvJob { const float* W; bf16_t* WT; const float* kscale; int K, Nsrc, mode; };
__device__ __forceinline__ bool conv_locate(const Params& p, int ti, ConvJob& J, int& local) {
    constexpr int T_IN = 16 * 56, T_OUT = 16 * 16, T_GU = 16 * 88, T_D = 44 * 16, T_L = T_IN + T_OUT + T_GU + T_D, T_W1 = 32 * 2, T_W2 = 2, T_S = T_W1 + T_W2;
    unsigned char* ws = p.ws;
    if (ti < DEPTH * T_L) {
        const int l = ti / T_L; int r = ti % T_L;
        if (r < T_IN) { J = ConvJob{p.in[I_WIN] + (size_t)l * DM * NIN, (bf16_t*)(ws + WS_WIN) + (size_t)l * NPAD * DM, p.in[I_LN1] + l * DM, DM, NIN, 1}; local = r; return true; }
        r -= T_IN;
        if (r < T_OUT) { J = ConvJob{p.in[I_WOUT] + (size_t)l * DM * DM, (bf16_t*)(ws + WS_WOUT) + (size_t)l * DM * DM, nullptr, DM, DM, 0}; local = r; return true; }
        r -= T_OUT;
        if (r < T_GU) { J = ConvJob{p.in[I_WGU] + (size_t)l * DM * NGU, (bf16_t*)(ws + WS_WGU) + (size_t)l * NGU * DM, p.in[I_LN2] + l * DM, DM, NGU, 2}; local = r; return true; }
        r -= T_GU;
        J = ConvJob{p.in[I_WD] + (size_t)l * FF * DM, (bf16_t*)(ws + WS_WD) + (size_t)l * DM * FF, nullptr, FF, DM, 0}; local = r; return true;
    }
    int r = ti - DEPTH * T_L;
    if (r >= DEPTH * 2 * T_S) return false;
    const int lk = r / T_S; r = r % T_S;
    if (r < T_W1) { J = ConvJob{p.in[I_W1] + (size_t)lk * 2048 * 128, (bf16_t*)(ws + WS_CW1) + (size_t)lk * 128 * 2048, nullptr, 2048, 128, 0}; local = r; return true; }
    J = ConvJob{p.in[I_W2] + (size_t)lk * 128 * 64, (bf16_t*)(ws + WS_W2T) + (size_t)lk * 64 * 128, nullptr, 128, 64, 0}; local = r - T_W1; return true;
}
__device__ void phase_prologue(const Params& p, float* lds) {
    unsigned char* ws = p.ws;
    const int tid = my_tid(), lane = tid & 63, wave = tid >> 6;
    constexpr int T_ALL = DEPTH * (16 * 56 + 16 * 16 + 16 * 88 + 44 * 16) + DEPTH * 2 * (64 + 2);
    for (int G = my_bid(); G < (T_ALL + 3) / 4; G += gridDim.x) {
#pragma unroll
        for (int t = 0; t < 4; ++t) {
            ConvJob J; int local;
            if (conv_locate(p, 4 * G + t, J, local)) {
                const int nk = J.K / 64, k0 = (local % nk) * 64, n0 = (local / nk) * 64;
                float* tile = lds + t * (64 * 65);
#pragma unroll
                for (int i = 0; i < 8; ++i) {
                    const int r = (tid >> 6) + 8 * i, c = tid & 63, n = n0 + c;
                    const int sc = J.mode == 0 ? n : (J.mode == 1 ? in_srccol(n) : gu_srccol(n));
                    float v = 0.f;
                    if (sc >= 0) v = J.W[(size_t)(k0 + r) * J.Nsrc + sc] * (J.kscale ? J.kscale[k0 + r] : 1.f);
                    tile[r * 65 + c] = v;
                }
            }
        }
        __syncthreads();
#pragma unroll
        for (int t = 0; t < 4; ++t) {
            ConvJob J; int local;
            if (conv_locate(p, 4 * G + t, J, local)) {
                const int nk = J.K / 64, k0 = (local % nk) * 64, n0 = (local / nk) * 64;
                const float* tile = lds + t * (64 * 65);
#pragma unroll
                for (int i = 0; i < 8; ++i) {
                    const int r = (tid >> 6) + 8 * i, c = tid & 63;
                    J.WT[(size_t)(n0 + r) * J.K + k0 + c] = f2bf(tile[c * 65 + r]);
                }
            }
        }
        __syncthreads();
    }
    {
        float* peb = (float*)(ws + WS_PEB);
        for (int o = my_bid() * 8 + wave; o < DEPTH * 2 * 128; o += gridDim.x * 8) {
            const int lk = o >> 7, hid = o & 127;
            const float* w1 = p.in[I_W1] + (size_t)lk * 2048 * 128 + hid; const float* pe = p.in[I_PE] + (size_t)lk * 2048;
            float sacc = 0.f;
#pragma unroll 8
            for (int f = lane; f < 2048; f += 64) sacc += w1[(size_t)f * 128] * pe[f];
            sacc = wave_sum(sacc);
            if (lane == 0) peb[o] = sacc;
        }
    }
    float* biasP = (float*)(ws + WS_BIAS);
    for (int i = my_bid() * NT + tid; i < DEPTH * NPAD; i += gridDim.x * NT) {
        const int l = i / NPAD, n = i % NPAD; const int sc = in_srccol(n);
        biasP[i] = sc >= 0 ? p.in[I_BIN][l * NIN + sc] : 0.f;
    }
    const float* x = p.in[I_X]; bf16_t* xb = (bf16_t*)(ws + WS_XB); float* ss = (float*)(ws + WS_SS);
    for (int m = (my_bid() * 8 + wave) * 2; m < M; m += gridDim.x * 16) {
        f32x4 v[2][4];
#pragma unroll
        for (int rr = 0; rr < 2; ++rr)
#pragma unroll
            for (int j = 0; j < 4; ++j) v[rr][j] = ((const f32x4*)(x + (size_t)(m + rr) * DM) + lane)[64 * j];
#pragma unroll
        for (int rr = 0; rr < 2; ++rr)
#pragma unroll
            for (int j = 0; j < 4; ++j) {
                const f32x4 q = v[rr][j];
                float sq = (q.x * q.x + q.y * q.y) + (q.z * q.z + q.w * q.w);
                sq += __shfl_xor(sq, 1); sq += __shfl_xor(sq, 2); sq += __shfl_xor(sq, 4); sq += __shfl_xor(sq, 8);
                if ((lane & 15) == 0) ss[(size_t)(m + rr) * 16 + 4 * j + (lane >> 4)] = sq;
                u32x2 o; o.x = pk2(q.x, q.y); o.y = pk2(q.z, q.w);
                *(u32x2*)(xb + (size_t)(m + rr) * DM + 256 * j + 4 * lane) = o;
            }
    }
}

namespace pg8 {
#define PG8_LAS __attribute__((address_space(3)))
typedef short bf16x8 __attribute__((ext_vector_type(8)));
constexpr int BM = 256, BK = 64, HALF = 128, HTB = HALF * BK * 2  , STAGE_BYTES = 8 * HTB, NXCD = 8, WGM = 8;
__host__ __device__ __forceinline__ int lds_byte(int r, int c) { const int st = (r >> 4) * 2 + (c >> 5), rr = r & 15, cc = c & 31, ob = rr * 64 + cc * 2; return st * 1024 + (ob ^ (((ob >> 9) & 1) << 5)); }
__host__ __device__ __forceinline__ void stage_rc(int b, int& R, int& C) { const int st = b / 1024, sb = b % 1024, swz = sb ^ (((sb >> 9) & 1) << 5); R = (st >> 1) * 16 + swz / 64; C = (st & 1) * 32 + (swz % 64) / 2; }
__host__ __device__ __forceinline__ int perm32(int rho) { const int n = rho >> 4, i = rho & 15; return 8 * (i >> 2) + 4 * n + (i & 3); }
struct Unit { int pm, pn; };
struct Gemm { const bf16_t* A; const bf16_t* Bt; int M, N, K; };
struct StaticOrder {
    int nM, nN, nwg, G, c;
    __host__ __device__ void init(int M_, int N_, int G_, int c_) { nM = M_ / BM; nN = N_ / BM; nwg = nM * nN; G = G_; c = c_; }
    __host__ __device__ bool next(int i, Unit& u) const {
        const long L = (long)i * G + c; if (L >= nwg) return false;
        int wgid = (int)L; { const int q = nwg / NXCD, r = nwg % NXCD, xcd = wgid % NXCD, off = wgid / NXCD; wgid = (xcd < r ? xcd * (q + 1) : r * (q + 1) + (xcd - r) * q) + off; }
        const int nig = WGM * nN, gid = wgid / nig, fm = gid * WGM, gsz = (nM - fm) < WGM ? (nM - fm) : WGM;
        u.pm = fm + ((wgid % nig) % gsz); u.pn = (wgid % nig) / gsz; return true;
    }
    __device__ __forceinline__ void a_ready(const Unit&) const {}
    __device__ __forceinline__ void done(const Unit&) const {}
};
__device__ __forceinline__ unsigned cvt_pk_bf16(float lo, float hi) { unsigned r; asm volatile("v_cvt_pk_bf16_f32 %0, %1, %2" : "=v"(r) : "v"(lo), "v"(hi)); return r; }

__device__ __forceinline__ float row_rstd(const float* ss, int row, int fq) {
    const f32x4 pq = *(const f32x4*)(ss + (size_t)row * 16 + 4 * fq);
    float s = (pq.x + pq.y) + (pq.z + pq.w);
    s += __shfl_xor(s, 16); s += __shfl_xor(s, 32);
    return rsqrtf(s * (1.f / DM) + EPS);
}
struct EpiInT {
    static constexpr bool PERM = true, AFTER_DRAIN = false;
    const float* ss; const float* bias; bf16_t* proj; float* gates;
    __device__ __forceinline__ void operator()(const f32x4 (&acc)[2][2][4][2], const Unit& u, int wr, int wc, int fr, int fq) const {
        const int row0 = u.pm * BM + wr * 64 + fr, col0 = u.pn * BM + wc * 32 + 8 * fq;
        f32x4 bv[2][2];
#pragma unroll
        for (int bj = 0; bj < 2; ++bj)
#pragma unroll
            for (int n = 0; n < 2; ++n) bv[bj][n] = *(const f32x4*)(bias + col0 + bj * HALF + 4 * n);
#pragma unroll
        for (int ai = 0; ai < 2; ++ai)
#pragma unroll
            for (int m = 0; m < 4; ++m) {
                const int row = row0 + ai * HALF + m * 16;
                const float r = row_rstd(ss, row, fq);
                if (u.pn < 13) {
                    bf16_t* rowp = proj + (size_t)row * NPROJ + col0;
#pragma unroll
                    for (int bj = 0; bj < 2; ++bj) {
                        const f32x4 v0 = acc[ai][bj][m][0] * r + bv[bj][0], v1 = acc[ai][bj][m][1] * r + bv[bj][1];
                        u32x4 w; w.x = cvt_pk_bf16(v0[0], v0[1]); w.y = cvt_pk_bf16(v0[2], v0[3]); w.z = cvt_pk_bf16(v1[0], v1[1]); w.w = cvt_pk_bf16(v1[2], v1[3]);
                        *(u32x4*)(rowp + bj * HALF) = w;
                    }
                } else if (wc == 0) {
                    const f32x4 v0 = acc[ai][0][m][0] * r + bv[0][0], v1 = acc[ai][0][m][1] * r + bv[0][1];
                    float* gp = gates + (size_t)row * 32 + 8 * fq;
                    *(f32x4*)gp = v0; *(f32x4*)(gp + 4) = v1;
                }
            }
    }
};
struct EpiResT {
    static constexpr bool PERM = true, AFTER_DRAIN = false;
    const float* base; float* out; bf16_t* xb; float* ss;
    __device__ __forceinline__ void operator()(const f32x4 (&acc)[2][2][4][2], const Unit& u, int wr, int wc, int fr, int fq) const {
        const int row0 = u.pm * BM + wr * 64 + fr, col0 = u.pn * BM + wc * 32 + 8 * fq;
#pragma unroll
        for (int ai = 0; ai < 2; ++ai)
#pragma unroll
            for (int m = 0; m < 4; ++m) {
                const int row = row0 + ai * HALF + m * 16;
                const size_t off = (size_t)row * DM + col0;
                float sq = 0.f;
#pragma unroll
                for (int bj = 0; bj < 2; ++bj) {
                    const f32x4 x0 = *(const f32x4*)(base + off + bj * HALF) + acc[ai][bj][m][0];
                    const f32x4 x1 = *(const f32x4*)(base + off + bj * HALF + 4) + acc[ai][bj][m][1];
                    *(f32x4*)(out + off + bj * HALF) = x0; *(f32x4*)(out + off + bj * HALF + 4) = x1;
                    u32x4 w; w.x = cvt_pk_bf16(x0[0], x0[1]); w.y = cvt_pk_bf16(x0[2], x0[3]); w.z = cvt_pk_bf16(x1[0], x1[1]); w.w = cvt_pk_bf16(x1[2], x1[3]);
                    *(u32x4*)(xb + off + bj * HALF) = w;
                    sq += (x0[0] * x0[0] + x0[1] * x0[1]) + (x0[2] * x0[2] + x0[3] * x0[3]) + (x1[0] * x1[0] + x1[1] * x1[1]) + (x1[2] * x1[2] + x1[3] * x1[3]);
                }
                sq += __shfl_xor(sq, 16); sq += __shfl_xor(sq, 32);
                if (fq == 0) ss[(size_t)row * 16 + u.pn * 4 + wc] = sq;
                asm volatile("" ::: "memory");
            }
    }
};
struct EpiGUT {
    static constexpr bool PERM = true, AFTER_DRAIN = false;
    const float* ss; bf16_t* act;
    __device__ __forceinline__ void operator()(const f32x4 (&acc)[2][2][4][2], const Unit& u, int wr, int wc, int fr, int fq) const {
        const int row0 = u.pm * BM + wr * 64 + fr, hid0 = u.pn * HALF + wc * 32 + 8 * fq;
#pragma unroll
        for (int ai = 0; ai < 2; ++ai)
#pragma unroll
            for (int m = 0; m < 4; ++m) {
                const int row = row0 + ai * HALF + m * 16;
                const float r = row_rstd(ss, row, fq);
                float a[8];
#pragma unroll
                for (int n = 0; n < 2; ++n)
#pragma unroll
                    for (int j = 0; j < 4; ++j) {
                        const float g = acc[ai][0][m][n][j] * r, up = acc[ai][1][m][n][j] * r;
                        a[4 * n + j] = g * __builtin_amdgcn_rcpf(1.f + __builtin_amdgcn_exp2f(-1.4426950408889634f * g)) * up;
                    }
                u32x4 w; w.x = cvt_pk_bf16(a[0], a[1]); w.y = cvt_pk_bf16(a[2], a[3]); w.z = cvt_pk_bf16(a[4], a[5]); w.w = cvt_pk_bf16(a[6], a[7]);
                *(u32x4*)(act + (size_t)row * FF + hid0) = w;
            }
    }
};

template <class Epi, class Sched, bool ALIGN_EPI = false, bool SP2 = false>
__device__ __forceinline__ void gemm_phase(PG8_LAS unsigned char* lds, const Gemm g, const Sched& S, const Epi& E) {
    const int tid = my_tid(), wid = __builtin_amdgcn_readfirstlane(tid >> 6), lane = tid & 63, wr = wid >> 2, wc = wid & 3, fr = lane & 15, fq = lane >> 4;
    const int K = g.K, nt = K / BK;
    unsigned voffA[2], voffB[2];
#pragma unroll
    for (int i = 0; i < 2; ++i) { int R, C; stage_rc(tid * 16 + i * 8192, R, C); const int Rb = Epi::PERM ? ((R & ~31) + perm32(R & 31)) : R;
        voffA[i] = (unsigned)(R * K + C) * 2u; voffB[i] = (unsigned)(Rb * K + C) * 2u; }
    const size_t kstep = (size_t)(BK * 2);
    const size_t hstep = (size_t)HALF * K * 2;
    const size_t tstep = 2 * hstep;
    const unsigned ldsw = (unsigned)wid * 1024u;
    const int aoff = lds_byte(wr * 64 + fr, fq * 8), boff = lds_byte(wc * 32 + fr, fq * 8);
#define PG8_SA(b, h) (((b) * 2 + (h)) * HTB)
#define PG8_SB(b, h) ((4 + (b) * 2 + (h)) * HTB)
#define PG8_STAGE(bufoff, gbase, voff) do { _Pragma("unroll") for (int _i = 0; _i < 2; ++_i) \
        __builtin_amdgcn_global_load_lds((const unsigned*)((const char*)(gbase) + (voff)[_i]), (PG8_LAS unsigned*)(lds + (bufoff) + ldsw + _i * 8192), 16, 0, 0); } while (0)
#define PG8_LDA(dst, b, h) do { _Pragma("unroll") for (int m = 0; m < 4; ++m) _Pragma("unroll") for (int k = 0; k < 2; ++k) dst[m][k] = *(const PG8_LAS bf16x8*)(lds + PG8_SA(b, h) + aoff + m * 2048 + k * 1024); } while (0)
#define PG8_LDB(dst, b, h) do { _Pragma("unroll") for (int n = 0; n < 2; ++n) _Pragma("unroll") for (int k = 0; k < 2; ++k) dst[n][k] = *(const PG8_LAS bf16x8*)(lds + PG8_SB(b, h) + boff + n * 2048 + k * 1024); } while (0)
#define PG8_MMA(ai, bj, At, Bt) do { __builtin_amdgcn_s_setprio(1); _Pragma("unroll") for (int m = 0; m < 4; ++m) _Pragma("unroll") for (int n = 0; n < 2; ++n) _Pragma("unroll") for (int k = 0; k < 2; ++k) \
        acc[ai][bj][m][n] = __builtin_amdgcn_mfma_f32_16x16x32_bf16(Bt[n][k], At[m][k], acc[ai][bj][m][n], 0, 0, 0); __builtin_amdgcn_s_setprio(0); } while (0)
#define PG8_WAIT_V(n) asm volatile("s_waitcnt vmcnt(" #n ")" ::: "memory")
#define PG8_WAIT_L(n) asm volatile("s_waitcnt lgkmcnt(" #n ")" ::: "memory")
#define PG8_BAR __builtin_amdgcn_s_barrier()
#define PG8_SCHED __builtin_amdgcn_sched_barrier(0)
    Unit cur, nxt; int ui = 0;
    if (!S.next(0, cur)) return;
    f32x4 acc[2][2][4][2];
#pragma unroll
    for (int a = 0; a < 2; ++a)
#pragma unroll
        for (int b = 0; b < 2; ++b)
#pragma unroll
            for (int m = 0; m < 4; ++m)
#pragma unroll
                for (int n = 0; n < 2; ++n) acc[a][b][m][n] = (f32x4){0.f, 0.f, 0.f, 0.f};
    bf16x8 At[4][2], B0[2][2], B1[2][2];
    const char* cA = (const char*)g.A + (size_t)cur.pm * tstep; const char* cB = (const char*)g.Bt + (size_t)cur.pn * tstep;
    S.a_ready(cur);
    if constexpr (SP2) {
        PG8_STAGE(PG8_SB(0, 0), cB, voffB); PG8_STAGE(PG8_SB(0, 1), cB + hstep, voffB); PG8_STAGE(PG8_SA(0, 0), cA, voffA); PG8_STAGE(PG8_SA(0, 1), cA + hstep, voffA);
        if (wr == 1) PG8_BAR;
        PG8_WAIT_V(2); PG8_BAR;
        PG8_STAGE(PG8_SB(1, 0), cB + kstep, voffB); PG8_STAGE(PG8_SA(1, 0), cA + kstep, voffA); PG8_STAGE(PG8_SB(1, 1), cB + hstep + kstep, voffB);
        PG8_WAIT_V(6); PG8_BAR;
    } else {
        PG8_STAGE(PG8_SB(0, 0), cB, voffB); PG8_STAGE(PG8_SA(0, 0), cA, voffA); PG8_STAGE(PG8_SB(0, 1), cB + hstep, voffB); PG8_STAGE(PG8_SA(0, 1), cA + hstep, voffA);
        if (wr == 1) PG8_BAR;
        PG8_WAIT_V(4); PG8_BAR;
        PG8_STAGE(PG8_SB(1, 0), cB + kstep, voffB); PG8_STAGE(PG8_SA(1, 0), cA + kstep, voffA); PG8_STAGE(PG8_SB(1, 1), cB + hstep + kstep, voffB);
        PG8_WAIT_V(6); PG8_BAR;
    }
    for (;;) {
        const bool has_next = S.next(ui + 1, nxt);
        const char* nA = has_next ? (const char*)g.A + (size_t)nxt.pm * tstep : cA; const char* nB = has_next ? (const char*)g.Bt + (size_t)nxt.pn * tstep : cB;
        for (int t = 0; t < nt; t += 2) {
            const bool last = (t == nt - 2);
            const char* a1 = cA + (size_t)(t + 1) * kstep;
            const char* a2 = last ? nA : cA + (size_t)(t + 2) * kstep; const char* b2 = last ? nB : cB + (size_t)(t + 2) * kstep;
            const char* a3 = a2 + kstep; const char* b3 = b2 + kstep;
            if (last && has_next) S.a_ready(nxt);
            if constexpr (SP2) {
            PG8_LDB(B0, 0, 0); PG8_LDB(B1, 0, 1); PG8_SCHED; PG8_LDA(At, 0, 0); PG8_STAGE(PG8_SA(1, 1), a1 + hstep, voffA);
            PG8_WAIT_V(8); PG8_WAIT_L(0); PG8_BAR; PG8_MMA(0, 0, At, B0); PG8_MMA(0, 1, At, B1); PG8_BAR; PG8_SCHED;
            PG8_LDA(At, 0, 1); PG8_STAGE(PG8_SB(0, 0), b2, voffB); PG8_STAGE(PG8_SB(0, 1), b2 + hstep, voffB); PG8_STAGE(PG8_SA(0, 0), a2, voffA);
            PG8_WAIT_V(8); PG8_WAIT_L(0); PG8_BAR; PG8_MMA(1, 0, At, B0); PG8_MMA(1, 1, At, B1); PG8_BAR; PG8_SCHED;
            PG8_LDB(B0, 1, 0); PG8_LDB(B1, 1, 1); PG8_SCHED; PG8_LDA(At, 1, 0); PG8_STAGE(PG8_SA(0, 1), a2 + hstep, voffA);
            PG8_WAIT_V(8); PG8_WAIT_L(0); PG8_BAR; PG8_MMA(0, 0, At, B0); PG8_MMA(0, 1, At, B1); PG8_BAR; PG8_SCHED;
            PG8_LDA(At, 1, 1); PG8_STAGE(PG8_SB(1, 0), b3, voffB); PG8_STAGE(PG8_SB(1, 1), b3 + hstep, voffB); PG8_STAGE(PG8_SA(1, 0), a3, voffA);
            PG8_WAIT_V(8); PG8_WAIT_L(0); PG8_BAR; PG8_MMA(1, 0, At, B0); PG8_MMA(1, 1, At, B1); PG8_BAR; PG8_SCHED;
            } else {
            PG8_LDB(B0, 0, 0); PG8_SCHED; PG8_LDA(At, 0, 0); PG8_STAGE(PG8_SA(1, 1), a1 + hstep, voffA);
            PG8_WAIT_L(8); PG8_BAR; PG8_WAIT_L(0); PG8_MMA(0, 0, At, B0); PG8_BAR; PG8_SCHED;
            PG8_LDB(B1, 0, 1); PG8_STAGE(PG8_SB(0, 0), b2, voffB);
            PG8_BAR; PG8_WAIT_L(0); PG8_MMA(0, 1, At, B1); PG8_BAR;
            PG8_LDA(At, 0, 1); PG8_STAGE(PG8_SA(0, 0), a2, voffA);
            PG8_BAR; PG8_WAIT_L(0); PG8_MMA(1, 0, At, B0); PG8_BAR; PG8_SCHED;
            PG8_STAGE(PG8_SB(0, 1), b2 + hstep, voffB);
            PG8_WAIT_V(6); PG8_BAR; PG8_MMA(1, 1, At, B1); PG8_BAR;
            PG8_LDB(B0, 1, 0); PG8_SCHED; PG8_LDA(At, 1, 0); PG8_STAGE(PG8_SA(0, 1), a2 + hstep, voffA);
            PG8_WAIT_L(8); PG8_BAR; PG8_WAIT_L(0); PG8_MMA(0, 0, At, B0); PG8_BAR; PG8_SCHED;
            PG8_LDB(B1, 1, 1); PG8_STAGE(PG8_SB(1, 0), b3, voffB);
            PG8_BAR; PG8_WAIT_L(0); PG8_MMA(0, 1, At, B1); PG8_BAR;
            PG8_LDA(At, 1, 1); PG8_STAGE(PG8_SA(1, 0), a3, voffA);
            PG8_BAR; PG8_WAIT_L(0); PG8_MMA(1, 0, At, B0); PG8_BAR; PG8_SCHED;
            PG8_STAGE(PG8_SB(1, 1), b3 + hstep, voffB);
            PG8_WAIT_V(6); PG8_BAR; PG8_MMA(1, 1, At, B1); PG8_BAR;
            }
        }
        if constexpr (ALIGN_EPI) { if (wr == 0) PG8_BAR; }
        if constexpr (!Epi::AFTER_DRAIN) { E(acc, cur, wr, wc, fr, fq); S.done(cur); }
        if (!has_next) break;
#pragma unroll
        for (int a = 0; a < 2; ++a)
#pragma unroll
            for (int b = 0; b < 2; ++b)
#pragma unroll
                for (int m = 0; m < 4; ++m)
#pragma unroll
                    for (int n = 0; n < 2; ++n) acc[a][b][m][n] = (f32x4){0.f, 0.f, 0.f, 0.f};
        cur = nxt; cA = nA; cB = nB; ++ui;
        if constexpr (ALIGN_EPI) { if (wr == 1) PG8_BAR; }
    }
    PG8_WAIT_V(0);
    if constexpr (!ALIGN_EPI) { if (wr == 0) PG8_BAR; }
    PG8_BAR;
#undef PG8_SA
#undef PG8_SB
#undef PG8_STAGE
#undef PG8_LDA
#undef PG8_LDB
#undef PG8_MMA
#undef PG8_WAIT_V
#undef PG8_WAIT_L
#undef PG8_BAR
#undef PG8_SCHED
}
}

__device__ void phase_rowpass(const Params& p, int l) {
    unsigned char* ws = p.ws;
    bf16_t* proj = (bf16_t*)(ws + WS_PROJ); bf16_t* qkc = (bf16_t*)(ws + WS_XB);
    const float* qg = p.in[I_QG] + l * 64; const float* kg = p.in[I_KG] + l * 192;
    const float* cw = p.in[I_CW] + l * 4096; const float* cb = p.in[I_CB] + l * 1024;
    const int tid = my_tid(), lane = tid & 63, wave = tid >> 6;
    for (int m = my_bid() * 8 + wave; m < M; m += gridDim.x * 8) {
        const int t = m % SEQ;
        bf16_t* row = proj + (size_t)m * NPROJ;
        {
            const u32x4 raw = *(const u32x4*)(row + C_QA + lane * 8); float f[8]; unpack8(raw, f);
            float s = 0.f;
#pragma unroll
            for (int j = 0; j < 8; ++j) s += f[j] * f[j];
            s += __shfl_xor(s, 1); s += __shfl_xor(s, 2); s += __shfl_xor(s, 4);
            const float r = rsqrtf(s * (1.f / 64.f) + EPS);
            const int d0 = (lane & 7) * 8;
            u32x4 o; o.x = pk2(f[0] * r * qg[d0], f[1] * r * qg[d0 + 1]); o.y = pk2(f[2] * r * qg[d0 + 2], f[3] * r * qg[d0 + 3]);
            o.z = pk2(f[4] * r * qg[d0 + 4], f[5] * r * qg[d0 + 5]); o.w = pk2(f[6] * r * qg[d0 + 6], f[7] * r * qg[d0 + 7]);
            *(u32x4*)(row + C_QA + lane * 8) = o;
        }
        {
            const int which = lane >> 5, w4 = (lane & 31) * 4;
            bf16_t* pp = row + (which ? C_KW : C_KS) + w4;
            const u32x2 raw = *(const u32x2*)pp;
            float f[4] = {lo16(raw.x), hi16(raw.x), lo16(raw.y), hi16(raw.y)};
            float s = (f[0] * f[0] + f[1] * f[1]) + (f[2] * f[2] + f[3] * f[3]);
            s += __shfl_xor(s, 1); s += __shfl_xor(s, 2); s += __shfl_xor(s, 4); s += __shfl_xor(s, 8);
            const float r = rsqrtf(s * (1.f / 64.f) + EPS);
            const float* g = kg + (1 + which) * 64 + (w4 & 63);
            u32x2 o; o.x = pk2(f[0] * r * g[0], f[1] * r * g[1]); o.y = pk2(f[2] * r * g[2], f[3] * r * g[3]);
            *(u32x2*)pp = o;
        }
#pragma unroll
        for (int part = 0; part < 2; ++part) {
            const int c0 = part * 512 + lane * 8;
            float acc[8];
#pragma unroll
            for (int j = 0; j < 8; ++j) acc[j] = cb[c0 + j];
#pragma unroll
            for (int w = 0; w < 4; ++w) {
                if (t - 3 + w >= 0) {
                    const u32x4 raw = *(const u32x4*)(proj + (size_t)(m - 3 + w) * NPROJ + C_QB + c0); float f[8]; unpack8(raw, f);
#pragma unroll
                    for (int j = 0; j < 8; ++j) acc[j] += f[j] * cw[w * 1024 + c0 + j];
                }
            }
            const float sc = part ? 0.08838834764831845f : 1.f;
            float y[8];
#pragma unroll
            for (int j = 0; j < 8; ++j) y[j] = silu_f(acc[j]) * sc;
            u32x4 o; o.x = pk2(y[0], y[1]); o.y = pk2(y[2], y[3]); o.z = pk2(y[4], y[5]); o.w = pk2(y[6], y[7]);
            *(u32x4*)(qkc + (size_t)m * 1024 + c0) = o;
        }
    }
}

__device__ void phase_compress(const Params& p, int l, float* lds) {
    unsigned char* ws = p.ws;
    const bf16_t* proj = (const bf16_t*)(ws + WS_PROJ);
    const float* pe = p.in[I_PE] + (size_t)l * 2 * 2048; const float* w1 = p.in[I_W1] + (size_t)l * 2 * 2048 * 128; const float* w2 = p.in[I_W2] + (size_t)l * 2 * 128 * 64;
    const float* kg0 = p.in[I_KG] + l * 192;
    float* tok = lds;
    float* red = lds + 144 * 64;
    float* hidb = red + 4 * 8 * 128;
    const int tid = my_tid(), lane = tid & 63;
    for (int u = my_bid(); u < BATCH * 2 * 2 * 32; u += gridDim.x) {
        const int ib = u & 31, kv = (u >> 5) & 1, g = (u >> 6) & 1, b = u >> 7;
        const int i0 = ib * 8, ni = (NCMP - i0) < 8 ? (NCMP - i0) : 8;
        const int ntok = 16 * ni + 16;
        const int col = (kv ? C_VC : C_KC) + g * 64;
        __syncthreads();
        for (int e = tid; e < 144 * 64; e += NT) {
            const int tt = e >> 6, d = e & 63;
            tok[e] = tt < ntok ? bf2f(proj[(size_t)(b * SEQ + 16 * i0 + tt) * NPROJ + col + d]) : 0.f;
        }
        __syncthreads();
        {
            const int hid = tid & 127, part = tid >> 7;
            float acc[8], accP = 0.f;
#pragma unroll
            for (int ii = 0; ii < 8; ++ii) acc[ii] = 0.f;
            const float* w1p = w1 + (size_t)kv * 2048 * 128 + hid; const float* pep = pe + kv * 2048;
#pragma unroll 2
            for (int f = part * 512; f < part * 512 + 512; ++f) {
                const float w = w1p[(size_t)f * 128];
                accP += w * pep[f];
#pragma unroll
                for (int ii = 0; ii < 8; ++ii) acc[ii] += w * tok[16 * 64 * ii + f];
            }
#pragma unroll
            for (int ii = 0; ii < 8; ++ii) red[(part * 8 + ii) * 128 + hid] = acc[ii] + accP;
        }
        __syncthreads();
        for (int e = tid; e < 8 * 128; e += NT) {
            const float s = (red[e] + red[1024 + e]) + (red[2048 + e] + red[3072 + e]);
            hidb[e] = silu_f(s);
        }
        __syncthreads();
        {
            const int ii = tid >> 6, d = lane;
            float o = 0.f;
            const float* w2p = w2 + (size_t)kv * 128 * 64 + d;
            for (int h = 0; h < 128; ++h) o += hidb[ii * 128 + h] * w2p[h * 64];
            if (kv == 0) { const float s = wave_sum(o * o); o = o * rsqrtf(s * (1.f / 64.f) + EPS) * kg0[d]; }
            bf16_t* dst = (bf16_t*)(ws + (kv ? WS_VCMP : WS_KCMP));
            if (ii < ni) dst[(size_t)((b * 2 + g) * NCMPP + i0 + ii) * 64 + d] = f2bf(o);
        }
    }
    __syncthreads();
}

__device__ __forceinline__ float log_sigmoid_f(float x) { return fminf(x, 0.f) - log1pf(__expf(-fabsf(x))); }
__device__ void mlstm_gates(const float* gates, const float* fb, int m0, int h, float* bcum, float* ig) {
    const int tid = my_tid();
    __syncthreads();
    if (tid < 64) {
        const float lf = log_sigmoid_f(gates[(size_t)(m0 + tid) * 32 + 28 + h] + fb[h]);
        ig[tid] = gates[(size_t)(m0 + tid) * 32 + 24 + h];
        float v = lf;
#pragma unroll
        for (int o = 1; o < 64; o <<= 1) { const float t = __shfl_up(v, o); if (tid >= o) v += t; }
        bcum[tid] = v;
    }
    __syncthreads();
}

__device__ void phase_chunkstate(const Params& p, int l, float* lds) {
    unsigned char* ws = p.ws;
    const bf16_t* proj = (const bf16_t*)(ws + WS_PROJ); const float* gates = (const float*)(ws + WS_GATES);
    const float* cw = p.in[I_CW] + l * 4096; const float* cb = p.in[I_CB] + l * 1024; const float* fb = p.in[I_FB] + l * 4;
    bf16_t* ST = (bf16_t*)(ws + WS_ST); float* STN = (float*)(ws + WS_STN); float* STM = (float*)(ws + WS_STM);
    float* kw = lds;
    float* vv = lds + 8192;
    float* bcum = lds + 16384; float* ig = bcum + 64; float* wsc = ig + 64; float* misc = wsc + 64;
    const int tid = my_tid();
    for (int u = my_bid(); u < BATCH * 4 * 64; u += gridDim.x) {
        const int c = u & 63, h = (u >> 6) & 3, b = u >> 8;
        const int m0 = b * SEQ + c * 64, bh = b * 4 + h;
        mlstm_gates(gates, fb, m0, h, bcum, ig);
        if (tid < 64) {
            const float gv = bcum[63] - bcum[tid] + ig[tid];
            const float mx = wave_max(gv);
            wsc[tid] = __expf(gv - mx);
            if (tid == 0) { misc[0] = mx; STM[bh * 64 + c] = mx; STM[2048 + bh * 64 + c] = bcum[63]; }
        }
        __syncthreads();
        for (int e = tid; e < 64 * 16; e += NT) {
            const int s = e >> 4, d0 = (e & 15) * 8;
            const int t = c * 64 + s, ch = 512 + h * 128 + d0;
            float acc[8];
#pragma unroll
            for (int j = 0; j < 8; ++j) acc[j] = cb[ch + j];
#pragma unroll
            for (int w = 0; w < 4; ++w) {
                if (t - 3 + w >= 0) {
                    const u32x4 raw = *(const u32x4*)(proj + (size_t)(m0 + s - 3 + w) * NPROJ + C_QB + ch); float f[8]; unpack8(raw, f);
#pragma unroll
                    for (int j = 0; j < 8; ++j) acc[j] += f[j] * cw[w * 1024 + ch + j];
                }
            }
            const float sc = 0.08838834764831845f * wsc[s];
#pragma unroll
            for (int j = 0; j < 8; ++j) kw[s * 128 + d0 + j] = silu_f(acc[j]) * sc;
            const u32x4 rv = *(const u32x4*)(proj + (size_t)(m0 + s) * NPROJ + C_VB + h * 128 + d0); float fv[8]; unpack8(rv, fv);
#pragma unroll
            for (int j = 0; j < 8; ++j) vv[s * 128 + d0 + j] = fv[j];
        }
        __syncthreads();
        {
            const int e0 = (tid >> 4) * 4, d0 = (tid & 15) * 8;
            float acc[4][8];
#pragma unroll
            for (int i = 0; i < 4; ++i)
#pragma unroll
                for (int j = 0; j < 8; ++j) acc[i][j] = 0.f;
#pragma unroll 2
            for (int s = 0; s < 64; ++s) {
                const f32x4 ve = *(const f32x4*)(vv + s * 128 + e0);
                const f32x4 k0 = *(const f32x4*)(kw + s * 128 + d0), k1 = *(const f32x4*)(kw + s * 128 + d0 + 4);
                const float va[4] = {ve.x, ve.y, ve.z, ve.w}; const float ka[8] = {k0.x, k0.y, k0.z, k0.w, k1.x, k1.y, k1.z, k1.w};
#pragma unroll
                for (int i = 0; i < 4; ++i)
#pragma unroll
                    for (int j = 0; j < 8; ++j) acc[i][j] += va[i] * ka[j];
            }
#pragma unroll
            for (int i = 0; i < 4; ++i) {
                u32x4 o; o.x = pk2(acc[i][0], acc[i][1]); o.y = pk2(acc[i][2], acc[i][3]); o.z = pk2(acc[i][4], acc[i][5]); o.w = pk2(acc[i][6], acc[i][7]);
                *(u32x4*)(ST + ((size_t)(bh * 64 + c) * 128 + e0 + i) * 128 + d0) = o;
            }
        }
        if (tid < 128) {
            float s = 0.f;
            for (int q = 0; q < 64; ++q) s += kw[q * 128 + tid];
            STN[(size_t)(bh * 64 + c) * 128 + tid] = s;
        }
    }
    __syncthreads();
}

__device__ void phase_scan(const Params& p) {
    unsigned char* ws = p.ws;
    bf16_t* ST = (bf16_t*)(ws + WS_ST); float* STN = (float*)(ws + WS_STN); float* STM = (float*)(ws + WS_STM);
    const int tid = my_tid();
    for (int u = my_bid(); u < 256; u += gridDim.x) {
        const int bh = u >> 3, idx = ((u & 7) * NT + tid) * 4;
        float C[4] = {0.f, 0.f, 0.f, 0.f};
        float nval = 0.f; const bool do_n = (u & 7) == 0 && tid < 128;
        float m = 0.f;
        for (int c0 = 0; c0 < 64; c0 += 8) {
            u32x2 raw[8]; float dn[8], dec[8], scl[8];
#pragma unroll
            for (int k = 0; k < 8; ++k) {
                raw[k] = *(const u32x2*)(ST + (size_t)(bh * 64 + c0 + k) * 16384 + idx);
                dn[k] = do_n ? STN[(size_t)(bh * 64 + c0 + k) * 128 + tid] : 0.f;
            }
#pragma unroll
            for (int k = 0; k < 8; ++k) {
                const float mloc = STM[bh * 64 + c0 + k], bl = STM[2048 + bh * 64 + c0 + k];
                const float mnew = fmaxf(bl + m, mloc);
                dec[k] = __expf(bl + m - mnew); scl[k] = __expf(mloc - mnew);
                if ((u & 7) == 0 && tid == 0) STM[4096 + bh * 64 + c0 + k] = m;
                m = mnew;
            }
#pragma unroll
            for (int k = 0; k < 8; ++k) {
                u32x2 o; o.x = pk2(C[0], C[1]); o.y = pk2(C[2], C[3]);
                *(u32x2*)(ST + (size_t)(bh * 64 + c0 + k) * 16384 + idx) = o;
                const float f[4] = {lo16(raw[k].x), hi16(raw[k].x), lo16(raw[k].y), hi16(raw[k].y)};
#pragma unroll
                for (int j = 0; j < 4; ++j) C[j] = dec[k] * C[j] + scl[k] * f[j];
                if (do_n) { STN[(size_t)(bh * 64 + c0 + k) * 128 + tid] = nval; nval = dec[k] * nval + scl[k] * dn[k]; }
            }
        }
    }
}

__device__ void phase_attn_naive(const Params& p, int l, float* lds) {
    unsigned char* ws = p.ws;
    const bf16_t* proj = (const bf16_t*)(ws + WS_PROJ); const float* gates = (const float*)(ws + WS_GATES);
    const bf16_t* kcmp = (const bf16_t*)(ws + WS_KCMP); const bf16_t* vcmp = (const bf16_t*)(ws + WS_VCMP);
    bf16_t* Y = (bf16_t*)(ws + WS_Y);
    const float* oga = p.in[I_OGA] + l * 512;
    const int tid = my_tid(), lane = tid & 63, wave = tid >> 6;
    float* qs = lds + wave * (256 + 1024);
    float* pb = qs + 256;
    for (int u = my_bid(); u < BATCH * 2 * (SEQ / 8); u += gridDim.x) {
        const int tb = u % (SEQ / 8), g = (u / (SEQ / 8)) & 1, b = u / (SEQ / 4);
        const int t = tb * 8 + wave; const int m = b * SEQ + t;
        const bf16_t* prow = proj + (size_t)m * NPROJ;
#pragma unroll
        for (int hg = 0; hg < 4; ++hg) qs[hg * 64 + lane] = bf2f(prow[C_QA + g * 256 + hg * 64 + lane]);
        float otot[4] = {0.f, 0.f, 0.f, 0.f};
        const float* gt = gates + (size_t)m * 32 + g * 12;
        const int nval = t >= 31 ? ((t - 31) >> 4) + 1 : 0;
        float sc[4][4];
        float mx[4] = {-INFINITY, -INFINITY, -INFINITY, -INFINITY};
        const bf16_t* kc = kcmp + (size_t)(b * 2 + g) * NCMPP * 64; const bf16_t* vc = vcmp + (size_t)(b * 2 + g) * NCMPP * 64;
#pragma unroll
        for (int it = 0; it < 4; ++it) {
            asm volatile("" ::: "memory");
            const int i = it * 64 + lane;
            float a[4] = {0.f, 0.f, 0.f, 0.f};
            if (i < nval) {
#pragma unroll 1
                for (int d8 = 0; d8 < 8; ++d8) {
                    const u32x4 raw = *(const u32x4*)(kc + (size_t)i * 64 + d8 * 8); float f[8]; unpack8(raw, f);
#pragma unroll
                    for (int j = 0; j < 8; ++j)
#pragma unroll
                        for (int hg = 0; hg < 4; ++hg) a[hg] += qs[hg * 64 + d8 * 8 + j] * f[j];
                }
            }
#pragma unroll
            for (int hg = 0; hg < 4; ++hg) { sc[it][hg] = i < nval ? a[hg] * 0.125f : -INFINITY; mx[hg] = fmaxf(mx[hg], sc[it][hg]); }
        }
        float sm[4];
#pragma unroll
        for (int hg = 0; hg < 4; ++hg) {
            mx[hg] = wave_max(mx[hg]);
            float s = 0.f;
#pragma unroll
            for (int it = 0; it < 4; ++it) { const float e = (it * 64 + lane) < nval ? __expf(sc[it][hg] - mx[hg]) : 0.f; sc[it][hg] = e; s += e; }
            sm[hg] = wave_sum(s);
        }
#pragma unroll
        for (int it = 0; it < 4; ++it)
#pragma unroll
            for (int hg = 0; hg < 4; ++hg) pb[hg * 256 + it * 64 + lane] = nval > 0 ? sc[it][hg] / sm[hg] : 0.f;
        {
            float o[4] = {0.f, 0.f, 0.f, 0.f};
            for (int i = 0; i < nval; ++i) {
                const float v = bf2f(vc[(size_t)i * 64 + lane]);
#pragma unroll
                for (int hg = 0; hg < 4; ++hg) o[hg] += pb[hg * 256 + i] * v;
            }
#pragma unroll
            for (int hg = 0; hg < 4; ++hg) otot[hg] += sigmoid_f(gt[hg * 3 + 0]) * o[hg];
        }
        const int cur = t >> 6;
        float imp = 0.f;
#pragma unroll
        for (int k = -1; k < 4; ++k) {
            const int i = 4 * lane + k;
            if (i >= 0 && i < nval) imp += (pb[i] + pb[256 + i]) + (pb[512 + i] + pb[768 + i]);
        }
        const bool valid = lane <= cur;
        const bool forced = (lane == 0) || (lane == cur) || (lane == cur - 1);
        const float score = valid ? imp + (forced ? 1e4f : 0.f) : -1e30f;
        int rank = 0;
        for (int k = 0; k < 64; ++k) {
            const float sk = __shfl(score, k);
            rank += (sk > score || (sk == score && k < lane)) ? 1 : 0;
        }
        const unsigned long long selmask = __ballot(rank < 16 && valid);
#pragma unroll 1
        for (int br = 0; br < 2; ++br) {
            const int kcol = (br ? C_KW : C_KS) + g * 64, vcol = (br ? C_VW : C_VS) + g * 64;
            float mr[4] = {-INFINITY, -INFINITY, -INFINITY, -INFINITY}, lr[4] = {0.f, 0.f, 0.f, 0.f}, o[4] = {0.f, 0.f, 0.f, 0.f};
            const int jlo = br ? (cur >= 8 ? cur - 8 : 0) : 0;
            for (int j = jlo; j <= cur; ++j) {
                if (br == 0 && !((selmask >> j) & 1ull)) continue;
                asm volatile("" ::: "memory");
                const int pos = j * 64 + lane;
                const bool ok = pos <= t && (br == 0 || pos > t - 512);
                float a[4] = {0.f, 0.f, 0.f, 0.f};
                const bf16_t* kr = proj + (size_t)(b * SEQ + pos) * NPROJ + kcol;
#pragma unroll 1
                for (int d8 = 0; d8 < 8; ++d8) {
                    const u32x4 raw = *(const u32x4*)(kr + d8 * 8); float f[8]; unpack8(raw, f);
#pragma unroll
                    for (int jj = 0; jj < 8; ++jj)
#pragma unroll
                        for (int hg = 0; hg < 4; ++hg) a[hg] += qs[hg * 64 + d8 * 8 + jj] * f[jj];
                }
                float alpha[4];
#pragma unroll
                for (int hg = 0; hg < 4; ++hg) {
                    const float s = ok ? a[hg] * 0.125f : -INFINITY;
                    const float bm = wave_max(s);
                    const float mn = fmaxf(mr[hg], bm);
                    alpha[hg] = (mn == -INFINITY) ? 1.f : __expf(mr[hg] - mn);
                    const float e = (ok && mn > -INFINITY) ? __expf(s - mn) : 0.f;
                    lr[hg] = lr[hg] * alpha[hg] + wave_sum(e);
                    mr[hg] = mn;
                    pb[hg * 256 + lane] = e;
                    o[hg] *= alpha[hg];
                }
                const bf16_t* vr = proj + (size_t)(b * SEQ + j * 64) * NPROJ + vcol + lane;
                for (int k = 0; k < 64; ++k) {
                    const float v = bf2f(vr[(size_t)k * NPROJ]);
#pragma unroll
                    for (int hg = 0; hg < 4; ++hg) o[hg] += pb[hg * 256 + k] * v;
                }
            }
#pragma unroll
            for (int hg = 0; hg < 4; ++hg) otot[hg] += sigmoid_f(gt[hg * 3 + 1 + br]) * (lr[hg] > 0.f ? o[hg] / lr[hg] : 0.f);
        }
#pragma unroll
        for (int hg = 0; hg < 4; ++hg) {
            const float s = wave_sum(otot[hg] * otot[hg]);
            const float y = otot[hg] * rsqrtf(s * (1.f / 64.f) + EPS) * oga[(g * 4 + hg) * 64 + lane];
            Y[(size_t)m * 1024 + (g * 4 + hg) * 64 + lane] = f2bf(y);
        }
    }
}

namespace att {
typedef short bf16x8 __attribute__((ext_vector_type(8)));
typedef short s16x4 __attribute__((ext_vector_type(4)));
typedef float f32x16 __attribute__((ext_vector_type(16)));
#define ATT_LAS __attribute__((address_space(3)))
constexpr int L_K = 0, L_V = 16384, L_IMP = 32768, IMP_STRIDE = 65, L_SEL = L_IMP + 4 * 64 * IMP_STRIDE * 4, L_INV = L_SEL + 512, L_WS = L_INV + 1024, L_OST = L_WS + 8 * 256, L_END = L_OST + 8 * 4096;
static_assert(L_END <= LDS_BYTES, "attention LDS map");
constexpr float LOG2E = 1.4426950408889634f;
__device__ __forceinline__ int crow(int r, int hi) { return (r & 3) + 8 * (r >> 2) + 4 * hi; }
__device__ __forceinline__ unsigned cvtpk(float lo, float hi) { unsigned r; asm("v_cvt_pk_bf16_f32 %0, %1, %2" : "=v"(r) : "v"(lo), "v"(hi)); return r; }
__device__ __forceinline__ s16x4 vtr(ATT_LAS const unsigned char* p) { return __builtin_bit_cast(s16x4, __builtin_amdgcn_ds_read_tr16_b64_v4i16((ATT_LAS s16x4*)p)); }

struct Ctx {
    ATT_LAS unsigned char* lds;
    int lane, wave, r32, hi;
    u32x4 kreg, vreg;
};
__device__ __forceinline__ void tile_load(Ctx& C, const bf16_t* kbase, const bf16_t* vbase, int pitch) {
    C.kreg = *(const u32x4*)(kbase + (size_t)C.lane * pitch + C.wave * 8);
    C.vreg = *(const u32x4*)(vbase + (size_t)(16 * (C.wave & 3) + (C.lane >> 2)) * pitch + (C.wave >> 2) * 32 + (C.lane & 3) * 8);
}
__device__ __forceinline__ void tile_store(Ctx& C, int buf) {
    *(ATT_LAS u32x4*)(C.lds + L_K + buf * 8192 + C.wave * 1024 + C.lane * 16) = C.kreg;
    *(ATT_LAS u32x4*)(C.lds + L_V + buf * 8192 + C.wave * 1024 + C.lane * 16) = C.vreg;
}
__device__ __forceinline__ void qkt(const Ctx& C, int buf, const bf16x8 (&qr)[4], f32x16& p0, f32x16& p1) {
    ATT_LAS const unsigned char* kb = C.lds + L_K + buf * 8192 + C.hi * 1024 + C.r32 * 16;
    p0 = (f32x16){0.f, 0.f, 0.f, 0.f, 0.f, 0.f, 0.f, 0.f, 0.f, 0.f, 0.f, 0.f, 0.f, 0.f, 0.f, 0.f}; p1 = p0;
#pragma unroll
    for (int d0 = 0; d0 < 4; ++d0) {
        const bf16x8 b0 = *(ATT_LAS const bf16x8*)(kb + d0 * 2048);
        const bf16x8 b1 = *(ATT_LAS const bf16x8*)(kb + d0 * 2048 + 512);
        p0 = __builtin_amdgcn_mfma_f32_32x32x16_bf16(b0, qr[d0], p0, 0, 0, 0);
        p1 = __builtin_amdgcn_mfma_f32_32x32x16_bf16(b1, qr[d0], p1, 0, 0, 0);
    }
}
__device__ __forceinline__ void pv(const Ctx& C, int buf, const f32x16& p0, const f32x16& p1, f32x16 (&o)[2]) {
    ATT_LAS const unsigned char* vp = C.lds + L_V + buf * 8192 + ((C.lane >> 4) & 1) * 32 + (C.lane & 3) * 8 + (4 * C.hi + ((C.lane & 15) >> 2)) * 64;
    bf16x8 pa[4];
#pragma unroll
    for (int s2 = 0; s2 < 2; ++s2) {
        u32x4 w0, w1;
        w0.x = cvtpk(p0[8 * s2 + 0], p0[8 * s2 + 1]); w0.y = cvtpk(p0[8 * s2 + 2], p0[8 * s2 + 3]); w0.z = cvtpk(p0[8 * s2 + 4], p0[8 * s2 + 5]); w0.w = cvtpk(p0[8 * s2 + 6], p0[8 * s2 + 7]);
        w1.x = cvtpk(p1[8 * s2 + 0], p1[8 * s2 + 1]); w1.y = cvtpk(p1[8 * s2 + 2], p1[8 * s2 + 3]); w1.z = cvtpk(p1[8 * s2 + 4], p1[8 * s2 + 5]); w1.w = cvtpk(p1[8 * s2 + 6], p1[8 * s2 + 7]);
        pa[s2] = __builtin_bit_cast(bf16x8, w0); pa[2 + s2] = __builtin_bit_cast(bf16x8, w1);
    }
#pragma unroll
    for (int d0 = 0; d0 < 2; ++d0)
#pragma unroll
        for (int ks = 0; ks < 4; ++ks) {
            const s16x4 lo = vtr(vp + d0 * 4096 + ks * 1024), hh = vtr(vp + d0 * 4096 + ks * 1024 + 512);
            const bf16x8 vf = (bf16x8){lo[0], lo[1], lo[2], lo[3], hh[0], hh[1], hh[2], hh[3]};
            o[d0] = __builtin_amdgcn_mfma_f32_32x32x16_bf16(pa[ks], vf, o[d0], 0, 0, 0);
        }
}
__device__ __forceinline__ float sum16(const f32x16& p) {
    return ((p[0] + p[1]) + (p[2] + p[3])) + ((p[4] + p[5]) + (p[6] + p[7])) + (((p[8] + p[9]) + (p[10] + p[11])) + ((p[12] + p[13]) + (p[14] + p[15])));
}
__device__ __forceinline__ void accum_scaled(const Ctx& C, f32x16 (&otot)[2], const f32x16 (&o)[2], float fac) {
    ATT_LAS float* wsf = (ATT_LAS float*)(C.lds + L_WS) + C.wave * 64;
    asm volatile("s_waitcnt lgkmcnt(0)" ::: "memory");
    if (C.hi == 0) wsf[C.r32] = fac;
    asm volatile("s_waitcnt lgkmcnt(0)" ::: "memory");
#pragma unroll
    for (int r = 0; r < 16; ++r) { const float f = wsf[crow(r, C.hi)]; otot[0][r] += o[0][r] * f; otot[1][r] += o[1][r] * f; }
    asm volatile("s_waitcnt lgkmcnt(0)" : "+v"(otot[0]), "+v"(otot[1]) :: "memory");
}

__device__ void unit(const Params& p, int l, int b, int g, int c, ATT_LAS unsigned char* lds) {
    unsigned char* ws = p.ws;
    const bf16_t* proj = (const bf16_t*)(ws + WS_PROJ); const float* gates = (const float*)(ws + WS_GATES);
    const bf16_t* kcmp = (const bf16_t*)(ws + WS_KCMP) + (size_t)(b * 2 + g) * NCMPP * 64; const bf16_t* vcmp = (const bf16_t*)(ws + WS_VCMP) + (size_t)(b * 2 + g) * NCMPP * 64;
    bf16_t* Y = (bf16_t*)(ws + WS_Y);
    const float* kg = p.in[I_KG] + l * 192; const float* oga = p.in[I_OGA] + l * 512;
    Ctx C; C.lds = lds;
    const int tid = my_tid(); C.lane = tid & 63; C.wave = __builtin_amdgcn_readfirstlane(tid >> 6); C.r32 = C.lane & 31; C.hi = C.lane >> 5;
    const int lane = C.lane, wave = C.wave, r32 = C.r32, hi = C.hi, hg = wave >> 1, th = wave & 1;
    const int t = 64 * c + 32 * th + r32; const size_t m = (size_t)b * SEQ + t;
    const bf16_t* prow0 = proj + (size_t)b * SEQ * NPROJ;
    bf16x8 qr[4]; float qsq = 0.f;
#pragma unroll
    for (int d0 = 0; d0 < 4; ++d0) {
        const u32x4 raw = *(const u32x4*)(proj + m * NPROJ + C_QA + g * 256 + hg * 64 + 16 * d0 + 8 * hi);
        qr[d0] = __builtin_bit_cast(bf16x8, raw);
        float f[8]; unpack8(raw, f);
#pragma unroll
        for (int j = 0; j < 8; ++j) qsq += f[j] * f[j];
    }
    qsq += __shfl_xor(qsq, 32);
    const float qn = sqrtf(qsq) * 1.01f * LOG2E;
    const float off_c = qn * wave_max(fabsf(kg[lane])), off_s = qn * wave_max(fabsf(kg[64 + lane])), off_w = qn * wave_max(fabsf(kg[128 + lane]));
    const float* gt = gates + m * 32 + (g * 4 + hg) * 3;
    const float gq0 = sigmoid_f(gt[0]), gq1 = sigmoid_f(gt[1]), gq2 = sigmoid_f(gt[2]);
    constexpr float C2 = 0.125f * LOG2E;
    f32x16 otot[2]; otot[0] = (f32x16){0.f, 0.f, 0.f, 0.f, 0.f, 0.f, 0.f, 0.f, 0.f, 0.f, 0.f, 0.f, 0.f, 0.f, 0.f, 0.f}; otot[1] = otot[0];
    const f32x16 zero16 = otot[0];
    {
        const int nval = t >= 31 ? ((t - 31) >> 4) + 1 : 0;
        const int ntc = (4 * c + 3 + 63) >> 6;
        f32x16 o[2]; o[0] = zero16; o[1] = zero16;
        float lsum = 0.f, yprev = 0.f;
        ATT_LAS float* imp = (ATT_LAS float*)(lds + L_IMP) + (hg * 64 + 32 * th + r32) * IMP_STRIDE;
        tile_load(C, kcmp, vcmp, 64); tile_store(C, 0); __syncthreads();
#pragma unroll
        for (int jt = 0; jt < 4; ++jt) {
            if (jt < ntc) {
                if (jt + 1 < ntc) tile_load(C, kcmp + (size_t)(jt + 1) * 64 * 64, vcmp + (size_t)(jt + 1) * 64 * 64, 64);
                f32x16 p0, p1; qkt(C, jt & 1, qr, p0, p1);
#pragma unroll
                for (int r = 0; r < 16; ++r) {
                    const int i0 = 64 * jt + crow(r, hi);
                    p0[r] = i0 < nval ? __builtin_amdgcn_exp2f(p0[r] * C2 - off_c) : 0.f;
                    p1[r] = i0 + 32 < nval ? __builtin_amdgcn_exp2f(p1[r] * C2 - off_c) : 0.f;
                }
                lsum += sum16(p0) + sum16(p1);
#pragma unroll
                for (int H = 0; H < 2; ++H)
#pragma unroll
                    for (int rr = 0; rr < 4; ++rr) {
                        const f32x16& pp = H ? p1 : p0;
                        const float L = pp[4 * rr + 3], S4 = (pp[4 * rr] + pp[4 * rr + 1]) + (pp[4 * rr + 2] + L);
                        const float y = __shfl_xor(L, 32);
                        imp[2 * ((jt * 2 + H) * 4 + rr) + hi] = S4 + (hi ? y : yprev);
                        yprev = y;
                    }
                pv(C, jt & 1, p0, p1, o);
                if (jt + 1 < ntc) tile_store(C, (jt + 1) & 1);
                __syncthreads();
            }
        }
        lsum += __shfl_xor(lsum, 32);
        const float inv = lsum > 0.f ? 1.f / lsum : 0.f;
        if (hi == 0) ((ATT_LAS float*)(lds + L_INV))[hg * 64 + 32 * th + r32] = inv;
        accum_scaled(C, otot, o, gq0 * inv);
    }
    __syncthreads();
    {
        ATT_LAS unsigned long long* selm = (ATT_LAS unsigned long long*)(lds + L_SEL);
        const ATT_LAS float* impb = (const ATT_LAS float*)(lds + L_IMP);
        for (int i = 0; i < 8; ++i) {
            const int q = wave * 8 + i;
            unsigned long long msk;
            if (c < 16) msk = (2ull << c) - 1ull;
            else {
                const bool valid = lane <= c;
                float sc = -1e30f;
                if (valid) {
                    const ATT_LAS float* invb = (const ATT_LAS float*)(lds + L_INV);
                    sc = (impb[(0 * 64 + q) * IMP_STRIDE + lane] * invb[q] + impb[(1 * 64 + q) * IMP_STRIDE + lane] * invb[64 + q]) + (impb[(2 * 64 + q) * IMP_STRIDE + lane] * invb[128 + q] + impb[(3 * 64 + q) * IMP_STRIDE + lane] * invb[192 + q]);
                    if (lane == 0 || lane == c || lane == c - 1) sc += 1e4f;
                }
                int rank = 0;
                for (int k = 0; k <= c; ++k) { const float sk = __shfl(sc, k); rank += (sk > sc || (sk == sc && k < lane)) ? 1 : 0; }
                msk = __ballot(valid && rank < 16);
            }
            if (lane == 0) selm[q] = msk;
        }
    }
    __syncthreads();
    const unsigned long long mysel = ((ATT_LAS const unsigned long long*)(lds + L_SEL))[32 * th + r32];
    unsigned long long blkmask;
    {
        unsigned long long v = ((ATT_LAS const unsigned long long*)(lds + L_SEL))[lane];
#pragma unroll
        for (int o2 = 1; o2 < 64; o2 <<= 1) v |= __shfl_xor(v, o2);
        blkmask = ((unsigned long long)__builtin_amdgcn_readfirstlane((unsigned)(v >> 32)) << 32) | (unsigned)__builtin_amdgcn_readfirstlane((unsigned)v);
    }
    {
        f32x16 o[2]; o[0] = zero16; o[1] = zero16; float lsum = 0.f;
        const bf16_t* kb = prow0 + C_KS + g * 64; const bf16_t* vb = prow0 + C_VS + g * 64;
        unsigned long long rem = blkmask;
        int j = __builtin_ctzll(rem); rem &= rem - 1ull;
        tile_load(C, kb + (size_t)j * 64 * NPROJ, vb + (size_t)j * 64 * NPROJ, NPROJ); tile_store(C, 0); __syncthreads();
        int buf = 0;
        for (;;) {
            const int jn = rem ? __builtin_ctzll(rem) : -1;
            if (jn >= 0) { rem &= rem - 1ull; tile_load(C, kb + (size_t)jn * 64 * NPROJ, vb + (size_t)jn * 64 * NPROJ, NPROJ); }
            f32x16 p0, p1; qkt(C, buf, qr, p0, p1);
            const bool sel = (mysel >> j) & 1ull;
            const int lim = t - 64 * j;
#pragma unroll
            for (int r = 0; r < 16; ++r) {
                const int kk = crow(r, hi);
                p0[r] = (sel && kk <= lim) ? __builtin_amdgcn_exp2f(p0[r] * C2 - off_s) : 0.f;
                p1[r] = (sel && kk + 32 <= lim) ? __builtin_amdgcn_exp2f(p1[r] * C2 - off_s) : 0.f;
            }
            lsum += sum16(p0) + sum16(p1);
            pv(C, buf, p0, p1, o);
            if (jn >= 0) tile_store(C, buf ^ 1);
            __syncthreads();
            if (jn < 0) break;
            j = jn; buf ^= 1;
        }
        lsum += __shfl_xor(lsum, 32);
        accum_scaled(C, otot, o, gq1 / lsum);
    }
    {
        f32x16 o[2]; o[0] = zero16; o[1] = zero16; float lsum = 0.f;
        const bf16_t* kb = prow0 + C_KW + g * 64; const bf16_t* vb = prow0 + C_VW + g * 64;
        const int jlo = c >= 8 ? c - 8 : 0;
        tile_load(C, kb + (size_t)jlo * 64 * NPROJ, vb + (size_t)jlo * 64 * NPROJ, NPROJ); tile_store(C, 0); __syncthreads();
        int buf = 0;
        for (int j = jlo; j <= c; ++j) {
            if (j < c) tile_load(C, kb + (size_t)(j + 1) * 64 * NPROJ, vb + (size_t)(j + 1) * 64 * NPROJ, NPROJ);
            f32x16 p0, p1; qkt(C, buf, qr, p0, p1);
            const int lim = t - 64 * j;
#pragma unroll
            for (int r = 0; r < 16; ++r) {
                const int kk = crow(r, hi);
                p0[r] = (kk <= lim && kk > lim - 512) ? __builtin_amdgcn_exp2f(p0[r] * C2 - off_w) : 0.f;
                p1[r] = (kk + 32 <= lim && kk + 32 > lim - 512) ? __builtin_amdgcn_exp2f(p1[r] * C2 - off_w) : 0.f;
            }
            lsum += sum16(p0) + sum16(p1);
            pv(C, buf, p0, p1, o);
            if (j < c) tile_store(C, buf ^ 1);
            __syncthreads();
            buf ^= 1;
        }
        lsum += __shfl_xor(lsum, 32);
        accum_scaled(C, otot, o, gq2 / lsum);
    }
    {
        ATT_LAS bf16_t* stg = (ATT_LAS bf16_t*)(lds + L_OST) + wave * 2048;
        const float g0 = oga[(g * 4 + hg) * 64 + r32], g1 = oga[(g * 4 + hg) * 64 + 32 + r32];
#pragma unroll
        for (int r = 0; r < 16; ++r) {
            float sq = otot[0][r] * otot[0][r] + otot[1][r] * otot[1][r];
            sq += __shfl_xor(sq, 1); sq += __shfl_xor(sq, 2); sq += __shfl_xor(sq, 4); sq += __shfl_xor(sq, 8); sq += __shfl_xor(sq, 16);
            const float rs = rsqrtf(sq * (1.f / 64.f) + EPS);
            const int q = crow(r, hi);
            stg[q * 64 + r32] = f2bf(otot[0][r] * rs * g0);
            stg[q * 64 + 32 + r32] = f2bf(otot[1][r] * rs * g1);
        }
        asm volatile("s_waitcnt lgkmcnt(0)" ::: "memory");
        bf16_t* yb = Y + ((size_t)b * SEQ + 64 * c + 32 * th) * 1024 + (g * 4 + hg) * 64;
#pragma unroll
        for (int i = 0; i < 4; ++i) {
            const int row = i * 8 + (lane >> 3), ch = lane & 7;
            const u32x4 v = *(ATT_LAS const u32x4*)(stg + row * 64 + ch * 8);
            *(u32x4*)(yb + (size_t)row * 1024 + ch * 8) = v;
        }
    }
    __syncthreads();
}
}

__device__ void phase_attn_mfma(const Params& p, int l, unsigned char* lds_raw) {
    for (int v = my_bid(); v < 1024; v += gridDim.x) {
        const int r = v >> 8, x = (v >> 4) & 15, bg = v & 15;
        const int c = r == 0 ? 63 - x : (r == 1 ? 32 + x : (r == 2 ? 31 - x : x));
        att::unit(p, l, bg >> 1, bg & 1, c, (ATT_LAS unsigned char*)lds_raw);
    }
}

__device__ void phase_mlstm_out(const Params& p, int l, float* lds) {
    unsigned char* ws = p.ws;
    const bf16_t* proj = (const bf16_t*)(ws + WS_PROJ); const float* gates = (const float*)(ws + WS_GATES);
    const bf16_t* qkc = (const bf16_t*)(ws + WS_XB);
    const bf16_t* ST = (const bf16_t*)(ws + WS_ST); const float* STN = (const float*)(ws + WS_STN); const float* STM = (const float*)(ws + WS_STM);
    const float* fb = p.in[I_FB] + l * 4; const float* ogm = p.in[I_OGM] + l * 512;
    bf16_t* Y = (bf16_t*)(ws + WS_Y);
    float* qq = lds;
    float* kk = lds + 8192;
    float* Cs = lds + 16384;
    float* Ws = lds + 32768;
    float* bcum = Ws + 64 * 65; float* ig = bcum + 64; float* mt = ig + 64; float* wint = mt + 64; float* den = wint + 64; float* npv = den + 64;
    const int tid = my_tid(), lane = tid & 63, wave = tid >> 6;
    for (int u = my_bid(); u < BATCH * 4 * 64; u += gridDim.x) {
        const int c = u & 63, h = (u >> 6) & 3, b = u >> 8;
        const int m0 = b * SEQ + c * 64, bh = b * 4 + h;
        mlstm_gates(gates, fb, m0, h, bcum, ig);
        const float mprev = STM[4096 + bh * 64 + c];
        for (int e = tid; e < 64 * 16; e += NT) {
            const int s = e >> 4, d0 = (e & 15) * 8;
            const u32x4 rq = *(const u32x4*)(qkc + (size_t)(m0 + s) * 1024 + h * 128 + d0); float f[8]; unpack8(rq, f);
            const u32x4 rk = *(const u32x4*)(qkc + (size_t)(m0 + s) * 1024 + 512 + h * 128 + d0); float fk[8]; unpack8(rk, fk);
#pragma unroll
            for (int j = 0; j < 8; ++j) { qq[s * 128 + d0 + j] = f[j]; kk[s * 128 + d0 + j] = fk[j]; }
        }
        if (tid < 128) npv[tid] = STN[(size_t)(bh * 64 + c) * 128 + tid];
        for (int e8 = tid; e8 < 128 * 16; e8 += NT) {
            const int e = e8 >> 4, d0 = (e8 & 15) * 8;
            const u32x4 rc = *(const u32x4*)(ST + ((size_t)(bh * 64 + c) * 128 + e) * 128 + d0); float f[8]; unpack8(rc, f);
#pragma unroll
            for (int j = 0; j < 8; ++j) Cs[(d0 + j) * 128 + e] = f[j];
        }
        __syncthreads();
        {
            const int t = tid >> 3, s0 = (tid & 7) * 8;
            float a[8] = {0.f, 0.f, 0.f, 0.f, 0.f, 0.f, 0.f, 0.f};
#pragma unroll 2
            for (int d = 0; d < 128; ++d) {
                const float qv = qq[t * 128 + d];
#pragma unroll
                for (int j = 0; j < 8; ++j) a[j] += qv * kk[(s0 + j) * 128 + d];
            }
#pragma unroll
            for (int j = 0; j < 8; ++j) Ws[t * 65 + s0 + j] = a[j];
        }
        __syncthreads();
        for (int r = 0; r < 8; ++r) {
            const int t = wave * 8 + r;
            const float dv = lane <= t ? bcum[t] - bcum[lane] + ig[lane] : -INFINITY;
            const float a = bcum[t] + mprev;
            const float m_t = fmaxf(a, wave_max(dv));
            const float w = lane <= t ? __expf(dv - m_t) * Ws[t * 65 + lane] : 0.f;
            Ws[t * 65 + lane] = w;
            const float wi = __expf(a - m_t);
            const float qn = wave_sum(qq[t * 128 + lane] * npv[lane] + qq[t * 128 + 64 + lane] * npv[64 + lane]);
            const float dsum = wave_sum(w);
            if (lane == 0) { mt[t] = m_t; wint[t] = wi; den[t] = wi * qn + dsum; }
        }
        __syncthreads();
        for (int e = tid; e < 64 * 16; e += NT) {
            const int s = e >> 4, d0 = (e & 15) * 8;
            const u32x4 rv = *(const u32x4*)(proj + (size_t)(m0 + s) * NPROJ + C_VB + h * 128 + d0); float f[8]; unpack8(rv, f);
#pragma unroll
            for (int j = 0; j < 8; ++j) kk[s * 128 + d0 + j] = f[j];
        }
        __syncthreads();
        float hv[16];
        {
            const int e = tid & 127, t0 = (tid >> 7) * 16;
            float a1[16], a2[16];
#pragma unroll
            for (int i = 0; i < 16; ++i) { a1[i] = 0.f; a2[i] = 0.f; }
#pragma unroll 2
            for (int d = 0; d < 128; ++d) {
                const float cv = Cs[d * 128 + e];
#pragma unroll
                for (int i = 0; i < 16; ++i) a1[i] += qq[(t0 + i) * 128 + d] * cv;
            }
#pragma unroll 2
            for (int s = 0; s < 64; ++s) {
                const float vv = kk[s * 128 + e];
#pragma unroll
                for (int i = 0; i < 16; ++i) a2[i] += Ws[(t0 + i) * 65 + s] * vv;
            }
#pragma unroll
            for (int i = 0; i < 16; ++i) {
                const int t = t0 + i;
                const float num = wint[t] * a1[i] + a2[i];
                hv[i] = num / fmaxf(fabsf(den[t]), __expf(-mt[t]));
            }
        }
        __syncthreads();
        {
            const int e = tid & 127, t0 = (tid >> 7) * 16;
#pragma unroll
            for (int i = 0; i < 16; ++i) Cs[(t0 + i) * 128 + e] = hv[i];
        }
        __syncthreads();
        for (int r = 0; r < 8; ++r) {
            const int t = wave * 8 + r;
            const float h0 = Cs[t * 128 + lane], h1 = Cs[t * 128 + 64 + lane];
            const float s = wave_sum(h0 * h0 + h1 * h1);
            const float rr = rsqrtf(s * (1.f / 128.f) + EPS);
            const bf16_t* op = proj + (size_t)(m0 + t) * NPROJ + C_OB + h * 128;
            const float y0 = h0 * rr * ogm[h * 128 + lane] * sigmoid_f(bf2f(op[lane]));
            const float y1 = h1 * rr * ogm[h * 128 + 64 + lane] * sigmoid_f(bf2f(op[64 + lane]));
            Y[(size_t)(m0 + t) * 1024 + 512 + h * 128 + lane] = f2bf(y0);
            Y[(size_t)(m0 + t) * 1024 + 512 + h * 128 + 64 + lane] = f2bf(y1);
        }
        __syncthreads();
    }
}

namespace mls {
typedef short bf16x8 __attribute__((ext_vector_type(8)));
typedef short s16x4 __attribute__((ext_vector_type(4)));
typedef float f32x16 __attribute__((ext_vector_type(16)));
#define MLS_LAS __attribute__((address_space(3)))
__device__ __forceinline__ s16x4 vtr(MLS_LAS const unsigned char* p) { return __builtin_bit_cast(s16x4, __builtin_amdgcn_ds_read_tr16_b64_v4i16((MLS_LAS s16x4*)p)); }
__device__ __forceinline__ bf16x8 trfrag(MLS_LAS const unsigned char* p) { const s16x4 lo = vtr(p), hh = vtr(p + 512); return (bf16x8){lo[0], lo[1], lo[2], lo[3], hh[0], hh[1], hh[2], hh[3]}; }
__device__ __forceinline__ float incl_scan64(float v, int lane) {
#pragma unroll
    for (int o = 1; o < 64; o <<= 1) { const float t = __shfl_up(v, o); if (lane >= o) v += t; }
    return v;
}
constexpr float KSCALE = 0.08838834764831845f;

__device__ void chunk_unit(const Params& p, int l, int b, int c, MLS_LAS unsigned char* lds) {
    unsigned char* ws = p.ws;
    const bf16_t* proj = (const bf16_t*)(ws + WS_PROJ); const float* gates = (const float*)(ws + WS_GATES);
    const float* cw = p.in[I_CW] + l * 4096; const float* cb = p.in[I_CB] + l * 1024; const float* fb = p.in[I_FB] + l * 4;
    bf16_t* ST = (bf16_t*)(ws + WS_ST); float* STN = (float*)(ws + WS_STN); float* STM = (float*)(ws + WS_STM);
    const int tid = my_tid(), lane = tid & 63, wave = __builtin_amdgcn_readfirstlane(tid >> 6), r32 = lane & 31, hi = lane >> 5, h = wave >> 1, half = wave & 1;
    const size_t m0 = (size_t)b * SEQ + 64 * c; const int bh = b * 4 + h;
    const float lf = log_sigmoid_f(gates[(m0 + lane) * 32 + 28 + h] + fb[h]);
    const float igv = gates[(m0 + lane) * 32 + 24 + h];
    const float bc = incl_scan64(lf, lane);
    const float blast = __shfl(bc, 63);
    const float gv = blast - bc + igv;
    const float mloc = wave_max(gv);
    const float wsc = __expf(gv - mloc);
    if (half == 0 && lane == 0) { STM[bh * 64 + c] = mloc; STM[2048 + bh * 64 + c] = blast; }
    MLS_LAS unsigned char* vimg = lds + h * 32768; MLS_LAS unsigned char* kimg = vimg + 16384;
    bf16_t* qkc = (bf16_t*)(ws + WS_XB);
    {
        const int pc = lane & 15;
#pragma unroll
        for (int isk = 1; isk >= 0; --isk) {
            const int ch = isk * 512 + h * 128 + pc * 8;
            float cwv[4][8], cbv[8];
#pragma unroll
            for (int j = 0; j < 8; ++j) { cbv[j] = cb[ch + j];
#pragma unroll
                for (int w = 0; w < 4; ++w) cwv[w][j] = cw[w * 1024 + ch + j]; }
#pragma unroll 2
            for (int it = 0; it < 8; ++it) {
                const int s = 32 * half + 4 * it + (lane >> 4);
                if (isk) {
                    const u32x4 rv = *(const u32x4*)(proj + (m0 + s) * NPROJ + C_VB + h * 128 + pc * 8);
                    *(MLS_LAS u32x4*)(vimg + (pc >> 2) * 4096 + s * 64 + (pc & 3) * 16) = rv;
                }
                float acc[8];
#pragma unroll
                for (int j = 0; j < 8; ++j) acc[j] = cbv[j];
#pragma unroll
                for (int w = 0; w < 4; ++w) {
                    const bool ok = 64 * c + s - 3 + w >= 0;
                    const u32x4 raw = *(const u32x4*)(proj + (m0 + (ok ? s - 3 + w : 0)) * NPROJ + C_QB + ch); float f[8]; unpack8(raw, f);
                    const float z = ok ? 1.f : 0.f;
#pragma unroll
                    for (int j = 0; j < 8; ++j) acc[j] += f[j] * (cwv[w][j] * z);
                }
                float y[8];
#pragma unroll
                for (int j = 0; j < 8; ++j) y[j] = silu_f(acc[j]) * (isk ? KSCALE : 1.f);
                u32x4 o; o.x = pk2(y[0], y[1]); o.y = pk2(y[2], y[3]); o.z = pk2(y[4], y[5]); o.w = pk2(y[6], y[7]);
                *(u32x4*)(qkc + (m0 + s) * 1024 + ch) = o;
                if (isk) {
                    const float sc = __shfl(wsc, s);
                    u32x4 o2; o2.x = pk2(y[0] * sc, y[1] * sc); o2.y = pk2(y[2] * sc, y[3] * sc); o2.z = pk2(y[4] * sc, y[5] * sc); o2.w = pk2(y[6] * sc, y[7] * sc);
                    *(MLS_LAS u32x4*)(kimg + (pc >> 2) * 4096 + s * 64 + (pc & 3) * 16) = o2;
                }
            }
        }
    }
    {
        const float* qg = p.in[I_QG] + l * 64; const float* kg = p.in[I_KG] + l * 192;
#pragma unroll 1
        for (int pass = 0; pass < 2; ++pass) {
            if (pass == 1 && tid >= 256) break;
            bf16_t* ptr; const float* gn;
            if (pass == 0) { ptr = (bf16_t*)proj + (m0 + (tid >> 3)) * NPROJ + C_QA + (tid & 7) * 64; gn = qg; }
            else { const int kind = (tid >> 1) & 1; ptr = (bf16_t*)proj + (m0 + (tid >> 2)) * NPROJ + (kind ? C_KW : C_KS) + (tid & 1) * 64; gn = kg + (1 + kind) * 64; }
            u32x4 raw[8]; float sq = 0.f;
#pragma unroll
            for (int i = 0; i < 8; ++i) { raw[i] = *(const u32x4*)(ptr + 8 * i); float f[8]; unpack8(raw[i], f);
#pragma unroll
                for (int j = 0; j < 8; ++j) sq += f[j] * f[j]; }
            const float r = rsqrtf(sq * (1.f / 64.f) + EPS);
#pragma unroll
            for (int i = 0; i < 8; ++i) { float f[8]; unpack8(raw[i], f);
                const f32x4 g0 = *(const f32x4*)(gn + 8 * i), g1 = *(const f32x4*)(gn + 8 * i + 4);
                u32x4 o; o.x = pk2(f[0] * r * g0.x, f[1] * r * g0.y); o.y = pk2(f[2] * r * g0.z, f[3] * r * g0.w); o.z = pk2(f[4] * r * g1.x, f[5] * r * g1.y); o.w = pk2(f[6] * r * g1.z, f[7] * r * g1.w);
                *(u32x4*)(ptr + 8 * i) = o; }
        }
    }
    __syncthreads();
    f32x16 acc[2][4];
#pragma unroll
    for (int e2 = 0; e2 < 2; ++e2)
#pragma unroll
        for (int db = 0; db < 4; ++db) acc[e2][db] = (f32x16){0.f, 0.f, 0.f, 0.f, 0.f, 0.f, 0.f, 0.f, 0.f, 0.f, 0.f, 0.f, 0.f, 0.f, 0.f, 0.f};
    {
        const int tro = ((lane >> 4) & 1) * 32 + (lane & 3) * 8 + (4 * hi + ((lane & 15) >> 2)) * 64;
#pragma unroll
        for (int ks = 0; ks < 4; ++ks) {
            const bf16x8 a0 = trfrag(vimg + tro + (2 * half) * 4096 + ks * 1024), a1 = trfrag(vimg + tro + (2 * half + 1) * 4096 + ks * 1024);
#pragma unroll
            for (int db = 0; db < 4; ++db) {
                const bf16x8 bfr = trfrag(kimg + tro + db * 4096 + ks * 1024);
                acc[0][db] = __builtin_amdgcn_mfma_f32_32x32x16_bf16(a0, bfr, acc[0][db], 0, 0, 0);
                acc[1][db] = __builtin_amdgcn_mfma_f32_32x32x16_bf16(a1, bfr, acc[1][db], 0, 0, 0);
            }
        }
    }
    {
        const int hh = tid >> 7, d = tid & 127;
        MLS_LAS const bf16_t* kp = (MLS_LAS const bf16_t*)(lds + hh * 32768 + 16384 + (d >> 5) * 4096) + (d & 31);
        float sm = 0.f;
#pragma unroll 8
        for (int s2 = 0; s2 < 64; ++s2) sm += bf2f(kp[s2 * 32]);
        STN[(size_t)((b * 4 + hh) * 64 + c) * 128 + d] = sm;
    }
    __syncthreads();
    {
        MLS_LAS bf16_t* stg = (MLS_LAS bf16_t*)(lds + h * 32768 + half * 16384);
#pragma unroll
        for (int e2 = 0; e2 < 2; ++e2)
#pragma unroll
            for (int db = 0; db < 4; ++db)
#pragma unroll
                for (int r = 0; r < 16; ++r) stg[(32 * e2 + att::crow(r, hi)) * 128 + 32 * db + r32] = f2bf(acc[e2][db][r]);
        asm volatile("s_waitcnt lgkmcnt(0)" ::: "memory");
        bf16_t* dst = ST + ((size_t)(bh * 64 + c) * 128 + 64 * half) * 128;
#pragma unroll 4
        for (int it = 0; it < 16; ++it) {
            const int idx = it * 64 + lane;
            *(u32x4*)(dst + (size_t)idx * 8) = *(MLS_LAS const u32x4*)(stg + idx * 8);
        }
    }
    __syncthreads();
}

constexpr int LO_V = 0, LO_STG = 65536, LO_G = 131072;
__device__ void out_unit(const Params& p, int l, int b, int c, MLS_LAS unsigned char* lds) {
    unsigned char* ws = p.ws;
    const bf16_t* proj = (const bf16_t*)(ws + WS_PROJ); const float* gates = (const float*)(ws + WS_GATES);
    const bf16_t* qkc = (const bf16_t*)(ws + WS_XB);
    const bf16_t* ST = (const bf16_t*)(ws + WS_ST); const float* STN = (const float*)(ws + WS_STN); const float* STM = (const float*)(ws + WS_STM);
    const float* fb = p.in[I_FB] + l * 4; const float* ogm = p.in[I_OGM] + l * 512;
    bf16_t* Y = (bf16_t*)(ws + WS_Y);
    const int tid = my_tid(), lane = tid & 63, wave = __builtin_amdgcn_readfirstlane(tid >> 6), r32 = lane & 31, hi = lane >> 5, h = wave >> 1, th = wave & 1;
    const size_t m0 = (size_t)b * SEQ + 64 * c; const int bh = b * 4 + h;
    MLS_LAS unsigned char* vimg = lds + LO_V + h * 16384;
    MLS_LAS float* garr = (MLS_LAS float*)(lds + LO_G + wave * 512);
#pragma unroll 4
    for (int it = 0; it < 8; ++it) {
        const int s = 32 * th + 4 * it + (lane >> 4), pc = lane & 15;
        const u32x4 rv = *(const u32x4*)(proj + (m0 + s) * NPROJ + C_VB + h * 128 + pc * 8);
        *(MLS_LAS u32x4*)(vimg + (pc >> 2) * 4096 + s * 64 + (pc & 3) * 16) = rv;
    }
    {
        const float lf = log_sigmoid_f(gates[(m0 + lane) * 32 + 28 + h] + fb[h]);
        garr[lane] = incl_scan64(lf, lane);
        garr[64 + lane] = gates[(m0 + lane) * 32 + 24 + h];
    }
    const float mprev = STM[4096 + bh * 64 + c];
    const int tl = 32 * th + r32;
    bf16x8 qf[8];
#pragma unroll
    for (int ks = 0; ks < 8; ++ks) qf[ks] = __builtin_bit_cast(bf16x8, *(const u32x4*)(qkc + (m0 + tl) * 1024 + h * 128 + 16 * ks + 8 * hi));
    f32x16 p0 = (f32x16){0.f, 0.f, 0.f, 0.f, 0.f, 0.f, 0.f, 0.f, 0.f, 0.f, 0.f, 0.f, 0.f, 0.f, 0.f, 0.f}, p1 = p0;
#pragma unroll
    for (int ks = 0; ks < 8; ++ks) {
        const bf16x8 k0 = __builtin_bit_cast(bf16x8, *(const u32x4*)(qkc + (m0 + r32) * 1024 + 512 + h * 128 + 16 * ks + 8 * hi));
        const bf16x8 k1 = __builtin_bit_cast(bf16x8, *(const u32x4*)(qkc + (m0 + 32 + r32) * 1024 + 512 + h * 128 + 16 * ks + 8 * hi));
        p0 = __builtin_amdgcn_mfma_f32_32x32x16_bf16(k0, qf[ks], p0, 0, 0, 0);
        p1 = __builtin_amdgcn_mfma_f32_32x32x16_bf16(k1, qf[ks], p1, 0, 0, 0);
    }
    float qn = 0.f;
    {
        const float* np = STN + (size_t)(bh * 64 + c) * 128;
#pragma unroll
        for (int ks = 0; ks < 8; ++ks) {
            const f32x4 n0 = *(const f32x4*)(np + 16 * ks + 8 * hi), n1 = *(const f32x4*)(np + 16 * ks + 8 * hi + 4);
            float f[8]; unpack8(__builtin_bit_cast(u32x4, qf[ks]), f);
            qn += (f[0] * n0.x + f[1] * n0.y) + (f[2] * n0.z + f[3] * n0.w) + (f[4] * n1.x + f[5] * n1.y) + (f[6] * n1.z + f[7] * n1.w);
        }
        qn += __shfl_xor(qn, 32);
    }
    asm volatile("s_waitcnt lgkmcnt(0)" ::: "memory");
    const float bt = garr[tl];
    float dv0[16], dv1[16]; float mx = -INFINITY;
#pragma unroll
    for (int r = 0; r < 16; ++r) {
        const int s0 = att::crow(r, hi);
        dv0[r] = s0 <= tl ? bt - garr[s0] + garr[64 + s0] : -INFINITY;
        dv1[r] = s0 + 32 <= tl ? bt - garr[s0 + 32] + garr[64 + s0 + 32] : -INFINITY;
        mx = fmaxf(mx, fmaxf(dv0[r], dv1[r]));
    }
    mx = fmaxf(mx, __shfl_xor(mx, 32));
    const float a_t = bt + mprev;
    const float m_t = fmaxf(a_t, mx);
    float dsum = 0.f;
#pragma unroll
    for (int r = 0; r < 16; ++r) {
        p0[r] = __expf(dv0[r] - m_t) * p0[r];
        p1[r] = __expf(dv1[r] - m_t) * p1[r];
        dsum += p0[r] + p1[r];
    }
    dsum += __shfl_xor(dsum, 32);
    const float winter = __expf(a_t - m_t);
    const float den = winter * qn + dsum;
    const float scl = 1.f / fmaxf(fabsf(den), __expf(-m_t));
    const float fq = winter * scl;
    bf16x8 pa[4];
#pragma unroll
    for (int s2 = 0; s2 < 2; ++s2) {
        u32x4 w0, w1;
        w0.x = att::cvtpk(p0[8 * s2 + 0] * scl, p0[8 * s2 + 1] * scl); w0.y = att::cvtpk(p0[8 * s2 + 2] * scl, p0[8 * s2 + 3] * scl); w0.z = att::cvtpk(p0[8 * s2 + 4] * scl, p0[8 * s2 + 5] * scl); w0.w = att::cvtpk(p0[8 * s2 + 6] * scl, p0[8 * s2 + 7] * scl);
        w1.x = att::cvtpk(p1[8 * s2 + 0] * scl, p1[8 * s2 + 1] * scl); w1.y = att::cvtpk(p1[8 * s2 + 2] * scl, p1[8 * s2 + 3] * scl); w1.z = att::cvtpk(p1[8 * s2 + 4] * scl, p1[8 * s2 + 5] * scl); w1.w = att::cvtpk(p1[8 * s2 + 6] * scl, p1[8 * s2 + 7] * scl);
        pa[s2] = __builtin_bit_cast(bf16x8, w0); pa[2 + s2] = __builtin_bit_cast(bf16x8, w1);
    }
#pragma unroll
    for (int ks = 0; ks < 8; ++ks) {
        float f[8]; unpack8(__builtin_bit_cast(u32x4, qf[ks]), f);
        u32x4 w; w.x = att::cvtpk(f[0] * fq, f[1] * fq); w.y = att::cvtpk(f[2] * fq, f[3] * fq); w.z = att::cvtpk(f[4] * fq, f[5] * fq); w.w = att::cvtpk(f[6] * fq, f[7] * fq);
        qf[ks] = __builtin_bit_cast(bf16x8, w);
    }
    f32x16 acc[4];
#pragma unroll
    for (int eb = 0; eb < 4; ++eb) acc[eb] = (f32x16){0.f, 0.f, 0.f, 0.f, 0.f, 0.f, 0.f, 0.f, 0.f, 0.f, 0.f, 0.f, 0.f, 0.f, 0.f, 0.f};
    {
        const bf16_t* cp = ST + (size_t)(bh * 64 + c) * 16384 + (size_t)r32 * 128 + 8 * hi;
#pragma unroll
        for (int eb = 0; eb < 4; ++eb)
#pragma unroll
            for (int ks = 0; ks < 8; ++ks) {
                const bf16x8 cf = __builtin_bit_cast(bf16x8, *(const u32x4*)(cp + eb * 32 * 128 + 16 * ks));
                acc[eb] = __builtin_amdgcn_mfma_f32_32x32x16_bf16(qf[ks], cf, acc[eb], 0, 0, 0);
            }
    }
    __syncthreads();
    {
        const int tro = ((lane >> 4) & 1) * 32 + (lane & 3) * 8 + (4 * hi + ((lane & 15) >> 2)) * 64;
#pragma unroll
        for (int eb = 0; eb < 4; ++eb)
#pragma unroll
            for (int ks = 0; ks < 4; ++ks) acc[eb] = __builtin_amdgcn_mfma_f32_32x32x16_bf16(pa[ks], trfrag(vimg + tro + eb * 4096 + ks * 1024), acc[eb], 0, 0, 0);
    }
    {
        MLS_LAS bf16_t* stg = (MLS_LAS bf16_t*)(lds + LO_STG + wave * 8192);
        float gn[4];
#pragma unroll
        for (int eb = 0; eb < 4; ++eb) gn[eb] = ogm[h * 128 + 32 * eb + r32];
#pragma unroll
        for (int r = 0; r < 16; ++r) {
            float sq = (acc[0][r] * acc[0][r] + acc[1][r] * acc[1][r]) + (acc[2][r] * acc[2][r] + acc[3][r] * acc[3][r]);
            sq += __shfl_xor(sq, 1); sq += __shfl_xor(sq, 2); sq += __shfl_xor(sq, 4); sq += __shfl_xor(sq, 8); sq += __shfl_xor(sq, 16);
            const float rs = rsqrtf(sq * (1.f / 128.f) + EPS);
            const int q = att::crow(r, hi);
#pragma unroll
            for (int eb = 0; eb < 4; ++eb) stg[q * 128 + 32 * eb + r32] = f2bf(acc[eb][r] * rs * gn[eb]);
        }
        asm volatile("s_waitcnt lgkmcnt(0)" ::: "memory");
#pragma unroll 2
        for (int it = 0; it < 8; ++it) {
            const int idx = it * 64 + lane, row = idx >> 4, pc = idx & 15;
            const u32x4 hv = *(MLS_LAS const u32x4*)(stg + row * 128 + pc * 8);
            const u32x4 ov = *(const u32x4*)(proj + (m0 + 32 * th + row) * NPROJ + C_OB + h * 128 + pc * 8);
            float fh[8], fo[8]; unpack8(hv, fh); unpack8(ov, fo);
            float y[8];
#pragma unroll
            for (int j = 0; j < 8; ++j) y[j] = fh[j] * sigmoid_f(fo[j]);
            u32x4 o; o.x = pk2(y[0], y[1]); o.y = pk2(y[2], y[3]); o.z = pk2(y[4], y[5]); o.w = pk2(y[6], y[7]);
            *(u32x4*)(Y + (m0 + 32 * th + row) * 1024 + 512 + h * 128 + pc * 8) = o;
        }
    }
    __syncthreads();
}
}

__device__ void phase_chunkstate_mfma(const Params& p, int l, unsigned char* lds_raw) {
    for (int u = my_bid(); u < BATCH * 64; u += gridDim.x) mls::chunk_unit(p, l, u >> 6, u & 63, (MLS_LAS unsigned char*)lds_raw);
}
__device__ void phase_mlstm_out_mfma(const Params& p, int l, unsigned char* lds_raw) {
    for (int u = my_bid(); u < BATCH * 64; u += gridDim.x) mls::out_unit(p, l, u >> 6, u & 63, (MLS_LAS unsigned char*)lds_raw);
}

namespace cmpx {
typedef short bf16x8 __attribute__((ext_vector_type(8)));
typedef float f32x16 __attribute__((ext_vector_type(16)));
#define CMP_LAS __attribute__((address_space(3)))
constexpr int LC_PART = 0  , LC_HID = 32768  ;
__device__ void unit(const Params& p, int l, int b, int g, int kv, int ib, CMP_LAS unsigned char* lds) {
    unsigned char* ws = p.ws;
    const bf16_t* proj = (const bf16_t*)(ws + WS_PROJ);
    const bf16_t* w1t = (const bf16_t*)(ws + WS_CW1) + (size_t)(l * 2 + kv) * 128 * 2048;
    const bf16_t* w2t = (const bf16_t*)(ws + WS_W2T) + (size_t)(l * 2 + kv) * 64 * 128;
    const float* peb = (const float*)(ws + WS_PEB) + (l * 2 + kv) * 128;
    const float* kg0 = p.in[I_KG] + l * 192;
    const int tid = my_tid(), lane = tid & 63, wave = __builtin_amdgcn_readfirstlane(tid >> 6), r32 = lane & 31, hi = lane >> 5, hb = wave & 3, kh = wave >> 2;
    const int col = (kv ? C_VC : C_KC) + g * 64;
    const int i = 32 * ib + r32;
    const f32x16 zero16 = (f32x16){0.f, 0.f, 0.f, 0.f, 0.f, 0.f, 0.f, 0.f, 0.f, 0.f, 0.f, 0.f, 0.f, 0.f, 0.f, 0.f};
    {
        f32x16 acc = zero16;
        const bf16_t* bp = w1t + (size_t)(32 * hb + r32) * 2048 + 1024 * kh + 8 * hi;
        const int tok0 = 16 * i + 16 * kh;
#pragma unroll 8
        for (int ks = 0; ks < 64; ++ks) {
            int tok = tok0 + (ks >> 2); tok = tok < SEQ ? tok : SEQ - 1;
            const bf16x8 af = __builtin_bit_cast(bf16x8, *(const u32x4*)(proj + ((size_t)b * SEQ + tok) * NPROJ + col + 16 * (ks & 3) + 8 * hi));
            const bf16x8 bf = __builtin_bit_cast(bf16x8, *(const u32x4*)(bp + 16 * ks));
            acc = __builtin_amdgcn_mfma_f32_32x32x16_bf16(af, bf, acc, 0, 0, 0);
        }
        CMP_LAS float* part = (CMP_LAS float*)(lds + LC_PART) + kh * 32 * 128;
#pragma unroll
        for (int r = 0; r < 16; ++r) part[att::crow(r, hi) * 128 + 32 * hb + r32] = acc[r];
    }
    __syncthreads();
    {
        const CMP_LAS float* part = (const CMP_LAS float*)(lds + LC_PART);
        CMP_LAS bf16_t* hbuf = (CMP_LAS bf16_t*)(lds + LC_HID);
#pragma unroll
        for (int e = 0; e < 8; ++e) {
            const int idx = e * NT + tid, row = idx >> 7, hid = idx & 127;
            hbuf[row * 136 + hid] = f2bf(silu_f(part[idx] + part[4096 + idx] + peb[hid]));
        }
    }
    __syncthreads();
    if (wave == 0) {
        const CMP_LAS bf16_t* hbuf = (const CMP_LAS bf16_t*)(lds + LC_HID);
        f32x16 o0 = zero16, o1 = zero16;
#pragma unroll
        for (int ks = 0; ks < 8; ++ks) {
            const bf16x8 af = *(const CMP_LAS bf16x8*)(hbuf + r32 * 136 + 16 * ks + 8 * hi);
            const bf16x8 b0 = __builtin_bit_cast(bf16x8, *(const u32x4*)(w2t + (size_t)r32 * 128 + 16 * ks + 8 * hi));
            const bf16x8 b1 = __builtin_bit_cast(bf16x8, *(const u32x4*)(w2t + (size_t)(32 + r32) * 128 + 16 * ks + 8 * hi));
            o0 = __builtin_amdgcn_mfma_f32_32x32x16_bf16(af, b0, o0, 0, 0, 0);
            o1 = __builtin_amdgcn_mfma_f32_32x32x16_bf16(af, b1, o1, 0, 0, 0);
        }
        bf16_t* dst = (bf16_t*)(ws + (kv ? WS_VCMP : WS_KCMP)) + (size_t)(b * 2 + g) * NCMPP * 64;
        const float g0 = kv ? 1.f : kg0[r32], g1 = kv ? 1.f : kg0[32 + r32];
#pragma unroll
        for (int r = 0; r < 16; ++r) {
            float rs = 1.f;
            if (kv == 0) {
                float sq = o0[r] * o0[r] + o1[r] * o1[r];
                sq += __shfl_xor(sq, 1); sq += __shfl_xor(sq, 2); sq += __shfl_xor(sq, 4); sq += __shfl_xor(sq, 8); sq += __shfl_xor(sq, 16);
                rs = rsqrtf(sq * (1.f / 64.f) + EPS);
            }
            const int row = 32 * ib + att::crow(r, hi);
            const bool ok = row < NCMP;
            dst[(size_t)row * 64 + r32] = ok ? f2bf(o0[r] * rs * g0) : (bf16_t)0;
            dst[(size_t)row * 64 + 32 + r32] = ok ? f2bf(o1[r] * rs * g1) : (bf16_t)0;
        }
    }
    __syncthreads();
}
}
__device__ void phase_compress_mfma(const Params& p, int l, unsigned char* lds_raw) {
    for (int u = my_bid(); u < BATCH * 2 * 2 * 8; u += gridDim.x) cmpx::unit(p, l, u >> 5, (u >> 4) & 1, (u >> 3) & 1, u & 7, (CMP_LAS unsigned char*)lds_raw);
}

#define XB_TMO      128
#define XB_XCNT(j)  (256  + 64 * (j))
#define XB_XSUB(j)  (1280 + 64 * (j))
#define XB_XGEN(j)  (2304 + 64 * (j))
#define XB_TOP      3328
#define XB_TOPGEN   3392
#define XCD_BAR_WORDS 3456
#define XB_SPIN_CAP (1u << 18)
#define XLAS __attribute__((address_space(3)))
__device__ __forceinline__ unsigned xb_ld(unsigned* p)              { return __hip_atomic_load(p, __ATOMIC_RELAXED, __HIP_MEMORY_SCOPE_AGENT); }
__device__ __forceinline__ unsigned xb_add(unsigned* p, unsigned v) { return __hip_atomic_fetch_add(p, v, __ATOMIC_RELAXED, __HIP_MEMORY_SCOPE_AGENT); }
__device__ __forceinline__ unsigned xb_xcc_id() { return (unsigned)__builtin_amdgcn_s_getreg((3 << 11) | 20) & 0xFu; }
#define XB_SPIN(cond, bar) do { unsigned _sp = 0; while (cond) { __builtin_amdgcn_s_sleep(1); \
    if ((++_sp & 255u) == 0u) { if (xb_ld(&(bar)[XB_TMO])) break; if (_sp > XB_SPIN_CAP) { atomicAdd(&(bar)[XB_TMO], 1u); break; } } } } while (0)
struct XcdBarrier { unsigned* bar; unsigned x; volatile XLAS unsigned* st; };
__device__ __forceinline__ XcdBarrier xcd_barrier_post(unsigned* bar, volatile XLAS unsigned* st) {
    XcdBarrier b; b.bar = bar; b.x = xb_xcc_id(); b.st = st;
    if (threadIdx.x == 0) (void)xb_add(&bar[XB_XCNT(b.x)], 1u);
    return b;
}
__device__ __forceinline__ void xcd_barrier_complete(unsigned* bar, unsigned x, unsigned& nloc, unsigned& nx) {
    const unsigned G = gridDim.x * gridDim.y * gridDim.z;
    unsigned sum, cnt, mine, sp = 0u;
    for (;;) {
        sum = 0u; cnt = 0u; mine = 0u;
#pragma unroll
        for (unsigned j = 0; j < 16; ++j) { const unsigned c = xb_ld(&bar[XB_XCNT(j)]); sum += c; cnt += (c > 0u) ? 1u : 0u; mine = (j == x) ? c : mine; }
        if (sum == G) break;
        __builtin_amdgcn_s_sleep(1);
        if ((++sp & 255u) == 0u) { if (xb_ld(&bar[XB_TMO])) break; if (sp > XB_SPIN_CAP) { atomicAdd(&bar[XB_TMO], 1u); break; } }
    }
    nloc = mine > 0u ? mine : 1u; nx = cnt > 0u ? cnt : 1u;
}
__device__ __forceinline__ void xcd_barrier(const XcdBarrier& b) {
    asm volatile("s_waitcnt vmcnt(0)" ::: "memory");
    __syncthreads();
    if (threadIdx.x == 0) {
        unsigned* bar = b.bar;
        __builtin_amdgcn_s_waitcnt(0);
        unsigned nloc = b.st[0], nx = b.st[1];
        if (nloc == 0u) { xcd_barrier_complete(bar, b.x, nloc, nx); b.st[0] = nloc; b.st[1] = nx; }
        const unsigned old = xb_add(&bar[XB_XSUB(b.x)], 1u);
        const unsigned gen = old / nloc;
        if (old + 1u == (gen + 1u) * nloc) {
            __builtin_amdgcn_fence(__ATOMIC_RELEASE, "agent");
            asm volatile("s_waitcnt vmcnt(0)" ::: "memory");
            const unsigned og = xb_add(&bar[XB_TOP], 1u);
            const unsigned tg = og / nx;
            if (og + 1u == (tg + 1u) * nx) xb_add(&bar[XB_TOPGEN], 1u);
            else XB_SPIN(xb_ld(&bar[XB_TOPGEN]) == tg, bar);
            __builtin_amdgcn_fence(__ATOMIC_ACQUIRE, "agent");
            xb_add(&bar[XB_XGEN(b.x)], 1u);
            asm volatile("s_waitcnt vmcnt(0)" ::: "memory");
        } else {
            XB_SPIN(xb_ld(&bar[XB_XGEN(b.x)]) == gen, bar);
            __builtin_amdgcn_fence(__ATOMIC_ACQUIRE, "agent");
            asm volatile("s_waitcnt vmcnt(0)" ::: "memory");
        }
    }
    __syncthreads();
}

#ifndef DUP
#define DUP 0
#endif
#define REP(bit) for (int rep_ = 0; rep_ < ((DUP & (bit)) ? 2 : 1); ++rep_)
constexpr int NPHASE = 1 + 7 * DEPTH;
template <bool COOP, int PMASK>
__global__ void __launch_bounds__(NT) mega(Params p) {
    extern __shared__ __attribute__((aligned(16))) unsigned char lds_raw[];
    float* lds = (float*)lds_raw;
    unsigned char* ws = p.ws;
    volatile XLAS unsigned* bst = (volatile XLAS unsigned*)((XLAS unsigned char*)lds_raw + LDS_BYTES - 16);
    if (threadIdx.x < 4) bst[threadIdx.x] = 0u;
    __syncthreads();
    XcdBarrier gbar = xcd_barrier_post((unsigned*)(ws + WS_CTL), bst);
#ifndef PROBE_MASK
#define PROBE_MASK 0
#endif
    unsigned long long pr_t0 = 0, pr_acc = 0;
    for (int ph = p.lo; ph < p.hi; ++ph) {
        if (PROBE_MASK && ((PROBE_MASK >> ph) & 1)) pr_t0 = __builtin_amdgcn_s_memrealtime();
        if (ph == 0) {
            if (PMASK & 128) phase_prologue(p, lds);
        } else {
            const int l = (ph - 1) / 7, k = (ph - 1) % 7;
            if (k == 0 && (PMASK & 1)) {
                pg8::Gemm g{(const bf16_t*)(ws + WS_XB), (const bf16_t*)(ws + WS_WIN) + (size_t)l * NPAD * DM, M, NPAD, DM};
                pg8::StaticOrder S; S.init(M, NPAD, (int)gridDim.x, (int)blockIdx.x);
                pg8::EpiInT E{(const float*)(ws + WS_SS), (const float*)(ws + WS_BIAS) + l * NPAD, (bf16_t*)(ws + WS_PROJ), (float*)(ws + WS_GATES)};
                REP(1) pg8::gemm_phase<pg8::EpiInT, pg8::StaticOrder, true, true>((PG8_LAS unsigned char*)lds_raw, g, S, E);
            } else if (k == 1 && (PMASK & 2)) {
                REP(2) phase_compress_mfma(p, l, lds_raw);
                REP(4) phase_chunkstate_mfma(p, l, lds_raw);
            } else if (k == 2 && (PMASK & 4)) {
                phase_scan(p);
                REP(8) phase_attn_mfma(p, l, lds_raw);
            } else if (k == 3 && (PMASK & 8)) {
                REP(16) phase_mlstm_out_mfma(p, l, lds_raw);
            } else if (k == 4 && (PMASK & 16)) {
                pg8::Gemm g{(const bf16_t*)(ws + WS_Y), (const bf16_t*)(ws + WS_WOUT) + (size_t)l * DM * DM, M, DM, DM};
                pg8::StaticOrder S; S.init(M, DM, (int)gridDim.x, (int)blockIdx.x);
                pg8::EpiResT E{l == 0 ? p.in[I_X] : p.out, p.out, (bf16_t*)(ws + WS_XB), (float*)(ws + WS_SS)};
                pg8::gemm_phase<pg8::EpiResT, pg8::StaticOrder, true, true>((PG8_LAS unsigned char*)lds_raw, g, S, E);
            } else if (k == 5 && (PMASK & 32)) {
                pg8::Gemm g{(const bf16_t*)(ws + WS_XB), (const bf16_t*)(ws + WS_WGU) + (size_t)l * NGU * DM, M, NGU, DM};
                pg8::StaticOrder S; S.init(M, NGU, (int)gridDim.x, (int)blockIdx.x);
                pg8::EpiGUT E{(const float*)(ws + WS_SS), (bf16_t*)(ws + WS_PROJ)};
                REP(32) pg8::gemm_phase<pg8::EpiGUT, pg8::StaticOrder, true, true>((PG8_LAS unsigned char*)lds_raw, g, S, E);
            } else if (k == 6 && (PMASK & 64)) {
                pg8::Gemm g{(const bf16_t*)(ws + WS_PROJ), (const bf16_t*)(ws + WS_WD) + (size_t)l * DM * FF, M, DM, FF};
                pg8::StaticOrder S; S.init(M, DM, (int)gridDim.x, (int)blockIdx.x);
                pg8::EpiResT E{p.out, p.out, (bf16_t*)(ws + WS_XB), (float*)(ws + WS_SS)};
                pg8::gemm_phase<pg8::EpiResT, pg8::StaticOrder, true, true>((PG8_LAS unsigned char*)lds_raw, g, S, E);
            }
        }
        if (COOP && ph + 1 < p.hi) {
            if (ph == 0) cg::this_grid().sync();
            else xcd_barrier(gbar);
        }
        if (PROBE_MASK && ((PROBE_MASK >> ph) & 1)) pr_acc += __builtin_amdgcn_s_memrealtime() - pr_t0;
    }
    if (PROBE_MASK && blockIdx.x == 0) {
        const unsigned long long te = __builtin_amdgcn_s_memrealtime();
        while (__builtin_amdgcn_s_memrealtime() - te < 4ull * pr_acc) __builtin_amdgcn_s_sleep(8);
    }
}

extern "C" void kernel_launch(void* const* d_in, const int* in_sizes, int n_in, void* d_out, int out_size, void* d_ws, size_t ws_size, hipStream_t stream) {
    static int grid = 0;
    if (grid == 0) {
        if (n_in != 18 || ws_size < WS_END) { fprintf(stderr, "kernel_launch: unexpected n_in %d / ws_size %zu\n", n_in, ws_size); grid = -1; return; }
        int dev = 0, cus = 0, per_cu = 0;
        (void)hipGetDevice(&dev);
        (void)hipDeviceGetAttribute(&cus, hipDeviceAttributeMultiprocessorCount, dev);
        (void)hipFuncSetAttribute((const void*)mega<true, 0xff>, hipFuncAttributeMaxDynamicSharedMemorySize, LDS_BYTES);
        (void)hipOccupancyMaxActiveBlocksPerMultiprocessor(&per_cu, (const void*)mega<true, 0xff>, NT, LDS_BYTES);
        if (per_cu < 1) { fprintf(stderr, "kernel_launch: occupancy query reports %d blocks/CU\n", per_cu); grid = -1; return; }
        grid = (cus > 0 ? cus : 256) * 1;
        (void)hipGetLastError();
    }
    if (grid < 0) return;
    Params p{};
    for (int i = 0; i < 18; ++i) p.in[i] = (const float*)d_in[i];
    p.out = (float*)d_out; p.ws = (unsigned char*)d_ws;
    p.lo = 0; p.hi = NPHASE;
    (void)hipMemsetAsync((unsigned char*)d_ws + WS_CTL, 0, 16384, stream);
    void* args[] = {&p};
    hipError_t e = hipLaunchCooperativeKernel((const void*)mega<true, 0xff>, dim3(grid), dim3(NT), args, LDS_BYTES, stream);
    if (e != hipSuccess) fprintf(stderr, "cooperative launch failed: %s (grid %d)\n", hipGetErrorString(e), grid);
}
```

```cpp
#include <hip/hip_runtime.h>
#include <hip/hip_cooperative_groups.h>
#include <cstdint>
#include <cstdio>
namespace cg = cooperative_groups;

typedef unsigned short bf16_t;
typedef unsigned u32x4 __attribute__((ext_vector_type(4)));
typedef unsigned u32x2 __attribute__((ext_vector_type(2)));
typedef float f32x4 __attribute__((ext_vector_type(4)));

constexpr int BATCH = 8, SEQ = 4096, DM = 1024, M = BATCH * SEQ, DEPTH = 2;
constexpr int NIN = 3360, NPROJ = 3328, NPAD = 3584, FF = 2816, NGU = 2 * FF;
constexpr int NCMP = 255, NCMPP = 256;
constexpr float EPS = 1e-6f;
constexpr int NT = 512;
constexpr int LDS_BYTES = 152 * 1024;

constexpr int C_QA = 0, C_KC = 512, C_VC = 640, C_KS = 768, C_VS = 896, C_KW = 1024, C_VW = 1152, C_QB = 1280, C_KB = 1792, C_VB = 2304, C_OB = 2816;

constexpr size_t MiB = 1u << 20;
constexpr size_t WS_CTL = 0;
constexpr size_t WS_WIN = 1 * MiB;
constexpr size_t WS_WOUT = 15 * MiB;
constexpr size_t WS_WGU = 19 * MiB;
constexpr size_t WS_WD = 41 * MiB;
constexpr size_t WS_BIAS = 52 * MiB;
constexpr size_t WS_SS = 53 * MiB;
constexpr size_t WS_GATES = 55 * MiB;
constexpr size_t WS_KCMP = 59 * MiB;
constexpr size_t WS_VCMP = 59 * MiB + 512 * 1024;
constexpr size_t WS_STN = 60 * MiB;
constexpr size_t WS_STM = 61 * MiB;
constexpr size_t WS_W2T = 61 * MiB + 256 * 1024;
constexpr size_t WS_PEB = 61 * MiB + 512 * 1024;
constexpr size_t WS_CW1 = 62 * MiB;
constexpr size_t WS_XB = 64 * MiB;
constexpr size_t WS_Y = 128 * MiB;
constexpr size_t WS_ST = 192 * MiB;
constexpr size_t WS_PROJ = 256 * MiB;
constexpr size_t WS_END = 464 * MiB;

struct Params {
    const float* in[18];
    float* out;
    unsigned char* ws;
    int lo, hi;
};
enum { I_X = 0, I_LN1, I_WIN, I_BIN, I_QG, I_KG, I_PE, I_W1, I_W2, I_CW, I_CB, I_FB, I_OGA, I_OGM, I_WOUT, I_LN2, I_WGU, I_WD };

__device__ __forceinline__ float bf2f(bf16_t v) { return __uint_as_float(((unsigned)v) << 16); }
__device__ __forceinline__ bf16_t f2bf(float f) { unsigned u = __float_as_uint(f); return (bf16_t)((u + 0x7fffu + ((u >> 16) & 1u)) >> 16); }
__device__ __forceinline__ unsigned pk2(float lo, float hi) { return (unsigned)f2bf(lo) | ((unsigned)f2bf(hi) << 16); }
__device__ __forceinline__ float lo16(unsigned w) { return __uint_as_float(w << 16); }
__device__ __forceinline__ float hi16(unsigned w) { return __uint_as_float(w & 0xffff0000u); }
__device__ __forceinline__ float silu_f(float x) { return x / (1.f + __expf(-x)); }
__device__ __forceinline__ float sigmoid_f(float x) { return 1.f / (1.f + __expf(-x)); }
__device__ __forceinline__ float wave_sum(float v) {
#pragma unroll
    for (int o = 1; o < 64; o <<= 1) v += __shfl_xor(v, o);
    return v;
}
__device__ __forceinline__ float wave_max(float v) {
#pragma unroll
    for (int o = 1; o < 64; o <<= 1) v = fmaxf(v, __shfl_xor(v, o));
    return v;
}
__device__ __forceinline__ int my_tid() { int t = threadIdx.x; asm volatile("" : "+v"(t)); return t; }
__device__ __forceinline__ int my_bid() { int b = blockIdx.x; asm volatile("" : "+s"(b)); return b; }
__device__ __forceinline__ void unpack8(u32x4 w, float* f) {
    f[0] = lo16(w.x); f[1] = hi16(w.x); f[2] = lo16(w.y); f[3] = hi16(w.y);
    f[4] = lo16(w.z); f[5] = hi16(w.z); f[6] = lo16(w.w); f[7] = hi16(w.w);
}

__device__ __forceinline__ int in_srccol(int n) {
    if (n < 1280) return n;
    if (n < 2816) return n + 24;
    if (n < 3328) return n + 32;
    if (n < 3352) return n - 3328 + 1280;
    if (n < 3360) return n - 3352 + 2840;
    return -1;
}
__device__ __forceinline__ int gu_srccol(int n) {
    const int t = n >> 8, w = n & 255;
    return (w < 128) ? (t * 128 + w) : (FF + t * 128 + (w - 128));
}

struct ConvJob { const float* W; bf16_t* WT; const float* kscale; int K, Nsrc, mode; };
__device__ __forceinline__ bool conv_locate(const Params& p, int ti, ConvJob& J, int& local) {
    constexpr int T_IN = 16 * 56, T_OUT = 16 * 16, T_GU = 16 * 88, T_D = 44 * 16, T_L = T_IN + T_OUT + T_GU + T_D, T_W1 = 32 * 2, T_W2 = 2, T_S = T_W1 + T_W2;
    unsigned char* ws = p.ws;
    if (ti < DEPTH * T_L) {
        const int l = ti / T_L; int r = ti % T_L;
        if (r < T_IN) { J = ConvJob{p.in[I_WIN] + (size_t)l * DM * NIN, (bf16_t*)(ws + WS_WIN) + (size_t)l * NPAD * DM, p.in[I_LN1] + l * DM, DM, NIN, 1}; local = r; return true; }
        r -= T_IN;
        if (r < T_OUT) { J = ConvJob{p.in[I_WOUT] + (size_t)l * DM * DM, (bf16_t*)(ws + WS_WOUT) + (size_t)l * DM * DM, nullptr, DM, DM, 0}; local = r; return true; }
        r -= T_OUT;
        if (r < T_GU) { J = ConvJob{p.in[I_WGU] + (size_t)l * DM * NGU, (bf16_t*)(ws + WS_WGU) + (size_t)l * NGU * DM, p.in[I_LN2] + l * DM, DM, NGU, 2}; local = r; return true; }
        r -= T_GU;
        J = ConvJob{p.in[I_WD] + (size_t)l * FF * DM, (bf16_t*)(ws + WS_WD) + (size_t)l * DM * FF, nullptr, FF, DM, 0}; local = r; return true;
    }
    int r = ti - DEPTH * T_L;
    if (r >= DEPTH * 2 * T_S) return false;
    const int lk = r / T_S; r = r % T_S;
    if (r < T_W1) { J = ConvJob{p.in[I_W1] + (size_t)lk * 2048 * 128, (bf16_t*)(ws + WS_CW1) + (size_t)lk * 128 * 2048, nullptr, 2048, 128, 0}; local = r; return true; }
    J = ConvJob{p.in[I_W2] + (size_t)lk * 128 * 64, (bf16_t*)(ws + WS_W2T) + (size_t)lk * 64 * 128, nullptr, 128, 64, 0}; local = r - T_W1; return true;
}
__device__ void phase_prologue(const Params& p, float* lds) {
    unsigned char* ws = p.ws;
    const int tid = my_tid(), lane = tid & 63, wave = tid >> 6;
    constexpr int T_ALL = DEPTH * (16 * 56 + 16 * 16 + 16 * 88 + 44 * 16) + DEPTH * 2 * (64 + 2);
    for (int G = my_bid(); G < (T_ALL + 3) / 4; G += gridDim.x) {
#pragma unroll
        for (int t = 0; t < 4; ++t) {
            ConvJob J; int local;
            if (conv_locate(p, 4 * G + t, J, local)) {
                const int nk = J.K / 64, k0 = (local % nk) * 64, n0 = (local / nk) * 64;
                float* tile = lds + t * (64 * 65);
#pragma unroll
                for (int i = 0; i < 8; ++i) {
                    const int r = (tid >> 6) + 8 * i, c = tid & 63, n = n0 + c;
                    const int sc = J.mode == 0 ? n : (J.mode == 1 ? in_srccol(n) : gu_srccol(n));
                    float v = 0.f;
                    if (sc >= 0) v = J.W[(size_t)(k0 + r) * J.Nsrc + sc] * (J.kscale ? J.kscale[k0 + r] : 1.f);
                    tile[r * 65 + c] = v;
                }
            }
        }
        __syncthreads();
#pragma unroll
        for (int t = 0; t < 4; ++t) {
            ConvJob J; int local;
            if (conv_locate(p, 4 * G + t, J, local)) {
                const int nk = J.K / 64, k0 = (local % nk) * 64, n0 = (local / nk) * 64;
                const float* tile = lds + t * (64 * 65);
#pragma unroll
                for (int i = 0; i < 8; ++i) {
                    const int r = (tid >> 6) + 8 * i, c = tid & 63;
                    J.WT[(size_t)(n0 + r) * J.K + k0 + c] = f2bf(tile[c * 65 + r]);
                }
            }
        }
        __syncthreads();
    }
    {
        float* peb = (float*)(ws + WS_PEB);
        for (int o = my_bid() * 8 + wave; o < DEPTH * 2 * 128; o += gridDim.x * 8) {
            const int lk = o >> 7, hid = o & 127;
            const float* w1 = p.in[I_W1] + (size_t)lk * 2048 * 128 + hid; const float* pe = p.in[I_PE] + (size_t)lk * 2048;
            float sacc = 0.f;
#pragma unroll 8
            for (int f = lane; f < 2048; f += 64) sacc += w1[(size_t)f * 128] * pe[f];
            sacc = wave_sum(sacc);
            if (lane == 0) peb[o] = sacc;
        }
    }
    float* biasP = (float*)(ws + WS_BIAS);
    for (int i = my_bid() * NT + tid; i < DEPTH * NPAD; i += gridDim.x * NT) {
        const int l = i / NPAD, n = i % NPAD; const int sc = in_srccol(n);
        biasP[i] = sc >= 0 ? p.in[I_BIN][l * NIN + sc] : 0.f;
    }
    const float* x = p.in[I_X]; bf16_t* xb = (bf16_t*)(ws + WS_XB); float* ss = (float*)(ws + WS_SS);
    for (int m = (my_bid() * 8 + wave) * 2; m < M; m += gridDim.x * 16) {
        f32x4 v[2][4];
#pragma unroll
        for (int rr = 0; rr < 2; ++rr)
#pragma unroll
            for (int j = 0; j < 4; ++j) v[rr][j] = ((const f32x4*)(x + (size_t)(m + rr) * DM) + lane)[64 * j];
#pragma unroll
        for (int rr = 0; rr < 2; ++rr)
#pragma unroll
            for (int j = 0; j < 4; ++j) {
                const f32x4 q = v[rr][j];
                float sq = (q.x * q.x + q.y * q.y) + (q.z * q.z + q.w * q.w);
                sq += __shfl_xor(sq, 1); sq += __shfl_xor(sq, 2); sq += __shfl_xor(sq, 4); sq += __shfl_xor(sq, 8);
                if ((lane & 15) == 0) ss[(size_t)(m + rr) * 16 + 4 * j + (lane >> 4)] = sq;
                u32x2 o; o.x = pk2(q.x, q.y); o.y = pk2(q.z, q.w);
                *(u32x2*)(xb + (size_t)(m + rr) * DM + 256 * j + 4 * lane) = o;
            }
    }
}

namespace pg8 {
#define PG8_LAS __attribute__((address_space(3)))
typedef short bf16x8 __attribute__((ext_vector_type(8)));
constexpr int BM = 256, BK = 64, HALF = 128, HTB = HALF * BK * 2  , STAGE_BYTES = 8 * HTB, NXCD = 8, WGM = 8;
__host__ __device__ __forceinline__ int lds_byte(int r, int c) { const int st = (r >> 4) * 2 + (c >> 5), rr = r & 15, cc = c & 31, ob = rr * 64 + cc * 2; return st * 1024 + (ob ^ (((ob >> 9) & 1) << 5)); }
__host__ __device__ __forceinline__ void stage_rc(int b, int& R, int& C) { const int st = b / 1024, sb = b % 1024, swz = sb ^ (((sb >> 9) & 1) << 5); R = (st >> 1) * 16 + swz / 64; C = (st & 1) * 32 + (swz % 64) / 2; }
__host__ __device__ __forceinline__ int perm32(int rho) { const int n = rho >> 4, i = rho & 15; return 8 * (i >> 2) + 4 * n + (i & 3); }
struct Unit { int pm, pn; };
struct Gemm { const bf16_t* A; const bf16_t* Bt; int M, N, K; };
struct StaticOrder {
    int nM, nN, nwg, G, c;
    __host__ __device__ void init(int M_, int N_, int G_, int c_) { nM = M_ / BM; nN = N_ / BM; nwg = nM * nN; G = G_; c = c_; }
    __host__ __device__ bool next(int i, Unit& u) const {
        const long L = (long)i * G + c; if (L >= nwg) return false;
        int wgid = (int)L; { const int q = nwg / NXCD, r = nwg % NXCD, xcd = wgid % NXCD, off = wgid / NXCD; wgid = (xcd < r ? xcd * (q + 1) : r * (q + 1) + (xcd - r) * q) + off; }
        const int nig = WGM * nN, gid = wgid / nig, fm = gid * WGM, gsz = (nM - fm) < WGM ? (nM - fm) : WGM;
        u.pm = fm + ((wgid % nig) % gsz); u.pn = (wgid % nig) / gsz; return true;
    }
    __device__ __forceinline__ void a_ready(const Unit&) const {}
    __device__ __forceinline__ void done(const Unit&) const {}
};
__device__ __forceinline__ unsigned cvt_pk_bf16(float lo, float hi) { unsigned r; asm volatile("v_cvt_pk_bf16_f32 %0, %1, %2" : "=v"(r) : "v"(lo), "v"(hi)); return r; }

__device__ __forceinline__ float row_rstd(const float* ss, int row, int fq) {
    const f32x4 pq = *(const f32x4*)(ss + (size_t)row * 16 + 4 * fq);
    float s = (pq.x + pq.y) + (pq.z + pq.w);
    s += __shfl_xor(s, 16); s += __shfl_xor(s, 32);
    return rsqrtf(s * (1.f / DM) + EPS);
}
struct EpiInT {
    static constexpr bool PERM = true, AFTER_DRAIN = false;
    const float* ss; const float* bias; bf16_t* proj; float* gates;
    __device__ __forceinline__ void operator()(const f32x4 (&acc)[2][2][4][2], const Unit& u, int wr, int wc, int fr, int fq) const {
        const int row0 = u.pm * BM + wr * 64 + fr, col0 = u.pn * BM + wc * 32 + 8 * fq;
        f32x4 bv[2][2];
#pragma unroll
        for (int bj = 0; bj < 2; ++bj)
#pragma unroll
            for (int n = 0; n < 2; ++n) bv[bj][n] = *(const f32x4*)(bias + col0 + bj * HALF + 4 * n);
#pragma unroll
        for (int ai = 0; ai < 2; ++ai)
#pragma unroll
            for (int m = 0; m < 4; ++m) {
                const int row = row0 + ai * HALF + m * 16;
                const float r = row_rstd(ss, row, fq);
                if (u.pn < 13) {
                    bf16_t* rowp = proj + (size_t)row * NPROJ + col0;
#pragma unroll
                    for (int bj = 0; bj < 2; ++bj) {
                        const f32x4 v0 = acc[ai][bj][m][0] * r + bv[bj][0], v1 = acc[ai][bj][m][1] * r + bv[bj][1];
                        u32x4 w; w.x = cvt_pk_bf16(v0[0], v0[1]); w.y = cvt_pk_bf16(v0[2], v0[3]); w.z = cvt_pk_bf16(v1[0], v1[1]); w.w = cvt_pk_bf16(v1[2], v1[3]);
                        *(u32x4*)(rowp + bj * HALF) = w;
                    }
                } else if (wc == 0) {
                    const f32x4 v0 = acc[ai][0][m][0] * r + bv[0][0], v1 = acc[ai][0][m][1] * r + bv[0][1];
                    float* gp = gates + (size_t)row * 32 + 8 * fq;
                    *(f32x4*)gp = v0; *(f32x4*)(gp + 4) = v1;
                }
            }
    }
};
struct EpiResT {
    static constexpr bool PERM = true, AFTER_DRAIN = false;
    const float* base; float* out; bf16_t* xb; float* ss;
    __device__ __forceinline__ void operator()(const f32x4 (&acc)[2][2][4][2], const Unit& u, int wr, int wc, int fr, int fq) const {
        const int row0 = u.pm * BM + wr * 64 + fr, col0 = u.pn * BM + wc * 32 + 8 * fq;
#pragma unroll
        for (int ai = 0; ai < 2; ++ai)
#pragma unroll
            for (int m = 0; m < 4; ++m) {
                const int row = row0 + ai * HALF + m * 16;
                const size_t off = (size_t)row * DM + col0;
                float sq = 0.f;
#pragma unroll
                for (int bj = 0; bj < 2; ++bj) {
                    const f32x4 x0 = *(const f32x4*)(base + off + bj * HALF) + acc[ai][bj][m][0];
                    const f32x4 x1 = *(const f32x4*)(base + off + bj * HALF + 4) + acc[ai][bj][m][1];
                    *(f32x4*)(out + off + bj * HALF) = x0; *(f32x4*)(out + off + bj * HALF + 4) = x1;
                    u32x4 w; w.x = cvt_pk_bf16(x0[0], x0[1]); w.y = cvt_pk_bf16(x0[2], x0[3]); w.z = cvt_pk_bf16(x1[0], x1[1]); w.w = cvt_pk_bf16(x1[2], x1[3]);
                    *(u32x4*)(xb + off + bj * HALF) = w;
                    sq += (x0[0] * x0[0] + x0[1] * x0[1]) + (x0[2] * x0[2] + x0[3] * x0[3]) + (x1[0] * x1[0] + x1[1] * x1[1]) + (x1[2] * x1[2] + x1[3] * x1[3]);
                }
                sq += __shfl_xor(sq, 16); sq += __shfl_xor(sq, 32);
                if (fq == 0) ss[(size_t)row * 16 + u.pn * 4 + wc] = sq;
                asm volatile("" ::: "memory");
            }
    }
};
struct EpiGUT {
    static constexpr bool PERM = true, AFTER_DRAIN = false;
    const float* ss; bf16_t* act;
    __device__ __forceinline__ void operator()(const f32x4 (&acc)[2][2][4][2], const Unit& u, int wr, int wc, int fr, int fq) const {
        const int row0 = u.pm * BM + wr * 64 + fr, hid0 = u.pn * HALF + wc * 32 + 8 * fq;
#pragma unroll
        for (int ai = 0; ai < 2; ++ai)
#pragma unroll
            for (int m = 0; m < 4; ++m) {
                const int row = row0 + ai * HALF + m * 16;
                const float r = row_rstd(ss, row, fq);
                float a[8];
#pragma unroll
                for (int n = 0; n < 2; ++n)
#pragma unroll
                    for (int j = 0; j < 4; ++j) {
                        const float g = acc[ai][0][m][n][j] * r, up = acc[ai][1][m][n][j] * r;
                        a[4 * n + j] = g * __builtin_amdgcn_rcpf(1.f + __builtin_amdgcn_exp2f(-1.4426950408889634f * g)) * up;
                    }
                u32x4 w; w.x = cvt_pk_bf16(a[0], a[1]); w.y = cvt_pk_bf16(a[2], a[3]); w.z = cvt_pk_bf16(a[4], a[5]); w.w = cvt_pk_bf16(a[6], a[7]);
                *(u32x4*)(act + (size_t)row * FF + hid0) = w;
            }
    }
};

template <class Epi, class Sched, bool ALIGN_EPI = false, bool SP2 = false>
__device__ __forceinline__ void gemm_phase(PG8_LAS unsigned char* lds, const Gemm g, const Sched& S, const Epi& E) {
    const int tid = my_tid(), wid = __builtin_amdgcn_readfirstlane(tid >> 6), lane = tid & 63, wr = wid >> 2, wc = wid & 3, fr = lane & 15, fq = lane >> 4;
    const int K = g.K, nt = K / BK;
    unsigned voffA[2], voffB[2];
#pragma unroll
    for (int i = 0; i < 2; ++i) { int R, C; stage_rc(tid * 16 + i * 8192, R, C); const int Rb = Epi::PERM ? ((R & ~31) + perm32(R & 31)) : R;
        voffA[i] = (unsigned)(R * K + C) * 2u; voffB[i] = (unsigned)(Rb * K + C) * 2u; }
    const size_t kstep = (size_t)(BK * 2);
    const size_t hstep = (size_t)HALF * K * 2;
    const size_t tstep = 2 * hstep;
    const unsigned ldsw = (unsigned)wid * 1024u;
    const int aoff = lds_byte(wr * 64 + fr, fq * 8), boff = lds_byte(wc * 32 + fr, fq * 8);
#define PG8_SA(b, h) (((b) * 2 + (h)) * HTB)
#define PG8_SB(b, h) ((4 + (b) * 2 + (h)) * HTB)
#define PG8_STAGE(bufoff, gbase, voff) do { _Pragma("unroll") for (int _i = 0; _i < 2; ++_i) \
        __builtin_amdgcn_global_load_lds((const unsigned*)((const char*)(gbase) + (voff)[_i]), (PG8_LAS unsigned*)(lds + (bufoff) + ldsw + _i * 8192), 16, 0, 0); } while (0)
#define PG8_LDA(dst, b, h) do { _Pragma("unroll") for (int m = 0; m < 4; ++m) _Pragma("unroll") for (int k = 0; k < 2; ++k) dst[m][k] = *(const PG8_LAS bf16x8*)(lds + PG8_SA(b, h) + aoff + m * 2048 + k * 1024); } while (0)
#define PG8_LDB(dst, b, h) do { _Pragma("unroll") for (int n = 0; n < 2; ++n) _Pragma("unroll") for (int k = 0; k < 2; ++k) dst[n][k] = *(const PG8_LAS bf16x8*)(lds + PG8_SB(b, h) + boff + n * 2048 + k * 1024); } while (0)
#define PG8_MMA(ai, bj, At, Bt) do { __builtin_amdgcn_s_setprio(1); _Pragma("unroll") for (int m = 0; m < 4; ++m) _Pragma("unroll") for (int n = 0; n < 2; ++n) _Pragma("unroll") for (int k = 0; k < 2; ++k) \
        acc[ai][bj][m][n] = __builtin_amdgcn_mfma_f32_16x16x32_bf16(Bt[n][k], At[m][k], acc[ai][bj][m][n], 0, 0, 0); __builtin_amdgcn_s_setprio(0); } while (0)
#define PG8_WAIT_V(n) asm volatile("s_waitcnt vmcnt(" #n ")" ::: "memory")
#define PG8_WAIT_L(n) asm volatile("s_waitcnt lgkmcnt(" #n ")" ::: "memory")
#define PG8_BAR __builtin_amdgcn_s_barrier()
#define PG8_SCHED __builtin_amdgcn_sched_barrier(0)
    Unit cur, nxt; int ui = 0;
    if (!S.next(0, cur)) return;
    f32x4 acc[2][2][4][2];
#pragma unroll
    for (int a = 0; a < 2; ++a)
#pragma unroll
        for (int b = 0; b < 2; ++b)
#pragma unroll
            for (int m = 0; m < 4; ++m)
#pragma unroll
                for (int n = 0; n < 2; ++n) acc[a][b][m][n] = (f32x4){0.f, 0.f, 0.f, 0.f};
    bf16x8 At[4][2], B0[2][2], B1[2][2];
    const char* cA = (const char*)g.A + (size_t)cur.pm * tstep; const char* cB = (const char*)g.Bt + (size_t)cur.pn * tstep;
    S.a_ready(cur);
    if constexpr (SP2) {
        PG8_STAGE(PG8_SB(0, 0), cB, voffB); PG8_STAGE(PG8_SB(0, 1), cB + hstep, voffB); PG8_STAGE(PG8_SA(0, 0), cA, voffA); PG8_STAGE(PG8_SA(0, 1), cA + hstep, voffA);
        if (wr == 1) PG8_BAR;
        PG8_WAIT_V(2); PG8_BAR;
        PG8_STAGE(PG8_SB(1, 0), cB + kstep, voffB); PG8_STAGE(PG8_SA(1, 0), cA + kstep, voffA); PG8_STAGE(PG8_SB(1, 1), cB + hstep + kstep, voffB);
        PG8_WAIT_V(6); PG8_BAR;
    } else {
        PG8_STAGE(PG8_SB(0, 0), cB, voffB); PG8_STAGE(PG8_SA(0, 0), cA, voffA); PG8_STAGE(PG8_SB(0, 1), cB + hstep, voffB); PG8_STAGE(PG8_SA(0, 1), cA + hstep, voffA);
        if (wr == 1) PG8_BAR;
        PG8_WAIT_V(4); PG8_BAR;
        PG8_STAGE(PG8_SB(1, 0), cB + kstep, voffB); PG8_STAGE(PG8_SA(1, 0), cA + kstep, voffA); PG8_STAGE(PG8_SB(1, 1), cB + hstep + kstep, voffB);
        PG8_WAIT_V(6); PG8_BAR;
    }
    for (;;) {
        const bool has_next = S.next(ui + 1, nxt);
        const char* nA = has_next ? (const char*)g.A + (size_t)nxt.pm * tstep : cA; const char* nB = has_next ? (const char*)g.Bt + (size_t)nxt.pn * tstep : cB;
        for (int t = 0; t < nt; t += 2) {
            const bool last = (t == nt - 2);
            const char* a1 = cA + (size_t)(t + 1) * kstep;
            const char* a2 = last ? nA : cA + (size_t)(t + 2) * kstep; const char* b2 = last ? nB : cB + (size_t)(t + 2) * kstep;
            const char* a3 = a2 + kstep; const char* b3 = b2 + kstep;
            if (last && has_next) S.a_ready(nxt);
            if constexpr (SP2) {
            PG8_LDB(B0, 0, 0); PG8_LDB(B1, 0, 1); PG8_SCHED; PG8_LDA(At, 0, 0); PG8_STAGE(PG8_SA(1, 1), a1 + hstep, voffA);
            PG8_WAIT_V(8); PG8_WAIT_L(0); PG8_BAR; PG8_MMA(0, 0, At, B0); PG8_MMA(0, 1, At, B1); PG8_BAR; PG8_SCHED;
            PG8_LDA(At, 0, 1); PG8_STAGE(PG8_SB(0, 0), b2, voffB); PG8_STAGE(PG8_SB(0, 1), b2 + hstep, voffB); PG8_STAGE(PG8_SA(0, 0), a2, voffA);
            PG8_WAIT_V(8); PG8_WAIT_L(0); PG8_BAR; PG8_MMA(1, 0, At, B0); PG8_MMA(1, 1, At, B1); PG8_BAR; PG8_SCHED;
            PG8_LDB(B0, 1, 0); PG8_LDB(B1, 1, 1); PG8_SCHED; PG8_LDA(At, 1, 0); PG8_STAGE(PG8_SA(0, 1), a2 + hstep, voffA);
            PG8_WAIT_V(8); PG8_WAIT_L(0); PG8_BAR; PG8_MMA(0, 0, At, B0); PG8_MMA(0, 1, At, B1); PG8_BAR; PG8_SCHED;
            PG8_LDA(At, 1, 1); PG8_STAGE(PG8_SB(1, 0), b3, voffB); PG8_STAGE(PG8_SB(1, 1), b3 + hstep, voffB); PG8_STAGE(PG8_SA(1, 0), a3, voffA);
            PG8_WAIT_V(8); PG8_WAIT_L(0); PG8_BAR; PG8_MMA(1, 0, At, B0); PG8_MMA(1, 1, At, B1); PG8_BAR; PG8_SCHED;
            } else {
            PG8_LDB(B0, 0, 0); PG8_SCHED; PG8_LDA(At, 0, 0); PG8_STAGE(PG8_SA(1, 1), a1 + hstep, voffA);
            PG8_WAIT_L(8); PG8_BAR; PG8_WAIT_L(0); PG8_MMA(0, 0, At, B0); PG8_BAR; PG8_SCHED;
            PG8_LDB(B1, 0, 1); PG8_STAGE(PG8_SB(0, 0), b2, voffB);
            PG8_BAR; PG8_WAIT_L(0); PG8_MMA(0, 1, At, B1); PG8_BAR;
            PG8_LDA(At, 0, 1); PG8_STAGE(PG8_SA(0, 0), a2, voffA);
            PG8_BAR; PG8_WAIT_L(0); PG8_MMA(1, 0, At, B0); PG8_BAR; PG8_SCHED;
            PG8_STAGE(PG8_SB(0, 1), b2 + hstep, voffB);
            PG8_WAIT_V(6); PG8_BAR; PG8_MMA(1, 1, At, B1); PG8_BAR;
            PG8_LDB(B0, 1, 0); PG8_SCHED; PG8_LDA(At, 1, 0); PG8_STAGE(PG8_SA(0, 1), a2 + hstep, voffA);
            PG8_WAIT_L(8); PG8_BAR; PG8_WAIT_L(0); PG8_MMA(0, 0, At, B0); PG8_BAR; PG8_SCHED;
            PG8_LDB(B1, 1, 1); PG8_STAGE(PG8_SB(1, 0), b3, voffB);
            PG8_BAR; PG8_WAIT_L(0); PG8_MMA(0, 1, At, B1); PG8_BAR;
            PG8_LDA(At, 1, 1); PG8_STAGE(PG8_SA(1, 0), a3, voffA);
            PG8_BAR; PG8_WAIT_L(0); PG8_MMA(1, 0, At, B0); PG8_BAR; PG8_SCHED;
            PG8_STAGE(PG8_SB(1, 1), b3 + hstep, voffB);
            PG8_WAIT_V(6); PG8_BAR; PG8_MMA(1, 1, At, B1); PG8_BAR;
            }
        }
        if constexpr (ALIGN_EPI) { if (wr == 0) PG8_BAR; }
        if constexpr (!Epi::AFTER_DRAIN) { E(acc, cur, wr, wc, fr, fq); S.done(cur); }
        if (!has_next) break;
#pragma unroll
        for (int a = 0; a < 2; ++a)
#pragma unroll
            for (int b = 0; b < 2; ++b)
#pragma unroll
                for (int m = 0; m < 4; ++m)
#pragma unroll
                    for (int n = 0; n < 2; ++n) acc[a][b][m][n] = (f32x4){0.f, 0.f, 0.f, 0.f};
        cur = nxt; cA = nA; cB = nB; ++ui;
        if constexpr (ALIGN_EPI) { if (wr == 1) PG8_BAR; }
    }
    PG8_WAIT_V(0);
    if constexpr (!ALIGN_EPI) { if (wr == 0) PG8_BAR; }
    PG8_BAR;
#undef PG8_SA
#undef PG8_SB
#undef PG8_STAGE
#undef PG8_LDA
#undef PG8_LDB
#undef PG8_MMA
#undef PG8_WAIT_V
#undef PG8_WAIT_L
#undef PG8_BAR
#undef PG8_SCHED
}
}

__device__ void phase_rowpass(const Params& p, int l) {
    unsigned char* ws = p.ws;
    bf16_t* proj = (bf16_t*)(ws + WS_PROJ); bf16_t* qkc = (bf16_t*)(ws + WS_XB);
    const float* qg = p.in[I_QG] + l * 64; const float* kg = p.in[I_KG] + l * 192;
    const float* cw = p.in[I_CW] + l * 4096; const float* cb = p.in[I_CB] + l * 1024;
    const int tid = my_tid(), lane = tid & 63, wave = tid >> 6;
    for (int m = my_bid() * 8 + wave; m < M; m += gridDim.x * 8) {
        const int t = m % SEQ;
        bf16_t* row = proj + (size_t)m * NPROJ;
        {
            const u32x4 raw = *(const u32x4*)(row + C_QA + lane * 8); float f[8]; unpack8(raw, f);
            float s = 0.f;
#pragma unroll
            for (int j = 0; j < 8; ++j) s += f[j] * f[j];
            s += __shfl_xor(s, 1); s += __shfl_xor(s, 2); s += __shfl_xor(s, 4);
            const float r = rsqrtf(s * (1.f / 64.f) + EPS);
            const int d0 = (lane & 7) * 8;
            u32x4 o; o.x = pk2(f[0] * r * qg[d0], f[1] * r * qg[d0 + 1]); o.y = pk2(f[2] * r * qg[d0 + 2], f[3] * r * qg[d0 + 3]);
            o.z = pk2(f[4] * r * qg[d0 + 4], f[5] * r * qg[d0 + 5]); o.w = pk2(f[6] * r * qg[d0 + 6], f[7] * r * qg[d0 + 7]);
            *(u32x4*)(row + C_QA + lane * 8) = o;
        }
        {
            const int which = lane >> 5, w4 = (lane & 31) * 4;
            bf16_t* pp = row + (which ? C_KW : C_KS) + w4;
            const u32x2 raw = *(const u32x2*)pp;
            float f[4] = {lo16(raw.x), hi16(raw.x), lo16(raw.y), hi16(raw.y)};
            float s = (f[0] * f[0] + f[1] * f[1]) + (f[2] * f[2] + f[3] * f[3]);
            s += __shfl_xor(s, 1); s += __shfl_xor(s, 2); s += __shfl_xor(s, 4); s += __shfl_xor(s, 8);
            const float r = rsqrtf(s * (1.f / 64.f) + EPS);
            const float* g = kg + (1 + which) * 64 + (w4 & 63);
            u32x2 o; o.x = pk2(f[0] * r * g[0], f[1] * r * g[1]); o.y = pk2(f[2] * r * g[2], f[3] * r * g[3]);
            *(u32x2*)pp = o;
        }
#pragma unroll
        for (int part = 0; part < 2; ++part) {
            const int c0 = part * 512 + lane * 8;
            float acc[8];
#pragma unroll
            for (int j = 0; j < 8; ++j) acc[j] = cb[c0 + j];
#pragma unroll
            for (int w = 0; w < 4; ++w) {
                if (t - 3 + w >= 0) {
                    const u32x4 raw = *(const u32x4*)(proj + (size_t)(m - 3 + w) * NPROJ + C_QB + c0); float f[8]; unpack8(raw, f);
#pragma unroll
                    for (int j = 0; j < 8; ++j) acc[j] += f[j] * cw[w * 1024 + c0 + j];
                }
            }
            const float sc = part ? 0.08838834764831845f : 1.f;
            float y[8];
#pragma unroll
            for (int j = 0; j < 8; ++j) y[j] = silu_f(acc[j]) * sc;
            u32x4 o; o.x = pk2(y[0], y[1]); o.y = pk2(y[2], y[3]); o.z = pk2(y[4], y[5]); o.w = pk2(y[6], y[7]);
            *(u32x4*)(qkc + (size_t)m * 1024 + c0) = o;
        }
    }
}

__device__ void phase_compress(const Params& p, int l, float* lds) {
    unsigned char* ws = p.ws;
    const bf16_t* proj = (const bf16_t*)(ws + WS_PROJ);
    const float* pe = p.in[I_PE] + (size_t)l * 2 * 2048; const float* w1 = p.in[I_W1] + (size_t)l * 2 * 2048 * 128; const float* w2 = p.in[I_W2] + (size_t)l * 2 * 128 * 64;
    const float* kg0 = p.in[I_KG] + l * 192;
    float* tok = lds;
    float* red = lds + 144 * 64;
    float* hidb = red + 4 * 8 * 128;
    const int tid = my_tid(), lane = tid & 63;
    for (int u = my_bid(); u < BATCH * 2 * 2 * 32; u += gridDim.x) {
        const int ib = u & 31, kv = (u >> 5) & 1, g = (u >> 6) & 1, b = u >> 7;
        const int i0 = ib * 8, ni = (NCMP - i0) < 8 ? (NCMP - i0) : 8;
        const int ntok = 16 * ni + 16;
        const int col = (kv ? C_VC : C_KC) + g * 64;
        __syncthreads();
        for (int e = tid; e < 144 * 64; e += NT) {
            const int tt = e >> 6, d = e & 63;
            tok[e] = tt < ntok ? bf2f(proj[(size_t)(b * SEQ + 16 * i0 + tt) * NPROJ + col + d]) : 0.f;
        }
        __syncthreads();
        {
            const int hid = tid & 127, part = tid >> 7;
            float acc[8], accP = 0.f;
#pragma unroll
            for (int ii = 0; ii < 8; ++ii) acc[ii] = 0.f;
            const float* w1p = w1 + (size_t)kv * 2048 * 128 + hid; const float* pep = pe + kv * 2048;
#pragma unroll 2
            for (int f = part * 512; f < part * 512 + 512; ++f) {
                const float w = w1p[(size_t)f * 128];
                accP += w * pep[f];
#pragma unroll
                for (int ii = 0; ii < 8; ++ii) acc[ii] += w * tok[16 * 64 * ii + f];
            }
#pragma unroll
            for (int ii = 0; ii < 8; ++ii) red[(part * 8 + ii) * 128 + hid] = acc[ii] + accP;
        }
        __syncthreads();
        for (int e = tid; e < 8 * 128; e += NT) {
            const float s = (red[e] + red[1024 + e]) + (red[2048 + e] + red[3072 + e]);
            hidb[e] = silu_f(s);
        }
        __syncthreads();
        {
            const int ii = tid >> 6, d = lane;
            float o = 0.f;
            const float* w2p = w2 + (size_t)kv * 128 * 64 + d;
            for (int h = 0; h < 128; ++h) o += hidb[ii * 128 + h] * w2p[h * 64];
            if (kv == 0) { const float s = wave_sum(o * o); o = o * rsqrtf(s * (1.f / 64.f) + EPS) * kg0[d]; }
            bf16_t* dst = (bf16_t*)(ws + (kv ? WS_VCMP : WS_KCMP));
            if (ii < ni) dst[(size_t)((b * 2 + g) * NCMPP + i0 + ii) * 64 + d] = f2bf(o);
        }
    }
    __syncthreads();
}

__device__ __forceinline__ float log_sigmoid_f(float x) { return fminf(x, 0.f) - log1pf(__expf(-fabsf(x))); }
__device__ void mlstm_gates(const float* gates, const float* fb, int m0, int h, float* bcum, float* ig) {
    const int tid = my_tid();
    __syncthreads();
    if (tid < 64) {
        const float lf = log_sigmoid_f(gates[(size_t)(m0 + tid) * 32 + 28 + h] + fb[h]);
        ig[tid] = gates[(size_t)(m0 + tid) * 32 + 24 + h];
        float v = lf;
#pragma unroll
        for (int o = 1; o < 64; o <<= 1) { const float t = __shfl_up(v, o); if (tid >= o) v += t; }
        bcum[tid] = v;
    }
    __syncthreads();
}

__device__ void phase_chunkstate(const Params& p, int l, float* lds) {
    unsigned char* ws = p.ws;
    const bf16_t* proj = (const bf16_t*)(ws + WS_PROJ); const float* gates = (const float*)(ws + WS_GATES);
    const float* cw = p.in[I_CW] + l * 4096; const float* cb = p.in[I_CB] + l * 1024; const float* fb = p.in[I_FB] + l * 4;
    bf16_t* ST = (bf16_t*)(ws + WS_ST); float* STN = (float*)(ws + WS_STN); float* STM = (float*)(ws + WS_STM);
    float* kw = lds;
    float* vv = lds + 8192;
    float* bcum = lds + 16384; float* ig = bcum + 64; float* wsc = ig + 64; float* misc = wsc + 64;
    const int tid = my_tid();
    for (int u = my_bid(); u < BATCH * 4 * 64; u += gridDim.x) {
        const int c = u & 63, h = (u >> 6) & 3, b = u >> 8;
        const int m0 = b * SEQ + c * 64, bh = b * 4 + h;
        mlstm_gates(gates, fb, m0, h, bcum, ig);
        if (tid < 64) {
            const float gv = bcum[63] - bcum[tid] + ig[tid];
            const float mx = wave_max(gv);
            wsc[tid] = __expf(gv - mx);
            if (tid == 0) { misc[0] = mx; STM[bh * 64 + c] = mx; STM[2048 + bh * 64 + c] = bcum[63]; }
        }
        __syncthreads();
        for (int e = tid; e < 64 * 16; e += NT) {
            const int s = e >> 4, d0 = (e & 15) * 8;
            const int t = c * 64 + s, ch = 512 + h * 128 + d0;
            float acc[8];
#pragma unroll
            for (int j = 0; j < 8; ++j) acc[j] = cb[ch + j];
#pragma unroll
            for (int w = 0; w < 4; ++w) {
                if (t - 3 + w >= 0) {
                    const u32x4 raw = *(const u32x4*)(proj + (size_t)(m0 + s - 3 + w) * NPROJ + C_QB + ch); float f[8]; unpack8(raw, f);
#pragma unroll
                    for (int j = 0; j < 8; ++j) acc[j] += f[j] * cw[w * 1024 + ch + j];
                }
            }
            const float sc = 0.08838834764831845f * wsc[s];
#pragma unroll
            for (int j = 0; j < 8; ++j) kw[s * 128 + d0 + j] = silu_f(acc[j]) * sc;
            const u32x4 rv = *(const u32x4*)(proj + (size_t)(m0 + s) * NPROJ + C_VB + h * 128 + d0); float fv[8]; unpack8(rv, fv);
#pragma unroll
            for (int j = 0; j < 8; ++j) vv[s * 128 + d0 + j] = fv[j];
        }
        __syncthreads();
        {
            const int e0 = (tid >> 4) * 4, d0 = (tid & 15) * 8;
            float acc[4][8];
#pragma unroll
            for (int i = 0; i < 4; ++i)
#pragma unroll
                for (int j = 0; j < 8; ++j) acc[i][j] = 0.f;
#pragma unroll 2
            for (int s = 0; s < 64; ++s) {
                const f32x4 ve = *(const f32x4*)(vv + s * 128 + e0);
                const f32x4 k0 = *(const f32x4*)(kw + s * 128 + d0), k1 = *(const f32x4*)(kw + s * 128 + d0 + 4);
                const float va[4] = {ve.x, ve.y, ve.z, ve.w}; const float ka[8] = {k0.x, k0.y, k0.z, k0.w, k1.x, k1.y, k1.z, k1.w};
#pragma unroll
                for (int i = 0; i < 4; ++i)
#pragma unroll
                    for (int j = 0; j < 8; ++j) acc[i][j] += va[i] * ka[j];
            }
#pragma unroll
            for (int i = 0; i < 4; ++i) {
                u32x4 o; o.x = pk2(acc[i][0], acc[i][1]); o.y = pk2(acc[i][2], acc[i][3]); o.z = pk2(acc[i][4], acc[i][5]); o.w = pk2(acc[i][6], acc[i][7]);
                *(u32x4*)(ST + ((size_t)(bh * 64 + c) * 128 + e0 + i) * 128 + d0) = o;
            }
        }
        if (tid < 128) {
            float s = 0.f;
            for (int q = 0; q < 64; ++q) s += kw[q * 128 + tid];
            STN[(size_t)(bh * 64 + c) * 128 + tid] = s;
        }
    }
    __syncthreads();
}

__device__ void phase_scan(const Params& p) {
    unsigned char* ws = p.ws;
    bf16_t* ST = (bf16_t*)(ws + WS_ST); float* STN = (float*)(ws + WS_STN); float* STM = (float*)(ws + WS_STM);
    const int tid = my_tid();
    for (int u = my_bid(); u < 256; u += gridDim.x) {
        const int bh = u >> 3, idx = ((u & 7) * NT + tid) * 4;
        float C[4] = {0.f, 0.f, 0.f, 0.f};
        float nval = 0.f; const bool do_n = (u & 7) == 0 && tid < 128;
        float m = 0.f;
        for (int c0 = 0; c0 < 64; c0 += 8) {
            u32x2 raw[8]; float dn[8], dec[8], scl[8];
#pragma unroll
            for (int k = 0; k < 8; ++k) {
                raw[k] = *(const u32x2*)(ST + (size_t)(bh * 64 + c0 + k) * 16384 + idx);
                dn[k] = do_n ? STN[(size_t)(bh * 64 + c0 + k) * 128 + tid] : 0.f;
            }
#pragma unroll
            for (int k = 0; k < 8; ++k) {
                const float mloc = STM[bh * 64 + c0 + k], bl = STM[2048 + bh * 64 + c0 + k];
                const float mnew = fmaxf(bl + m, mloc);
                dec[k] = __expf(bl + m - mnew); scl[k] = __expf(mloc - mnew);
                if ((u & 7) == 0 && tid == 0) STM[4096 + bh * 64 + c0 + k] = m;
                m = mnew;
            }
#pragma unroll
            for (int k = 0; k < 8; ++k) {
                u32x2 o; o.x = pk2(C[0], C[1]); o.y = pk2(C[2], C[3]);
                *(u32x2*)(ST + (size_t)(bh * 64 + c0 + k) * 16384 + idx) = o;
                const float f[4] = {lo16(raw[k].x), hi16(raw[k].x), lo16(raw[k].y), hi16(raw[k].y)};
#pragma unroll
                for (int j = 0; j < 4; ++j) C[j] = dec[k] * C[j] + scl[k] * f[j];
                if (do_n) { STN[(size_t)(bh * 64 + c0 + k) * 128 + tid] = nval; nval = dec[k] * nval + scl[k] * dn[k]; }
            }
        }
    }
}

__device__ void phase_attn_naive(const Params& p, int l, float* lds) {
    unsigned char* ws = p.ws;
    const bf16_t* proj = (const bf16_t*)(ws + WS_PROJ); const float* gates = (const float*)(ws + WS_GATES);
    const bf16_t* kcmp = (const bf16_t*)(ws + WS_KCMP); const bf16_t* vcmp = (const bf16_t*)(ws + WS_VCMP);
    bf16_t* Y = (bf16_t*)(ws + WS_Y);
    const float* oga = p.in[I_OGA] + l * 512;
    const int tid = my_tid(), lane = tid & 63, wave = tid >> 6;
    float* qs = lds + wave * (256 + 1024);
    float* pb = qs + 256;
    for (int u = my_bid(); u < BATCH * 2 * (SEQ / 8); u += gridDim.x) {
        const int tb = u % (SEQ / 8), g = (u / (SEQ / 8)) & 1, b = u / (SEQ / 4);
        const int t = tb * 8 + wave; const int m = b * SEQ + t;
        const bf16_t* prow = proj + (size_t)m * NPROJ;
#pragma unroll
        for (int hg = 0; hg < 4; ++hg) qs[hg * 64 + lane] = bf2f(prow[C_QA + g * 256 + hg * 64 + lane]);
        float otot[4] = {0.f, 0.f, 0.f, 0.f};
        const float* gt = gates + (size_t)m * 32 + g * 12;
        const int nval = t >= 31 ? ((t - 31) >> 4) + 1 : 0;
        float sc[4][4];
        float mx[4] = {-INFINITY, -INFINITY, -INFINITY, -INFINITY};
        const bf16_t* kc = kcmp + (size_t)(b * 2 + g) * NCMPP * 64; const bf16_t* vc = vcmp + (size_t)(b * 2 + g) * NCMPP * 64;
#pragma unroll
        for (int it = 0; it < 4; ++it) {
            asm volatile("" ::: "memory");
            const int i = it * 64 + lane;
            float a[4] = {0.f, 0.f, 0.f, 0.f};
            if (i < nval) {
#pragma unroll 1
                for (int d8 = 0; d8 < 8; ++d8) {
                    const u32x4 raw = *(const u32x4*)(kc + (size_t)i * 64 + d8 * 8); float f[8]; unpack8(raw, f);
#pragma unroll
                    for (int j = 0; j < 8; ++j)
#pragma unroll
                        for (int hg = 0; hg < 4; ++hg) a[hg] += qs[hg * 64 + d8 * 8 + j] * f[j];
                }
            }
#pragma unroll
            for (int hg = 0; hg < 4; ++hg) { sc[it][hg] = i < nval ? a[hg] * 0.125f : -INFINITY; mx[hg] = fmaxf(mx[hg], sc[it][hg]); }
        }
        float sm[4];
#pragma unroll
        for (int hg = 0; hg < 4; ++hg) {
            mx[hg] = wave_max(mx[hg]);
            float s = 0.f;
#pragma unroll
            for (int it = 0; it < 4; ++it) { const float e = (it * 64 + lane) < nval ? __expf(sc[it][hg] - mx[hg]) : 0.f; sc[it][hg] = e; s += e; }
            sm[hg] = wave_sum(s);
        }
#pragma unroll
        for (int it = 0; it < 4; ++it)
#pragma unroll
            for (int hg = 0; hg < 4; ++hg) pb[hg * 256 + it * 64 + lane] = nval > 0 ? sc[it][hg] / sm[hg] : 0.f;
        {
            float o[4] = {0.f, 0.f, 0.f, 0.f};
            for (int i = 0; i < nval; ++i) {
                const float v = bf2f(vc[(size_t)i * 64 + lane]);
#pragma unroll
                for (int hg = 0; hg < 4; ++hg) o[hg] += pb[hg * 256 + i] * v;
            }
#pragma unroll
            for (int hg = 0; hg < 4; ++hg) otot[hg] += sigmoid_f(gt[hg * 3 + 0]) * o[hg];
        }
        const int cur = t >> 6;
        float imp = 0.f;
#pragma unroll
        for (int k = -1; k < 4; ++k) {
            const int i = 4 * lane + k;
            if (i >= 0 && i < nval) imp += (pb[i] + pb[256 + i]) + (pb[512 + i] + pb[768 + i]);
        }
        const bool valid = lane <= cur;
        const bool forced = (lane == 0) || (lane == cur) || (lane == cur - 1);
        const float score = valid ? imp + (forced ? 1e4f : 0.f) : -1e30f;
        int rank = 0;
        for (int k = 0; k < 64; ++k) {
            const float sk = __shfl(score, k);
            rank += (sk > score || (sk == score && k < lane)) ? 1 : 0;
        }
        const unsigned long long selmask = __ballot(rank < 16 && valid);
#pragma unroll 1
        for (int br = 0; br < 2; ++br) {
            const int kcol = (br ? C_KW : C_KS) + g * 64, vcol = (br ? C_VW : C_VS) + g * 64;
            float mr[4] = {-INFINITY, -INFINITY, -INFINITY, -INFINITY}, lr[4] = {0.f, 0.f, 0.f, 0.f}, o[4] = {0.f, 0.f, 0.f, 0.f};
            const int jlo = br ? (cur >= 8 ? cur - 8 : 0) : 0;
            for (int j = jlo; j <= cur; ++j) {
                if (br == 0 && !((selmask >> j) & 1ull)) continue;
                asm volatile("" ::: "memory");
                const int pos = j * 64 + lane;
                const bool ok = pos <= t && (br == 0 || pos > t - 512);
                float a[4] = {0.f, 0.f, 0.f, 0.f};
                const bf16_t* kr = proj + (size_t)(b * SEQ + pos) * NPROJ + kcol;
#pragma unroll 1
                for (int d8 = 0; d8 < 8; ++d8) {
                    const u32x4 raw = *(const u32x4*)(kr + d8 * 8); float f[8]; unpack8(raw, f);
#pragma unroll
                    for (int jj = 0; jj < 8; ++jj)
#pragma unroll
                        for (int hg = 0; hg < 4; ++hg) a[hg] += qs[hg * 64 + d8 * 8 + jj] * f[jj];
                }
                float alpha[4];
#pragma unroll
                for (int hg = 0; hg < 4; ++hg) {
                    const float s = ok ? a[hg] * 0.125f : -INFINITY;
                    const float bm = wave_max(s);
                    const float mn = fmaxf(mr[hg], bm);
                    alpha[hg] = (mn == -INFINITY) ? 1.f : __expf(mr[hg] - mn);
                    const float e = (ok && mn > -INFINITY) ? __expf(s - mn) : 0.f;
                    lr[hg] = lr[hg] * alpha[hg] + wave_sum(e);
                    mr[hg] = mn;
                    pb[hg * 256 + lane] = e;
                    o[hg] *= alpha[hg];
                }
                const bf16_t* vr = proj + (size_t)(b * SEQ + j * 64) * NPROJ + vcol + lane;
                for (int k = 0; k < 64; ++k) {
                    const float v = bf2f(vr[(size_t)k * NPROJ]);
#pragma unroll
                    for (int hg = 0; hg < 4; ++hg) o[hg] += pb[hg * 256 + k] * v;
                }
            }
#pragma unroll
            for (int hg = 0; hg < 4; ++hg) otot[hg] += sigmoid_f(gt[hg * 3 + 1 + br]) * (lr[hg] > 0.f ? o[hg] / lr[hg] : 0.f);
        }
#pragma unroll
        for (int hg = 0; hg < 4; ++hg) {
            const float s = wave_sum(otot[hg] * otot[hg]);
            const float y = otot[hg] * rsqrtf(s * (1.f / 64.f) + EPS) * oga[(g * 4 + hg) * 64 + lane];
            Y[(size_t)m * 1024 + (g * 4 + hg) * 64 + lane] = f2bf(y);
        }
    }
}

namespace att {
typedef short bf16x8 __attribute__((ext_vector_type(8)));
typedef short s16x4 __attribute__((ext_vector_type(4)));
typedef float f32x16 __attribute__((ext_vector_type(16)));
#define ATT_LAS __attribute__((address_space(3)))
constexpr int L_K = 0, L_V = 16384, L_IMP = 32768, IMP_STRIDE = 65, L_SEL = L_IMP + 4 * 64 * IMP_STRIDE * 4, L_INV = L_SEL + 512, L_WS = L_INV + 1024, L_OST = L_WS + 8 * 256, L_END = L_OST + 8 * 4096;
static_assert(L_END <= LDS_BYTES, "attention LDS map");
constexpr float LOG2E = 1.4426950408889634f;
__device__ __forceinline__ int crow(int r, int hi) { return (r & 3) + 8 * (r >> 2) + 4 * hi; }
__device__ __forceinline__ unsigned cvtpk(float lo, float hi) { unsigned r; asm("v_cvt_pk_bf16_f32 %0, %1, %2" : "=v"(r) : "v"(lo), "v"(hi)); return r; }
__device__ __forceinline__ s16x4 vtr(ATT_LAS const unsigned char* p) { return __builtin_bit_cast(s16x4, __builtin_amdgcn_ds_read_tr16_b64_v4i16((ATT_LAS s16x4*)p)); }

struct Ctx {
    ATT_LAS unsigned char* lds;
    int lane, wave, r32, hi;
    u32x4 kreg, vreg;
};
__device__ __forceinline__ void tile_load(Ctx& C, const bf16_t* kbase, const bf16_t* vbase, int pitch) {
    C.kreg = *(const u32x4*)(kbase + (size_t)C.lane * pitch + C.wave * 8);
    C.vreg = *(const u32x4*)(vbase + (size_t)(16 * (C.wave & 3) + (C.lane >> 2)) * pitch + (C.wave >> 2) * 32 + (C.lane & 3) * 8);
}
__device__ __forceinline__ void tile_store(Ctx& C, int buf) {
    *(ATT_LAS u32x4*)(C.lds + L_K + buf * 8192 + C.wave * 1024 + C.lane * 16) = C.kreg;
    *(ATT_LAS u32x4*)(C.lds + L_V + buf * 8192 + C.wave * 1024 + C.lane * 16) = C.vreg;
}
__device__ __forceinline__ void qkt(const Ctx& C, int buf, const bf16x8 (&qr)[4], f32x16& p0, f32x16& p1) {
    ATT_LAS const unsigned char* kb = C.lds + L_K + buf * 8192 + C.hi * 1024 + C.r32 * 16;
    p0 = (f32x16){0.f, 0.f, 0.f, 0.f, 0.f, 0.f, 0.f, 0.f, 0.f, 0.f, 0.f, 0.f, 0.f, 0.f, 0.f, 0.f}; p1 = p0;
#pragma unroll
    for (int d0 = 0; d0 < 4; ++d0) {
        const bf16x8 b0 = *(ATT_LAS const bf16x8*)(kb + d0 * 2048);
        const bf16x8 b1 = *(ATT_LAS const bf16x8*)(kb + d0 * 2048 + 512);
        p0 = __builtin_amdgcn_mfma_f32_32x32x16_bf16(b0, qr[d0], p0, 0, 0, 0);
        p1 = __builtin_amdgcn_mfma_f32_32x32x16_bf16(b1, qr[d0], p1, 0, 0, 0);
    }
}
__device__ __forceinline__ void pv(const Ctx& C, int buf, const f32x16& p0, const f32x16& p1, f32x16 (&o)[2]) {
    ATT_LAS const unsigned char* vp = C.lds + L_V + buf * 8192 + ((C.lane >> 4) & 1) * 32 + (C.lane & 3) * 8 + (4 * C.hi + ((C.lane & 15) >> 2)) * 64;
    bf16x8 pa[4];
#pragma unroll
    for (int s2 = 0; s2 < 2; ++s2) {
        u32x4 w0, w1;
        w0.x = cvtpk(p0[8 * s2 + 0], p0[8 * s2 + 1]); w0.y = cvtpk(p0[8 * s2 + 2], p0[8 * s2 + 3]); w0.z = cvtpk(p0[8 * s2 + 4], p0[8 * s2 + 5]); w0.w = cvtpk(p0[8 * s2 + 6], p0[8 * s2 + 7]);
        w1.x = cvtpk(p1[8 * s2 + 0], p1[8 * s2 + 1]); w1.y = cvtpk(p1[8 * s2 + 2], p1[8 * s2 + 3]); w1.z = cvtpk(p1[8 * s2 + 4], p1[8 * s2 + 5]); w1.w = cvtpk(p1[8 * s2 + 6], p1[8 * s2 + 7]);
        pa[s2] = __builtin_bit_cast(bf16x8, w0); pa[2 + s2] = __builtin_bit_cast(bf16x8, w1);
    }
#pragma unroll
    for (int d0 = 0; d0 < 2; ++d0)
#pragma unroll
        for (int ks = 0; ks < 4; ++ks) {
            const s16x4 lo = vtr(vp + d0 * 4096 + ks * 1024), hh = vtr(vp + d0 * 4096 + ks * 1024 + 512);
            const bf16x8 vf = (bf16x8){lo[0], lo[1], lo[2], lo[3], hh[0], hh[1], hh[2], hh[3]};
            o[d0] = __builtin_amdgcn_mfma_f32_32x32x16_bf16(pa[ks], vf, o[d0], 0, 0, 0);
        }
}
__device__ __forceinline__ float sum16(const f32x16& p) {
    return ((p[0] + p[1]) + (p[2] + p[3])) + ((p[4] + p[5]) + (p[6] + p[7])) + (((p[8] + p[9]) + (p[10] + p[11])) + ((p[12] + p[13]) + (p[14] + p[15])));
}
__device__ __forceinline__ void accum_scaled(const Ctx& C, f32x16 (&otot)[2], const f32x16 (&o)[2], float fac) {
    ATT_LAS float* wsf = (ATT_LAS float*)(C.lds + L_WS) + C.wave * 64;
    asm volatile("s_waitcnt lgkmcnt(0)" ::: "memory");
    if (C.hi == 0) wsf[C.r32] = fac;
    asm volatile("s_waitcnt lgkmcnt(0)" ::: "memory");
#pragma unroll
    for (int r = 0; r < 16; ++r) { const float f = wsf[crow(r, C.hi)]; otot[0][r] += o[0][r] * f; otot[1][r] += o[1][r] * f; }
    asm volatile("s_waitcnt lgkmcnt(0)" : "+v"(otot[0]), "+v"(otot[1]) :: "memory");
}

__device__ void unit(const Params& p, int l, int b, int g, int c, ATT_LAS unsigned char* lds) {
    unsigned char* ws = p.ws;
    const bf16_t* proj = (const bf16_t*)(ws + WS_PROJ); const float* gates = (const float*)(ws + WS_GATES);
    const bf16_t* kcmp = (const bf16_t*)(ws + WS_KCMP) + (size_t)(b * 2 + g) * NCMPP * 64; const bf16_t* vcmp = (const bf16_t*)(ws + WS_VCMP) + (size_t)(b * 2 + g) * NCMPP * 64;
    bf16_t* Y = (bf16_t*)(ws + WS_Y);
    const float* kg = p.in[I_KG] + l * 192; const float* oga = p.in[I_OGA] + l * 512;
    Ctx C; C.lds = lds;
    const int tid = my_tid(); C.lane = tid & 63; C.wave = __builtin_amdgcn_readfirstlane(tid >> 6); C.r32 = C.lane & 31; C.hi = C.lane >> 5;
    const int lane = C.lane, wave = C.wave, r32 = C.r32, hi = C.hi, hg = wave >> 1, th = wave & 1;
    const int t = 64 * c + 32 * th + r32; const size_t m = (size_t)b * SEQ + t;
    const bf16_t* prow0 = proj + (size_t)b * SEQ * NPROJ;
    bf16x8 qr[4]; float qsq = 0.f;
#pragma unroll
    for (int d0 = 0; d0 < 4; ++d0) {
        const u32x4 raw = *(const u32x4*)(proj + m * NPROJ + C_QA + g * 256 + hg * 64 + 16 * d0 + 8 * hi);
        qr[d0] = __builtin_bit_cast(bf16x8, raw);
        float f[8]; unpack8(raw, f);
#pragma unroll
        for (int j = 0; j < 8; ++j) qsq += f[j] * f[j];
    }
    qsq += __shfl_xor(qsq, 32);
    const float qn = sqrtf(qsq) * 1.01f * LOG2E;
    const float off_c = qn * wave_max(fabsf(kg[lane])), off_s = qn * wave_max(fabsf(kg[64 + lane])), off_w = qn * wave_max(fabsf(kg[128 + lane]));
    const float* gt = gates + m * 32 + (g * 4 + hg) * 3;
    const float gq0 = sigmoid_f(gt[0]), gq1 = sigmoid_f(gt[1]), gq2 = sigmoid_f(gt[2]);
    constexpr float C2 = 0.125f * LOG2E;
    f32x16 otot[2]; otot[0] = (f32x16){0.f, 0.f, 0.f, 0.f, 0.f, 0.f, 0.f, 0.f, 0.f, 0.f, 0.f, 0.f, 0.f, 0.f, 0.f, 0.f}; otot[1] = otot[0];
    const f32x16 zero16 = otot[0];
    {
        const int nval = t >= 31 ? ((t - 31) >> 4) + 1 : 0;
        const int ntc = (4 * c + 3 + 63) >> 6;
        f32x16 o[2]; o[0] = zero16; o[1] = zero16;
        float lsum = 0.f, yprev = 0.f;
        ATT_LAS float* imp = (ATT_LAS float*)(lds + L_IMP) + (hg * 64 + 32 * th + r32) * IMP_STRIDE;
        tile_load(C, kcmp, vcmp, 64); tile_store(C, 0); __syncthreads();
#pragma unroll
        for (int jt = 0; jt < 4; ++jt) {
            if (jt < ntc) {
                if (jt + 1 < ntc) tile_load(C, kcmp + (size_t)(jt + 1) * 64 * 64, vcmp + (size_t)(jt + 1) * 64 * 64, 64);
                f32x16 p0, p1; qkt(C, jt & 1, qr, p0, p1);
#pragma unroll
                for (int r = 0; r < 16; ++r) {
                    const int i0 = 64 * jt + crow(r, hi);
                    p0[r] = i0 < nval ? __builtin_amdgcn_exp2f(p0[r] * C2 - off_c) : 0.f;
                    p1[r] = i0 + 32 < nval ? __builtin_amdgcn_exp2f(p1[r] * C2 - off_c) : 0.f;
                }
                lsum += sum16(p0) + sum16(p1);
#pragma unroll
                for (int H = 0; H < 2; ++H)
#pragma unroll
                    for (int rr = 0; rr < 4; ++rr) {
                        const f32x16& pp = H ? p1 : p0;
                        const float L = pp[4 * rr + 3], S4 = (pp[4 * rr] + pp[4 * rr + 1]) + (pp[4 * rr + 2] + L);
                        const float y = __shfl_xor(L, 32);
                        imp[2 * ((jt * 2 + H) * 4 + rr) + hi] = S4 + (hi ? y : yprev);
                        yprev = y;
                    }
                pv(C, jt & 1, p0, p1, o);
                if (jt + 1 < ntc) tile_store(C, (jt + 1) & 1);
                __syncthreads();
            }
        }
        lsum += __shfl_xor(lsum, 32);
        const float inv = lsum > 0.f ? 1.f / lsum : 0.f;
        if (hi == 0) ((ATT_LAS float*)(lds + L_INV))[hg * 64 + 32 * th + r32] = inv;
        accum_scaled(C, otot, o, gq0 * inv);
    }
    __syncthreads();
    {
        ATT_LAS unsigned long long* selm = (ATT_LAS unsigned long long*)(lds + L_SEL);
        const ATT_LAS float* impb = (const ATT_LAS float*)(lds + L_IMP);
        for (int i = 0; i < 8; ++i) {
            const int q = wave * 8 + i;
            unsigned long long msk;
            if (c < 16) msk = (2ull << c) - 1ull;
            else {
                const bool valid = lane <= c;
                float sc = -1e30f;
                if (valid) {
                    const ATT_LAS float* invb = (const ATT_LAS float*)(lds + L_INV);
                    sc = (impb[(0 * 64 + q) * IMP_STRIDE + lane] * invb[q] + impb[(1 * 64 + q) * IMP_STRIDE + lane] * invb[64 + q]) + (impb[(2 * 64 + q) * IMP_STRIDE + lane] * invb[128 + q] + impb[(3 * 64 + q) * IMP_STRIDE + lane] * invb[192 + q]);
                    if (lane == 0 || lane == c || lane == c - 1) sc += 1e4f;
                }
                int rank = 0;
                for (int k = 0; k <= c; ++k) { const float sk = __shfl(sc, k); rank += (sk > sc || (sk == sc && k < lane)) ? 1 : 0; }
                msk = __ballot(valid && rank < 16);
            }
            if (lane == 0) selm[q] = msk;
        }
    }
    __syncthreads();
    const unsigned long long mysel = ((ATT_LAS const unsigned long long*)(lds + L_SEL))[32 * th + r32];
    unsigned long long blkmask;
    {
        unsigned long long v = ((ATT_LAS const unsigned long long*)(lds + L_SEL))[lane];
#pragma unroll
        for (int o2 = 1; o2 < 64; o2 <<= 1) v |= __shfl_xor(v, o2);
        blkmask = ((unsigned long long)__builtin_amdgcn_readfirstlane((unsigned)(v >> 32)) << 32) | (unsigned)__builtin_amdgcn_readfirstlane((unsigned)v);
    }
    {
        f32x16 o[2]; o[0] = zero16; o[1] = zero16; float lsum = 0.f;
        const bf16_t* kb = prow0 + C_KS + g * 64; const bf16_t* vb = prow0 + C_VS + g * 64;
        unsigned long long rem = blkmask;
        int j = __builtin_ctzll(rem); rem &= rem - 1ull;
        tile_load(C, kb + (size_t)j * 64 * NPROJ, vb + (size_t)j * 64 * NPROJ, NPROJ); tile_store(C, 0); __syncthreads();
        int buf = 0;
        for (;;) {
            const int jn = rem ? __builtin_ctzll(rem) : -1;
            if (jn >= 0) { rem &= rem - 1ull; tile_load(C, kb + (size_t)jn * 64 * NPROJ, vb + (size_t)jn * 64 * NPROJ, NPROJ); }
            f32x16 p0, p1; qkt(C, buf, qr, p0, p1);
            const bool sel = (mysel >> j) & 1ull;
            const int lim = t - 64 * j;
#pragma unroll
            for (int r = 0; r < 16; ++r) {
                const int kk = crow(r, hi);
                p0[r] = (sel && kk <= lim) ? __builtin_amdgcn_exp2f(p0[r] * C2 - off_s) : 0.f;
                p1[r] = (sel && kk + 32 <= lim) ? __builtin_amdgcn_exp2f(p1[r] * C2 - off_s) : 0.f;
            }
            lsum += sum16(p0) + sum16(p1);
            pv(C, buf, p0, p1, o);
            if (jn >= 0) tile_store(C, buf ^ 1);
            __syncthreads();
            if (jn < 0) break;
            j = jn; buf ^= 1;
        }
        lsum += __shfl_xor(lsum, 32);
        accum_scaled(C, otot, o, gq1 / lsum);
    }
    {
        f32x16 o[2]; o[0] = zero16; o[1] = zero16; float lsum = 0.f;
        const bf16_t* kb = prow0 + C_KW + g * 64; const bf16_t* vb = prow0 + C_VW + g * 64;
        const int jlo = c >= 8 ? c - 8 : 0;
        tile_load(C, kb + (size_t)jlo * 64 * NPROJ, vb + (size_t)jlo * 64 * NPROJ, NPROJ); tile_store(C, 0); __syncthreads();
        int buf = 0;
        for (int j = jlo; j <= c; ++j) {
            if (j < c) tile_load(C, kb + (size_t)(j + 1) * 64 * NPROJ, vb + (size_t)(j + 1) * 64 * NPROJ, NPROJ);
            f32x16 p0, p1; qkt(C, buf, qr, p0, p1);
            const int lim = t - 64 * j;
#pragma unroll
            for (int r = 0; r < 16; ++r) {
                const int kk = crow(r, hi);
                p0[r] = (kk <= lim && kk > lim - 512) ? __builtin_amdgcn_exp2f(p0[r] * C2 - off_w) : 0.f;
                p1[r] = (kk + 32 <= lim && kk + 32 > lim - 512) ? __builtin_amdgcn_exp2f(p1[r] * C2 - off_w) : 0.f;
            }
            lsum += sum16(p0) + sum16(p1);
            pv(C, buf, p0, p1, o);
            if (j < c) tile_store(C, buf ^ 1);
            __syncthreads();
            buf ^= 1;
        }
        lsum += __shfl_xor(lsum, 32);
        accum_scaled(C, otot, o, gq2 / lsum);
    }
    {
        ATT_LAS bf16_t* stg = (ATT_LAS bf16_t*)(lds + L_OST) + wave * 2048;
        const float g0 = oga[(g * 4 + hg) * 64 + r32], g1 = oga[(g * 4 + hg) * 64 + 32 + r32];
#pragma unroll
        for (int r = 0; r < 16; ++r) {
            float sq = otot[0][r] * otot[0][r] + otot[1][r] * otot[1][r];
            sq += __shfl_xor(sq, 1); sq += __shfl_xor(sq, 2); sq += __shfl_xor(sq, 4); sq += __shfl_xor(sq, 8); sq += __shfl_xor(sq, 16);
            const float rs = rsqrtf(sq * (1.f / 64.f) + EPS);
            const int q = crow(r, hi);
            stg[q * 64 + r32] = f2bf(otot[0][r] * rs * g0);
            stg[q * 64 + 32 + r32] = f2bf(otot[1][r] * rs * g1);
        }
        asm volatile("s_waitcnt lgkmcnt(0)" ::: "memory");
        bf16_t* yb = Y + ((size_t)b * SEQ + 64 * c + 32 * th) * 1024 + (g * 4 + hg) * 64;
#pragma unroll
        for (int i = 0; i < 4; ++i) {
            const int row = i * 8 + (lane >> 3), ch = lane & 7;
            const u32x4 v = *(ATT_LAS const u32x4*)(stg + row * 64 + ch * 8);
            *(u32x4*)(yb + (size_t)row * 1024 + ch * 8) = v;
        }
    }
    __syncthreads();
}
}

__device__ void phase_attn_mfma(const Params& p, int l, unsigned char* lds_raw) {
    for (int v = my_bid(); v < 1024; v += gridDim.x) {
        const int r = v >> 8, x = (v >> 4) & 15, bg = v & 15;
        const int c = r == 0 ? 63 - x : (r == 1 ? 32 + x : (r == 2 ? 31 - x : x));
        att::unit(p, l, bg >> 1, bg & 1, c, (ATT_LAS unsigned char*)lds_raw);
    }
}

__device__ void phase_mlstm_out(const Params& p, int l, float* lds) {
    unsigned char* ws = p.ws;
    const bf16_t* proj = (const bf16_t*)(ws + WS_PROJ); const float* gates = (const float*)(ws + WS_GATES);
    const bf16_t* qkc = (const bf16_t*)(ws + WS_XB);
    const bf16_t* ST = (const bf16_t*)(ws + WS_ST); const float* STN = (const float*)(ws + WS_STN); const float* STM = (const float*)(ws + WS_STM);
    const float* fb = p.in[I_FB] + l * 4; const float* ogm = p.in[I_OGM] + l * 512;
    bf16_t* Y = (bf16_t*)(ws + WS_Y);
    float* qq = lds;
    float* kk = lds + 8192;
    float* Cs = lds + 16384;
    float* Ws = lds + 32768;
    float* bcum = Ws + 64 * 65; float* ig = bcum + 64; float* mt = ig + 64; float* wint = mt + 64; float* den = wint + 64; float* npv = den + 64;
    const int tid = my_tid(), lane = tid & 63, wave = tid >> 6;
    for (int u = my_bid(); u < BATCH * 4 * 64; u += gridDim.x) {
        const int c = u & 63, h = (u >> 6) & 3, b = u >> 8;
        const int m0 = b * SEQ + c * 64, bh = b * 4 + h;
        mlstm_gates(gates, fb, m0, h, bcum, ig);
        const float mprev = STM[4096 + bh * 64 + c];
        for (int e = tid; e < 64 * 16; e += NT) {
            const int s = e >> 4, d0 = (e & 15) * 8;
            const u32x4 rq = *(const u32x4*)(qkc + (size_t)(m0 + s) * 1024 + h * 128 + d0); float f[8]; unpack8(rq, f);
            const u32x4 rk = *(const u32x4*)(qkc + (size_t)(m0 + s) * 1024 + 512 + h * 128 + d0); float fk[8]; unpack8(rk, fk);
#pragma unroll
            for (int j = 0; j < 8; ++j) { qq[s * 128 + d0 + j] = f[j]; kk[s * 128 + d0 + j] = fk[j]; }
        }
        if (tid < 128) npv[tid] = STN[(size_t)(bh * 64 + c) * 128 + tid];
        for (int e8 = tid; e8 < 128 * 16; e8 += NT) {
            const int e = e8 >> 4, d0 = (e8 & 15) * 8;
            const u32x4 rc = *(const u32x4*)(ST + ((size_t)(bh * 64 + c) * 128 + e) * 128 + d0); float f[8]; unpack8(rc, f);
#pragma unroll
            for (int j = 0; j < 8; ++j) Cs[(d0 + j) * 128 + e] = f[j];
        }
        __syncthreads();
        {
            const int t = tid >> 3, s0 = (tid & 7) * 8;
            float a[8] = {0.f, 0.f, 0.f, 0.f, 0.f, 0.f, 0.f, 0.f};
#pragma unroll 2
            for (int d = 0; d < 128; ++d) {
                const float qv = qq[t * 128 + d];
#pragma unroll
                for (int j = 0; j < 8; ++j) a[j] += qv * kk[(s0 + j) * 128 + d];
            }
#pragma unroll
            for (int j = 0; j < 8; ++j) Ws[t * 65 + s0 + j] = a[j];
        }
        __syncthreads();
        for (int r = 0; r < 8; ++r) {
            const int t = wave * 8 + r;
            const float dv = lane <= t ? bcum[t] - bcum[lane] + ig[lane] : -INFINITY;
            const float a = bcum[t] + mprev;
            const float m_t = fmaxf(a, wave_max(dv));
            const float w = lane <= t ? __expf(dv - m_t) * Ws[t * 65 + lane] : 0.f;
            Ws[t * 65 + lane] = w;
            const float wi = __expf(a - m_t);
            const float qn = wave_sum(qq[t * 128 + lane] * npv[lane] + qq[t * 128 + 64 + lane] * npv[64 + lane]);
            const float dsum = wave_sum(w);
            if (lane == 0) { mt[t] = m_t; wint[t] = wi; den[t] = wi * qn + dsum; }
        }
        __syncthreads();
        for (int e = tid; e < 64 * 16; e += NT) {
            const int s = e >> 4, d0 = (e & 15) * 8;
            const u32x4 rv = *(const u32x4*)(proj + (size_t)(m0 + s) * NPROJ + C_VB + h * 128 + d0); float f[8]; unpack8(rv, f);
#pragma unroll
            for (int j = 0; j < 8; ++j) kk[s * 128 + d0 + j] = f[j];
        }
        __syncthreads();
        float hv[16];
        {
            const int e = tid & 127, t0 = (tid >> 7) * 16;
            float a1[16], a2[16];
#pragma unroll
            for (int i = 0; i < 16; ++i) { a1[i] = 0.f; a2[i] = 0.f; }
#pragma unroll 2
            for (int d = 0; d < 128; ++d) {
                const float cv = Cs[d * 128 + e];
#pragma unroll
                for (int i = 0; i < 16; ++i) a1[i] += qq[(t0 + i) * 128 + d] * cv;
            }
#pragma unroll 2
            for (int s = 0; s < 64; ++s) {
                const float vv = kk[s * 128 + e];
#pragma unroll
                for (int i = 0; i < 16; ++i) a2[i] += Ws[(t0 + i) * 65 + s] * vv;
            }
#pragma unroll
            for (int i = 0; i < 16; ++i) {
                const int t = t0 + i;
                const float num = wint[t] * a1[i] + a2[i];
                hv[i] = num / fmaxf(fabsf(den[t]), __expf(-mt[t]));
            }
        }
        __syncthreads();
        {
            const int e = tid & 127, t0 = (tid >> 7) * 16;
#pragma unroll
            for (int i = 0; i < 16; ++i) Cs[(t0 + i) * 128 + e] = hv[i];
        }
        __syncthreads();
        for (int r = 0; r < 8; ++r) {
            const int t = wave * 8 + r;
            const float h0 = Cs[t * 128 + lane], h1 = Cs[t * 128 + 64 + lane];
            const float s = wave_sum(h0 * h0 + h1 * h1);
            const float rr = rsqrtf(s * (1.f / 128.f) + EPS);
            const bf16_t* op = proj + (size_t)(m0 + t) * NPROJ + C_OB + h * 128;
            const float y0 = h0 * rr * ogm[h * 128 + lane] * sigmoid_f(bf2f(op[lane]));
            const float y1 = h1 * rr * ogm[h * 128 + 64 + lane] * sigmoid_f(bf2f(op[64 + lane]));
            Y[(size_t)(m0 + t) * 1024 + 512 + h * 128 + lane] = f2bf(y0);
            Y[(size_t)(m0 + t) * 1024 + 512 + h * 128 + 64 + lane] = f2bf(y1);
        }
        __syncthreads();
    }
}

namespace mls {
typedef short bf16x8 __attribute__((ext_vector_type(8)));
typedef short s16x4 __attribute__((ext_vector_type(4)));
typedef float f32x16 __attribute__((ext_vector_type(16)));
#define MLS_LAS __attribute__((address_space(3)))
__device__ __forceinline__ s16x4 vtr(MLS_LAS const unsigned char* p) { return __builtin_bit_cast(s16x4, __builtin_amdgcn_ds_read_tr16_b64_v4i16((MLS_LAS s16x4*)p)); }
__device__ __forceinline__ bf16x8 trfrag(MLS_LAS const unsigned char* p) { const s16x4 lo = vtr(p), hh = vtr(p + 512); return (bf16x8){lo[0], lo[1], lo[2], lo[3], hh[0], hh[1], hh[2], hh[3]}; }
__device__ __forceinline__ float incl_scan64(float v, int lane) {
#pragma unroll
    for (int o = 1; o < 64; o <<= 1) { const float t = __shfl_up(v, o); if (lane >= o) v += t; }
    return v;
}
constexpr float KSCALE = 0.08838834764831845f;
constexpr int LC_W = 131072;

__device__ void chunk_unit(const Params& p, int l, int b, int c, MLS_LAS unsigned char* lds) {
    unsigned char* ws = p.ws;
    const bf16_t* proj = (const bf16_t*)(ws + WS_PROJ); const float* gates = (const float*)(ws + WS_GATES);
    const float* cw = p.in[I_CW] + l * 4096; const float* cb = p.in[I_CB] + l * 1024; const float* fb = p.in[I_FB] + l * 4;
    bf16_t* ST = (bf16_t*)(ws + WS_ST); float* STN = (float*)(ws + WS_STN); float* STM = (float*)(ws + WS_STM);
    const int tid = my_tid(), lane = tid & 63, wave = __builtin_amdgcn_readfirstlane(tid >> 6), r32 = lane & 31, hi = lane >> 5, h = wave >> 1, half = wave & 1;
    const size_t m0 = (size_t)b * SEQ + 64 * c; const int bh = b * 4 + h;
    const float lf = log_sigmoid_f(gates[(m0 + lane) * 32 + 28 + h] + fb[h]);
    const float igv = gates[(m0 + lane) * 32 + 24 + h];
    const float bc = incl_scan64(lf, lane);
    const float blast = __shfl(bc, 63);
    const float gv = blast - bc + igv;
    const float mloc = wave_max(gv);
    const float wsc = __expf(gv - mloc);
    if (half == 0 && lane == 0) { STM[bh * 64 + c] = mloc; STM[2048 + bh * 64 + c] = blast; }
    MLS_LAS unsigned char* vimg = lds + h * 32768; MLS_LAS unsigned char* kimg = vimg + 16384;
    bf16_t* qkc = (bf16_t*)(ws + WS_XB);
    const MLS_LAS float* cwl = (const MLS_LAS float*)(lds + LC_W);
    {
        const int pc = lane & 15;
#pragma unroll
        for (int isk = 1; isk >= 0; --isk) {
            const int ch = isk * 512 + h * 128 + pc * 8;
            float cwv[4][8], cbv[8];
#pragma unroll
            for (int w = 0; w < 4; ++w) { const f32x4 a0 = *(const MLS_LAS f32x4*)(cwl + w * 1024 + ch), a1 = *(const MLS_LAS f32x4*)(cwl + w * 1024 + ch + 4);
                cwv[w][0] = a0.x; cwv[w][1] = a0.y; cwv[w][2] = a0.z; cwv[w][3] = a0.w; cwv[w][4] = a1.x; cwv[w][5] = a1.y; cwv[w][6] = a1.z; cwv[w][7] = a1.w; }
            { const f32x4 a0 = *(const MLS_LAS f32x4*)(cwl + 4096 + ch), a1 = *(const MLS_LAS f32x4*)(cwl + 4096 + ch + 4);
                cbv[0] = a0.x; cbv[1] = a0.y; cbv[2] = a0.z; cbv[3] = a0.w; cbv[4] = a1.x; cbv[5] = a1.y; cbv[6] = a1.z; cbv[7] = a1.w; }
#pragma unroll 1
            for (int bq = 0; bq < 2; ++bq) {
                u32x4 taps[4][4], vv[4];
#pragma unroll
                for (int i = 0; i < 4; ++i) {
                    const int s = 32 * half + 4 * (4 * bq + i) + (lane >> 4);
#pragma unroll
                    for (int w = 0; w < 4; ++w) {
                        const bool ok = 64 * c + s - 3 + w >= 0;
                        taps[i][w] = *(const u32x4*)(proj + (m0 + (ok ? s - 3 + w : 0)) * NPROJ + C_QB + ch);
                    }
                    if (isk) vv[i] = *(const u32x4*)(proj + (m0 + s) * NPROJ + C_VB + h * 128 + pc * 8);
                }
#pragma unroll
                for (int i = 0; i < 4; ++i) {
                    const int s = 32 * half + 4 * (4 * bq + i) + (lane >> 4);
                    if (isk) *(MLS_LAS u32x4*)(vimg + (pc >> 2) * 4096 + s * 64 + (pc & 3) * 16) = vv[i];
                    float acc[8];
#pragma unroll
                    for (int j = 0; j < 8; ++j) acc[j] = cbv[j];
#pragma unroll
                    for (int w = 0; w < 4; ++w) {
                        const float z = (64 * c + s - 3 + w >= 0) ? 1.f : 0.f;
                        float f[8]; unpack8(taps[i][w], f);
#pragma unroll
                        for (int j = 0; j < 8; ++j) acc[j] += f[j] * (cwv[w][j] * z);
                    }
                    float y[8];
#pragma unroll
                    for (int j = 0; j < 8; ++j) y[j] = silu_f(acc[j]) * (isk ? KSCALE : 1.f);
                    u32x4 o; o.x = pk2(y[0], y[1]); o.y = pk2(y[2], y[3]); o.z = pk2(y[4], y[5]); o.w = pk2(y[6], y[7]);
                    *(u32x4*)(qkc + (m0 + s) * 1024 + ch) = o;
                    if (isk) {
                        const float sc = __shfl(wsc, s);
                        u32x4 o2; o2.x = pk2(y[0] * sc, y[1] * sc); o2.y = pk2(y[2] * sc, y[3] * sc); o2.z = pk2(y[4] * sc, y[5] * sc); o2.w = pk2(y[6] * sc, y[7] * sc);
                        *(MLS_LAS u32x4*)(kimg + (pc >> 2) * 4096 + s * 64 + (pc & 3) * 16) = o2;
                    }
                }
            }
        }
    }
    {
#pragma unroll 1
        for (int pass = 0; pass < 2; ++pass) {
            if (pass == 1 && tid >= 256) break;
            bf16_t* ptr; const MLS_LAS float* gn;
            if (pass == 0) { ptr = (bf16_t*)proj + (m0 + (tid >> 3)) * NPROJ + C_QA + (tid & 7) * 64; gn = cwl + 5120; }
            else { const int kind = (tid >> 1) & 1; ptr = (bf16_t*)proj + (m0 + (tid >> 2)) * NPROJ + (kind ? C_KW : C_KS) + (tid & 1) * 64; gn = cwl + 5120 + 64 + (1 + kind) * 64; }
            u32x4 raw[8]; float sq = 0.f;
#pragma unroll
            for (int i = 0; i < 8; ++i) { raw[i] = *(const u32x4*)(ptr + 8 * i); float f[8]; unpack8(raw[i], f);
#pragma unroll
                for (int j = 0; j < 8; ++j) sq += f[j] * f[j]; }
            const float r = rsqrtf(sq * (1.f / 64.f) + EPS);
#pragma unroll
            for (int i = 0; i < 8; ++i) { float f[8]; unpack8(raw[i], f);
                const f32x4 g0 = *(const MLS_LAS f32x4*)(gn + 8 * i), g1 = *(const MLS_LAS f32x4*)(gn + 8 * i + 4);
                u32x4 o; o.x = pk2(f[0] * r * g0.x, f[1] * r * g0.y); o.y = pk2(f[2] * r * g0.z, f[3] * r * g0.w); o.z = pk2(f[4] * r * g1.x, f[5] * r * g1.y); o.w = pk2(f[6] * r * g1.z, f[7] * r * g1.w);
                *(u32x4*)(ptr + 8 * i) = o; }
        }
    }
    __syncthreads();
    f32x16 acc[2][4];
#pragma unroll
    for (int e2 = 0; e2 < 2; ++e2)
#pragma unroll
        for (int db = 0; db < 4; ++db) acc[e2][db] = (f32x16){0.f, 0.f, 0.f, 0.f, 0.f, 0.f, 0.f, 0.f, 0.f, 0.f, 0.f, 0.f, 0.f, 0.f, 0.f, 0.f};
    {
        const int tro = ((lane >> 4) & 1) * 32 + (lane & 3) * 8 + (4 * hi + ((lane & 15) >> 2)) * 64;
#pragma unroll
        for (int ks = 0; ks < 4; ++ks) {
            const bf16x8 a0 = trfrag(vimg + tro + (2 * half) * 4096 + ks * 1024), a1 = trfrag(vimg + tro + (2 * half + 1) * 4096 + ks * 1024);
#pragma unroll
            for (int db = 0; db < 4; ++db) {
                const bf16x8 bfr = trfrag(kimg + tro + db * 4096 + ks * 1024);
                acc[0][db] = __builtin_amdgcn_mfma_f32_32x32x16_bf16(a0, bfr, acc[0][db], 0, 0, 0);
                acc[1][db] = __builtin_amdgcn_mfma_f32_32x32x16_bf16(a1, bfr, acc[1][db], 0, 0, 0);
            }
        }
    }
    {
        const int hh = tid >> 7, d = tid & 127;
        MLS_LAS const bf16_t* kp = (MLS_LAS const bf16_t*)(lds + hh * 32768 + 16384 + (d >> 5) * 4096) + (d & 31);
        float sm = 0.f;
#pragma unroll 8
        for (int s2 = 0; s2 < 64; ++s2) sm += bf2f(kp[s2 * 32]);
        STN[(size_t)((b * 4 + hh) * 64 + c) * 128 + d] = sm;
    }
    __syncthreads();
    {
        MLS_LAS bf16_t* stg = (MLS_LAS bf16_t*)(lds + h * 32768 + half * 16384);
#pragma unroll
        for (int e2 = 0; e2 < 2; ++e2)
#pragma unroll
            for (int db = 0; db < 4; ++db)
#pragma unroll
                for (int r = 0; r < 16; ++r) stg[(32 * e2 + att::crow(r, hi)) * 128 + 32 * db + r32] = f2bf(acc[e2][db][r]);
        asm volatile("s_waitcnt lgkmcnt(0)" ::: "memory");
        bf16_t* dst = ST + ((size_t)(bh * 64 + c) * 128 + 64 * half) * 128;
#pragma unroll 4
        for (int it = 0; it < 16; ++it) {
            const int idx = it * 64 + lane;
            *(u32x4*)(dst + (size_t)idx * 8) = *(MLS_LAS const u32x4*)(stg + idx * 8);
        }
    }
    __syncthreads();
}

constexpr int LO_V = 0, LO_STG = 65536, LO_G = 131072;
__device__ void out_unit(const Params& p, int l, int b, int c, MLS_LAS unsigned char* lds) {
    unsigned char* ws = p.ws;
    const bf16_t* proj = (const bf16_t*)(ws + WS_PROJ); const float* gates = (const float*)(ws + WS_GATES);
    const bf16_t* qkc = (const bf16_t*)(ws + WS_XB);
    const bf16_t* ST = (const bf16_t*)(ws + WS_ST); const float* STN = (const float*)(ws + WS_STN); const float* STM = (const float*)(ws + WS_STM);
    const float* fb = p.in[I_FB] + l * 4; const float* ogm = p.in[I_OGM] + l * 512;
    bf16_t* Y = (bf16_t*)(ws + WS_Y);
    const int tid = my_tid(), lane = tid & 63, wave = __builtin_amdgcn_readfirstlane(tid >> 6), r32 = lane & 31, hi = lane >> 5, h = wave >> 1, th = wave & 1;
    const size_t m0 = (size_t)b * SEQ + 64 * c; const int bh = b * 4 + h;
    MLS_LAS unsigned char* vimg = lds + LO_V + h * 16384;
    MLS_LAS float* garr = (MLS_LAS float*)(lds + LO_G + wave * 512);
#pragma unroll 4
    for (int it = 0; it < 8; ++it) {
        const int s = 32 * th + 4 * it + (lane >> 4), pc = lane & 15;
        const u32x4 rv = *(const u32x4*)(proj + (m0 + s) * NPROJ + C_VB + h * 128 + pc * 8);
        *(MLS_LAS u32x4*)(vimg + (pc >> 2) * 4096 + s * 64 + (pc & 3) * 16) = rv;
    }
    {
        const float lf = log_sigmoid_f(gates[(m0 + lane) * 32 + 28 + h] + fb[h]);
        garr[lane] = incl_scan64(lf, lane);
        garr[64 + lane] = gates[(m0 + lane) * 32 + 24 + h];
    }
    const float mprev = STM[4096 + bh * 64 + c];
    const int tl = 32 * th + r32;
    bf16x8 qf[8];
#pragma unroll
    for (int ks = 0; ks < 8; ++ks) qf[ks] = __builtin_bit_cast(bf16x8, *(const u32x4*)(qkc + (m0 + tl) * 1024 + h * 128 + 16 * ks + 8 * hi));
    f32x16 p0 = (f32x16){0.f, 0.f, 0.f, 0.f, 0.f, 0.f, 0.f, 0.f, 0.f, 0.f, 0.f, 0.f, 0.f, 0.f, 0.f, 0.f}, p1 = p0;
#pragma unroll
    for (int ks = 0; ks < 8; ++ks) {
        const bf16x8 k0 = __builtin_bit_cast(bf16x8, *(const u32x4*)(qkc + (m0 + r32) * 1024 + 512 + h * 128 + 16 * ks + 8 * hi));
        const bf16x8 k1 = __builtin_bit_cast(bf16x8, *(const u32x4*)(qkc + (m0 + 32 + r32) * 1024 + 512 + h * 128 + 16 * ks + 8 * hi));
        p0 = __builtin_amdgcn_mfma_f32_32x32x16_bf16(k0, qf[ks], p0, 0, 0, 0);
        p1 = __builtin_amdgcn_mfma_f32_32x32x16_bf16(k1, qf[ks], p1, 0, 0, 0);
    }
    float qn = 0.f;
    {
        const float* np = STN + (size_t)(bh * 64 + c) * 128;
#pragma unroll
        for (int ks = 0; ks < 8; ++ks) {
            const f32x4 n0 = *(const f32x4*)(np + 16 * ks + 8 * hi), n1 = *(const f32x4*)(np + 16 * ks + 8 * hi + 4);
            float f[8]; unpack8(__builtin_bit_cast(u32x4, qf[ks]), f);
            qn += (f[0] * n0.x + f[1] * n0.y) + (f[2] * n0.z + f[3] * n0.w) + (f[4] * n1.x + f[5] * n1.y) + (f[6] * n1.z + f[7] * n1.w);
        }
        qn += __shfl_xor(qn, 32);
    }
    asm volatile("s_waitcnt lgkmcnt(0)" ::: "memory");
    const float bt = garr[tl];
    float dv0[16], dv1[16]; float mx = -INFINITY;
#pragma unroll
    for (int r = 0; r < 16; ++r) {
        const int s0 = att::crow(r, hi);
        dv0[r] = s0 <= tl ? bt - garr[s0] + garr[64 + s0] : -INFINITY;
        dv1[r] = s0 + 32 <= tl ? bt - garr[s0 + 32] + garr[64 + s0 + 32] : -INFINITY;
        mx = fmaxf(mx, fmaxf(dv0[r], dv1[r]));
    }
    mx = fmaxf(mx, __shfl_xor(mx, 32));
    const float a_t = bt + mprev;
    const float m_t = fmaxf(a_t, mx);
    float dsum = 0.f;
#pragma unroll
    for (int r = 0; r < 16; ++r) {
        p0[r] = __expf(dv0[r] - m_t) * p0[r];
        p1[r] = __expf(dv1[r] - m_t) * p1[r];
        dsum += p0[r] + p1[r];
    }
    dsum += __shfl_xor(dsum, 32);
    const float winter = __expf(a_t - m_t);
    const float den = winter * qn + dsum;
    const float scl = 1.f / fmaxf(fabsf(den), __expf(-m_t));
    const float fq = winter * scl;
    bf16x8 pa[4];
#pragma unroll
    for (int s2 = 0; s2 < 2; ++s2) {
        u32x4 w0, w1;
        w0.x = att::cvtpk(p0[8 * s2 + 0] * scl, p0[8 * s2 + 1] * scl); w0.y = att::cvtpk(p0[8 * s2 + 2] * scl, p0[8 * s2 + 3] * scl); w0.z = att::cvtpk(p0[8 * s2 + 4] * scl, p0[8 * s2 + 5] * scl); w0.w = att::cvtpk(p0[8 * s2 + 6] * scl, p0[8 * s2 + 7] * scl);
        w1.x = att::cvtpk(p1[8 * s2 + 0] * scl, p1[8 * s2 + 1] * scl); w1.y = att::cvtpk(p1[8 * s2 + 2] * scl, p1[8 * s2 + 3] * scl); w1.z = att::cvtpk(p1[8 * s2 + 4] * scl, p1[8 * s2 + 5] * scl); w1.w = att::cvtpk(p1[8 * s2 + 6] * scl, p1[8 * s2 + 7] * scl);
        pa[s2] = __builtin_bit_cast(bf16x8, w0); pa[2 + s2] = __builtin_bit_cast(bf16x8, w1);
    }
#pragma unroll
    for (int ks = 0; ks < 8; ++ks) {
        float f[8]; unpack8(__builtin_bit_cast(u32x4, qf[ks]), f);
        u32x4 w; w.x = att::cvtpk(f[0] * fq, f[1] * fq); w.y = att::cvtpk(f[2] * fq, f[3] * fq); w.z = att::cvtpk(f[4] * fq, f[5] * fq); w.w = att::cvtpk(f[6] * fq, f[7] * fq);
        qf[ks] = __builtin_bit_cast(bf16x8, w);
    }
    f32x16 acc[4];
#pragma unroll
    for (int eb = 0; eb < 4; ++eb) acc[eb] = (f32x16){0.f, 0.f, 0.f, 0.f, 0.f, 0.f, 0.f, 0.f, 0.f, 0.f, 0.f, 0.f, 0.f, 0.f, 0.f, 0.f};
    {
        const bf16_t* cp = ST + (size_t)(bh * 64 + c) * 16384 + (size_t)r32 * 128 + 8 * hi;
#pragma unroll
        for (int eb = 0; eb < 4; ++eb)
#pragma unroll
            for (int ks = 0; ks < 8; ++ks) {
                const bf16x8 cf = __builtin_bit_cast(bf16x8, *(const u32x4*)(cp + eb * 32 * 128 + 16 * ks));
                acc[eb] = __builtin_amdgcn_mfma_f32_32x32x16_bf16(qf[ks], cf, acc[eb], 0, 0, 0);
            }
    }
    __syncthreads();
    {
        const int tro = ((lane >> 4) & 1) * 32 + (lane & 3) * 8 + (4 * hi + ((lane & 15) >> 2)) * 64;
#pragma unroll
        for (int eb = 0; eb < 4; ++eb)
#pragma unroll
            for (int ks = 0; ks < 4; ++ks) acc[eb] = __builtin_amdgcn_mfma_f32_32x32x16_bf16(pa[ks], trfrag(vimg + tro + eb * 4096 + ks * 1024), acc[eb], 0, 0, 0);
    }
    {
        MLS_LAS bf16_t* stg = (MLS_LAS bf16_t*)(lds + LO_STG + wave * 8192);
        float gn[4];
#pragma unroll
        for (int eb = 0; eb < 4; ++eb) gn[eb] = ogm[h * 128 + 32 * eb + r32];
#pragma unroll
        for (int r = 0; r < 16; ++r) {
            float sq = (acc[0][r] * acc[0][r] + acc[1][r] * acc[1][r]) + (acc[2][r] * acc[2][r] + acc[3][r] * acc[3][r]);
            sq += __shfl_xor(sq, 1); sq += __shfl_xor(sq, 2); sq += __shfl_xor(sq, 4); sq += __shfl_xor(sq, 8); sq += __shfl_xor(sq, 16);
            const float rs = rsqrtf(sq * (1.f / 128.f) + EPS);
            const int q = att::crow(r, hi);
#pragma unroll
            for (int eb = 0; eb < 4; ++eb) stg[q * 128 + 32 * eb + r32] = f2bf(acc[eb][r] * rs * gn[eb]);
        }
        asm volatile("s_waitcnt lgkmcnt(0)" ::: "memory");
#pragma unroll 2
        for (int it = 0; it < 8; ++it) {
            const int idx = it * 64 + lane, row = idx >> 4, pc = idx & 15;
            const u32x4 hv = *(MLS_LAS const u32x4*)(stg + row * 128 + pc * 8);
            const u32x4 ov = *(const u32x4*)(proj + (m0 + 32 * th + row) * NPROJ + C_OB + h * 128 + pc * 8);
            float fh[8], fo[8]; unpack8(hv, fh); unpack8(ov, fo);
            float y[8];
#pragma unroll
            for (int j = 0; j < 8; ++j) y[j] = fh[j] * sigmoid_f(fo[j]);
            u32x4 o; o.x = pk2(y[0], y[1]); o.y = pk2(y[2], y[3]); o.z = pk2(y[4], y[5]); o.w = pk2(y[6], y[7]);
            *(u32x4*)(Y + (m0 + 32 * th + row) * 1024 + 512 + h * 128 + pc * 8) = o;
        }
    }
    __syncthreads();
}
}

__device__ void phase_chunkstate_mfma(const Params& p, int l, unsigned char* lds_raw) {
    {
        float* wl = (float*)(lds_raw + mls::LC_W);
        const float* cw = p.in[I_CW] + l * 4096; const float* cb = p.in[I_CB] + l * 1024; const float* qg = p.in[I_QG] + l * 64; const float* kg = p.in[I_KG] + l * 192;
        for (int i = my_tid(); i < 5376; i += NT) wl[i] = i < 4096 ? cw[i] : (i < 5120 ? cb[i - 4096] : (i < 5184 ? qg[i - 5120] : kg[i - 5184]));
        __syncthreads();
    }
    for (int u = my_bid(); u < BATCH * 64; u += gridDim.x) mls::chunk_unit(p, l, u >> 6, u & 63, (MLS_LAS unsigned char*)lds_raw);
}
__device__ void phase_mlstm_out_mfma(const Params& p, int l, unsigned char* lds_raw) {
    for (int u = my_bid(); u < BATCH * 64; u += gridDim.x) mls::out_unit(p, l, u >> 6, u & 63, (MLS_LAS unsigned char*)lds_raw);
}

namespace cmpx {
typedef short bf16x8 __attribute__((ext_vector_type(8)));
typedef float f32x16 __attribute__((ext_vector_type(16)));
#define CMP_LAS __attribute__((address_space(3)))
constexpr int LC_PART = 0  , LC_HID = 32768  ;
__device__ void unit(const Params& p, int l, int b, int g, int kv, int ib, CMP_LAS unsigned char* lds) {
    unsigned char* ws = p.ws;
    const bf16_t* proj = (const bf16_t*)(ws + WS_PROJ);
    const bf16_t* w1t = (const bf16_t*)(ws + WS_CW1) + (size_t)(l * 2 + kv) * 128 * 2048;
    const bf16_t* w2t = (const bf16_t*)(ws + WS_W2T) + (size_t)(l * 2 + kv) * 64 * 128;
    const float* peb = (const float*)(ws + WS_PEB) + (l * 2 + kv) * 128;
    const float* kg0 = p.in[I_KG] + l * 192;
    const int tid = my_tid(), lane = tid & 63, wave = __builtin_amdgcn_readfirstlane(tid >> 6), r32 = lane & 31, hi = lane >> 5, hb = wave & 3, kh = wave >> 2;
    const int col = (kv ? C_VC : C_KC) + g * 64;
    const int i = 32 * ib + r32;
    const f32x16 zero16 = (f32x16){0.f, 0.f, 0.f, 0.f, 0.f, 0.f, 0.f, 0.f, 0.f, 0.f, 0.f, 0.f, 0.f, 0.f, 0.f, 0.f};
    {
        f32x16 acc = zero16;
        const bf16_t* bp = w1t + (size_t)(32 * hb + r32) * 2048 + 1024 * kh + 8 * hi;
        const int tok0 = 16 * i + 16 * kh;
#pragma unroll 16
        for (int ks = 0; ks < 64; ++ks) {
            int tok = tok0 + (ks >> 2); tok = tok < SEQ ? tok : SEQ - 1;
            const bf16x8 af = __builtin_bit_cast(bf16x8, *(const u32x4*)(proj + ((size_t)b * SEQ + tok) * NPROJ + col + 16 * (ks & 3) + 8 * hi));
            const bf16x8 bf = __builtin_bit_cast(bf16x8, *(const u32x4*)(bp + 16 * ks));
            acc = __builtin_amdgcn_mfma_f32_32x32x16_bf16(af, bf, acc, 0, 0, 0);
        }
        CMP_LAS float* part = (CMP_LAS float*)(lds + LC_PART) + kh * 32 * 128;
#pragma unroll
        for (int r = 0; r < 16; ++r) part[att::crow(r, hi) * 128 + 32 * hb + r32] = acc[r];
    }
    __syncthreads();
    {
        const CMP_LAS float* part = (const CMP_LAS float*)(lds + LC_PART);
        CMP_LAS bf16_t* hbuf = (CMP_LAS bf16_t*)(lds + LC_HID);
#pragma unroll
        for (int e = 0; e < 8; ++e) {
            const int idx = e * NT + tid, row = idx >> 7, hid = idx & 127;
            hbuf[row * 136 + hid] = f2bf(silu_f(part[idx] + part[4096 + idx] + peb[hid]));
        }
    }
    __syncthreads();
    if (wave == 0) {
        const CMP_LAS bf16_t* hbuf = (const CMP_LAS bf16_t*)(lds + LC_HID);
        f32x16 o0 = zero16, o1 = zero16;
#pragma unroll
        for (int ks = 0; ks < 8; ++ks) {
            const bf16x8 af = *(const CMP_LAS bf16x8*)(hbuf + r32 * 136 + 16 * ks + 8 * hi);
            const bf16x8 b0 = __builtin_bit_cast(bf16x8, *(const u32x4*)(w2t + (size_t)r32 * 128 + 16 * ks + 8 * hi));
            const bf16x8 b1 = __builtin_bit_cast(bf16x8, *(const u32x4*)(w2t + (size_t)(32 + r32) * 128 + 16 * ks + 8 * hi));
            o0 = __builtin_amdgcn_mfma_f32_32x32x16_bf16(af, b0, o0, 0, 0, 0);
            o1 = __builtin_amdgcn_mfma_f32_32x32x16_bf16(af, b1, o1, 0, 0, 0);
        }
        bf16_t* dst = (bf16_t*)(ws + (kv ? WS_VCMP : WS_KCMP)) + (size_t)(b * 2 + g) * NCMPP * 64;
        const float g0 = kv ? 1.f : kg0[r32], g1 = kv ? 1.f : kg0[32 + r32];
#pragma unroll
        for (int r = 0; r < 16; ++r) {
            float rs = 1.f;
            if (kv == 0) {
                float sq = o0[r] * o0[r] + o1[r] * o1[r];
                sq += __shfl_xor(sq, 1); sq += __shfl_xor(sq, 2); sq += __shfl_xor(sq, 4); sq += __shfl_xor(sq, 8); sq += __shfl_xor(sq, 16);
                rs = rsqrtf(sq * (1.f / 64.f) + EPS);
            }
            const int row = 32 * ib + att::crow(r, hi);
            const bool ok = row < NCMP;
            dst[(size_t)row * 64 + r32] = ok ? f2bf(o0[r] * rs * g0) : (bf16_t)0;
            dst[(size_t)row * 64 + 32 + r32] = ok ? f2bf(o1[r] * rs * g1) : (bf16_t)0;
        }
    }
    __syncthreads();
}
}
__device__ void phase_compress_mfma(const Params& p, int l, unsigned char* lds_raw) {
    for (int u = my_bid(); u < BATCH * 2 * 2 * 8; u += gridDim.x) cmpx::unit(p, l, u >> 5, (u >> 4) & 1, (u >> 3) & 1, u & 7, (CMP_LAS unsigned char*)lds_raw);
}

#define XB_TMO      128
#define XB_XCNT(j)  (256  + 64 * (j))
#define XB_XSUB(j)  (1280 + 64 * (j))
#define XB_XGEN(j)  (2304 + 64 * (j))
#define XB_TOP      3328
#define XB_TOPGEN   3392
#define XCD_BAR_WORDS 3456
#define XB_SPIN_CAP (1u << 18)
#define XLAS __attribute__((address_space(3)))
__device__ __forceinline__ unsigned xb_ld(unsigned* p)              { return __hip_atomic_load(p, __ATOMIC_RELAXED, __HIP_MEMORY_SCOPE_AGENT); }
__device__ __forceinline__ unsigned xb_add(unsigned* p, unsigned v) { return __hip_atomic_fetch_add(p, v, __ATOMIC_RELAXED, __HIP_MEMORY_SCOPE_AGENT); }
__device__ __forceinline__ unsigned xb_xcc_id() { return (unsigned)__builtin_amdgcn_s_getreg((3 << 11) | 20) & 0xFu; }
#define XB_SPIN(cond, bar) do { unsigned _sp = 0; while (cond) { __builtin_amdgcn_s_sleep(1); \
    if ((++_sp & 255u) == 0u) { if (xb_ld(&(bar)[XB_TMO])) break; if (_sp > XB_SPIN_CAP) { atomicAdd(&(bar)[XB_TMO], 1u); break; } } } } while (0)
struct XcdBarrier { unsigned* bar; unsigned x; volatile XLAS unsigned* st; };
__device__ __forceinline__ XcdBarrier xcd_barrier_post(unsigned* bar, volatile XLAS unsigned* st) {
    XcdBarrier b; b.bar = bar; b.x = xb_xcc_id(); b.st = st;
    if (threadIdx.x == 0) (void)xb_add(&bar[XB_XCNT(b.x)], 1u);
    return b;
}
__device__ __forceinline__ void xcd_barrier_complete(unsigned* bar, unsigned x, unsigned& nloc, unsigned& nx) {
    const unsigned G = gridDim.x * gridDim.y * gridDim.z;
    unsigned sum, cnt, mine, sp = 0u;
    for (;;) {
        sum = 0u; cnt = 0u; mine = 0u;
#pragma unroll
        for (unsigned j = 0; j < 16; ++j) { const unsigned c = xb_ld(&bar[XB_XCNT(j)]); sum += c; cnt += (c > 0u) ? 1u : 0u; mine = (j == x) ? c : mine; }
        if (sum == G) break;
        __builtin_amdgcn_s_sleep(1);
        if ((++sp & 255u) == 0u) { if (xb_ld(&bar[XB_TMO])) break; if (sp > XB_SPIN_CAP) { atomicAdd(&bar[XB_TMO], 1u); break; } }
    }
    nloc = mine > 0u ? mine : 1u; nx = cnt > 0u ? cnt : 1u;
}
__device__ __forceinline__ void xcd_barrier(const XcdBarrier& b) {
    asm volatile("s_waitcnt vmcnt(0)" ::: "memory");
    __syncthreads();
    if (threadIdx.x == 0) {
        unsigned* bar = b.bar;
        __builtin_amdgcn_s_waitcnt(0);
        unsigned nloc = b.st[0], nx = b.st[1];
        if (nloc == 0u) { xcd_barrier_complete(bar, b.x, nloc, nx); b.st[0] = nloc; b.st[1] = nx; }
        const unsigned old = xb_add(&bar[XB_XSUB(b.x)], 1u);
        const unsigned gen = old / nloc;
        if (old + 1u == (gen + 1u) * nloc) {
            __builtin_amdgcn_fence(__ATOMIC_RELEASE, "agent");
            asm volatile("s_waitcnt vmcnt(0)" ::: "memory");
            const unsigned og = xb_add(&bar[XB_TOP], 1u);
            const unsigned tg = og / nx;
            if (og + 1u == (tg + 1u) * nx) xb_add(&bar[XB_TOPGEN], 1u);
            else XB_SPIN(xb_ld(&bar[XB_TOPGEN]) == tg, bar);
            __builtin_amdgcn_fence(__ATOMIC_ACQUIRE, "agent");
            xb_add(&bar[XB_XGEN(b.x)], 1u);
            asm volatile("s_waitcnt vmcnt(0)" ::: "memory");
        } else {
            XB_SPIN(xb_ld(&bar[XB_XGEN(b.x)]) == gen, bar);
            __builtin_amdgcn_fence(__ATOMIC_ACQUIRE, "agent");
            asm volatile("s_waitcnt vmcnt(0)" ::: "memory");
        }
    }
    __syncthreads();
}

#ifndef DUP
#define DUP 0
#endif
#define REP(bit) for (int rep_ = 0; rep_ < ((DUP & (bit)) ? 2 : 1); ++rep_)
constexpr int NPHASE = 1 + 7 * DEPTH;
template <bool COOP, int PMASK>
__global__ void __launch_bounds__(NT) mega(Params p) {
    extern __shared__ __attribute__((aligned(16))) unsigned char lds_raw[];
    float* lds = (float*)lds_raw;
    unsigned char* ws = p.ws;
    volatile XLAS unsigned* bst = (volatile XLAS unsigned*)((XLAS unsigned char*)lds_raw + LDS_BYTES - 16);
    if (threadIdx.x < 4) bst[threadIdx.x] = 0u;
    __syncthreads();
    XcdBarrier gbar = xcd_barrier_post((unsigned*)(ws + WS_CTL), bst);
#ifndef PROBE_MASK
#define PROBE_MASK 0
#endif
    unsigned long long pr_t0 = 0, pr_acc = 0;
    for (int ph = p.lo; ph < p.hi; ++ph) {
        if (PROBE_MASK && ((PROBE_MASK >> ph) & 1)) pr_t0 = __builtin_amdgcn_s_memrealtime();
        if (ph == 0) {
            if (PMASK & 128) phase_prologue(p, lds);
        } else {
            const int l = (ph - 1) / 7, k = (ph - 1) % 7;
            if (k == 0 && (PMASK & 1)) {
                pg8::Gemm g{(const bf16_t*)(ws + WS_XB), (const bf16_t*)(ws + WS_WIN) + (size_t)l * NPAD * DM, M, NPAD, DM};
                pg8::StaticOrder S; S.init(M, NPAD, (int)gridDim.x, (int)blockIdx.x);
                pg8::EpiInT E{(const float*)(ws + WS_SS), (const float*)(ws + WS_BIAS) + l * NPAD, (bf16_t*)(ws + WS_PROJ), (float*)(ws + WS_GATES)};
                REP(1) pg8::gemm_phase<pg8::EpiInT, pg8::StaticOrder, true, true>((PG8_LAS unsigned char*)lds_raw, g, S, E);
            } else if (k == 1 && (PMASK & 2)) {
                REP(2) phase_compress_mfma(p, l, lds_raw);
                REP(4) phase_chunkstate_mfma(p, l, lds_raw);
            } else if (k == 2 && (PMASK & 4)) {
                phase_scan(p);
                REP(8) phase_attn_mfma(p, l, lds_raw);
            } else if (k == 3 && (PMASK & 8)) {
                REP(16) phase_mlstm_out_mfma(p, l, lds_raw);
            } else if (k == 4 && (PMASK & 16)) {
                pg8::Gemm g{(const bf16_t*)(ws + WS_Y), (const bf16_t*)(ws + WS_WOUT) + (size_t)l * DM * DM, M, DM, DM};
                pg8::StaticOrder S; S.init(M, DM, (int)gridDim.x, (int)blockIdx.x);
                pg8::EpiResT E{l == 0 ? p.in[I_X] : p.out, p.out, (bf16_t*)(ws + WS_XB), (float*)(ws + WS_SS)};
                pg8::gemm_phase<pg8::EpiResT, pg8::StaticOrder, true, true>((PG8_LAS unsigned char*)lds_raw, g, S, E);
            } else if (k == 5 && (PMASK & 32)) {
                pg8::Gemm g{(const bf16_t*)(ws + WS_XB), (const bf16_t*)(ws + WS_WGU) + (size_t)l * NGU * DM, M, NGU, DM};
                pg8::StaticOrder S; S.init(M, NGU, (int)gridDim.x, (int)blockIdx.x);
                pg8::EpiGUT E{(const float*)(ws + WS_SS), (bf16_t*)(ws + WS_PROJ)};
                REP(32) pg8::gemm_phase<pg8::EpiGUT, pg8::StaticOrder, true, true>((PG8_LAS unsigned char*)lds_raw, g, S, E);
            } else if (k == 6 && (PMASK & 64)) {
                pg8::Gemm g{(const bf16_t*)(ws + WS_PROJ), (const bf16_t*)(ws + WS_WD) + (size_t)l * DM * FF, M, DM, FF};
                pg8::StaticOrder S; S.init(M, DM, (int)gridDim.x, (int)blockIdx.x);
                pg8::EpiResT E{p.out, p.out, (bf16_t*)(ws + WS_XB), (float*)(ws + WS_SS)};
                pg8::gemm_phase<pg8::EpiResT, pg8::StaticOrder, true, true>((PG8_LAS unsigned char*)lds_raw, g, S, E);
            }
        }
        if (COOP && ph + 1 < p.hi) {
            if (ph == 0) cg::this_grid().sync();
            else xcd_barrier(gbar);
        }
        if (PROBE_MASK && ((PROBE_MASK >> ph) & 1)) pr_acc += __builtin_amdgcn_s_memrealtime() - pr_t0;
    }
    if (PROBE_MASK && blockIdx.x == 0) {
        const unsigned long long te = __builtin_amdgcn_s_memrealtime();
        while (__builtin_amdgcn_s_memrealtime() - te < 4ull * pr_acc) __builtin_amdgcn_s_sleep(8);
    }
}

extern "C" void kernel_launch(void* const* d_in, const int* in_sizes, int n_in, void* d_out, int out_size, void* d_ws, size_t ws_size, hipStream_t stream) {
    static int grid = 0;
    if (grid == 0) {
        if (n_in != 18 || ws_size < WS_END) { fprintf(stderr, "kernel_launch: unexpected n_in %d / ws_size %zu\n", n_in, ws_size); grid = -1; return; }
        int dev = 0, cus = 0, per_cu = 0;
        (void)hipGetDevice(&dev);
        (void)hipDeviceGetAttribute(&cus, hipDeviceAttributeMultiprocessorCount, dev);
        (void)hipFuncSetAttribute((const void*)mega<true, 0xff>, hipFuncAttributeMaxDynamicSharedMemorySize, LDS_BYTES);
        (void)hipOccupancyMaxActiveBlocksPerMultiprocessor(&per_cu, (const void*)mega<true, 0xff>, NT, LDS_BYTES);
        if (per_cu < 1) { fprintf(stderr, "kernel_launch: occupancy query reports %d blocks/CU\n", per_cu); grid = -1; return; }
        grid = (cus > 0 ? cus : 256) * 1;
        (void)hipGetLastError();
    }
    if (grid < 0) return;
    Params p{};
    for (int i = 0; i < 18; ++i) p.in[i] = (const float*)d_in[i];
    p.out = (float*)d_out; p.ws = (unsigned char*)d_ws;
    p.lo = 0; p.hi = NPHASE;
    (void)hipMemsetAsync((unsigned char*)d_ws + WS_CTL, 0, 16384, stream);
    void* args[] = {&p};
    hipError_t e = hipLaunchCooperativeKernel((const void*)mega<true, 0xff>, dim3(grid), dim3(NT), args, LDS_BYTES, stream);
    if (e != hipSuccess) fprintf(stderr, "cooperative launch failed: %s (grid %d)\n", hipGetErrorString(e), grid);
}
```

```cpp
#include <hip/hip_runtime.h>
#include <hip/hip_cooperative_groups.h>
#include <cstdint>
#include <cstdio>
namespace cg = cooperative_groups;

typedef unsigned short bf16_t;
typedef unsigned u32x4 __attribute__((ext_vector_type(4)));
typedef unsigned u32x2 __attribute__((ext_vector_type(2)));
typedef float f32x4 __attribute__((ext_vector_type(4)));

constexpr int BATCH = 8, SEQ = 4096, DM = 1024, M = BATCH * SEQ, DEPTH = 2;
constexpr int NIN = 3360, NPROJ = 3328, NPAD = 3584, FF = 2816, NGU = 2 * FF;
constexpr int NCMP = 255, NCMPP = 256;
constexpr float EPS = 1e-6f;
constexpr int NT = 512;
constexpr int LDS_BYTES = 152 * 1024;

constexpr int C_QA = 0, C_KC = 512, C_VC = 640, C_KS = 768, C_VS = 896, C_KW = 1024, C_VW = 1152, C_QB = 1280, C_KB = 1792, C_VB = 2304, C_OB = 2816;

constexpr size_t MiB = 1u << 20;
constexpr size_t WS_CTL = 0;
constexpr size_t WS_WIN = 1 * MiB;
constexpr size_t WS_WOUT = 15 * MiB;
constexpr size_t WS_WGU = 19 * MiB;
constexpr size_t WS_WD = 41 * MiB;
constexpr size_t WS_BIAS = 52 * MiB;
constexpr size_t WS_SS = 53 * MiB;
constexpr size_t WS_GATES = 55 * MiB;
constexpr size_t WS_KCMP = 59 * MiB;
constexpr size_t WS_VCMP = 59 * MiB + 512 * 1024;
constexpr size_t WS_STN = 60 * MiB;
constexpr size_t WS_STM = 61 * MiB;
constexpr size_t WS_W2T = 61 * MiB + 256 * 1024;
constexpr size_t WS_PEB = 61 * MiB + 512 * 1024;
constexpr size_t WS_CW1 = 62 * MiB;
constexpr size_t WS_XB = 64 * MiB;
constexpr size_t WS_Y = 128 * MiB;
constexpr size_t WS_ST = 192 * MiB;
constexpr size_t WS_PROJ = 256 * MiB;
constexpr size_t WS_END = 464 * MiB;

struct Params {
    const float* in[18];
    float* out;
    unsigned char* ws;
    int lo, hi;
};
enum { I_X = 0, I_LN1, I_WIN, I_BIN, I_QG, I_KG, I_PE, I_W1, I_W2, I_CW, I_CB, I_FB, I_OGA, I_OGM, I_WOUT, I_LN2, I_WGU, I_WD };

__device__ __forceinline__ float bf2f(bf16_t v) { return __uint_as_float(((unsigned)v) << 16); }
__device__ __forceinline__ bf16_t f2bf(float f) { unsigned u = __float_as_uint(f); return (bf16_t)((u + 0x7fffu + ((u >> 16) & 1u)) >> 16); }
__device__ __forceinline__ unsigned pk2(float lo, float hi) { return (unsigned)f2bf(lo) | ((unsigned)f2bf(hi) << 16); }
__device__ __forceinline__ float lo16(unsigned w) { return __uint_as_float(w << 16); }
__device__ __forceinline__ float hi16(unsigned w) { return __uint_as_float(w & 0xffff0000u); }
__device__ __forceinline__ float silu_f(float x) { return x / (1.f + __expf(-x)); }
__device__ __forceinline__ float sigmoid_f(float x) { return 1.f / (1.f + __expf(-x)); }
__device__ __forceinline__ float wave_sum(float v) {
#pragma unroll
    for (int o = 1; o < 64; o <<= 1) v += __shfl_xor(v, o);
    return v;
}
__device__ __forceinline__ float wave_max(float v) {
#pragma unroll
    for (int o = 1; o < 64; o <<= 1) v = fmaxf(v, __shfl_xor(v, o));
    return v;
}
__device__ __forceinline__ int my_tid() { int t = threadIdx.x; asm volatile("" : "+v"(t)); return t; }
__device__ __forceinline__ int my_bid() { int b = blockIdx.x; asm volatile("" : "+s"(b)); return b; }
__device__ __forceinline__ void unpack8(u32x4 w, float* f) {
    f[0] = lo16(w.x); f[1] = hi16(w.x); f[2] = lo16(w.y); f[3] = hi16(w.y);
    f[4] = lo16(w.z); f[5] = hi16(w.z); f[6] = lo16(w.w); f[7] = hi16(w.w);
}

__device__ __forceinline__ int in_srccol(int n) {
    if (n < 1280) return n;
    if (n < 2816) return n + 24;
    if (n < 3328) return n + 32;
    if (n < 3352) return n - 3328 + 1280;
    if (n < 3360) return n - 3352 + 2840;
    return -1;
}
__device__ __forceinline__ int gu_srccol(int n) {
    const int t = n >> 8, w = n & 255;
    return (w < 128) ? (t * 128 + w) : (FF + t * 128 + (w - 128));
}

struct ConvJob { const float* W; bf16_t* WT; const float* kscale; int K, Nsrc, mode; };
__device__ __forceinline__ bool conv_locate(const Params& p, int ti, ConvJob& J, int& local) {
    constexpr int T_IN = 16 * 56, T_OUT = 16 * 16, T_GU = 16 * 88, T_D = 44 * 16, T_L = T_IN + T_OUT + T_GU + T_D, T_W1 = 32 * 2, T_W2 = 2, T_S = T_W1 + T_W2;
    unsigned char* ws = p.ws;
    if (ti < DEPTH * T_L) {
        const int l = ti / T_L; int r = ti % T_L;
        if (r < T_IN) { J = ConvJob{p.in[I_WIN] + (size_t)l * DM * NIN, (bf16_t*)(ws + WS_WIN) + (size_t)l * NPAD * DM, p.in[I_LN1] + l * DM, DM, NIN, 1}; local = r; return true; }
        r -= T_IN;
        if (r < T_OUT) { J = ConvJob{p.in[I_WOUT] + (size_t)l * DM * DM, (bf16_t*)(ws + WS_WOUT) + (size_t)l * DM * DM, nullptr, DM, DM, 0}; local = r; return true; }
        r -= T_OUT;
        if (r < T_GU) { J = ConvJob{p.in[I_WGU] + (size_t)l * DM * NGU, (bf16_t*)(ws + WS_WGU) + (size_t)l * NGU * DM, p.in[I_LN2] + l * DM, DM, NGU, 2}; local = r; return true; }
        r -= T_GU;
        J = ConvJob{p.in[I_WD] + (size_t)l * FF * DM, (bf16_t*)(ws + WS_WD) + (size_t)l * DM * FF, nullptr, FF, DM, 0}; local = r; return true;
    }
    int r = ti - DEPTH * T_L;
    if (r >= DEPTH * 2 * T_S) return false;
    const int lk = r / T_S; r = r % T_S;
    if (r < T_W1) { J = ConvJob{p.in[I_W1] + (size_t)lk * 2048 * 128, (bf16_t*)(ws + WS_CW1) + (size_t)lk * 128 * 2048, nullptr, 2048, 128, 0}; local = r; return true; }
    J = ConvJob{p.in[I_W2] + (size_t)lk * 128 * 64, (bf16_t*)(ws + WS_W2T) + (size_t)lk * 64 * 128, nullptr, 128, 64, 0}; local = r - T_W1; return true;
}
__device__ void phase_prologue(const Params& p, float* lds) {
    unsigned char* ws = p.ws;
    const int tid = my_tid(), lane = tid & 63, wave = tid >> 6;
    constexpr int T_ALL = DEPTH * (16 * 56 + 16 * 16 + 16 * 88 + 44 * 16) + DEPTH * 2 * (64 + 2);
    for (int G = my_bid(); G < (T_ALL + 3) / 4; G += gridDim.x) {
#pragma unroll
        for (int t = 0; t < 4; ++t) {
            ConvJob J; int local;
            if (conv_locate(p, 4 * G + t, J, local)) {
                const int nk = J.K / 64, k0 = (local % nk) * 64, n0 = (local / nk) * 64;
                float* tile = lds + t * (64 * 65);
#pragma unroll
                for (int i = 0; i < 8; ++i) {
                    const int r = (tid >> 6) + 8 * i, c = tid & 63, n = n0 + c;
                    const int sc = J.mode == 0 ? n : (J.mode == 1 ? in_srccol(n) : gu_srccol(n));
                    float v = 0.f;
                    if (sc >= 0) v = J.W[(size_t)(k0 + r) * J.Nsrc + sc] * (J.kscale ? J.kscale[k0 + r] : 1.f);
                    tile[r * 65 + c] = v;
                }
            }
        }
        __syncthreads();
#pragma unroll
        for (int t = 0; t < 4; ++t) {
            ConvJob J; int local;
            if (conv_locate(p, 4 * G + t, J, local)) {
                const int nk = J.K / 64, k0 = (local % nk) * 64, n0 = (local / nk) * 64;
                const float* tile = lds + t * (64 * 65);
#pragma unroll
                for (int i = 0; i < 8; ++i) {
                    const int r = (tid >> 6) + 8 * i, c = tid & 63;
                    J.WT[(size_t)(n0 + r) * J.K + k0 + c] = f2bf(tile[c * 65 + r]);
                }
            }
        }
        __syncthreads();
    }
    {
        float* peb = (float*)(ws + WS_PEB);
        for (int o = my_bid() * 8 + wave; o < DEPTH * 2 * 128; o += gridDim.x * 8) {
            const int lk = o >> 7, hid = o & 127;
            const float* w1 = p.in[I_W1] + (size_t)lk * 2048 * 128 + hid; const float* pe = p.in[I_PE] + (size_t)lk * 2048;
            float sacc = 0.f;
#pragma unroll 8
            for (int f = lane; f < 2048; f += 64) sacc += w1[(size_t)f * 128] * pe[f];
            sacc = wave_sum(sacc);
            if (lane == 0) peb[o] = sacc;
        }
    }
    float* biasP = (float*)(ws + WS_BIAS);
    for (int i = my_bid() * NT + tid; i < DEPTH * NPAD; i += gridDim.x * NT) {
        const int l = i / NPAD, n = i % NPAD; const int sc = in_srccol(n);
        biasP[i] = sc >= 0 ? p.in[I_BIN][l * NIN + sc] : 0.f;
    }
    const float* x = p.in[I_X]; bf16_t* xb = (bf16_t*)(ws + WS_XB); float* ss = (float*)(ws + WS_SS);
    for (int m = (my_bid() * 8 + wave) * 2; m < M; m += gridDim.x * 16) {
        f32x4 v[2][4];
#pragma unroll
        for (int rr = 0; rr < 2; ++rr)
#pragma unroll
            for (int j = 0; j < 4; ++j) v[rr][j] = ((const f32x4*)(x + (size_t)(m + rr) * DM) + lane)[64 * j];
#pragma unroll
        for (int rr = 0; rr < 2; ++rr)
#pragma unroll
            for (int j = 0; j < 4; ++j) {
                const f32x4 q = v[rr][j];
                float sq = (q.x * q.x + q.y * q.y) + (q.z * q.z + q.w * q.w);
                sq += __shfl_xor(sq, 1); sq += __shfl_xor(sq, 2); sq += __shfl_xor(sq, 4); sq += __shfl_xor(sq, 8);
                if ((lane & 15) == 0) ss[(size_t)(m + rr) * 16 + 4 * j + (lane >> 4)] = sq;
                u32x2 o; o.x = pk2(q.x, q.y); o.y = pk2(q.z, q.w);
                *(u32x2*)(xb + (size_t)(m + rr) * DM + 256 * j + 4 * lane) = o;
            }
    }
}

namespace pg8 {
#define PG8_LAS __attribute__((address_space(3)))
typedef short bf16x8 __attribute__((ext_vector_type(8)));
constexpr int BM = 256, BK = 64, HALF = 128, HTB = HALF * BK * 2  , STAGE_BYTES = 8 * HTB, NXCD = 8, WGM = 8;
__host__ __device__ __forceinline__ int lds_byte(int r, int c) { const int st = (r >> 4) * 2 + (c >> 5), rr = r & 15, cc = c & 31, ob = rr * 64 + cc * 2; return st * 1024 + (ob ^ (((ob >> 9) & 1) << 5)); }
__host__ __device__ __forceinline__ void stage_rc(int b, int& R, int& C) { const int st = b / 1024, sb = b % 1024, swz = sb ^ (((sb >> 9) & 1) << 5); R = (st >> 1) * 16 + swz / 64; C = (st & 1) * 32 + (swz % 64) / 2; }
__host__ __device__ __forceinline__ int perm32(int rho) { const int n = rho >> 4, i = rho & 15; return 8 * (i >> 2) + 4 * n + (i & 3); }
struct Unit { int pm, pn; };
struct Gemm { const bf16_t* A; const bf16_t* Bt; int M, N, K; };
struct StaticOrder {
    int nM, nN, nwg, G, c;
    __host__ __device__ void init(int M_, int N_, int G_, int c_) { nM = M_ / BM; nN = N_ / BM; nwg = nM * nN; G = G_; c = c_; }
    __host__ __device__ bool next(int i, Unit& u) const {
        const long L = (long)i * G + c; if (L >= nwg) return false;
        int wgid = (int)L; { const int q = nwg / NXCD, r = nwg % NXCD, xcd = wgid % NXCD, off = wgid / NXCD; wgid = (xcd < r ? xcd * (q + 1) : r * (q + 1) + (xcd - r) * q) + off; }
        const int nig = WGM * nN, gid = wgid / nig, fm = gid * WGM, gsz = (nM - fm) < WGM ? (nM - fm) : WGM;
        u.pm = fm + ((wgid % nig) % gsz); u.pn = (wgid % nig) / gsz; return true;
    }
    __device__ __forceinline__ void a_ready(const Unit&) const {}
    __device__ __forceinline__ void done(const Unit&) const {}
};
__device__ __forceinline__ unsigned cvt_pk_bf16(float lo, float hi) { unsigned r; asm volatile("v_cvt_pk_bf16_f32 %0, %1, %2" : "=v"(r) : "v"(lo), "v"(hi)); return r; }

__device__ __forceinline__ float row_rstd(const float* ss, int row, int fq) {
    const f32x4 pq = *(const f32x4*)(ss + (size_t)row * 16 + 4 * fq);
    float s = (pq.x + pq.y) + (pq.z + pq.w);
    s += __shfl_xor(s, 16); s += __shfl_xor(s, 32);
    return rsqrtf(s * (1.f / DM) + EPS);
}
struct EpiInT {
    static constexpr bool PERM = true, AFTER_DRAIN = false;
    const float* ss; const float* bias; bf16_t* proj; float* gates;
    __device__ __forceinline__ void operator()(const f32x4 (&acc)[2][2][4][2], const Unit& u, int wr, int wc, int fr, int fq) const {
        const int row0 = u.pm * BM + wr * 64 + fr, col0 = u.pn * BM + wc * 32 + 8 * fq;
        f32x4 bv[2][2];
#pragma unroll
        for (int bj = 0; bj < 2; ++bj)
#pragma unroll
            for (int n = 0; n < 2; ++n) bv[bj][n] = *(const f32x4*)(bias + col0 + bj * HALF + 4 * n);
#pragma unroll
        for (int ai = 0; ai < 2; ++ai)
#pragma unroll
            for (int m = 0; m < 4; ++m) {
                const int row = row0 + ai * HALF + m * 16;
                const float r = row_rstd(ss, row, fq);
                if (u.pn < 13) {
                    bf16_t* rowp = proj + (size_t)row * NPROJ + col0;
#pragma unroll
                    for (int bj = 0; bj < 2; ++bj) {
                        const f32x4 v0 = acc[ai][bj][m][0] * r + bv[bj][0], v1 = acc[ai][bj][m][1] * r + bv[bj][1];
                        u32x4 w; w.x = cvt_pk_bf16(v0[0], v0[1]); w.y = cvt_pk_bf16(v0[2], v0[3]); w.z = cvt_pk_bf16(v1[0], v1[1]); w.w = cvt_pk_bf16(v1[2], v1[3]);
                        *(u32x4*)(rowp + bj * HALF) = w;
                    }
                } else if (wc == 0) {
                    const f32x4 v0 = acc[ai][0][m][0] * r + bv[0][0], v1 = acc[ai][0][m][1] * r + bv[0][1];
                    float* gp = gates + (size_t)row * 32 + 8 * fq;
                    *(f32x4*)gp = v0; *(f32x4*)(gp + 4) = v1;
                }
            }
    }
};
template <bool FINAL>
struct EpiResT {
    static constexpr bool PERM = true, AFTER_DRAIN = false;
    bf16_t* xb; float* ss; float* out;
    __device__ __forceinline__ void operator()(const f32x4 (&acc)[2][2][4][2], const Unit& u, int wr, int wc, int fr, int fq) const {
        const int row0 = u.pm * BM + wr * 64 + fr, col0 = u.pn * BM + wc * 32 + 8 * fq;
#pragma unroll
        for (int ai = 0; ai < 2; ++ai) {
            u32x4 rb[4][2];
#pragma unroll
            for (int m = 0; m < 4; ++m)
#pragma unroll
                for (int bj = 0; bj < 2; ++bj) rb[m][bj] = *(const u32x4*)(xb + (size_t)(row0 + ai * HALF + m * 16) * DM + col0 + bj * HALF);
#pragma unroll
            for (int m = 0; m < 4; ++m) {
                const int row = row0 + ai * HALF + m * 16;
                const size_t off = (size_t)row * DM + col0;
                float sq = 0.f;
#pragma unroll
                for (int bj = 0; bj < 2; ++bj) {
                    float f[8]; unpack8(rb[m][bj], f);
                    const f32x4 x0 = (f32x4){f[0], f[1], f[2], f[3]} + acc[ai][bj][m][0];
                    const f32x4 x1 = (f32x4){f[4], f[5], f[6], f[7]} + acc[ai][bj][m][1];
                    if (FINAL) { *(f32x4*)(out + off + bj * HALF) = x0; *(f32x4*)(out + off + bj * HALF + 4) = x1; }
                    else {
                        u32x4 w; w.x = cvt_pk_bf16(x0[0], x0[1]); w.y = cvt_pk_bf16(x0[2], x0[3]); w.z = cvt_pk_bf16(x1[0], x1[1]); w.w = cvt_pk_bf16(x1[2], x1[3]);
                        *(u32x4*)(xb + off + bj * HALF) = w;
                        sq += (x0[0] * x0[0] + x0[1] * x0[1]) + (x0[2] * x0[2] + x0[3] * x0[3]) + (x1[0] * x1[0] + x1[1] * x1[1]) + (x1[2] * x1[2] + x1[3] * x1[3]);
                    }
                }
                if (!FINAL) {
                    sq += __shfl_xor(sq, 16); sq += __shfl_xor(sq, 32);
                    if (fq == 0) ss[(size_t)row * 16 + u.pn * 4 + wc] = sq;
                }
            }
            asm volatile("" ::: "memory");
        }
    }
};
struct EpiGUT {
    static constexpr bool PERM = true, AFTER_DRAIN = false;
    const float* ss; bf16_t* act;
    __device__ __forceinline__ void operator()(const f32x4 (&acc)[2][2][4][2], const Unit& u, int wr, int wc, int fr, int fq) const {
        const int row0 = u.pm * BM + wr * 64 + fr, hid0 = u.pn * HALF + wc * 32 + 8 * fq;
#pragma unroll
        for (int ai = 0; ai < 2; ++ai)
#pragma unroll
            for (int m = 0; m < 4; ++m) {
                const int row = row0 + ai * HALF + m * 16;
                const float r = row_rstd(ss, row, fq);
                float a[8];
#pragma unroll
                for (int n = 0; n < 2; ++n)
#pragma unroll
                    for (int j = 0; j < 4; ++j) {
                        const float g = acc[ai][0][m][n][j] * r, up = acc[ai][1][m][n][j] * r;
                        a[4 * n + j] = g * __builtin_amdgcn_rcpf(1.f + __builtin_amdgcn_exp2f(-1.4426950408889634f * g)) * up;
                    }
                u32x4 w; w.x = cvt_pk_bf16(a[0], a[1]); w.y = cvt_pk_bf16(a[2], a[3]); w.z = cvt_pk_bf16(a[4], a[5]); w.w = cvt_pk_bf16(a[6], a[7]);
                *(u32x4*)(act + (size_t)row * FF + hid0) = w;
            }
    }
};

template <class Epi, class Sched, bool ALIGN_EPI = false, bool SP2 = false>
__device__ __forceinline__ void gemm_phase(PG8_LAS unsigned char* lds, const Gemm g, const Sched& S, const Epi& E) {
    const int tid = my_tid(), wid = __builtin_amdgcn_readfirstlane(tid >> 6), lane = tid & 63, wr = wid >> 2, wc = wid & 3, fr = lane & 15, fq = lane >> 4;
    const int K = g.K, nt = K / BK;
    unsigned voffA[2], voffB[2];
#pragma unroll
    for (int i = 0; i < 2; ++i) { int R, C; stage_rc(tid * 16 + i * 8192, R, C); const int Rb = Epi::PERM ? ((R & ~31) + perm32(R & 31)) : R;
        voffA[i] = (unsigned)(R * K + C) * 2u; voffB[i] = (unsigned)(Rb * K + C) * 2u; }
    const size_t kstep = (size_t)(BK * 2);
    const size_t hstep = (size_t)HALF * K * 2;
    const size_t tstep = 2 * hstep;
    const unsigned ldsw = (unsigned)wid * 1024u;
    const int aoff = lds_byte(wr * 64 + fr, fq * 8), boff = lds_byte(wc * 32 + fr, fq * 8);
#define PG8_SA(b, h) (((b) * 2 + (h)) * HTB)
#define PG8_SB(b, h) ((4 + (b) * 2 + (h)) * HTB)
#define PG8_STAGE(bufoff, gbase, voff) do { _Pragma("unroll") for (int _i = 0; _i < 2; ++_i) \
        __builtin_amdgcn_global_load_lds((const unsigned*)((const char*)(gbase) + (voff)[_i]), (PG8_LAS unsigned*)(lds + (bufoff) + ldsw + _i * 8192), 16, 0, 0); } while (0)
#define PG8_LDA(dst, b, h) do { _Pragma("unroll") for (int m = 0; m < 4; ++m) _Pragma("unroll") for (int k = 0; k < 2; ++k) dst[m][k] = *(const PG8_LAS bf16x8*)(lds + PG8_SA(b, h) + aoff + m * 2048 + k * 1024); } while (0)
#define PG8_LDB(dst, b, h) do { _Pragma("unroll") for (int n = 0; n < 2; ++n) _Pragma("unroll") for (int k = 0; k < 2; ++k) dst[n][k] = *(const PG8_LAS bf16x8*)(lds + PG8_SB(b, h) + boff + n * 2048 + k * 1024); } while (0)
#define PG8_MMA(ai, bj, At, Bt) do { __builtin_amdgcn_s_setprio(1); _Pragma("unroll") for (int m = 0; m < 4; ++m) _Pragma("unroll") for (int n = 0; n < 2; ++n) _Pragma("unroll") for (int k = 0; k < 2; ++k) \
        acc[ai][bj][m][n] = __builtin_amdgcn_mfma_f32_16x16x32_bf16(Bt[n][k], At[m][k], acc[ai][bj][m][n], 0, 0, 0); __builtin_amdgcn_s_setprio(0); } while (0)
#define PG8_WAIT_V(n) asm volatile("s_waitcnt vmcnt(" #n ")" ::: "memory")
#define PG8_WAIT_L(n) asm volatile("s_waitcnt lgkmcnt(" #n ")" ::: "memory")
#define PG8_BAR __builtin_amdgcn_s_barrier()
#define PG8_SCHED __builtin_amdgcn_sched_barrier(0)
    Unit cur, nxt; int ui = 0;
    if (!S.next(0, cur)) return;
    f32x4 acc[2][2][4][2];
#pragma unroll
    for (int a = 0; a < 2; ++a)
#pragma unroll
        for (int b = 0; b < 2; ++b)
#pragma unroll
            for (int m = 0; m < 4; ++m)
#pragma unroll
                for (int n = 0; n < 2; ++n) acc[a][b][m][n] = (f32x4){0.f, 0.f, 0.f, 0.f};
    bf16x8 At[4][2], B0[2][2], B1[2][2];
    const char* cA = (const char*)g.A + (size_t)cur.pm * tstep; const char* cB = (const char*)g.Bt + (size_t)cur.pn * tstep;
    S.a_ready(cur);
    if constexpr (SP2) {
        PG8_STAGE(PG8_SB(0, 0), cB, voffB); PG8_STAGE(PG8_SB(0, 1), cB + hstep, voffB); PG8_STAGE(PG8_SA(0, 0), cA, voffA); PG8_STAGE(PG8_SA(0, 1), cA + hstep, voffA);
        if (wr == 1) PG8_BAR;
        PG8_WAIT_V(2); PG8_BAR;
        PG8_STAGE(PG8_SB(1, 0), cB + kstep, voffB); PG8_STAGE(PG8_SA(1, 0), cA + kstep, voffA); PG8_STAGE(PG8_SB(1, 1), cB + hstep + kstep, voffB);
        PG8_WAIT_V(6); PG8_BAR;
    } else {
        PG8_STAGE(PG8_SB(0, 0), cB, voffB); PG8_STAGE(PG8_SA(0, 0), cA, voffA); PG8_STAGE(PG8_SB(0, 1), cB + hstep, voffB); PG8_STAGE(PG8_SA(0, 1), cA + hstep, voffA);
        if (wr == 1) PG8_BAR;
        PG8_WAIT_V(4); PG8_BAR;
        PG8_STAGE(PG8_SB(1, 0), cB + kstep, voffB); PG8_STAGE(PG8_SA(1, 0), cA + kstep, voffA); PG8_STAGE(PG8_SB(1, 1), cB + hstep + kstep, voffB);
        PG8_WAIT_V(6); PG8_BAR;
    }
    for (;;) {
        const bool has_next = S.next(ui + 1, nxt);
        const char* nA = has_next ? (const char*)g.A + (size_t)nxt.pm * tstep : cA; const char* nB = has_next ? (const char*)g.Bt + (size_t)nxt.pn * tstep : cB;
        for (int t = 0; t < nt; t += 2) {
            const bool last = (t == nt - 2);
            const char* a1 = cA + (size_t)(t + 1) * kstep;
            const char* a2 = last ? nA : cA + (size_t)(t + 2) * kstep; const char* b2 = last ? nB : cB + (size_t)(t + 2) * kstep;
            const char* a3 = a2 + kstep; const char* b3 = b2 + kstep;
            if (last && has_next) S.a_ready(nxt);
            if constexpr (SP2) {
            PG8_LDB(B0, 0, 0); PG8_LDB(B1, 0, 1); PG8_SCHED; PG8_LDA(At, 0, 0); PG8_STAGE(PG8_SA(1, 1), a1 + hstep, voffA);
            PG8_WAIT_V(8); PG8_WAIT_L(0); PG8_BAR; PG8_MMA(0, 0, At, B0); PG8_MMA(0, 1, At, B1); PG8_BAR; PG8_SCHED;
            PG8_LDA(At, 0, 1); PG8_STAGE(PG8_SB(0, 0), b2, voffB); PG8_STAGE(PG8_SB(0, 1), b2 + hstep, voffB); PG8_STAGE(PG8_SA(0, 0), a2, voffA);
            PG8_WAIT_V(8); PG8_WAIT_L(0); PG8_BAR; PG8_MMA(1, 0, At, B0); PG8_MMA(1, 1, At, B1); PG8_BAR; PG8_SCHED;
            PG8_LDB(B0, 1, 0); PG8_LDB(B1, 1, 1); PG8_SCHED; PG8_LDA(At, 1, 0); PG8_STAGE(PG8_SA(0, 1), a2 + hstep, voffA);
            PG8_WAIT_V(8); PG8_WAIT_L(0); PG8_BAR; PG8_MMA(0, 0, At, B0); PG8_MMA(0, 1, At, B1); PG8_BAR; PG8_SCHED;
            PG8_LDA(At, 1, 1); PG8_STAGE(PG8_SB(1, 0), b3, voffB); PG8_STAGE(PG8_SB(1, 1), b3 + hstep, voffB); PG8_STAGE(PG8_SA(1, 0), a3, voffA);
            PG8_WAIT_V(8); PG8_WAIT_L(0); PG8_BAR; PG8_MMA(1, 0, At, B0); PG8_MMA(1, 1, At, B1); PG8_BAR; PG8_SCHED;
            } else {
            PG8_LDB(B0, 0, 0); PG8_SCHED; PG8_LDA(At, 0, 0); PG8_STAGE(PG8_SA(1, 1), a1 + hstep, voffA);
            PG8_WAIT_L(8); PG8_BAR; PG8_WAIT_L(0); PG8_MMA(0, 0, At, B0); PG8_BAR; PG8_SCHED;
            PG8_LDB(B1, 0, 1); PG8_STAGE(PG8_SB(0, 0), b2, voffB);
            PG8_BAR; PG8_WAIT_L(0); PG8_MMA(0, 1, At, B1); PG8_BAR;
            PG8_LDA(At, 0, 1); PG8_STAGE(PG8_SA(0, 0), a2, voffA);
            PG8_BAR; PG8_WAIT_L(0); PG8_MMA(1, 0, At, B0); PG8_BAR; PG8_SCHED;
            PG8_STAGE(PG8_SB(0, 1), b2 + hstep, voffB);
            PG8_WAIT_V(6); PG8_BAR; PG8_MMA(1, 1, At, B1); PG8_BAR;
            PG8_LDB(B0, 1, 0); PG8_SCHED; PG8_LDA(At, 1, 0); PG8_STAGE(PG8_SA(0, 1), a2 + hstep, voffA);
            PG8_WAIT_L(8); PG8_BAR; PG8_WAIT_L(0); PG8_MMA(0, 0, At, B0); PG8_BAR; PG8_SCHED;
            PG8_LDB(B1, 1, 1); PG8_STAGE(PG8_SB(1, 0), b3, voffB);
            PG8_BAR; PG8_WAIT_L(0); PG8_MMA(0, 1, At, B1); PG8_BAR;
            PG8_LDA(At, 1, 1); PG8_STAGE(PG8_SA(1, 0), a3, voffA);
            PG8_BAR; PG8_WAIT_L(0); PG8_MMA(1, 0, At, B0); PG8_BAR; PG8_SCHED;
            PG8_STAGE(PG8_SB(1, 1), b3 + hstep, voffB);
            PG8_WAIT_V(6); PG8_BAR; PG8_MMA(1, 1, At, B1); PG8_BAR;
            }
        }
        if constexpr (ALIGN_EPI) { if (wr == 0) PG8_BAR; }
        if constexpr (!Epi::AFTER_DRAIN) { E(acc, cur, wr, wc, fr, fq); S.done(cur); }
        if (!has_next) break;
#pragma unroll
        for (int a = 0; a < 2; ++a)
#pragma unroll
            for (int b = 0; b < 2; ++b)
#pragma unroll
                for (int m = 0; m < 4; ++m)
#pragma unroll
                    for (int n = 0; n < 2; ++n) acc[a][b][m][n] = (f32x4){0.f, 0.f, 0.f, 0.f};
        cur = nxt; cA = nA; cB = nB; ++ui;
        if constexpr (ALIGN_EPI) { if (wr == 1) PG8_BAR; }
    }
    PG8_WAIT_V(0);
    if constexpr (!ALIGN_EPI) { if (wr == 0) PG8_BAR; }
    PG8_BAR;
#undef PG8_SA
#undef PG8_SB
#undef PG8_STAGE
#undef PG8_LDA
#undef PG8_LDB
#undef PG8_MMA
#undef PG8_WAIT_V
#undef PG8_WAIT_L
#undef PG8_BAR
#undef PG8_SCHED
}
}

__device__ void phase_rowpass(const Params& p, int l) {
    unsigned char* ws = p.ws;
    bf16_t* proj = (bf16_t*)(ws + WS_PROJ); bf16_t* qkc = (bf16_t*)p.out;
    const float* qg = p.in[I_QG] + l * 64; const float* kg = p.in[I_KG] + l * 192;
    const float* cw = p.in[I_CW] + l * 4096; const float* cb = p.in[I_CB] + l * 1024;
    const int tid = my_tid(), lane = tid & 63, wave = tid >> 6;
    for (int m = my_bid() * 8 + wave; m < M; m += gridDim.x * 8) {
        const int t = m % SEQ;
        bf16_t* row = proj + (size_t)m * NPROJ;
        {
            const u32x4 raw = *(const u32x4*)(row + C_QA + lane * 8); float f[8]; unpack8(raw, f);
            float s = 0.f;
#pragma unroll
            for (int j = 0; j < 8; ++j) s += f[j] * f[j];
            s += __shfl_xor(s, 1); s += __shfl_xor(s, 2); s += __shfl_xor(s, 4);
            const float r = rsqrtf(s * (1.f / 64.f) + EPS);
            const int d0 = (lane & 7) * 8;
            u32x4 o; o.x = pk2(f[0] * r * qg[d0], f[1] * r * qg[d0 + 1]); o.y = pk2(f[2] * r * qg[d0 + 2], f[3] * r * qg[d0 + 3]);
            o.z = pk2(f[4] * r * qg[d0 + 4], f[5] * r * qg[d0 + 5]); o.w = pk2(f[6] * r * qg[d0 + 6], f[7] * r * qg[d0 + 7]);
            *(u32x4*)(row + C_QA + lane * 8) = o;
        }
        {
            const int which = lane >> 5, w4 = (lane & 31) * 4;
            bf16_t* pp = row + (which ? C_KW : C_KS) + w4;
            const u32x2 raw = *(const u32x2*)pp;
            float f[4] = {lo16(raw.x), hi16(raw.x), lo16(raw.y), hi16(raw.y)};
            float s = (f[0] * f[0] + f[1] * f[1]) + (f[2] * f[2] + f[3] * f[3]);
            s += __shfl_xor(s, 1); s += __shfl_xor(s, 2); s += __shfl_xor(s, 4); s += __shfl_xor(s, 8);
            const float r = rsqrtf(s * (1.f / 64.f) + EPS);
            const float* g = kg + (1 + which) * 64 + (w4 & 63);
            u32x2 o; o.x = pk2(f[0] * r * g[0], f[1] * r * g[1]); o.y = pk2(f[2] * r * g[2], f[3] * r * g[3]);
            *(u32x2*)pp = o;
        }
#pragma unroll
        for (int part = 0; part < 2; ++part) {
            const int c0 = part * 512 + lane * 8;
            float acc[8];
#pragma unroll
            for (int j = 0; j < 8; ++j) acc[j] = cb[c0 + j];
#pragma unroll
            for (int w = 0; w < 4; ++w) {
                if (t - 3 + w >= 0) {
                    const u32x4 raw = *(const u32x4*)(proj + (size_t)(m - 3 + w) * NPROJ + C_QB + c0); float f[8]; unpack8(raw, f);
#pragma unroll
                    for (int j = 0; j < 8; ++j) acc[j] += f[j] * cw[w * 1024 + c0 + j];
                }
            }
            const float sc = part ? 0.08838834764831845f : 1.f;
            float y[8];
#pragma unroll
            for (int j = 0; j < 8; ++j) y[j] = silu_f(acc[j]) * sc;
            u32x4 o; o.x = pk2(y[0], y[1]); o.y = pk2(y[2], y[3]); o.z = pk2(y[4], y[5]); o.w = pk2(y[6], y[7]);
            *(u32x4*)(qkc + (size_t)m * 1024 + c0) = o;
        }
    }
}

__device__ void phase_compress(const Params& p, int l, float* lds) {
    unsigned char* ws = p.ws;
    const bf16_t* proj = (const bf16_t*)(ws + WS_PROJ);
    const float* pe = p.in[I_PE] + (size_t)l * 2 * 2048; const float* w1 = p.in[I_W1] + (size_t)l * 2 * 2048 * 128; const float* w2 = p.in[I_W2] + (size_t)l * 2 * 128 * 64;
    const float* kg0 = p.in[I_KG] + l * 192;
    float* tok = lds;
    float* red = lds + 144 * 64;
    float* hidb = red + 4 * 8 * 128;
    const int tid = my_tid(), lane = tid & 63;
    for (int u = my_bid(); u < BATCH * 2 * 2 * 32; u += gridDim.x) {
        const int ib = u & 31, kv = (u >> 5) & 1, g = (u >> 6) & 1, b = u >> 7;
        const int i0 = ib * 8, ni = (NCMP - i0) < 8 ? (NCMP - i0) : 8;
        const int ntok = 16 * ni + 16;
        const int col = (kv ? C_VC : C_KC) + g * 64;
        __syncthreads();
        for (int e = tid; e < 144 * 64; e += NT) {
            const int tt = e >> 6, d = e & 63;
            tok[e] = tt < ntok ? bf2f(proj[(size_t)(b * SEQ + 16 * i0 + tt) * NPROJ + col + d]) : 0.f;
        }
        __syncthreads();
        {
            const int hid = tid & 127, part = tid >> 7;
            float acc[8], accP = 0.f;
#pragma unroll
            for (int ii = 0; ii < 8; ++ii) acc[ii] = 0.f;
            const float* w1p = w1 + (size_t)kv * 2048 * 128 + hid; const float* pep = pe + kv * 2048;
#pragma unroll 2
            for (int f = part * 512; f < part * 512 + 512; ++f) {
                const float w = w1p[(size_t)f * 128];
                accP += w * pep[f];
#pragma unroll
                for (int ii = 0; ii < 8; ++ii) acc[ii] += w * tok[16 * 64 * ii + f];
            }
#pragma unroll
            for (int ii = 0; ii < 8; ++ii) red[(part * 8 + ii) * 128 + hid] = acc[ii] + accP;
        }
        __syncthreads();
        for (int e = tid; e < 8 * 128; e += NT) {
            const float s = (red[e] + red[1024 + e]) + (red[2048 + e] + red[3072 + e]);
            hidb[e] = silu_f(s);
        }
        __syncthreads();
        {
            const int ii = tid >> 6, d = lane;
            float o = 0.f;
            const float* w2p = w2 + (size_t)kv * 128 * 64 + d;
            for (int h = 0; h < 128; ++h) o += hidb[ii * 128 + h] * w2p[h * 64];
            if (kv == 0) { const float s = wave_sum(o * o); o = o * rsqrtf(s * (1.f / 64.f) + EPS) * kg0[d]; }
            bf16_t* dst = (bf16_t*)(ws + (kv ? WS_VCMP : WS_KCMP));
            if (ii < ni) dst[(size_t)((b * 2 + g) * NCMPP + i0 + ii) * 64 + d] = f2bf(o);
        }
    }
    __syncthreads();
}

__device__ __forceinline__ float log_sigmoid_f(float x) { return fminf(x, 0.f) - log1pf(__expf(-fabsf(x))); }
__device__ void mlstm_gates(const float* gates, const float* fb, int m0, int h, float* bcum, float* ig) {
    const int tid = my_tid();
    __syncthreads();
    if (tid < 64) {
        const float lf = log_sigmoid_f(gates[(size_t)(m0 + tid) * 32 + 28 + h] + fb[h]);
        ig[tid] = gates[(size_t)(m0 + tid) * 32 + 24 + h];
        float v = lf;
#pragma unroll
        for (int o = 1; o < 64; o <<= 1) { const float t = __shfl_up(v, o); if (tid >= o) v += t; }
        bcum[tid] = v;
    }
    __syncthreads();
}

__device__ void phase_chunkstate(const Params& p, int l, float* lds) {
    unsigned char* ws = p.ws;
    const bf16_t* proj = (const bf16_t*)(ws + WS_PROJ); const float* gates = (const float*)(ws + WS_GATES);
    const float* cw = p.in[I_CW] + l * 4096; const float* cb = p.in[I_CB] + l * 1024; const float* fb = p.in[I_FB] + l * 4;
    bf16_t* ST = (bf16_t*)(ws + WS_ST); float* STN = (float*)(ws + WS_STN); float* STM = (float*)(ws + WS_STM);
    float* kw = lds;
    float* vv = lds + 8192;
    float* bcum = lds + 16384; float* ig = bcum + 64; float* wsc = ig + 64; float* misc = wsc + 64;
    const int tid = my_tid();
    for (int u = my_bid(); u < BATCH * 4 * 64; u += gridDim.x) {
        const int c = u & 63, h = (u >> 6) & 3, b = u >> 8;
        const int m0 = b * SEQ + c * 64, bh = b * 4 + h;
        mlstm_gates(gates, fb, m0, h, bcum, ig);
        if (tid < 64) {
            const float gv = bcum[63] - bcum[tid] + ig[tid];
            const float mx = wave_max(gv);
            wsc[tid] = __expf(gv - mx);
            if (tid == 0) { misc[0] = mx; STM[bh * 64 + c] = mx; STM[2048 + bh * 64 + c] = bcum[63]; }
        }
        __syncthreads();
        for (int e = tid; e < 64 * 16; e += NT) {
            const int s = e >> 4, d0 = (e & 15) * 8;
            const int t = c * 64 + s, ch = 512 + h * 128 + d0;
            float acc[8];
#pragma unroll
            for (int j = 0; j < 8; ++j) acc[j] = cb[ch + j];
#pragma unroll
            for (int w = 0; w < 4; ++w) {
                if (t - 3 + w >= 0) {
                    const u32x4 raw = *(const u32x4*)(proj + (size_t)(m0 + s - 3 + w) * NPROJ + C_QB + ch); float f[8]; unpack8(raw, f);
#pragma unroll
                    for (int j = 0; j < 8; ++j) acc[j] += f[j] * cw[w * 1024 + ch + j];
                }
            }
            const float sc = 0.08838834764831845f * wsc[s];
#pragma unroll
            for (int j = 0; j < 8; ++j) kw[s * 128 + d0 + j] = silu_f(acc[j]) * sc;
            const u32x4 rv = *(const u32x4*)(proj + (size_t)(m0 + s) * NPROJ + C_VB + h * 128 + d0); float fv[8]; unpack8(rv, fv);
#pragma unroll
            for (int j = 0; j < 8; ++j) vv[s * 128 + d0 + j] = fv[j];
        }
        __syncthreads();
        {
            const int e0 = (tid >> 4) * 4, d0 = (tid & 15) * 8;
            float acc[4][8];
#pragma unroll
            for (int i = 0; i < 4; ++i)
#pragma unroll
                for (int j = 0; j < 8; ++j) acc[i][j] = 0.f;
#pragma unroll 2
            for (int s = 0; s < 64; ++s) {
                const f32x4 ve = *(const f32x4*)(vv + s * 128 + e0);
                const f32x4 k0 = *(const f32x4*)(kw + s * 128 + d0), k1 = *(const f32x4*)(kw + s * 128 + d0 + 4);
                const float va[4] = {ve.x, ve.y, ve.z, ve.w}; const float ka[8] = {k0.x, k0.y, k0.z, k0.w, k1.x, k1.y, k1.z, k1.w};
#pragma unroll
                for (int i = 0; i < 4; ++i)
#pragma unroll
                    for (int j = 0; j < 8; ++j) acc[i][j] += va[i] * ka[j];
            }
#pragma unroll
            for (int i = 0; i < 4; ++i) {
                u32x4 o; o.x = pk2(acc[i][0], acc[i][1]); o.y = pk2(acc[i][2], acc[i][3]); o.z = pk2(acc[i][4], acc[i][5]); o.w = pk2(acc[i][6], acc[i][7]);
                *(u32x4*)(ST + ((size_t)(bh * 64 + c) * 128 + e0 + i) * 128 + d0) = o;
            }
        }
        if (tid < 128) {
            float s = 0.f;
            for (int q = 0; q < 64; ++q) s += kw[q * 128 + tid];
            STN[(size_t)(bh * 64 + c) * 128 + tid] = s;
        }
    }
    __syncthreads();
}

__device__ void phase_scan(const Params& p) {
    unsigned char* ws = p.ws;
    bf16_t* ST = (bf16_t*)(ws + WS_ST); float* STN = (float*)(ws + WS_STN); float* STM = (float*)(ws + WS_STM);
    const int tid = my_tid();
    for (int u = my_bid(); u < 256; u += gridDim.x) {
        const int bh = u >> 3, idx = ((u & 7) * NT + tid) * 4;
        float C[4] = {0.f, 0.f, 0.f, 0.f};
        float nval = 0.f; const bool do_n = (u & 7) == 0 && tid < 128;
        float m = 0.f;
        for (int c0 = 0; c0 < 64; c0 += 8) {
            u32x2 raw[8]; float dn[8], dec[8], scl[8];
#pragma unroll
            for (int k = 0; k < 8; ++k) {
                raw[k] = *(const u32x2*)(ST + (size_t)(bh * 64 + c0 + k) * 16384 + idx);
                dn[k] = do_n ? STN[(size_t)(bh * 64 + c0 + k) * 128 + tid] : 0.f;
            }
#pragma unroll
            for (int k = 0; k < 8; ++k) {
                const float mloc = STM[bh * 64 + c0 + k], bl = STM[2048 + bh * 64 + c0 + k];
                const float mnew = fmaxf(bl + m, mloc);
                dec[k] = __expf(bl + m - mnew); scl[k] = __expf(mloc - mnew);
                if ((u & 7) == 0 && tid == 0) STM[4096 + bh * 64 + c0 + k] = m;
                m = mnew;
            }
#pragma unroll
            for (int k = 0; k < 8; ++k) {
                u32x2 o; o.x = pk2(C[0], C[1]); o.y = pk2(C[2], C[3]);
                *(u32x2*)(ST + (size_t)(bh * 64 + c0 + k) * 16384 + idx) = o;
                const float f[4] = {lo16(raw[k].x), hi16(raw[k].x), lo16(raw[k].y), hi16(raw[k].y)};
#pragma unroll
                for (int j = 0; j < 4; ++j) C[j] = dec[k] * C[j] + scl[k] * f[j];
                if (do_n) { STN[(size_t)(bh * 64 + c0 + k) * 128 + tid] = nval; nval = dec[k] * nval + scl[k] * dn[k]; }
            }
        }
    }
}

__device__ void phase_attn_naive(const Params& p, int l, float* lds) {
    unsigned char* ws = p.ws;
    const bf16_t* proj = (const bf16_t*)(ws + WS_PROJ); const float* gates = (const float*)(ws + WS_GATES);
    const bf16_t* kcmp = (const bf16_t*)(ws + WS_KCMP); const bf16_t* vcmp = (const bf16_t*)(ws + WS_VCMP);
    bf16_t* Y = (bf16_t*)(ws + WS_Y);
    const float* oga = p.in[I_OGA] + l * 512;
    const int tid = my_tid(), lane = tid & 63, wave = tid >> 6;
    float* qs = lds + wave * (256 + 1024);
    float* pb = qs + 256;
    for (int u = my_bid(); u < BATCH * 2 * (SEQ / 8); u += gridDim.x) {
        const int tb = u % (SEQ / 8), g = (u / (SEQ / 8)) & 1, b = u / (SEQ / 4);
        const int t = tb * 8 + wave; const int m = b * SEQ + t;
        const bf16_t* prow = proj + (size_t)m * NPROJ;
#pragma unroll
        for (int hg = 0; hg < 4; ++hg) qs[hg * 64 + lane] = bf2f(prow[C_QA + g * 256 + hg * 64 + lane]);
        float otot[4] = {0.f, 0.f, 0.f, 0.f};
        const float* gt = gates + (size_t)m * 32 + g * 12;
        const int nval = t >= 31 ? ((t - 31) >> 4) + 1 : 0;
        float sc[4][4];
        float mx[4] = {-INFINITY, -INFINITY, -INFINITY, -INFINITY};
        const bf16_t* kc = kcmp + (size_t)(b * 2 + g) * NCMPP * 64; const bf16_t* vc = vcmp + (size_t)(b * 2 + g) * NCMPP * 64;
#pragma unroll
        for (int it = 0; it < 4; ++it) {
            asm volatile("" ::: "memory");
            const int i = it * 64 + lane;
            float a[4] = {0.f, 0.f, 0.f, 0.f};
            if (i < nval) {
#pragma unroll 1
                for (int d8 = 0; d8 < 8; ++d8) {
                    const u32x4 raw = *(const u32x4*)(kc + (size_t)i * 64 + d8 * 8); float f[8]; unpack8(raw, f);
#pragma unroll
                    for (int j = 0; j < 8; ++j)
#pragma unroll
                        for (int hg = 0; hg < 4; ++hg) a[hg] += qs[hg * 64 + d8 * 8 + j] * f[j];
                }
            }
#pragma unroll
            for (int hg = 0; hg < 4; ++hg) { sc[it][hg] = i < nval ? a[hg] * 0.125f : -INFINITY; mx[hg] = fmaxf(mx[hg], sc[it][hg]); }
        }
        float sm[4];
#pragma unroll
        for (int hg = 0; hg < 4; ++hg) {
            mx[hg] = wave_max(mx[hg]);
            float s = 0.f;
#pragma unroll
            for (int it = 0; it < 4; ++it) { const float e = (it * 64 + lane) < nval ? __expf(sc[it][hg] - mx[hg]) : 0.f; sc[it][hg] = e; s += e; }
            sm[hg] = wave_sum(s);
        }
#pragma unroll
        for (int it = 0; it < 4; ++it)
#pragma unroll
            for (int hg = 0; hg < 4; ++hg) pb[hg * 256 + it * 64 + lane] = nval > 0 ? sc[it][hg] / sm[hg] : 0.f;
        {
            float o[4] = {0.f, 0.f, 0.f, 0.f};
            for (int i = 0; i < nval; ++i) {
                const float v = bf2f(vc[(size_t)i * 64 + lane]);
#pragma unroll
                for (int hg = 0; hg < 4; ++hg) o[hg] += pb[hg * 256 + i] * v;
            }
#pragma unroll
            for (int hg = 0; hg < 4; ++hg) otot[hg] += sigmoid_f(gt[hg * 3 + 0]) * o[hg];
        }
        const int cur = t >> 6;
        float imp = 0.f;
#pragma unroll
        for (int k = -1; k < 4; ++k) {
            const int i = 4 * lane + k;
            if (i >= 0 && i < nval) imp += (pb[i] + pb[256 + i]) + (pb[512 + i] + pb[768 + i]);
        }
        const bool valid = lane <= cur;
        const bool forced = (lane == 0) || (lane == cur) || (lane == cur - 1);
        const float score = valid ? imp + (forced ? 1e4f : 0.f) : -1e30f;
        int rank = 0;
        for (int k = 0; k < 64; ++k) {
            const float sk = __shfl(score, k);
            rank += (sk > score || (sk == score && k < lane)) ? 1 : 0;
        }
        const unsigned long long selmask = __ballot(rank < 16 && valid);
#pragma unroll 1
        for (int br = 0; br < 2; ++br) {
            const int kcol = (br ? C_KW : C_KS) + g * 64, vcol = (br ? C_VW : C_VS) + g * 64;
            float mr[4] = {-INFINITY, -INFINITY, -INFINITY, -INFINITY}, lr[4] = {0.f, 0.f, 0.f, 0.f}, o[4] = {0.f, 0.f, 0.f, 0.f};
            const int jlo = br ? (cur >= 8 ? cur - 8 : 0) : 0;
            for (int j = jlo; j <= cur; ++j) {
                if (br == 0 && !((selmask >> j) & 1ull)) continue;
                asm volatile("" ::: "memory");
                const int pos = j * 64 + lane;
                const bool ok = pos <= t && (br == 0 || pos > t - 512);
                float a[4] = {0.f, 0.f, 0.f, 0.f};
                const bf16_t* kr = proj + (size_t)(b * SEQ + pos) * NPROJ + kcol;
#pragma unroll 1
                for (int d8 = 0; d8 < 8; ++d8) {
                    const u32x4 raw = *(const u32x4*)(kr + d8 * 8); float f[8]; unpack8(raw, f);
#pragma unroll
                    for (int jj = 0; jj < 8; ++jj)
#pragma unroll
                        for (int hg = 0; hg < 4; ++hg) a[hg] += qs[hg * 64 + d8 * 8 + jj] * f[jj];
                }
                float alpha[4];
#pragma unroll
                for (int hg = 0; hg < 4; ++hg) {
                    const float s = ok ? a[hg] * 0.125f : -INFINITY;
                    const float bm = wave_max(s);
                    const float mn = fmaxf(mr[hg], bm);
                    alpha[hg] = (mn == -INFINITY) ? 1.f : __expf(mr[hg] - mn);
                    const float e = (ok && mn > -INFINITY) ? __expf(s - mn) : 0.f;
                    lr[hg] = lr[hg] * alpha[hg] + wave_sum(e);
                    mr[hg] = mn;
                    pb[hg * 256 + lane] = e;
                    o[hg] *= alpha[hg];
                }
                const bf16_t* vr = proj + (size_t)(b * SEQ + j * 64) * NPROJ + vcol + lane;
                for (int k = 0; k < 64; ++k) {
                    const float v = bf2f(vr[(size_t)k * NPROJ]);
#pragma unroll
                    for (int hg = 0; hg < 4; ++hg) o[hg] += pb[hg * 256 + k] * v;
                }
            }
#pragma unroll
            for (int hg = 0; hg < 4; ++hg) otot[hg] += sigmoid_f(gt[hg * 3 + 1 + br]) * (lr[hg] > 0.f ? o[hg] / lr[hg] : 0.f);
        }
#pragma unroll
        for (int hg = 0; hg < 4; ++hg) {
            const float s = wave_sum(otot[hg] * otot[hg]);
            const float y = otot[hg] * rsqrtf(s * (1.f / 64.f) + EPS) * oga[(g * 4 + hg) * 64 + lane];
            Y[(size_t)m * 1024 + (g * 4 + hg) * 64 + lane] = f2bf(y);
        }
    }
}

namespace att {
typedef short bf16x8 __attribute__((ext_vector_type(8)));
typedef short s16x4 __attribute__((ext_vector_type(4)));
typedef float f32x16 __attribute__((ext_vector_type(16)));
#define ATT_LAS __attribute__((address_space(3)))
constexpr int L_K = 0, L_V = 16384, L_IMP = 32768, IMP_STRIDE = 65, L_SEL = L_IMP + 4 * 64 * IMP_STRIDE * 4, L_INV = L_SEL + 512, L_WS = L_INV + 1024, L_OST = L_WS + 8 * 256, L_END = L_OST + 8 * 4096;
static_assert(L_END <= LDS_BYTES, "attention LDS map");
constexpr float LOG2E = 1.4426950408889634f;
__device__ __forceinline__ int crow(int r, int hi) { return (r & 3) + 8 * (r >> 2) + 4 * hi; }
__device__ __forceinline__ unsigned cvtpk(float lo, float hi) { unsigned r; asm("v_cvt_pk_bf16_f32 %0, %1, %2" : "=v"(r) : "v"(lo), "v"(hi)); return r; }
__device__ __forceinline__ s16x4 vtr(ATT_LAS const unsigned char* p) { return __builtin_bit_cast(s16x4, __builtin_amdgcn_ds_read_tr16_b64_v4i16((ATT_LAS s16x4*)p)); }

struct Ctx {
    ATT_LAS unsigned char* lds;
    int lane, wave, r32, hi;
    u32x4 kreg, vreg;
};
__device__ __forceinline__ void tile_load(Ctx& C, const bf16_t* kbase, const bf16_t* vbase, int pitch) {
    C.kreg = *(const u32x4*)(kbase + (size_t)C.lane * pitch + C.wave * 8);
    C.vreg = *(const u32x4*)(vbase + (size_t)(16 * (C.wave & 3) + (C.lane >> 2)) * pitch + (C.wave >> 2) * 32 + (C.lane & 3) * 8);
}
__device__ __forceinline__ void tile_store(Ctx& C, int buf) {
    *(ATT_LAS u32x4*)(C.lds + L_K + buf * 8192 + C.wave * 1024 + C.lane * 16) = C.kreg;
    *(ATT_LAS u32x4*)(C.lds + L_V + buf * 8192 + C.wave * 1024 + C.lane * 16) = C.vreg;
}
__device__ __forceinline__ void qkt(const Ctx& C, int buf, const bf16x8 (&qr)[4], f32x16& p0, f32x16& p1) {
    ATT_LAS const unsigned char* kb = C.lds + L_K + buf * 8192 + C.hi * 1024 + C.r32 * 16;
    p0 = (f32x16){0.f, 0.f, 0.f, 0.f, 0.f, 0.f, 0.f, 0.f, 0.f, 0.f, 0.f, 0.f, 0.f, 0.f, 0.f, 0.f}; p1 = p0;
#pragma unroll
    for (int d0 = 0; d0 < 4; ++d0) {
        const bf16x8 b0 = *(ATT_LAS const bf16x8*)(kb + d0 * 2048);
        const bf16x8 b1 = *(ATT_LAS const bf16x8*)(kb + d0 * 2048 + 512);
        p0 = __builtin_amdgcn_mfma_f32_32x32x16_bf16(b0, qr[d0], p0, 0, 0, 0);
        p1 = __builtin_amdgcn_mfma_f32_32x32x16_bf16(b1, qr[d0], p1, 0, 0, 0);
    }
}
__device__ __forceinline__ void pv(const Ctx& C, int buf, const f32x16& p0, const f32x16& p1, f32x16 (&o)[2]) {
    ATT_LAS const unsigned char* vp = C.lds + L_V + buf * 8192 + ((C.lane >> 4) & 1) * 32 + (C.lane & 3) * 8 + (4 * C.hi + ((C.lane & 15) >> 2)) * 64;
    bf16x8 pa[4];
#pragma unroll
    for (int s2 = 0; s2 < 2; ++s2) {
        u32x4 w0, w1;
        w0.x = cvtpk(p0[8 * s2 + 0], p0[8 * s2 + 1]); w0.y = cvtpk(p0[8 * s2 + 2], p0[8 * s2 + 3]); w0.z = cvtpk(p0[8 * s2 + 4], p0[8 * s2 + 5]); w0.w = cvtpk(p0[8 * s2 + 6], p0[8 * s2 + 7]);
        w1.x = cvtpk(p1[8 * s2 + 0], p1[8 * s2 + 1]); w1.y = cvtpk(p1[8 * s2 + 2], p1[8 * s2 + 3]); w1.z = cvtpk(p1[8 * s2 + 4], p1[8 * s2 + 5]); w1.w = cvtpk(p1[8 * s2 + 6], p1[8 * s2 + 7]);
        pa[s2] = __builtin_bit_cast(bf16x8, w0); pa[2 + s2] = __builtin_bit_cast(bf16x8, w1);
    }
#pragma unroll
    for (int d0 = 0; d0 < 2; ++d0)
#pragma unroll
        for (int ks = 0; ks < 4; ++ks) {
            const s16x4 lo = vtr(vp + d0 * 4096 + ks * 1024), hh = vtr(vp + d0 * 4096 + ks * 1024 + 512);
            const bf16x8 vf = (bf16x8){lo[0], lo[1], lo[2], lo[3], hh[0], hh[1], hh[2], hh[3]};
            o[d0] = __builtin_amdgcn_mfma_f32_32x32x16_bf16(pa[ks], vf, o[d0], 0, 0, 0);
        }
}
__device__ __forceinline__ float sum16(const f32x16& p) {
    return ((p[0] + p[1]) + (p[2] + p[3])) + ((p[4] + p[5]) + (p[6] + p[7])) + (((p[8] + p[9]) + (p[10] + p[11])) + ((p[12] + p[13]) + (p[14] + p[15])));
}
__device__ __forceinline__ void accum_scaled(const Ctx& C, f32x16 (&otot)[2], const f32x16 (&o)[2], float fac) {
    ATT_LAS float* wsf = (ATT_LAS float*)(C.lds + L_WS) + C.wave * 64;
    asm volatile("s_waitcnt lgkmcnt(0)" ::: "memory");
    if (C.hi == 0) wsf[C.r32] = fac;
    asm volatile("s_waitcnt lgkmcnt(0)" ::: "memory");
#pragma unroll
    for (int r = 0; r < 16; ++r) { const float f = wsf[crow(r, C.hi)]; otot[0][r] += o[0][r] * f; otot[1][r] += o[1][r] * f; }
    asm volatile("s_waitcnt lgkmcnt(0)" : "+v"(otot[0]), "+v"(otot[1]) :: "memory");
}

__device__ void unit(const Params& p, int l, int b, int g, int c, ATT_LAS unsigned char* lds) {
    unsigned char* ws = p.ws;
    const bf16_t* proj = (const bf16_t*)(ws + WS_PROJ); const float* gates = (const float*)(ws + WS_GATES);
    const bf16_t* kcmp = (const bf16_t*)(ws + WS_KCMP) + (size_t)(b * 2 + g) * NCMPP * 64; const bf16_t* vcmp = (const bf16_t*)(ws + WS_VCMP) + (size_t)(b * 2 + g) * NCMPP * 64;
    bf16_t* Y = (bf16_t*)(ws + WS_Y);
    const float* kg = p.in[I_KG] + l * 192; const float* oga = p.in[I_OGA] + l * 512;
    Ctx C; C.lds = lds;
    const int tid = my_tid(); C.lane = tid & 63; C.wave = __builtin_amdgcn_readfirstlane(tid >> 6); C.r32 = C.lane & 31; C.hi = C.lane >> 5;
    const int lane = C.lane, wave = C.wave, r32 = C.r32, hi = C.hi, hg = wave >> 1, th = wave & 1;
    const int t = 64 * c + 32 * th + r32; const size_t m = (size_t)b * SEQ + t;
    const bf16_t* prow0 = proj + (size_t)b * SEQ * NPROJ;
    bf16x8 qr[4]; float qsq = 0.f;
#pragma unroll
    for (int d0 = 0; d0 < 4; ++d0) {
        const u32x4 raw = *(const u32x4*)(proj + m * NPROJ + C_QA + g * 256 + hg * 64 + 16 * d0 + 8 * hi);
        qr[d0] = __builtin_bit_cast(bf16x8, raw);
        float f[8]; unpack8(raw, f);
#pragma unroll
        for (int j = 0; j < 8; ++j) qsq += f[j] * f[j];
    }
    qsq += __shfl_xor(qsq, 32);
    const float qn = sqrtf(qsq) * 1.01f * LOG2E;
    const float off_c = qn * wave_max(fabsf(kg[lane])), off_s = qn * wave_max(fabsf(kg[64 + lane])), off_w = qn * wave_max(fabsf(kg[128 + lane]));
    const float* gt = gates + m * 32 + (g * 4 + hg) * 3;
    const float gq0 = sigmoid_f(gt[0]), gq1 = sigmoid_f(gt[1]), gq2 = sigmoid_f(gt[2]);
    constexpr float C2 = 0.125f * LOG2E;
    f32x16 otot[2]; otot[0] = (f32x16){0.f, 0.f, 0.f, 0.f, 0.f, 0.f, 0.f, 0.f, 0.f, 0.f, 0.f, 0.f, 0.f, 0.f, 0.f, 0.f}; otot[1] = otot[0];
    const f32x16 zero16 = otot[0];
    {
        const int nval = t >= 31 ? ((t - 31) >> 4) + 1 : 0;
        const int ntc = (4 * c + 3 + 63) >> 6;
        f32x16 o[2]; o[0] = zero16; o[1] = zero16;
        float lsum = 0.f, yprev = 0.f;
        ATT_LAS float* imp = (ATT_LAS float*)(lds + L_IMP) + (hg * 64 + 32 * th + r32) * IMP_STRIDE;
        tile_load(C, kcmp, vcmp, 64); tile_store(C, 0); __syncthreads();
#pragma unroll
        for (int jt = 0; jt < 4; ++jt) {
            if (jt < ntc) {
                if (jt + 1 < ntc) tile_load(C, kcmp + (size_t)(jt + 1) * 64 * 64, vcmp + (size_t)(jt + 1) * 64 * 64, 64);
                f32x16 p0, p1; qkt(C, jt & 1, qr, p0, p1);
#pragma unroll
                for (int r = 0; r < 16; ++r) {
                    const int i0 = 64 * jt + crow(r, hi);
                    p0[r] = i0 < nval ? __builtin_amdgcn_exp2f(p0[r] * C2 - off_c) : 0.f;
                    p1[r] = i0 + 32 < nval ? __builtin_amdgcn_exp2f(p1[r] * C2 - off_c) : 0.f;
                }
                lsum += sum16(p0) + sum16(p1);
#pragma unroll
                for (int H = 0; H < 2; ++H)
#pragma unroll
                    for (int rr = 0; rr < 4; ++rr) {
                        const f32x16& pp = H ? p1 : p0;
                        const float L = pp[4 * rr + 3], S4 = (pp[4 * rr] + pp[4 * rr + 1]) + (pp[4 * rr + 2] + L);
                        const float y = __shfl_xor(L, 32);
                        imp[2 * ((jt * 2 + H) * 4 + rr) + hi] = S4 + (hi ? y : yprev);
                        yprev = y;
                    }
                pv(C, jt & 1, p0, p1, o);
                if (jt + 1 < ntc) tile_store(C, (jt + 1) & 1);
                __syncthreads();
            }
        }
        lsum += __shfl_xor(lsum, 32);
        const float inv = lsum > 0.f ? 1.f / lsum : 0.f;
        if (hi == 0) ((ATT_LAS float*)(lds + L_INV))[hg * 64 + 32 * th + r32] = inv;
        accum_scaled(C, otot, o, gq0 * inv);
    }
    __syncthreads();
    {
        ATT_LAS unsigned long long* selm = (ATT_LAS unsigned long long*)(lds + L_SEL);
        const ATT_LAS float* impb = (const ATT_LAS float*)(lds + L_IMP);
        for (int i = 0; i < 8; ++i) {
            const int q = wave * 8 + i;
            unsigned long long msk;
            if (c < 16) msk = (2ull << c) - 1ull;
            else {
                const bool valid = lane <= c;
                float sc = -1e30f;
                if (valid) {
                    const ATT_LAS float* invb = (const ATT_LAS float*)(lds + L_INV);
                    sc = (impb[(0 * 64 + q) * IMP_STRIDE + lane] * invb[q] + impb[(1 * 64 + q) * IMP_STRIDE + lane] * invb[64 + q]) + (impb[(2 * 64 + q) * IMP_STRIDE + lane] * invb[128 + q] + impb[(3 * 64 + q) * IMP_STRIDE + lane] * invb[192 + q]);
                    if (lane == 0 || lane == c || lane == c - 1) sc += 1e4f;
                }
                int rank = 0;
                for (int k = 0; k <= c; ++k) { const float sk = __shfl(sc, k); rank += (sk > sc || (sk == sc && k < lane)) ? 1 : 0; }
                msk = __ballot(valid && rank < 16);
            }
            if (lane == 0) selm[q] = msk;
        }
    }
    __syncthreads();
    const unsigned long long mysel = ((ATT_LAS const unsigned long long*)(lds + L_SEL))[32 * th + r32];
    unsigned long long blkmask;
    {
        unsigned long long v = ((ATT_LAS const unsigned long long*)(lds + L_SEL))[lane];
#pragma unroll
        for (int o2 = 1; o2 < 64; o2 <<= 1) v |= __shfl_xor(v, o2);
        blkmask = ((unsigned long long)__builtin_amdgcn_readfirstlane((unsigned)(v >> 32)) << 32) | (unsigned)__builtin_amdgcn_readfirstlane((unsigned)v);
    }
    {
        f32x16 o[2]; o[0] = zero16; o[1] = zero16; float lsum = 0.f;
        const bf16_t* kb = prow0 + C_KS + g * 64; const bf16_t* vb = prow0 + C_VS + g * 64;
        unsigned long long rem = blkmask;
        int j = __builtin_ctzll(rem); rem &= rem - 1ull;
        tile_load(C, kb + (size_t)j * 64 * NPROJ, vb + (size_t)j * 64 * NPROJ, NPROJ); tile_store(C, 0); __syncthreads();
        int buf = 0;
        for (;;) {
            const int jn = rem ? __builtin_ctzll(rem) : -1;
            if (jn >= 0) { rem &= rem - 1ull; tile_load(C, kb + (size_t)jn * 64 * NPROJ, vb + (size_t)jn * 64 * NPROJ, NPROJ); }
            f32x16 p0, p1; qkt(C, buf, qr, p0, p1);
            const bool sel = (mysel >> j) & 1ull;
            const int lim = t - 64 * j;
#pragma unroll
            for (int r = 0; r < 16; ++r) {
                const int kk = crow(r, hi);
                p0[r] = (sel && kk <= lim) ? __builtin_amdgcn_exp2f(p0[r] * C2 - off_s) : 0.f;
                p1[r] = (sel && kk + 32 <= lim) ? __builtin_amdgcn_exp2f(p1[r] * C2 - off_s) : 0.f;
            }
            lsum += sum16(p0) + sum16(p1);
            pv(C, buf, p0, p1, o);
            if (jn >= 0) tile_store(C, buf ^ 1);
            __syncthreads();
            if (jn < 0) break;
            j = jn; buf ^= 1;
        }
        lsum += __shfl_xor(lsum, 32);
        accum_scaled(C, otot, o, gq1 / lsum);
    }
    {
        f32x16 o[2]; o[0] = zero16; o[1] = zero16; float lsum = 0.f;
        const bf16_t* kb = prow0 + C_KW + g * 64; const bf16_t* vb = prow0 + C_VW + g * 64;
        const int jlo = c >= 8 ? c - 8 : 0;
        tile_load(C, kb + (size_t)jlo * 64 * NPROJ, vb + (size_t)jlo * 64 * NPROJ, NPROJ); tile_store(C, 0); __syncthreads();
        int buf = 0;
        for (int j = jlo; j <= c; ++j) {
            if (j < c) tile_load(C, kb + (size_t)(j + 1) * 64 * NPROJ, vb + (size_t)(j + 1) * 64 * NPROJ, NPROJ);
            f32x16 p0, p1; qkt(C, buf, qr, p0, p1);
            const int lim = t - 64 * j;
#pragma unroll
            for (int r = 0; r < 16; ++r) {
                const int kk = crow(r, hi);
                p0[r] = (kk <= lim && kk > lim - 512) ? __builtin_amdgcn_exp2f(p0[r] * C2 - off_w) : 0.f;
                p1[r] = (kk + 32 <= lim && kk + 32 > lim - 512) ? __builtin_amdgcn_exp2f(p1[r] * C2 - off_w) : 0.f;
            }
            lsum += sum16(p0) + sum16(p1);
            pv(C, buf, p0, p1, o);
            if (j < c) tile_store(C, buf ^ 1);
            __syncthreads();
            buf ^= 1;
        }
        lsum += __shfl_xor(lsum, 32);
        accum_scaled(C, otot, o, gq2 / lsum);
    }
    {
        ATT_LAS bf16_t* stg = (ATT_LAS bf16_t*)(lds + L_OST) + wave * 2048;
        const float g0 = oga[(g * 4 + hg) * 64 + r32], g1 = oga[(g * 4 + hg) * 64 + 32 + r32];
#pragma unroll
        for (int r = 0; r < 16; ++r) {
            float sq = otot[0][r] * otot[0][r] + otot[1][r] * otot[1][r];
            sq += __shfl_xor(sq, 1); sq += __shfl_xor(sq, 2); sq += __shfl_xor(sq, 4); sq += __shfl_xor(sq, 8); sq += __shfl_xor(sq, 16);
            const float rs = rsqrtf(sq * (1.f / 64.f) + EPS);
            const int q = crow(r, hi);
            stg[q * 64 + r32] = f2bf(otot[0][r] * rs * g0);
            stg[q * 64 + 32 + r32] = f2bf(otot[1][r] * rs * g1);
        }
        asm volatile("s_waitcnt lgkmcnt(0)" ::: "memory");
        bf16_t* yb = Y + ((size_t)b * SEQ + 64 * c + 32 * th) * 1024 + (g * 4 + hg) * 64;
#pragma unroll
        for (int i = 0; i < 4; ++i) {
            const int row = i * 8 + (lane >> 3), ch = lane & 7;
            const u32x4 v = *(ATT_LAS const u32x4*)(stg + row * 64 + ch * 8);
            *(u32x4*)(yb + (size_t)row * 1024 + ch * 8) = v;
        }
    }
    __syncthreads();
}
}

__device__ void phase_attn_mfma(const Params& p, int l, unsigned char* lds_raw) {
    for (int v = my_bid(); v < 1024; v += gridDim.x) {
        const int r = v >> 8, x = (v >> 4) & 15, bg = v & 15;
        const int c = r == 0 ? 63 - x : (r == 1 ? 32 + x : (r == 2 ? 31 - x : x));
        att::unit(p, l, bg >> 1, bg & 1, c, (ATT_LAS unsigned char*)lds_raw);
    }
}

__device__ void phase_mlstm_out(const Params& p, int l, float* lds) {
    unsigned char* ws = p.ws;
    const bf16_t* proj = (const bf16_t*)(ws + WS_PROJ); const float* gates = (const float*)(ws + WS_GATES);
    const bf16_t* qkc = (const bf16_t*)p.out;
    const bf16_t* ST = (const bf16_t*)(ws + WS_ST); const float* STN = (const float*)(ws + WS_STN); const float* STM = (const float*)(ws + WS_STM);
    const float* fb = p.in[I_FB] + l * 4; const float* ogm = p.in[I_OGM] + l * 512;
    bf16_t* Y = (bf16_t*)(ws + WS_Y);
    float* qq = lds;
    float* kk = lds + 8192;
    float* Cs = lds + 16384;
    float* Ws = lds + 32768;
    float* bcum = Ws + 64 * 65; float* ig = bcum + 64; float* mt = ig + 64; float* wint = mt + 64; float* den = wint + 64; float* npv = den + 64;
    const int tid = my_tid(), lane = tid & 63, wave = tid >> 6;
    for (int u = my_bid(); u < BATCH * 4 * 64; u += gridDim.x) {
        const int c = u & 63, h = (u >> 6) & 3, b = u >> 8;
        const int m0 = b * SEQ + c * 64, bh = b * 4 + h;
        mlstm_gates(gates, fb, m0, h, bcum, ig);
        const float mprev = STM[4096 + bh * 64 + c];
        for (int e = tid; e < 64 * 16; e += NT) {
            const int s = e >> 4, d0 = (e & 15) * 8;
            const u32x4 rq = *(const u32x4*)(qkc + (size_t)(m0 + s) * 1024 + h * 128 + d0); float f[8]; unpack8(rq, f);
            const u32x4 rk = *(const u32x4*)(qkc + (size_t)(m0 + s) * 1024 + 512 + h * 128 + d0); float fk[8]; unpack8(rk, fk);
#pragma unroll
            for (int j = 0; j < 8; ++j) { qq[s * 128 + d0 + j] = f[j]; kk[s * 128 + d0 + j] = fk[j]; }
        }
        if (tid < 128) npv[tid] = STN[(size_t)(bh * 64 + c) * 128 + tid];
        for (int e8 = tid; e8 < 128 * 16; e8 += NT) {
            const int e = e8 >> 4, d0 = (e8 & 15) * 8;
            const u32x4 rc = *(const u32x4*)(ST + ((size_t)(bh * 64 + c) * 128 + e) * 128 + d0); float f[8]; unpack8(rc, f);
#pragma unroll
            for (int j = 0; j < 8; ++j) Cs[(d0 + j) * 128 + e] = f[j];
        }
        __syncthreads();
        {
            const int t = tid >> 3, s0 = (tid & 7) * 8;
            float a[8] = {0.f, 0.f, 0.f, 0.f, 0.f, 0.f, 0.f, 0.f};
#pragma unroll 2
            for (int d = 0; d < 128; ++d) {
                const float qv = qq[t * 128 + d];
#pragma unroll
                for (int j = 0; j < 8; ++j) a[j] += qv * kk[(s0 + j) * 128 + d];
            }
#pragma unroll
            for (int j = 0; j < 8; ++j) Ws[t * 65 + s0 + j] = a[j];
        }
        __syncthreads();
        for (int r = 0; r < 8; ++r) {
            const int t = wave * 8 + r;
            const float dv = lane <= t ? bcum[t] - bcum[lane] + ig[lane] : -INFINITY;
            const float a = bcum[t] + mprev;
            const float m_t = fmaxf(a, wave_max(dv));
            const float w = lane <= t ? __expf(dv - m_t) * Ws[t * 65 + lane] : 0.f;
            Ws[t * 65 + lane] = w;
            const float wi = __expf(a - m_t);
            const float qn = wave_sum(qq[t * 128 + lane] * npv[lane] + qq[t * 128 + 64 + lane] * npv[64 + lane]);
            const float dsum = wave_sum(w);
            if (lane == 0) { mt[t] = m_t; wint[t] = wi; den[t] = wi * qn + dsum; }
        }
        __syncthreads();
        for (int e = tid; e < 64 * 16; e += NT) {
            const int s = e >> 4, d0 = (e & 15) * 8;
            const u32x4 rv = *(const u32x4*)(proj + (size_t)(m0 + s) * NPROJ + C_VB + h * 128 + d0); float f[8]; unpack8(rv, f);
#pragma unroll
            for (int j = 0; j < 8; ++j) kk[s * 128 + d0 + j] = f[j];
        }
        __syncthreads();
        float hv[16];
        {
            const int e = tid & 127, t0 = (tid >> 7) * 16;
            float a1[16], a2[16];
#pragma unroll
            for (int i = 0; i < 16; ++i) { a1[i] = 0.f; a2[i] = 0.f; }
#pragma unroll 2
            for (int d = 0; d < 128; ++d) {
                const float cv = Cs[d * 128 + e];
#pragma unroll
                for (int i = 0; i < 16; ++i) a1[i] += qq[(t0 + i) * 128 + d] * cv;
            }
#pragma unroll 2
            for (int s = 0; s < 64; ++s) {
                const float vv = kk[s * 128 + e];
#pragma unroll
                for (int i = 0; i < 16; ++i) a2[i] += Ws[(t0 + i) * 65 + s] * vv;
            }
#pragma unroll
            for (int i = 0; i < 16; ++i) {
                const int t = t0 + i;
                const float num = wint[t] * a1[i] + a2[i];
                hv[i] = num / fmaxf(fabsf(den[t]), __expf(-mt[t]));
            }
        }
        __syncthreads();
        {
            const int e = tid & 127, t0 = (tid >> 7) * 16;
#pragma unroll
            for (int i = 0; i < 16; ++i) Cs[(t0 + i) * 128 + e] = hv[i];
        }
        __syncthreads();
        for (int r = 0; r < 8; ++r) {
            const int t = wave * 8 + r;
            const float h0 = Cs[t * 128 + lane], h1 = Cs[t * 128 + 64 + lane];
            const float s = wave_sum(h0 * h0 + h1 * h1);
            const float rr = rsqrtf(s * (1.f / 128.f) + EPS);
            const bf16_t* op = proj + (size_t)(m0 + t) * NPROJ + C_OB + h * 128;
            const float y0 = h0 * rr * ogm[h * 128 + lane] * sigmoid_f(bf2f(op[lane]));
            const float y1 = h1 * rr * ogm[h * 128 + 64 + lane] * sigmoid_f(bf2f(op[64 + lane]));
            Y[(size_t)(m0 + t) * 1024 + 512 + h * 128 + lane] = f2bf(y0);
            Y[(size_t)(m0 + t) * 1024 + 512 + h * 128 + 64 + lane] = f2bf(y1);
        }
        __syncthreads();
    }
}

namespace mls {
typedef short bf16x8 __attribute__((ext_vector_type(8)));
typedef short s16x4 __attribute__((ext_vector_type(4)));
typedef float f32x16 __attribute__((ext_vector_type(16)));
#define MLS_LAS __attribute__((address_space(3)))
__device__ __forceinline__ s16x4 vtr(MLS_LAS const unsigned char* p) { return __builtin_bit_cast(s16x4, __builtin_amdgcn_ds_read_tr16_b64_v4i16((MLS_LAS s16x4*)p)); }
__device__ __forceinline__ bf16x8 trfrag(MLS_LAS const unsigned char* p) { const s16x4 lo = vtr(p), hh = vtr(p + 512); return (bf16x8){lo[0], lo[1], lo[2], lo[3], hh[0], hh[1], hh[2], hh[3]}; }
__device__ __forceinline__ float incl_scan64(float v, int lane) {
#pragma unroll
    for (int o = 1; o < 64; o <<= 1) { const float t = __shfl_up(v, o); if (lane >= o) v += t; }
    return v;
}
constexpr float KSCALE = 0.08838834764831845f;
constexpr int LC_W = 131072;

__device__ void chunk_unit(const Params& p, int l, int b, int c, MLS_LAS unsigned char* lds) {
    unsigned char* ws = p.ws;
    const bf16_t* proj = (const bf16_t*)(ws + WS_PROJ); const float* gates = (const float*)(ws + WS_GATES);
    const float* cw = p.in[I_CW] + l * 4096; const float* cb = p.in[I_CB] + l * 1024; const float* fb = p.in[I_FB] + l * 4;
    bf16_t* ST = (bf16_t*)(ws + WS_ST); float* STN = (float*)(ws + WS_STN); float* STM = (float*)(ws + WS_STM);
    const int tid = my_tid(), lane = tid & 63, wave = __builtin_amdgcn_readfirstlane(tid >> 6), r32 = lane & 31, hi = lane >> 5, h = wave >> 1, half = wave & 1;
    const size_t m0 = (size_t)b * SEQ + 64 * c; const int bh = b * 4 + h;
    const float lf = log_sigmoid_f(gates[(m0 + lane) * 32 + 28 + h] + fb[h]);
    const float igv = gates[(m0 + lane) * 32 + 24 + h];
    const float bc = incl_scan64(lf, lane);
    const float blast = __shfl(bc, 63);
    const float gv = blast - bc + igv;
    const float mloc = wave_max(gv);
    const float wsc = __expf(gv - mloc);
    if (half == 0 && lane == 0) { STM[bh * 64 + c] = mloc; STM[2048 + bh * 64 + c] = blast; }
    MLS_LAS unsigned char* vimg = lds + h * 32768; MLS_LAS unsigned char* kimg = vimg + 16384;
    bf16_t* qkc = (bf16_t*)p.out;
    const MLS_LAS float* cwl = (const MLS_LAS float*)(lds + LC_W);
    {
        const int pc = lane & 15;
#pragma unroll
        for (int isk = 1; isk >= 0; --isk) {
            const int ch = isk * 512 + h * 128 + pc * 8;
            float cwv[4][8], cbv[8];
#pragma unroll
            for (int w = 0; w < 4; ++w) { const f32x4 a0 = *(const MLS_LAS f32x4*)(cwl + w * 1024 + ch), a1 = *(const MLS_LAS f32x4*)(cwl + w * 1024 + ch + 4);
                cwv[w][0] = a0.x; cwv[w][1] = a0.y; cwv[w][2] = a0.z; cwv[w][3] = a0.w; cwv[w][4] = a1.x; cwv[w][5] = a1.y; cwv[w][6] = a1.z; cwv[w][7] = a1.w; }
            { const f32x4 a0 = *(const MLS_LAS f32x4*)(cwl + 4096 + ch), a1 = *(const MLS_LAS f32x4*)(cwl + 4096 + ch + 4);
                cbv[0] = a0.x; cbv[1] = a0.y; cbv[2] = a0.z; cbv[3] = a0.w; cbv[4] = a1.x; cbv[5] = a1.y; cbv[6] = a1.z; cbv[7] = a1.w; }
#pragma unroll 1
            for (int bq = 0; bq < 2; ++bq) {
                u32x4 taps[4][4], vv[4];
#pragma unroll
                for (int i = 0; i < 4; ++i) {
                    const int s = 32 * half + 4 * (4 * bq + i) + (lane >> 4);
#pragma unroll
                    for (int w = 0; w < 4; ++w) {
                        const bool ok = 64 * c + s - 3 + w >= 0;
                        taps[i][w] = *(const u32x4*)(proj + (m0 + (ok ? s - 3 + w : 0)) * NPROJ + C_QB + ch);
                    }
                    if (isk) vv[i] = *(const u32x4*)(proj + (m0 + s) * NPROJ + C_VB + h * 128 + pc * 8);
                }
#pragma unroll
                for (int i = 0; i < 4; ++i) {
                    const int s = 32 * half + 4 * (4 * bq + i) + (lane >> 4);
                    if (isk) *(MLS_LAS u32x4*)(vimg + (pc >> 2) * 4096 + s * 64 + (pc & 3) * 16) = vv[i];
                    float acc[8];
#pragma unroll
                    for (int j = 0; j < 8; ++j) acc[j] = cbv[j];
#pragma unroll
                    for (int w = 0; w < 4; ++w) {
                        const float z = (64 * c + s - 3 + w >= 0) ? 1.f : 0.f;
                        float f[8]; unpack8(taps[i][w], f);
#pragma unroll
                        for (int j = 0; j < 8; ++j) acc[j] += f[j] * (cwv[w][j] * z);
                    }
                    float y[8];
#pragma unroll
                    for (int j = 0; j < 8; ++j) y[j] = silu_f(acc[j]) * (isk ? KSCALE : 1.f);
                    u32x4 o; o.x = pk2(y[0], y[1]); o.y = pk2(y[2], y[3]); o.z = pk2(y[4], y[5]); o.w = pk2(y[6], y[7]);
                    *(u32x4*)(qkc + (m0 + s) * 1024 + ch) = o;
                    if (isk) {
                        const float sc = __shfl(wsc, s);
                        u32x4 o2; o2.x = pk2(y[0] * sc, y[1] * sc); o2.y = pk2(y[2] * sc, y[3] * sc); o2.z = pk2(y[4] * sc, y[5] * sc); o2.w = pk2(y[6] * sc, y[7] * sc);
                        *(MLS_LAS u32x4*)(kimg + (pc >> 2) * 4096 + s * 64 + (pc & 3) * 16) = o2;
                    }
                }
            }
        }
    }
    {
#pragma unroll 1
        for (int pass = 0; pass < 2; ++pass) {
            if (pass == 1 && tid >= 256) break;
            bf16_t* ptr; const MLS_LAS float* gn;
            if (pass == 0) { ptr = (bf16_t*)proj + (m0 + (tid >> 3)) * NPROJ + C_QA + (tid & 7) * 64; gn = cwl + 5120; }
            else { const int kind = (tid >> 1) & 1; ptr = (bf16_t*)proj + (m0 + (tid >> 2)) * NPROJ + (kind ? C_KW : C_KS) + (tid & 1) * 64; gn = cwl + 5120 + 64 + (1 + kind) * 64; }
            u32x4 raw[8]; float sq = 0.f;
#pragma unroll
            for (int i = 0; i < 8; ++i) { raw[i] = *(const u32x4*)(ptr + 8 * i); float f[8]; unpack8(raw[i], f);
#pragma unroll
                for (int j = 0; j < 8; ++j) sq += f[j] * f[j]; }
            const float r = rsqrtf(sq * (1.f / 64.f) + EPS);
#pragma unroll
            for (int i = 0; i < 8; ++i) { float f[8]; unpack8(raw[i], f);
                const f32x4 g0 = *(const MLS_LAS f32x4*)(gn + 8 * i), g1 = *(const MLS_LAS f32x4*)(gn + 8 * i + 4);
                u32x4 o; o.x = pk2(f[0] * r * g0.x, f[1] * r * g0.y); o.y = pk2(f[2] * r * g0.z, f[3] * r * g0.w); o.z = pk2(f[4] * r * g1.x, f[5] * r * g1.y); o.w = pk2(f[6] * r * g1.z, f[7] * r * g1.w);
                *(u32x4*)(ptr + 8 * i) = o; }
        }
    }
    __syncthreads();
    f32x16 acc[2][4];
#pragma unroll
    for (int e2 = 0; e2 < 2; ++e2)
#pragma unroll
        for (int db = 0; db < 4; ++db) acc[e2][db] = (f32x16){0.f, 0.f, 0.f, 0.f, 0.f, 0.f, 0.f, 0.f, 0.f, 0.f, 0.f, 0.f, 0.f, 0.f, 0.f, 0.f};
    {
        const int tro = ((lane >> 4) & 1) * 32 + (lane & 3) * 8 + (4 * hi + ((lane & 15) >> 2)) * 64;
#pragma unroll
        for (int ks = 0; ks < 4; ++ks) {
            const bf16x8 a0 = trfrag(vimg + tro + (2 * half) * 4096 + ks * 1024), a1 = trfrag(vimg + tro + (2 * half + 1) * 4096 + ks * 1024);
#pragma unroll
            for (int db = 0; db < 4; ++db) {
                const bf16x8 bfr = trfrag(kimg + tro + db * 4096 + ks * 1024);
                acc[0][db] = __builtin_amdgcn_mfma_f32_32x32x16_bf16(a0, bfr, acc[0][db], 0, 0, 0);
                acc[1][db] = __builtin_amdgcn_mfma_f32_32x32x16_bf16(a1, bfr, acc[1][db], 0, 0, 0);
            }
        }
    }
    {
        const int hh = tid >> 7, d = tid & 127;
        MLS_LAS const bf16_t* kp = (MLS_LAS const bf16_t*)(lds + hh * 32768 + 16384 + (d >> 5) * 4096) + (d & 31);
        float sm = 0.f;
#pragma unroll 8
        for (int s2 = 0; s2 < 64; ++s2) sm += bf2f(kp[s2 * 32]);
        STN[(size_t)((b * 4 + hh) * 64 + c) * 128 + d] = sm;
    }
    __syncthreads();
    {
        MLS_LAS bf16_t* stg = (MLS_LAS bf16_t*)(lds + h * 32768 + half * 16384);
#pragma unroll
        for (int e2 = 0; e2 < 2; ++e2)
#pragma unroll
            for (int db = 0; db < 4; ++db)
#pragma unroll
                for (int r = 0; r < 16; ++r) stg[(32 * e2 + att::crow(r, hi)) * 128 + 32 * db + r32] = f2bf(acc[e2][db][r]);
        asm volatile("s_waitcnt lgkmcnt(0)" ::: "memory");
        bf16_t* dst = ST + ((size_t)(bh * 64 + c) * 128 + 64 * half) * 128;
#pragma unroll 4
        for (int it = 0; it < 16; ++it) {
            const int idx = it * 64 + lane;
            *(u32x4*)(dst + (size_t)idx * 8) = *(MLS_LAS const u32x4*)(stg + idx * 8);
        }
    }
    __syncthreads();
}

constexpr int LO_V = 0, LO_STG = 65536, LO_G = 131072;
__device__ void out_unit(const Params& p, int l, int b, int c, MLS_LAS unsigned char* lds) {
    unsigned char* ws = p.ws;
    const bf16_t* proj = (const bf16_t*)(ws + WS_PROJ); const float* gates = (const float*)(ws + WS_GATES);
    const bf16_t* qkc = (const bf16_t*)p.out;
    const bf16_t* ST = (const bf16_t*)(ws + WS_ST); const float* STN = (const float*)(ws + WS_STN); const float* STM = (const float*)(ws + WS_STM);
    const float* fb = p.in[I_FB] + l * 4; const float* ogm = p.in[I_OGM] + l * 512;
    bf16_t* Y = (bf16_t*)(ws + WS_Y);
    const int tid = my_tid(), lane = tid & 63, wave = __builtin_amdgcn_readfirstlane(tid >> 6), r32 = lane & 31, hi = lane >> 5, h = wave >> 1, th = wave & 1;
    const size_t m0 = (size_t)b * SEQ + 64 * c; const int bh = b * 4 + h;
    MLS_LAS unsigned char* vimg = lds + LO_V + h * 16384;
    MLS_LAS float* garr = (MLS_LAS float*)(lds + LO_G + wave * 512);
#pragma unroll 4
    for (int it = 0; it < 8; ++it) {
        const int s = 32 * th + 4 * it + (lane >> 4), pc = lane & 15;
        const u32x4 rv = *(const u32x4*)(proj + (m0 + s) * NPROJ + C_VB + h * 128 + pc * 8);
        *(MLS_LAS u32x4*)(vimg + (pc >> 2) * 4096 + s * 64 + (pc & 3) * 16) = rv;
    }
    {
        const float lf = log_sigmoid_f(gates[(m0 + lane) * 32 + 28 + h] + fb[h]);
        garr[lane] = incl_scan64(lf, lane);
        garr[64 + lane] = gates[(m0 + lane) * 32 + 24 + h];
    }
    const float mprev = STM[4096 + bh * 64 + c];
    const int tl = 32 * th + r32;
    bf16x8 qf[8];
#pragma unroll
    for (int ks = 0; ks < 8; ++ks) qf[ks] = __builtin_bit_cast(bf16x8, *(const u32x4*)(qkc + (m0 + tl) * 1024 + h * 128 + 16 * ks + 8 * hi));
    f32x16 p0 = (f32x16){0.f, 0.f, 0.f, 0.f, 0.f, 0.f, 0.f, 0.f, 0.f, 0.f, 0.f, 0.f, 0.f, 0.f, 0.f, 0.f}, p1 = p0;
#pragma unroll
    for (int ks = 0; ks < 8; ++ks) {
        const bf16x8 k0 = __builtin_bit_cast(bf16x8, *(const u32x4*)(qkc + (m0 + r32) * 1024 + 512 + h * 128 + 16 * ks + 8 * hi));
        const bf16x8 k1 = __builtin_bit_cast(bf16x8, *(const u32x4*)(qkc + (m0 + 32 + r32) * 1024 + 512 + h * 128 + 16 * ks + 8 * hi));
        p0 = __builtin_amdgcn_mfma_f32_32x32x16_bf16(k0, qf[ks], p0, 0, 0, 0);
        p1 = __builtin_amdgcn_mfma_f32_32x32x16_bf16(k1, qf[ks], p1, 0, 0, 0);
    }
    float qn = 0.f;
    {
        const float* np = STN + (size_t)(bh * 64 + c) * 128;
#pragma unroll
        for (int ks = 0; ks < 8; ++ks) {
            const f32x4 n0 = *(const f32x4*)(np + 16 * ks + 8 * hi), n1 = *(const f32x4*)(np + 16 * ks + 8 * hi + 4);
            float f[8]; unpack8(__builtin_bit_cast(u32x4, qf[ks]), f);
            qn += (f[0] * n0.x + f[1] * n0.y) + (f[2] * n0.z + f[3] * n0.w) + (f[4] * n1.x + f[5] * n1.y) + (f[6] * n1.z + f[7] * n1.w);
        }
        qn += __shfl_xor(qn, 32);
    }
    asm volatile("s_waitcnt lgkmcnt(0)" ::: "memory");
    const float bt = garr[tl];
    float dv0[16], dv1[16]; float mx = -INFINITY;
#pragma unroll
    for (int r = 0; r < 16; ++r) {
        const int s0 = att::crow(r, hi);
        dv0[r] = s0 <= tl ? bt - garr[s0] + garr[64 + s0] : -INFINITY;
        dv1[r] = s0 + 32 <= tl ? bt - garr[s0 + 32] + garr[64 + s0 + 32] : -INFINITY;
        mx = fmaxf(mx, fmaxf(dv0[r], dv1[r]));
    }
    mx = fmaxf(mx, __shfl_xor(mx, 32));
    const float a_t = bt + mprev;
    const float m_t = fmaxf(a_t, mx);
    float dsum = 0.f;
#pragma unroll
    for (int r = 0; r < 16; ++r) {
        p0[r] = __expf(dv0[r] - m_t) * p0[r];
        p1[r] = __expf(dv1[r] - m_t) * p1[r];
        dsum += p0[r] + p1[r];
    }
    dsum += __shfl_xor(dsum, 32);
    const float winter = __expf(a_t - m_t);
    const float den = winter * qn + dsum;
    const float scl = 1.f / fmaxf(fabsf(den), __expf(-m_t));
    const float fq = winter * scl;
    bf16x8 pa[4];
#pragma unroll
    for (int s2 = 0; s2 < 2; ++s2) {
        u32x4 w0, w1;
        w0.x = att::cvtpk(p0[8 * s2 + 0] * scl, p0[8 * s2 + 1] * scl); w0.y = att::cvtpk(p0[8 * s2 + 2] * scl, p0[8 * s2 + 3] * scl); w0.z = att::cvtpk(p0[8 * s2 + 4] * scl, p0[8 * s2 + 5] * scl); w0.w = att::cvtpk(p0[8 * s2 + 6] * scl, p0[8 * s2 + 7] * scl);
        w1.x = att::cvtpk(p1[8 * s2 + 0] * scl, p1[8 * s2 + 1] * scl); w1.y = att::cvtpk(p1[8 * s2 + 2] * scl, p1[8 * s2 + 3] * scl); w1.z = att::cvtpk(p1[8 * s2 + 4] * scl, p1[8 * s2 + 5] * scl); w1.w = att::cvtpk(p1[8 * s2 + 6] * scl, p1[8 * s2 + 7] * scl);
        pa[s2] = __builtin_bit_cast(bf16x8, w0); pa[2 + s2] = __builtin_bit_cast(bf16x8, w1);
    }
#pragma unroll
    for (int ks = 0; ks < 8; ++ks) {
        float f[8]; unpack8(__builtin_bit_cast(u32x4, qf[ks]), f);
        u32x4 w; w.x = att::cvtpk(f[0] * fq, f[1] * fq); w.y = att::cvtpk(f[2] * fq, f[3] * fq); w.z = att::cvtpk(f[4] * fq, f[5] * fq); w.w = att::cvtpk(f[6] * fq, f[7] * fq);
        qf[ks] = __builtin_bit_cast(bf16x8, w);
    }
    f32x16 acc[4];
#pragma unroll
    for (int eb = 0; eb < 4; ++eb) acc[eb] = (f32x16){0.f, 0.f, 0.f, 0.f, 0.f, 0.f, 0.f, 0.f, 0.f, 0.f, 0.f, 0.f, 0.f, 0.f, 0.f, 0.f};
    {
        const bf16_t* cp = ST + (size_t)(bh * 64 + c) * 16384 + (size_t)r32 * 128 + 8 * hi;
#pragma unroll
        for (int eb = 0; eb < 4; ++eb)
#pragma unroll
            for (int ks = 0; ks < 8; ++ks) {
                const bf16x8 cf = __builtin_bit_cast(bf16x8, *(const u32x4*)(cp + eb * 32 * 128 + 16 * ks));
                acc[eb] = __builtin_amdgcn_mfma_f32_32x32x16_bf16(qf[ks], cf, acc[eb], 0, 0, 0);
            }
    }
    __syncthreads();
    {
        const int tro = ((lane >> 4) & 1) * 32 + (lane & 3) * 8 + (4 * hi + ((lane & 15) >> 2)) * 64;
#pragma unroll
        for (int eb = 0; eb < 4; ++eb)
#pragma unroll
            for (int ks = 0; ks < 4; ++ks) acc[eb] = __builtin_amdgcn_mfma_f32_32x32x16_bf16(pa[ks], trfrag(vimg + tro + eb * 4096 + ks * 1024), acc[eb], 0, 0, 0);
    }
    {
        MLS_LAS bf16_t* stg = (MLS_LAS bf16_t*)(lds + LO_STG + wave * 8192);
        float gn[4];
#pragma unroll
        for (int eb = 0; eb < 4; ++eb) gn[eb] = ogm[h * 128 + 32 * eb + r32];
#pragma unroll
        for (int r = 0; r < 16; ++r) {
            float sq = (acc[0][r] * acc[0][r] + acc[1][r] * acc[1][r]) + (acc[2][r] * acc[2][r] + acc[3][r] * acc[3][r]);
            sq += __shfl_xor(sq, 1); sq += __shfl_xor(sq, 2); sq += __shfl_xor(sq, 4); sq += __shfl_xor(sq, 8); sq += __shfl_xor(sq, 16);
            const float rs = rsqrtf(sq * (1.f / 128.f) + EPS);
            const int q = att::crow(r, hi);
#pragma unroll
            for (int eb = 0; eb < 4; ++eb) stg[q * 128 + 32 * eb + r32] = f2bf(acc[eb][r] * rs * gn[eb]);
        }
        asm volatile("s_waitcnt lgkmcnt(0)" ::: "memory");
#pragma unroll 2
        for (int it = 0; it < 8; ++it) {
            const int idx = it * 64 + lane, row = idx >> 4, pc = idx & 15;
            const u32x4 hv = *(MLS_LAS const u32x4*)(stg + row * 128 + pc * 8);
            const u32x4 ov = *(const u32x4*)(proj + (m0 + 32 * th + row) * NPROJ + C_OB + h * 128 + pc * 8);
            float fh[8], fo[8]; unpack8(hv, fh); unpack8(ov, fo);
            float y[8];
#pragma unroll
            for (int j = 0; j < 8; ++j) y[j] = fh[j] * sigmoid_f(fo[j]);
            u32x4 o; o.x = pk2(y[0], y[1]); o.y = pk2(y[2], y[3]); o.z = pk2(y[4], y[5]); o.w = pk2(y[6], y[7]);
            *(u32x4*)(Y + (m0 + 32 * th + row) * 1024 + 512 + h * 128 + pc * 8) = o;
        }
    }
    __syncthreads();
}
}

__device__ void phase_chunkstate_mfma(const Params& p, int l, unsigned char* lds_raw) {
    {
        float* wl = (float*)(lds_raw + mls::LC_W);
        const float* cw = p.in[I_CW] + l * 4096; const float* cb = p.in[I_CB] + l * 1024; const float* qg = p.in[I_QG] + l * 64; const float* kg = p.in[I_KG] + l * 192;
        for (int i = my_tid(); i < 5376; i += NT) wl[i] = i < 4096 ? cw[i] : (i < 5120 ? cb[i - 4096] : (i < 5184 ? qg[i - 5120] : kg[i - 5184]));
        __syncthreads();
    }
    for (int u = my_bid(); u < BATCH * 64; u += gridDim.x) mls::chunk_unit(p, l, u >> 6, u & 63, (MLS_LAS unsigned char*)lds_raw);
}
__device__ void phase_mlstm_out_mfma(const Params& p, int l, unsigned char* lds_raw) {
    for (int u = my_bid(); u < BATCH * 64; u += gridDim.x) mls::out_unit(p, l, u >> 6, u & 63, (MLS_LAS unsigned char*)lds_raw);
}

namespace cmpx {
typedef short bf16x8 __attribute__((ext_vector_type(8)));
typedef float f32x16 __attribute__((ext_vector_type(16)));
#define CMP_LAS __attribute__((address_space(3)))
constexpr int LC_PART = 0  , LC_HID = 32768  ;
__device__ void unit(const Params& p, int l, int b, int g, int kv, int ib, CMP_LAS unsigned char* lds) {
    unsigned char* ws = p.ws;
    const bf16_t* proj = (const bf16_t*)(ws + WS_PROJ);
    const bf16_t* w1t = (const bf16_t*)(ws + WS_CW1) + (size_t)(l * 2 + kv) * 128 * 2048;
    const bf16_t* w2t = (const bf16_t*)(ws + WS_W2T) + (size_t)(l * 2 + kv) * 64 * 128;
    const float* peb = (const float*)(ws + WS_PEB) + (l * 2 + kv) * 128;
    const float* kg0 = p.in[I_KG] + l * 192;
    const int tid = my_tid(), lane = tid & 63, wave = __builtin_amdgcn_readfirstlane(tid >> 6), r32 = lane & 31, hi = lane >> 5, hb = wave & 3, kh = wave >> 2;
    const int col = (kv ? C_VC : C_KC) + g * 64;
    const int i = 32 * ib + r32;
    const f32x16 zero16 = (f32x16){0.f, 0.f, 0.f, 0.f, 0.f, 0.f, 0.f, 0.f, 0.f, 0.f, 0.f, 0.f, 0.f, 0.f, 0.f, 0.f};
    {
        f32x16 acc = zero16;
        const bf16_t* bp = w1t + (size_t)(32 * hb + r32) * 2048 + 1024 * kh + 8 * hi;
        const int tok0 = 16 * i + 16 * kh;
#pragma unroll 16
        for (int ks = 0; ks < 64; ++ks) {
            int tok = tok0 + (ks >> 2); tok = tok < SEQ ? tok : SEQ - 1;
            const bf16x8 af = __builtin_bit_cast(bf16x8, *(const u32x4*)(proj + ((size_t)b * SEQ + tok) * NPROJ + col + 16 * (ks & 3) + 8 * hi));
            const bf16x8 bf = __builtin_bit_cast(bf16x8, *(const u32x4*)(bp + 16 * ks));
            acc = __builtin_amdgcn_mfma_f32_32x32x16_bf16(af, bf, acc, 0, 0, 0);
        }
        CMP_LAS float* part = (CMP_LAS float*)(lds + LC_PART) + kh * 32 * 128;
#pragma unroll
        for (int r = 0; r < 16; ++r) part[att::crow(r, hi) * 128 + 32 * hb + r32] = acc[r];
    }
    __syncthreads();
    {
        const CMP_LAS float* part = (const CMP_LAS float*)(lds + LC_PART);
        CMP_LAS bf16_t* hbuf = (CMP_LAS bf16_t*)(lds + LC_HID);
#pragma unroll
        for (int e = 0; e < 8; ++e) {
            const int idx = e * NT + tid, row = idx >> 7, hid = idx & 127;
            hbuf[row * 136 + hid] = f2bf(silu_f(part[idx] + part[4096 + idx] + peb[hid]));
        }
    }
    __syncthreads();
    if (wave == 0) {
        const CMP_LAS bf16_t* hbuf = (const CMP_LAS bf16_t*)(lds + LC_HID);
        f32x16 o0 = zero16, o1 = zero16;
#pragma unroll
        for (int ks = 0; ks < 8; ++ks) {
            const bf16x8 af = *(const CMP_LAS bf16x8*)(hbuf + r32 * 136 + 16 * ks + 8 * hi);
            const bf16x8 b0 = __builtin_bit_cast(bf16x8, *(const u32x4*)(w2t + (size_t)r32 * 128 + 16 * ks + 8 * hi));
            const bf16x8 b1 = __builtin_bit_cast(bf16x8, *(const u32x4*)(w2t + (size_t)(32 + r32) * 128 + 16 * ks + 8 * hi));
            o0 = __builtin_amdgcn_mfma_f32_32x32x16_bf16(af, b0, o0, 0, 0, 0);
            o1 = __builtin_amdgcn_mfma_f32_32x32x16_bf16(af, b1, o1, 0, 0, 0);
        }
        bf16_t* dst = (bf16_t*)(ws + (kv ? WS_VCMP : WS_KCMP)) + (size_t)(b * 2 + g) * NCMPP * 64;
        const float g0 = kv ? 1.f : kg0[r32], g1 = kv ? 1.f : kg0[32 + r32];
#pragma unroll
        for (int r = 0; r < 16; ++r) {
            float rs = 1.f;
            if (kv == 0) {
                float sq = o0[r] * o0[r] + o1[r] * o1[r];
                sq += __shfl_xor(sq, 1); sq += __shfl_xor(sq, 2); sq += __shfl_xor(sq, 4); sq += __shfl_xor(sq, 8); sq += __shfl_xor(sq, 16);
                rs = rsqrtf(sq * (1.f / 64.f) + EPS);
            }
            const int row = 32 * ib + att::crow(r, hi);
            const bool ok = row < NCMP;
            dst[(size_t)row * 64 + r32] = ok ? f2bf(o0[r] * rs * g0) : (bf16_t)0;
            dst[(size_t)row * 64 + 32 + r32] = ok ? f2bf(o1[r] * rs * g1) : (bf16_t)0;
        }
    }
    __syncthreads();
}
}
__device__ void phase_compress_mfma(const Params& p, int l, unsigned char* lds_raw) {
    for (int u = my_bid(); u < BATCH * 2 * 2 * 8; u += gridDim.x) cmpx::unit(p, l, u >> 5, (u >> 4) & 1, (u >> 3) & 1, u & 7, (CMP_LAS unsigned char*)lds_raw);
}

#define XB_TMO      128
#define XB_XCNT(j)  (256  + 64 * (j))
#define XB_XSUB(j)  (1280 + 64 * (j))
#define XB_XGEN(j)  (2304 + 64 * (j))
#define XB_TOP      3328
#define XB_TOPGEN   3392
#define XCD_BAR_WORDS 3456
#define XB_SPIN_CAP (1u << 18)
#define XLAS __attribute__((address_space(3)))
__device__ __forceinline__ unsigned xb_ld(unsigned* p)              { return __hip_atomic_load(p, __ATOMIC_RELAXED, __HIP_MEMORY_SCOPE_AGENT); }
__device__ __forceinline__ unsigned xb_add(unsigned* p, unsigned v) { return __hip_atomic_fetch_add(p, v, __ATOMIC_RELAXED, __HIP_MEMORY_SCOPE_AGENT); }
__device__ __forceinline__ unsigned xb_xcc_id() { return (unsigned)__builtin_amdgcn_s_getreg((3 << 11) | 20) & 0xFu; }
#define XB_SPIN(cond, bar) do { unsigned _sp = 0; while (cond) { __builtin_amdgcn_s_sleep(1); \
    if ((++_sp & 255u) == 0u) { if (xb_ld(&(bar)[XB_TMO])) break; if (_sp > XB_SPIN_CAP) { atomicAdd(&(bar)[XB_TMO], 1u); break; } } } } while (0)
struct XcdBarrier { unsigned* bar; unsigned x; volatile XLAS unsigned* st; };
__device__ __forceinline__ XcdBarrier xcd_barrier_post(unsigned* bar, volatile XLAS unsigned* st) {
    XcdBarrier b; b.bar = bar; b.x = xb_xcc_id(); b.st = st;
    if (threadIdx.x == 0) (void)xb_add(&bar[XB_XCNT(b.x)], 1u);
    return b;
}
__device__ __forceinline__ void xcd_barrier_complete(unsigned* bar, unsigned x, unsigned& nloc, unsigned& nx) {
    const unsigned G = gridDim.x * gridDim.y * gridDim.z;
    unsigned sum, cnt, mine, sp = 0u;
    for (;;) {
        sum = 0u; cnt = 0u; mine = 0u;
#pragma unroll
        for (unsigned j = 0; j < 16; ++j) { const unsigned c = xb_ld(&bar[XB_XCNT(j)]); sum += c; cnt += (c > 0u) ? 1u : 0u; mine = (j == x) ? c : mine; }
        if (sum == G) break;
        __builtin_amdgcn_s_sleep(1);
        if ((++sp & 255u) == 0u) { if (xb_ld(&bar[XB_TMO])) break; if (sp > XB_SPIN_CAP) { atomicAdd(&bar[XB_TMO], 1u); break; } }
    }
    nloc = mine > 0u ? mine : 1u; nx = cnt > 0u ? cnt : 1u;
}
__device__ __forceinline__ void xcd_barrier(const XcdBarrier& b) {
    asm volatile("s_waitcnt vmcnt(0)" ::: "memory");
    __syncthreads();
    if (threadIdx.x == 0) {
        unsigned* bar = b.bar;
        __builtin_amdgcn_s_waitcnt(0);
        unsigned nloc = b.st[0], nx = b.st[1];
        if (nloc == 0u) { xcd_barrier_complete(bar, b.x, nloc, nx); b.st[0] = nloc; b.st[1] = nx; }
        const unsigned old = xb_add(&bar[XB_XSUB(b.x)], 1u);
        const unsigned gen = old / nloc;
        if (old + 1u == (gen + 1u) * nloc) {
            __builtin_amdgcn_fence(__ATOMIC_RELEASE, "agent");
            asm volatile("s_waitcnt vmcnt(0)" ::: "memory");
            const unsigned og = xb_add(&bar[XB_TOP], 1u);
            const unsigned tg = og / nx;
            if (og + 1u == (tg + 1u) * nx) xb_add(&bar[XB_TOPGEN], 1u);
            else XB_SPIN(xb_ld(&bar[XB_TOPGEN]) == tg, bar);
            __builtin_amdgcn_fence(__ATOMIC_ACQUIRE, "agent");
            xb_add(&bar[XB_XGEN(b.x)], 1u);
            asm volatile("s_waitcnt vmcnt(0)" ::: "memory");
        } else {
            XB_SPIN(xb_ld(&bar[XB_XGEN(b.x)]) == gen, bar);
            __builtin_amdgcn_fence(__ATOMIC_ACQUIRE, "agent");
            asm volatile("s_waitcnt vmcnt(0)" ::: "memory");
        }
    }
    __syncthreads();
}

#ifndef DUP
#define DUP 0
#endif
#define REP(bit) for (int rep_ = 0; rep_ < ((DUP & (bit)) ? 2 : 1); ++rep_)
constexpr int NPHASE = 1 + 7 * DEPTH;
template <bool COOP, int PMASK>
__global__ void __launch_bounds__(NT) mega(Params p) {
    extern __shared__ __attribute__((aligned(16))) unsigned char lds_raw[];
    float* lds = (float*)lds_raw;
    unsigned char* ws = p.ws;
    volatile XLAS unsigned* bst = (volatile XLAS unsigned*)((XLAS unsigned char*)lds_raw + LDS_BYTES - 16);
    if (threadIdx.x < 4) bst[threadIdx.x] = 0u;
    __syncthreads();
    XcdBarrier gbar = xcd_barrier_post((unsigned*)(ws + WS_CTL), bst);
#ifndef PROBE_MASK
#define PROBE_MASK 0
#endif
    unsigned long long pr_t0 = 0, pr_acc = 0;
    for (int ph = p.lo; ph < p.hi; ++ph) {
        if (PROBE_MASK && ((PROBE_MASK >> ph) & 1)) pr_t0 = __builtin_amdgcn_s_memrealtime();
        if (ph == 0) {
            if (PMASK & 128) phase_prologue(p, lds);
        } else {
            const int l = (ph - 1) / 7, k = (ph - 1) % 7;
            if (k == 0 && (PMASK & 1)) {
                pg8::Gemm g{(const bf16_t*)(ws + WS_XB), (const bf16_t*)(ws + WS_WIN) + (size_t)l * NPAD * DM, M, NPAD, DM};
                pg8::StaticOrder S; S.init(M, NPAD, (int)gridDim.x, (int)blockIdx.x);
                pg8::EpiInT E{(const float*)(ws + WS_SS), (const float*)(ws + WS_BIAS) + l * NPAD, (bf16_t*)(ws + WS_PROJ), (float*)(ws + WS_GATES)};
                REP(1) pg8::gemm_phase<pg8::EpiInT, pg8::StaticOrder, true, true>((PG8_LAS unsigned char*)lds_raw, g, S, E);
            } else if (k == 1 && (PMASK & 2)) {
                REP(2) phase_compress_mfma(p, l, lds_raw);
                REP(4) phase_chunkstate_mfma(p, l, lds_raw);
            } else if (k == 2 && (PMASK & 4)) {
                phase_scan(p);
                REP(8) phase_attn_mfma(p, l, lds_raw);
            } else if (k == 3 && (PMASK & 8)) {
                REP(16) phase_mlstm_out_mfma(p, l, lds_raw);
            } else if (k == 4 && (PMASK & 16)) {
                pg8::Gemm g{(const bf16_t*)(ws + WS_Y), (const bf16_t*)(ws + WS_WOUT) + (size_t)l * DM * DM, M, DM, DM};
                pg8::StaticOrder S; S.init(M, DM, (int)gridDim.x, (int)blockIdx.x);
                pg8::EpiResT<false> E{(bf16_t*)(ws + WS_XB), (float*)(ws + WS_SS), nullptr};
                pg8::gemm_phase<pg8::EpiResT<false>, pg8::StaticOrder, true, true>((PG8_LAS unsigned char*)lds_raw, g, S, E);
            } else if (k == 5 && (PMASK & 32)) {
                pg8::Gemm g{(const bf16_t*)(ws + WS_XB), (const bf16_t*)(ws + WS_WGU) + (size_t)l * NGU * DM, M, NGU, DM};
                pg8::StaticOrder S; S.init(M, NGU, (int)gridDim.x, (int)blockIdx.x);
                pg8::EpiGUT E{(const float*)(ws + WS_SS), (bf16_t*)(ws + WS_PROJ)};
                REP(32) pg8::gemm_phase<pg8::EpiGUT, pg8::StaticOrder, true, true>((PG8_LAS unsigned char*)lds_raw, g, S, E);
            } else if (k == 6 && (PMASK & 64)) {
                pg8::Gemm g{(const bf16_t*)(ws + WS_PROJ), (const bf16_t*)(ws + WS_WD) + (size_t)l * DM * FF, M, DM, FF};
                pg8::StaticOrder S; S.init(M, DM, (int)gridDim.x, (int)blockIdx.x);
                if (l + 1 < DEPTH) {
                    pg8::EpiResT<false> E{(bf16_t*)(ws + WS_XB), (float*)(ws + WS_SS), nullptr};
                    pg8::gemm_phase<pg8::EpiResT<false>, pg8::StaticOrder, true, true>((PG8_LAS unsigned char*)lds_raw, g, S, E);
                } else {
                    pg8::EpiResT<true> E{(bf16_t*)(ws + WS_XB), nullptr, p.out};
                    pg8::gemm_phase<pg8::EpiResT<true>, pg8::StaticOrder, true, true>((PG8_LAS unsigned char*)lds_raw, g, S, E);
                }
            }
        }
        if (COOP && ph + 1 < p.hi) {
            if (ph == 0) cg::this_grid().sync();
            else xcd_barrier(gbar);
        }
        if (PROBE_MASK && ((PROBE_MASK >> ph) & 1)) pr_acc += __builtin_amdgcn_s_memrealtime() - pr_t0;
    }
    if (PROBE_MASK && blockIdx.x == 0) {
        const unsigned long long te = __builtin_amdgcn_s_memrealtime();
        while (__builtin_amdgcn_s_memrealtime() - te < 4ull * pr_acc) __builtin_amdgcn_s_sleep(8);
    }
}

extern "C" void kernel_launch(void* const* d_in, const int* in_sizes, int n_in, void* d_out, int out_size, void* d_ws, size_t ws_size, hipStream_t stream) {
    static int grid = 0;
    if (grid == 0) {
        if (n_in != 18 || ws_size < WS_END) { fprintf(stderr, "kernel_launch: unexpected n_in %d / ws_size %zu\n", n_in, ws_size); grid = -1; return; }
        int dev = 0, cus = 0, per_cu = 0;
        (void)hipGetDevice(&dev);
        (void)hipDeviceGetAttribute(&cus, hipDeviceAttributeMultiprocessorCount, dev);
        (void)hipFuncSetAttribute((const void*)mega<true, 0xff>, hipFuncAttributeMaxDynamicSharedMemorySize, LDS_BYTES);
        (void)hipOccupancyMaxActiveBlocksPerMultiprocessor(&per_cu, (const void*)mega<true, 0xff>, NT, LDS_BYTES);
        if (per_cu < 1) { fprintf(stderr, "kernel_launch: occupancy query reports %d blocks/CU\n", per_cu); grid = -1; return; }
        grid = (cus > 0 ? cus : 256) * 1;
        (void)hipGetLastError();
    }
    if (grid < 0) return;
    Params p{};
    for (int i = 0; i < 18; ++i) p.in[i] = (const float*)d_in[i];
    p.out = (float*)d_out; p.ws = (unsigned char*)d_ws;
    p.lo = 0; p.hi = NPHASE;
    (void)hipMemsetAsync((unsigned char*)d_ws + WS_CTL, 0, 16384, stream);
    void* args[] = {&p};
    hipError_t e = hipLaunchCooperativeKernel((const void*)mega<true, 0xff>, dim3(grid), dim3(NT), args, LDS_BYTES, stream);
    if (e != hipSuccess) fprintf(stderr, "cooperative launch failed: %s (grid %d)\n", hipGetErrorString(e), grid);
}
```

```cpp
#include <hip/hip_runtime.h>
#include <hip/hip_cooperative_groups.h>
#include <cstdint>
#include <cstdio>
namespace cg = cooperative_groups;

typedef unsigned short bf16_t;
typedef unsigned u32x4 __attribute__((ext_vector_type(4)));
typedef unsigned u32x2 __attribute__((ext_vector_type(2)));
typedef float f32x4 __attribute__((ext_vector_type(4)));

constexpr int BATCH = 8, SEQ = 4096, DM = 1024, M = BATCH * SEQ, DEPTH = 2;
constexpr int NIN = 3360, NPROJ = 3328, NPAD = 3584, FF = 2816, NGU = 2 * FF;
constexpr int NCMP = 255, NCMPP = 256;
constexpr float EPS = 1e-6f;
constexpr int NT = 512;
constexpr int LDS_BYTES = 160 * 1024;

constexpr int C_QA = 0, C_KC = 512, C_VC = 640, C_KS = 768, C_VS = 896, C_KW = 1024, C_VW = 1152, C_QB = 1280, C_KB = 1792, C_VB = 2304, C_OB = 2816;

constexpr size_t MiB = 1u << 20;
constexpr size_t WS_CTL = 0;
constexpr size_t WS_WIN = 1 * MiB;
constexpr size_t WS_WOUT = 15 * MiB;
constexpr size_t WS_WGU = 19 * MiB;
constexpr size_t WS_WD = 41 * MiB;
constexpr size_t WS_BIAS = 52 * MiB;
constexpr size_t WS_SS = 53 * MiB;
constexpr size_t WS_GATES = 55 * MiB;
constexpr size_t WS_KCMP = 59 * MiB;
constexpr size_t WS_VCMP = 59 * MiB + 512 * 1024;
constexpr size_t WS_STN = 60 * MiB;
constexpr size_t WS_STM = 61 * MiB;
constexpr size_t WS_W2T = 61 * MiB + 256 * 1024;
constexpr size_t WS_PEB = 61 * MiB + 512 * 1024;
constexpr size_t WS_CW1 = 62 * MiB;
constexpr size_t WS_XB = 64 * MiB;
constexpr size_t WS_Y = 128 * MiB;
constexpr size_t WS_ST = 192 * MiB;
constexpr size_t WS_PROJ = 256 * MiB;
constexpr size_t WS_END = 464 * MiB;

struct Params {
    const float* in[18];
    float* out;
    unsigned char* ws;
    int lo, hi;
};
enum { I_X = 0, I_LN1, I_WIN, I_BIN, I_QG, I_KG, I_PE, I_W1, I_W2, I_CW, I_CB, I_FB, I_OGA, I_OGM, I_WOUT, I_LN2, I_WGU, I_WD };

__device__ __forceinline__ float bf2f(bf16_t v) { return __uint_as_float(((unsigned)v) << 16); }
__device__ __forceinline__ bf16_t f2bf(float f) { unsigned u = __float_as_uint(f); return (bf16_t)((u + 0x7fffu + ((u >> 16) & 1u)) >> 16); }
__device__ __forceinline__ unsigned pk2(float lo, float hi) { return (unsigned)f2bf(lo) | ((unsigned)f2bf(hi) << 16); }
__device__ __forceinline__ float lo16(unsigned w) { return __uint_as_float(w << 16); }
__device__ __forceinline__ float hi16(unsigned w) { return __uint_as_float(w & 0xffff0000u); }
__device__ __forceinline__ float silu_f(float x) { return x / (1.f + __expf(-x)); }
__device__ __forceinline__ float sigmoid_f(float x) { return 1.f / (1.f + __expf(-x)); }
__device__ __forceinline__ float wave_sum(float v) {
#pragma unroll
    for (int o = 1; o < 64; o <<= 1) v += __shfl_xor(v, o);
    return v;
}
__device__ __forceinline__ float wave_max(float v) {
#pragma unroll
    for (int o = 1; o < 64; o <<= 1) v = fmaxf(v, __shfl_xor(v, o));
    return v;
}
constexpr int LDS_WTAB = LDS_BYTES - 16 - 256;
__device__ __forceinline__ int hw_slot() { return (int)__builtin_amdgcn_s_getreg((5 << 11) | 4) & 63; }
__device__ __forceinline__ int my_tid() {
    const int w = __builtin_amdgcn_readfirstlane(*(const volatile __attribute__((address_space(3))) int*)(unsigned)(LDS_WTAB + 4 * hw_slot()));
    int t = (w << 6) | (int)__builtin_amdgcn_mbcnt_hi(~0u, __builtin_amdgcn_mbcnt_lo(~0u, 0u));
    asm volatile("" : "+v"(t)); return t;
}
__device__ __forceinline__ int my_bid() { int b = blockIdx.x; asm volatile("" : "+s"(b)); return b; }
__device__ __forceinline__ void unpack8(u32x4 w, float* f) {
    f[0] = lo16(w.x); f[1] = hi16(w.x); f[2] = lo16(w.y); f[3] = hi16(w.y);
    f[4] = lo16(w.z); f[5] = hi16(w.z); f[6] = lo16(w.w); f[7] = hi16(w.w);
}

__device__ __forceinline__ int in_srccol(int n) {
    if (n < 1280) return n;
    if (n < 2816) return n + 24;
    if (n < 3328) return n + 32;
    if (n < 3352) return n - 3328 + 1280;
    if (n < 3360) return n - 3352 + 2840;
    return -1;
}
__device__ __forceinline__ int gu_srccol(int n) {
    const int t = n >> 8, w = n & 255;
    return (w < 128) ? (t * 128 + w) : (FF + t * 128 + (w - 128));
}

struct ConvJob { const float* W; bf16_t* WT; const float* kscale; int K, Nsrc, mode; };
__device__ __forceinline__ bool conv_locate(const Params& p, int ti, ConvJob& J, int& local) {
    constexpr int T_IN = 16 * 56, T_OUT = 16 * 16, T_GU = 16 * 88, T_D = 44 * 16, T_L = T_IN + T_OUT + T_GU + T_D, T_W1 = 32 * 2, T_W2 = 2, T_S = T_W1 + T_W2;
    unsigned char* ws = p.ws;
    if (ti < DEPTH * T_L) {
        const int l = ti / T_L; int r = ti % T_L;
        if (r < T_IN) { J = ConvJob{p.in[I_WIN] + (size_t)l * DM * NIN, (bf16_t*)(ws + WS_WIN) + (size_t)l * NPAD * DM, p.in[I_LN1] + l * DM, DM, NIN, 1}; local = r; return true; }
        r -= T_IN;
        if (r < T_OUT) { J = ConvJob{p.in[I_WOUT] + (size_t)l * DM * DM, (bf16_t*)(ws + WS_WOUT) + (size_t)l * DM * DM, nullptr, DM, DM, 0}; local = r; return true; }
        r -= T_OUT;
        if (r < T_GU) { J = ConvJob{p.in[I_WGU] + (size_t)l * DM * NGU, (bf16_t*)(ws + WS_WGU) + (size_t)l * NGU * DM, p.in[I_LN2] + l * DM, DM, NGU, 2}; local = r; return true; }
        r -= T_GU;
        J = ConvJob{p.in[I_WD] + (size_t)l * FF * DM, (bf16_t*)(ws + WS_WD) + (size_t)l * DM * FF, nullptr, FF, DM, 0}; local = r; return true;
    }
    int r = ti - DEPTH * T_L;
    if (r >= DEPTH * 2 * T_S) return false;
    const int lk = r / T_S; r = r % T_S;
    if (r < T_W1) { J = ConvJob{p.in[I_W1] + (size_t)lk * 2048 * 128, (bf16_t*)(ws + WS_CW1) + (size_t)lk * 128 * 2048, nullptr, 2048, 128, 0}; local = r; return true; }
    J = ConvJob{p.in[I_W2] + (size_t)lk * 128 * 64, (bf16_t*)(ws + WS_W2T) + (size_t)lk * 64 * 128, nullptr, 128, 64, 0}; local = r - T_W1; return true;
}
__device__ void phase_prologue(const Params& p, float* lds) {
    unsigned char* ws = p.ws;
    const int tid = my_tid(), lane = tid & 63, wave = tid >> 6;
    constexpr int T_ALL = DEPTH * (16 * 56 + 16 * 16 + 16 * 88 + 44 * 16) + DEPTH * 2 * (64 + 2);
    for (int G = my_bid(); G < (T_ALL + 3) / 4; G += gridDim.x) {
#pragma unroll
        for (int t = 0; t < 4; ++t) {
            ConvJob J; int local;
            if (conv_locate(p, 4 * G + t, J, local)) {
                const int nk = J.K / 64, k0 = (local % nk) * 64, n0 = (local / nk) * 64;
                float* tile = lds + t * (64 * 65);
#pragma unroll
                for (int i = 0; i < 8; ++i) {
                    const int r = (tid >> 6) + 8 * i, c = tid & 63, n = n0 + c;
                    const int sc = J.mode == 0 ? n : (J.mode == 1 ? in_srccol(n) : gu_srccol(n));
                    float v = 0.f;
                    if (sc >= 0) v = J.W[(size_t)(k0 + r) * J.Nsrc + sc] * (J.kscale ? J.kscale[k0 + r] : 1.f);
                    tile[r * 65 + c] = v;
                }
            }
        }
        __syncthreads();
#pragma unroll
        for (int t = 0; t < 4; ++t) {
            ConvJob J; int local;
            if (conv_locate(p, 4 * G + t, J, local)) {
                const int nk = J.K / 64, k0 = (local % nk) * 64, n0 = (local / nk) * 64;
                const float* tile = lds + t * (64 * 65);
#pragma unroll
                for (int i = 0; i < 8; ++i) {
                    const int r = (tid >> 6) + 8 * i, c = tid & 63;
                    J.WT[(size_t)(n0 + r) * J.K + k0 + c] = f2bf(tile[c * 65 + r]);
                }
            }
        }
        __syncthreads();
    }
    {
        float* peb = (float*)(ws + WS_PEB);
        for (int o = my_bid() * 8 + wave; o < DEPTH * 2 * 128; o += gridDim.x * 8) {
            const int lk = o >> 7, hid = o & 127;
            const float* w1 = p.in[I_W1] + (size_t)lk * 2048 * 128 + hid; const float* pe = p.in[I_PE] + (size_t)lk * 2048;
            float sacc = 0.f;
#pragma unroll 8
            for (int f = lane; f < 2048; f += 64) sacc += w1[(size_t)f * 128] * pe[f];
            sacc = wave_sum(sacc);
            if (lane == 0) peb[o] = sacc;
        }
    }
    float* biasP = (float*)(ws + WS_BIAS);
    for (int i = my_bid() * NT + tid; i < DEPTH * NPAD; i += gridDim.x * NT) {
        const int l = i / NPAD, n = i % NPAD; const int sc = in_srccol(n);
        biasP[i] = sc >= 0 ? p.in[I_BIN][l * NIN + sc] : 0.f;
    }
    const float* x = p.in[I_X]; bf16_t* xb = (bf16_t*)(ws + WS_XB); float* ss = (float*)(ws + WS_SS);
    for (int m = (my_bid() * 8 + wave) * 2; m < M; m += gridDim.x * 16) {
        f32x4 v[2][4];
#pragma unroll
        for (int rr = 0; rr < 2; ++rr)
#pragma unroll
            for (int j = 0; j < 4; ++j) v[rr][j] = ((const f32x4*)(x + (size_t)(m + rr) * DM) + lane)[64 * j];
#pragma unroll
        for (int rr = 0; rr < 2; ++rr)
#pragma unroll
            for (int j = 0; j < 4; ++j) {
                const f32x4 q = v[rr][j];
                float sq = (q.x * q.x + q.y * q.y) + (q.z * q.z + q.w * q.w);
                sq += __shfl_xor(sq, 1); sq += __shfl_xor(sq, 2); sq += __shfl_xor(sq, 4); sq += __shfl_xor(sq, 8);
                if ((lane & 15) == 0) ss[(size_t)(m + rr) * 16 + 4 * j + (lane >> 4)] = sq;
                u32x2 o; o.x = pk2(q.x, q.y); o.y = pk2(q.z, q.w);
                *(u32x2*)(xb + (size_t)(m + rr) * DM + 256 * j + 4 * lane) = o;
            }
    }
}

namespace pg8 {
#define PG8_LAS __attribute__((address_space(3)))
typedef short bf16x8 __attribute__((ext_vector_type(8)));
constexpr int BM = 256, BK = 64, HALF = 128, HTB = HALF * BK * 2  , STAGE_BYTES = 8 * HTB, NXCD = 8, WGM = 8;
__host__ __device__ __forceinline__ int lds_byte(int r, int c) { const int st = (r >> 4) * 2 + (c >> 5), rr = r & 15, cc = c & 31, ob = rr * 64 + cc * 2; return st * 1024 + (ob ^ (((ob >> 9) & 1) << 5)); }
__host__ __device__ __forceinline__ void stage_rc(int b, int& R, int& C) { const int st = b / 1024, sb = b % 1024, swz = sb ^ (((sb >> 9) & 1) << 5); R = (st >> 1) * 16 + swz / 64; C = (st & 1) * 32 + (swz % 64) / 2; }
__host__ __device__ __forceinline__ int perm32(int rho) { const int n = rho >> 4, i = rho & 15; return 8 * (i >> 2) + 4 * n + (i & 3); }
struct Unit { int pm, pn; };
struct Gemm { const bf16_t* A; const bf16_t* Bt; int M, N, K; };
struct StaticOrder {
    int nM, nN, nwg, G, c;
    __host__ __device__ void init(int M_, int N_, int G_, int c_) { nM = M_ / BM; nN = N_ / BM; nwg = nM * nN; G = G_; c = c_; }
    __host__ __device__ bool next(int i, Unit& u) const {
        const long L = (long)i * G + c; if (L >= nwg) return false;
        int wgid = (int)L; { const int q = nwg / NXCD, r = nwg % NXCD, xcd = wgid % NXCD, off = wgid / NXCD; wgid = (xcd < r ? xcd * (q + 1) : r * (q + 1) + (xcd - r) * q) + off; }
        const int nig = WGM * nN, gid = wgid / nig, fm = gid * WGM, gsz = (nM - fm) < WGM ? (nM - fm) : WGM;
        u.pm = fm + ((wgid % nig) % gsz); u.pn = (wgid % nig) / gsz; return true;
    }
    __device__ __forceinline__ void a_ready(const Unit&) const {}
    __device__ __forceinline__ void done(const Unit&) const {}
};
__device__ __forceinline__ unsigned cvt_pk_bf16(float lo, float hi) { unsigned r; asm volatile("v_cvt_pk_bf16_f32 %0, %1, %2" : "=v"(r) : "v"(lo), "v"(hi)); return r; }

__device__ __forceinline__ float row_rstd(const float* ss, int row, int fq) {
    const f32x4 pq = *(const f32x4*)(ss + (size_t)row * 16 + 4 * fq);
    float s = (pq.x + pq.y) + (pq.z + pq.w);
    s += __shfl_xor(s, 16); s += __shfl_xor(s, 32);
    return rsqrtf(s * (1.f / DM) + EPS);
}
struct EpiInT {
    static constexpr bool PERM = true, AFTER_DRAIN = false;
    const float* ss; const float* bias; bf16_t* proj; float* gates;
    __device__ __forceinline__ void operator()(const f32x4 (&acc)[2][2][4][2], const Unit& u, int wr, int wc, int fr, int fq) const {
        const int row0 = u.pm * BM + wr * 64 + fr, col0 = u.pn * BM + wc * 32 + 8 * fq;
        f32x4 bv[2][2];
#pragma unroll
        for (int bj = 0; bj < 2; ++bj)
#pragma unroll
            for (int n = 0; n < 2; ++n) bv[bj][n] = *(const f32x4*)(bias + col0 + bj * HALF + 4 * n);
#pragma unroll
        for (int ai = 0; ai < 2; ++ai)
#pragma unroll
            for (int m = 0; m < 4; ++m) {
                const int row = row0 + ai * HALF + m * 16;
                const float r = row_rstd(ss, row, fq);
                if (u.pn < 13) {
                    bf16_t* rowp = proj + (size_t)row * NPROJ + col0;
#pragma unroll
                    for (int bj = 0; bj < 2; ++bj) {
                        const f32x4 v0 = acc[ai][bj][m][0] * r + bv[bj][0], v1 = acc[ai][bj][m][1] * r + bv[bj][1];
                        u32x4 w; w.x = cvt_pk_bf16(v0[0], v0[1]); w.y = cvt_pk_bf16(v0[2], v0[3]); w.z = cvt_pk_bf16(v1[0], v1[1]); w.w = cvt_pk_bf16(v1[2], v1[3]);
                        *(u32x4*)(rowp + bj * HALF) = w;
                    }
                } else if (wc == 0) {
                    const f32x4 v0 = acc[ai][0][m][0] * r + bv[0][0], v1 = acc[ai][0][m][1] * r + bv[0][1];
                    float* gp = gates + (size_t)row * 32 + 8 * fq;
                    *(f32x4*)gp = v0; *(f32x4*)(gp + 4) = v1;
                }
            }
    }
};
template <bool FINAL>
struct EpiResT {
    static constexpr bool PERM = true, AFTER_DRAIN = false;
    bf16_t* xb; float* ss; float* out;
    __device__ __forceinline__ void operator()(const f32x4 (&acc)[2][2][4][2], const Unit& u, int wr, int wc, int fr, int fq) const {
        const int row0 = u.pm * BM + wr * 64 + fr, col0 = u.pn * BM + wc * 32 + 8 * fq;
#pragma unroll
        for (int ai = 0; ai < 2; ++ai) {
            u32x4 rb[4][2];
#pragma unroll
            for (int m = 0; m < 4; ++m)
#pragma unroll
                for (int bj = 0; bj < 2; ++bj) rb[m][bj] = *(const u32x4*)(xb + (size_t)(row0 + ai * HALF + m * 16) * DM + col0 + bj * HALF);
#pragma unroll
            for (int m = 0; m < 4; ++m) {
                const int row = row0 + ai * HALF + m * 16;
                const size_t off = (size_t)row * DM + col0;
                float sq = 0.f;
#pragma unroll
                for (int bj = 0; bj < 2; ++bj) {
                    float f[8]; unpack8(rb[m][bj], f);
                    const f32x4 x0 = (f32x4){f[0], f[1], f[2], f[3]} + acc[ai][bj][m][0];
                    const f32x4 x1 = (f32x4){f[4], f[5], f[6], f[7]} + acc[ai][bj][m][1];
                    if (FINAL) { *(f32x4*)(out + off + bj * HALF) = x0; *(f32x4*)(out + off + bj * HALF + 4) = x1; }
                    else {
                        u32x4 w; w.x = cvt_pk_bf16(x0[0], x0[1]); w.y = cvt_pk_bf16(x0[2], x0[3]); w.z = cvt_pk_bf16(x1[0], x1[1]); w.w = cvt_pk_bf16(x1[2], x1[3]);
                        *(u32x4*)(xb + off + bj * HALF) = w;
                        sq += (x0[0] * x0[0] + x0[1] * x0[1]) + (x0[2] * x0[2] + x0[3] * x0[3]) + (x1[0] * x1[0] + x1[1] * x1[1]) + (x1[2] * x1[2] + x1[3] * x1[3]);
                    }
                }
                if (!FINAL) {
                    sq += __shfl_xor(sq, 16); sq += __shfl_xor(sq, 32);
                    if (fq == 0) ss[(size_t)row * 16 + u.pn * 4 + wc] = sq;
                }
            }
            asm volatile("" ::: "memory");
        }
    }
};
struct EpiGUT {
    static constexpr bool PERM = true, AFTER_DRAIN = false;
    const float* ss; bf16_t* act;
    __device__ __forceinline__ void operator()(const f32x4 (&acc)[2][2][4][2], const Unit& u, int wr, int wc, int fr, int fq) const {
        const int row0 = u.pm * BM + wr * 64 + fr, hid0 = u.pn * HALF + wc * 32 + 8 * fq;
#pragma unroll
        for (int ai = 0; ai < 2; ++ai)
#pragma unroll
            for (int m = 0; m < 4; ++m) {
                const int row = row0 + ai * HALF + m * 16;
                const float r = row_rstd(ss, row, fq);
                float a[8];
#pragma unroll
                for (int n = 0; n < 2; ++n)
#pragma unroll
                    for (int j = 0; j < 4; ++j) {
                        const float g = acc[ai][0][m][n][j] * r, up = acc[ai][1][m][n][j] * r;
                        a[4 * n + j] = g * __builtin_amdgcn_rcpf(1.f + __builtin_amdgcn_exp2f(-1.4426950408889634f * g)) * up;
                    }
                u32x4 w; w.x = cvt_pk_bf16(a[0], a[1]); w.y = cvt_pk_bf16(a[2], a[3]); w.z = cvt_pk_bf16(a[4], a[5]); w.w = cvt_pk_bf16(a[6], a[7]);
                *(u32x4*)(act + (size_t)row * FF + hid0) = w;
            }
    }
};

template <class Epi, class Sched, bool ALIGN_EPI = false, bool SP2 = false>
__device__ __forceinline__ void gemm_phase(PG8_LAS unsigned char* lds, const Gemm g, const Sched& S, const Epi& E) {
    const int tid = my_tid(), wid = __builtin_amdgcn_readfirstlane(tid >> 6), lane = tid & 63, wr = wid >> 2, wc = wid & 3, fr = lane & 15, fq = lane >> 4;
    const int K = g.K, nt = K / BK;
    unsigned voffA[2], voffB[2];
#pragma unroll
    for (int i = 0; i < 2; ++i) { int R, C; stage_rc(tid * 16 + i * 8192, R, C); const int Rb = Epi::PERM ? ((R & ~31) + perm32(R & 31)) : R;
        voffA[i] = (unsigned)(R * K + C) * 2u; voffB[i] = (unsigned)(Rb * K + C) * 2u; }
    const size_t kstep = (size_t)(BK * 2);
    const size_t hstep = (size_t)HALF * K * 2;
    const size_t tstep = 2 * hstep;
    const unsigned ldsw = (unsigned)wid * 1024u;
    const int aoff = lds_byte(wr * 64 + fr, fq * 8), boff = lds_byte(wc * 32 + fr, fq * 8);
#define PG8_SA(b, h) (((b) * 2 + (h)) * HTB)
#define PG8_SB(b, h) ((4 + (b) * 2 + (h)) * HTB)
#define PG8_STAGE(bufoff, gbase, voff) do { _Pragma("unroll") for (int _i = 0; _i < 2; ++_i) \
        __builtin_amdgcn_global_load_lds((const unsigned*)((const char*)(gbase) + (voff)[_i]), (PG8_LAS unsigned*)(lds + (bufoff) + ldsw + _i * 8192), 16, 0, 0); } while (0)
#define PG8_LDA(dst, b, h) do { _Pragma("unroll") for (int m = 0; m < 4; ++m) _Pragma("unroll") for (int k = 0; k < 2; ++k) dst[m][k] = *(const PG8_LAS bf16x8*)(lds + PG8_SA(b, h) + aoff + m * 2048 + k * 1024); } while (0)
#define PG8_LDB(dst, b, h) do { _Pragma("unroll") for (int n = 0; n < 2; ++n) _Pragma("unroll") for (int k = 0; k < 2; ++k) dst[n][k] = *(const PG8_LAS bf16x8*)(lds + PG8_SB(b, h) + boff + n * 2048 + k * 1024); } while (0)
#define PG8_MMA(ai, bj, At, Bt) do { __builtin_amdgcn_s_setprio(1); _Pragma("unroll") for (int m = 0; m < 4; ++m) _Pragma("unroll") for (int n = 0; n < 2; ++n) _Pragma("unroll") for (int k = 0; k < 2; ++k) \
        acc[ai][bj][m][n] = __builtin_amdgcn_mfma_f32_16x16x32_bf16(Bt[n][k], At[m][k], acc[ai][bj][m][n], 0, 0, 0); __builtin_amdgcn_s_setprio(0); } while (0)
#define PG8_WAIT_V(n) asm volatile("s_waitcnt vmcnt(" #n ")" ::: "memory")
#define PG8_WAIT_L(n) asm volatile("s_waitcnt lgkmcnt(" #n ")" ::: "memory")
#define PG8_BAR __builtin_amdgcn_s_barrier()
#define PG8_SCHED __builtin_amdgcn_sched_barrier(0)
    Unit cur, nxt; int ui = 0;
    if (!S.next(0, cur)) return;
    f32x4 acc[2][2][4][2];
#pragma unroll
    for (int a = 0; a < 2; ++a)
#pragma unroll
        for (int b = 0; b < 2; ++b)
#pragma unroll
            for (int m = 0; m < 4; ++m)
#pragma unroll
                for (int n = 0; n < 2; ++n) acc[a][b][m][n] = (f32x4){0.f, 0.f, 0.f, 0.f};
    bf16x8 At[4][2], B0[2][2], B1[2][2];
    const char* cA = (const char*)g.A + (size_t)cur.pm * tstep; const char* cB = (const char*)g.Bt + (size_t)cur.pn * tstep;
    S.a_ready(cur);
    if constexpr (SP2) {
        PG8_STAGE(PG8_SB(0, 0), cB, voffB); PG8_STAGE(PG8_SB(0, 1), cB + hstep, voffB); PG8_STAGE(PG8_SA(0, 0), cA, voffA); PG8_STAGE(PG8_SA(0, 1), cA + hstep, voffA);
        if (wr == 1) PG8_BAR;
        PG8_WAIT_V(2); PG8_BAR;
        PG8_STAGE(PG8_SB(1, 0), cB + kstep, voffB); PG8_STAGE(PG8_SA(1, 0), cA + kstep, voffA); PG8_STAGE(PG8_SB(1, 1), cB + hstep + kstep, voffB);
        PG8_WAIT_V(6); PG8_BAR;
    } else {
        PG8_STAGE(PG8_SB(0, 0), cB, voffB); PG8_STAGE(PG8_SA(0, 0), cA, voffA); PG8_STAGE(PG8_SB(0, 1), cB + hstep, voffB); PG8_STAGE(PG8_SA(0, 1), cA + hstep, voffA);
        if (wr == 1) PG8_BAR;
        PG8_WAIT_V(4); PG8_BAR;
        PG8_STAGE(PG8_SB(1, 0), cB + kstep, voffB); PG8_STAGE(PG8_SA(1, 0), cA + kstep, voffA); PG8_STAGE(PG8_SB(1, 1), cB + hstep + kstep, voffB);
        PG8_WAIT_V(6); PG8_BAR;
    }
    for (;;) {
        const bool has_next = S.next(ui + 1, nxt);
        const char* nA = has_next ? (const char*)g.A + (size_t)nxt.pm * tstep : cA; const char* nB = has_next ? (const char*)g.Bt + (size_t)nxt.pn * tstep : cB;
        for (int t = 0; t < nt; t += 2) {
            const bool last = (t == nt - 2);
            const char* a1 = cA + (size_t)(t + 1) * kstep;
            const char* a2 = last ? nA : cA + (size_t)(t + 2) * kstep; const char* b2 = last ? nB : cB + (size_t)(t + 2) * kstep;
            const char* a3 = a2 + kstep; const char* b3 = b2 + kstep;
            if (last && has_next) S.a_ready(nxt);
            if constexpr (SP2) {
            PG8_LDB(B0, 0, 0); PG8_LDB(B1, 0, 1); PG8_SCHED; PG8_LDA(At, 0, 0); PG8_STAGE(PG8_SA(1, 1), a1 + hstep, voffA);
            PG8_WAIT_V(8); PG8_WAIT_L(0); PG8_BAR; PG8_MMA(0, 0, At, B0); PG8_MMA(0, 1, At, B1); PG8_BAR; PG8_SCHED;
            PG8_LDA(At, 0, 1); PG8_STAGE(PG8_SB(0, 0), b2, voffB); PG8_STAGE(PG8_SB(0, 1), b2 + hstep, voffB); PG8_STAGE(PG8_SA(0, 0), a2, voffA);
            PG8_WAIT_V(8); PG8_WAIT_L(0); PG8_BAR; PG8_MMA(1, 0, At, B0); PG8_MMA(1, 1, At, B1); PG8_BAR; PG8_SCHED;
            PG8_LDB(B0, 1, 0); PG8_LDB(B1, 1, 1); PG8_SCHED; PG8_LDA(At, 1, 0); PG8_STAGE(PG8_SA(0, 1), a2 + hstep, voffA);
            PG8_WAIT_V(8); PG8_WAIT_L(0); PG8_BAR; PG8_MMA(0, 0, At, B0); PG8_MMA(0, 1, At, B1); PG8_BAR; PG8_SCHED;
            PG8_LDA(At, 1, 1); PG8_STAGE(PG8_SB(1, 0), b3, voffB); PG8_STAGE(PG8_SB(1, 1), b3 + hstep, voffB); PG8_STAGE(PG8_SA(1, 0), a3, voffA);
            PG8_WAIT_V(8); PG8_WAIT_L(0); PG8_BAR; PG8_MMA(1, 0, At, B0); PG8_MMA(1, 1, At, B1); PG8_BAR; PG8_SCHED;
            } else {
            PG8_LDB(B0, 0, 0); PG8_SCHED; PG8_LDA(At, 0, 0); PG8_STAGE(PG8_SA(1, 1), a1 + hstep, voffA);
            PG8_WAIT_L(8); PG8_BAR; PG8_WAIT_L(0); PG8_MMA(0, 0, At, B0); PG8_BAR; PG8_SCHED;
            PG8_LDB(B1, 0, 1); PG8_STAGE(PG8_SB(0, 0), b2, voffB);
            PG8_BAR; PG8_WAIT_L(0); PG8_MMA(0, 1, At, B1); PG8_BAR;
            PG8_LDA(At, 0, 1); PG8_STAGE(PG8_SA(0, 0), a2, voffA);
            PG8_BAR; PG8_WAIT_L(0); PG8_MMA(1, 0, At, B0); PG8_BAR; PG8_SCHED;
            PG8_STAGE(PG8_SB(0, 1), b2 + hstep, voffB);
            PG8_WAIT_V(6); PG8_BAR; PG8_MMA(1, 1, At, B1); PG8_BAR;
            PG8_LDB(B0, 1, 0); PG8_SCHED; PG8_LDA(At, 1, 0); PG8_STAGE(PG8_SA(0, 1), a2 + hstep, voffA);
            PG8_WAIT_L(8); PG8_BAR; PG8_WAIT_L(0); PG8_MMA(0, 0, At, B0); PG8_BAR; PG8_SCHED;
            PG8_LDB(B1, 1, 1); PG8_STAGE(PG8_SB(1, 0), b3, voffB);
            PG8_BAR; PG8_WAIT_L(0); PG8_MMA(0, 1, At, B1); PG8_BAR;
            PG8_LDA(At, 1, 1); PG8_STAGE(PG8_SA(1, 0), a3, voffA);
            PG8_BAR; PG8_WAIT_L(0); PG8_MMA(1, 0, At, B0); PG8_BAR; PG8_SCHED;
            PG8_STAGE(PG8_SB(1, 1), b3 + hstep, voffB);
            PG8_WAIT_V(6); PG8_BAR; PG8_MMA(1, 1, At, B1); PG8_BAR;
            }
        }
        if constexpr (ALIGN_EPI) { if (wr == 0) PG8_BAR; }
        if constexpr (!Epi::AFTER_DRAIN) { E(acc, cur, wr, wc, fr, fq); S.done(cur); }
        if (!has_next) break;
#pragma unroll
        for (int a = 0; a < 2; ++a)
#pragma unroll
            for (int b = 0; b < 2; ++b)
#pragma unroll
                for (int m = 0; m < 4; ++m)
#pragma unroll
                    for (int n = 0; n < 2; ++n) acc[a][b][m][n] = (f32x4){0.f, 0.f, 0.f, 0.f};
        cur = nxt; cA = nA; cB = nB; ++ui;
        if constexpr (ALIGN_EPI) { if (wr == 1) PG8_BAR; }
    }
    PG8_WAIT_V(0);
    if constexpr (!ALIGN_EPI) { if (wr == 0) PG8_BAR; }
    PG8_BAR;
#undef PG8_SA
#undef PG8_SB
#undef PG8_STAGE
#undef PG8_LDA
#undef PG8_LDB
#undef PG8_MMA
#undef PG8_WAIT_V
#undef PG8_WAIT_L
#undef PG8_BAR
#undef PG8_SCHED
}
}

__device__ void phase_rowpass(const Params& p, int l) {
    unsigned char* ws = p.ws;
    bf16_t* proj = (bf16_t*)(ws + WS_PROJ); bf16_t* qkc = (bf16_t*)p.out;
    const float* qg = p.in[I_QG] + l * 64; const float* kg = p.in[I_KG] + l * 192;
    const float* cw = p.in[I_CW] + l * 4096; const float* cb = p.in[I_CB] + l * 1024;
    const int tid = my_tid(), lane = tid & 63, wave = tid >> 6;
    for (int m = my_bid() * 8 + wave; m < M; m += gridDim.x * 8) {
        const int t = m % SEQ;
        bf16_t* row = proj + (size_t)m * NPROJ;
        {
            const u32x4 raw = *(const u32x4*)(row + C_QA + lane * 8); float f[8]; unpack8(raw, f);
            float s = 0.f;
#pragma unroll
            for (int j = 0; j < 8; ++j) s += f[j] * f[j];
            s += __shfl_xor(s, 1); s += __shfl_xor(s, 2); s += __shfl_xor(s, 4);
            const float r = rsqrtf(s * (1.f / 64.f) + EPS);
            const int d0 = (lane & 7) * 8;
            u32x4 o; o.x = pk2(f[0] * r * qg[d0], f[1] * r * qg[d0 + 1]); o.y = pk2(f[2] * r * qg[d0 + 2], f[3] * r * qg[d0 + 3]);
            o.z = pk2(f[4] * r * qg[d0 + 4], f[5] * r * qg[d0 + 5]); o.w = pk2(f[6] * r * qg[d0 + 6], f[7] * r * qg[d0 + 7]);
            *(u32x4*)(row + C_QA + lane * 8) = o;
        }
        {
            const int which = lane >> 5, w4 = (lane & 31) * 4;
            bf16_t* pp = row + (which ? C_KW : C_KS) + w4;
            const u32x2 raw = *(const u32x2*)pp;
            float f[4] = {lo16(raw.x), hi16(raw.x), lo16(raw.y), hi16(raw.y)};
            float s = (f[0] * f[0] + f[1] * f[1]) + (f[2] * f[2] + f[3] * f[3]);
            s += __shfl_xor(s, 1); s += __shfl_xor(s, 2); s += __shfl_xor(s, 4); s += __shfl_xor(s, 8);
            const float r = rsqrtf(s * (1.f / 64.f) + EPS);
            const float* g = kg + (1 + which) * 64 + (w4 & 63);
            u32x2 o; o.x = pk2(f[0] * r * g[0], f[1] * r * g[1]); o.y = pk2(f[2] * r * g[2], f[3] * r * g[3]);
            *(u32x2*)pp = o;
        }
#pragma unroll
        for (int part = 0; part < 2; ++part) {
            const int c0 = part * 512 + lane * 8;
            float acc[8];
#pragma unroll
            for (int j = 0; j < 8; ++j) acc[j] = cb[c0 + j];
#pragma unroll
            for (int w = 0; w < 4; ++w) {
                if (t - 3 + w >= 0) {
                    const u32x4 raw = *(const u32x4*)(proj + (size_t)(m - 3 + w) * NPROJ + C_QB + c0); float f[8]; unpack8(raw, f);
#pragma unroll
                    for (int j = 0; j < 8; ++j) acc[j] += f[j] * cw[w * 1024 + c0 + j];
                }
            }
            const float sc = part ? 0.08838834764831845f : 1.f;
            float y[8];
#pragma unroll
            for (int j = 0; j < 8; ++j) y[j] = silu_f(acc[j]) * sc;
            u32x4 o; o.x = pk2(y[0], y[1]); o.y = pk2(y[2], y[3]); o.z = pk2(y[4], y[5]); o.w = pk2(y[6], y[7]);
            *(u32x4*)(qkc + (size_t)m * 1024 + c0) = o;
        }
    }
}

__device__ void phase_compress(const Params& p, int l, float* lds) {
    unsigned char* ws = p.ws;
    const bf16_t* proj = (const bf16_t*)(ws + WS_PROJ);
    const float* pe = p.in[I_PE] + (size_t)l * 2 * 2048; const float* w1 = p.in[I_W1] + (size_t)l * 2 * 2048 * 128; const float* w2 = p.in[I_W2] + (size_t)l * 2 * 128 * 64;
    const float* kg0 = p.in[I_KG] + l * 192;
    float* tok = lds;
    float* red = lds + 144 * 64;
    float* hidb = red + 4 * 8 * 128;
    const int tid = my_tid(), lane = tid & 63;
    for (int u = my_bid(); u < BATCH * 2 * 2 * 32; u += gridDim.x) {
        const int ib = u & 31, kv = (u >> 5) & 1, g = (u >> 6) & 1, b = u >> 7;
        const int i0 = ib * 8, ni = (NCMP - i0) < 8 ? (NCMP - i0) : 8;
        const int ntok = 16 * ni + 16;
        const int col = (kv ? C_VC : C_KC) + g * 64;
        __syncthreads();
        for (int e = tid; e < 144 * 64; e += NT) {
            const int tt = e >> 6, d = e & 63;
            tok[e] = tt < ntok ? bf2f(proj[(size_t)(b * SEQ + 16 * i0 + tt) * NPROJ + col + d]) : 0.f;
        }
        __syncthreads();
        {
            const int hid = tid & 127, part = tid >> 7;
            float acc[8], accP = 0.f;
#pragma unroll
            for (int ii = 0; ii < 8; ++ii) acc[ii] = 0.f;
            const float* w1p = w1 + (size_t)kv * 2048 * 128 + hid; const float* pep = pe + kv * 2048;
#pragma unroll 2
            for (int f = part * 512; f < part * 512 + 512; ++f) {
                const float w = w1p[(size_t)f * 128];
                accP += w * pep[f];
#pragma unroll
                for (int ii = 0; ii < 8; ++ii) acc[ii] += w * tok[16 * 64 * ii + f];
            }
#pragma unroll
            for (int ii = 0; ii < 8; ++ii) red[(part * 8 + ii) * 128 + hid] = acc[ii] + accP;
        }
        __syncthreads();
        for (int e = tid; e < 8 * 128; e += NT) {
            const float s = (red[e] + red[1024 + e]) + (red[2048 + e] + red[3072 + e]);
            hidb[e] = silu_f(s);
        }
        __syncthreads();
        {
            const int ii = tid >> 6, d = lane;
            float o = 0.f;
            const float* w2p = w2 + (size_t)kv * 128 * 64 + d;
            for (int h = 0; h < 128; ++h) o += hidb[ii * 128 + h] * w2p[h * 64];
            if (kv == 0) { const float s = wave_sum(o * o); o = o * rsqrtf(s * (1.f / 64.f) + EPS) * kg0[d]; }
            bf16_t* dst = (bf16_t*)(ws + (kv ? WS_VCMP : WS_KCMP));
            if (ii < ni) dst[(size_t)((b * 2 + g) * NCMPP + i0 + ii) * 64 + d] = f2bf(o);
        }
    }
    __syncthreads();
}

__device__ __forceinline__ float log_sigmoid_f(float x) { return fminf(x, 0.f) - log1pf(__expf(-fabsf(x))); }
__device__ void mlstm_gates(const float* gates, const float* fb, int m0, int h, float* bcum, float* ig) {
    const int tid = my_tid();
    __syncthreads();
    if (tid < 64) {
        const float lf = log_sigmoid_f(gates[(size_t)(m0 + tid) * 32 + 28 + h] + fb[h]);
        ig[tid] = gates[(size_t)(m0 + tid) * 32 + 24 + h];
        float v = lf;
#pragma unroll
        for (int o = 1; o < 64; o <<= 1) { const float t = __shfl_up(v, o); if (tid >= o) v += t; }
        bcum[tid] = v;
    }
    __syncthreads();
}

__device__ void phase_chunkstate(const Params& p, int l, float* lds) {
    unsigned char* ws = p.ws;
    const bf16_t* proj = (const bf16_t*)(ws + WS_PROJ); const float* gates = (const float*)(ws + WS_GATES);
    const float* cw = p.in[I_CW] + l * 4096; const float* cb = p.in[I_CB] + l * 1024; const float* fb = p.in[I_FB] + l * 4;
    bf16_t* ST = (bf16_t*)(ws + WS_ST); float* STN = (float*)(ws + WS_STN); float* STM = (float*)(ws + WS_STM);
    float* kw = lds;
    float* vv = lds + 8192;
    float* bcum = lds + 16384; float* ig = bcum + 64; float* wsc = ig + 64; float* misc = wsc + 64;
    const int tid = my_tid();
    for (int u = my_bid(); u < BATCH * 4 * 64; u += gridDim.x) {
        const int c = u & 63, h = (u >> 6) & 3, b = u >> 8;
        const int m0 = b * SEQ + c * 64, bh = b * 4 + h;
        mlstm_gates(gates, fb, m0, h, bcum, ig);
        if (tid < 64) {
            const float gv = bcum[63] - bcum[tid] + ig[tid];
            const float mx = wave_max(gv);
            wsc[tid] = __expf(gv - mx);
            if (tid == 0) { misc[0] = mx; STM[bh * 64 + c] = mx; STM[2048 + bh * 64 + c] = bcum[63]; }
        }
        __syncthreads();
        for (int e = tid; e < 64 * 16; e += NT) {
            const int s = e >> 4, d0 = (e & 15) * 8;
            const int t = c * 64 + s, ch = 512 + h * 128 + d0;
            float acc[8];
#pragma unroll
            for (int j = 0; j < 8; ++j) acc[j] = cb[ch + j];
#pragma unroll
            for (int w = 0; w < 4; ++w) {
                if (t - 3 + w >= 0) {
                    const u32x4 raw = *(const u32x4*)(proj + (size_t)(m0 + s - 3 + w) * NPROJ + C_QB + ch); float f[8]; unpack8(raw, f);
#pragma unroll
                    for (int j = 0; j < 8; ++j) acc[j] += f[j] * cw[w * 1024 + ch + j];
                }
            }
            const float sc = 0.08838834764831845f * wsc[s];
#pragma unroll
            for (int j = 0; j < 8; ++j) kw[s * 128 + d0 + j] = silu_f(acc[j]) * sc;
            const u32x4 rv = *(const u32x4*)(proj + (size_t)(m0 + s) * NPROJ + C_VB + h * 128 + d0); float fv[8]; unpack8(rv, fv);
#pragma unroll
            for (int j = 0; j < 8; ++j) vv[s * 128 + d0 + j] = fv[j];
        }
        __syncthreads();
        {
            const int e0 = (tid >> 4) * 4, d0 = (tid & 15) * 8;
            float acc[4][8];
#pragma unroll
            for (int i = 0; i < 4; ++i)
#pragma unroll
                for (int j = 0; j < 8; ++j) acc[i][j] = 0.f;
#pragma unroll 2
            for (int s = 0; s < 64; ++s) {
                const f32x4 ve = *(const f32x4*)(vv + s * 128 + e0);
                const f32x4 k0 = *(const f32x4*)(kw + s * 128 + d0), k1 = *(const f32x4*)(kw + s * 128 + d0 + 4);
                const float va[4] = {ve.x, ve.y, ve.z, ve.w}; const float ka[8] = {k0.x, k0.y, k0.z, k0.w, k1.x, k1.y, k1.z, k1.w};
#pragma unroll
                for (int i = 0; i < 4; ++i)
#pragma unroll
                    for (int j = 0; j < 8; ++j) acc[i][j] += va[i] * ka[j];
            }
#pragma unroll
            for (int i = 0; i < 4; ++i) {
                u32x4 o; o.x = pk2(acc[i][0], acc[i][1]); o.y = pk2(acc[i][2], acc[i][3]); o.z = pk2(acc[i][4], acc[i][5]); o.w = pk2(acc[i][6], acc[i][7]);
                *(u32x4*)(ST + ((size_t)(bh * 64 + c) * 128 + e0 + i) * 128 + d0) = o;
            }
        }
        if (tid < 128) {
            float s = 0.f;
            for (int q = 0; q < 64; ++q) s += kw[q * 128 + tid];
            STN[(size_t)(bh * 64 + c) * 128 + tid] = s;
        }
    }
    __syncthreads();
}

__device__ void phase_scan(const Params& p) {
    unsigned char* ws = p.ws;
    bf16_t* ST = (bf16_t*)(ws + WS_ST); float* STN = (float*)(ws + WS_STN); float* STM = (float*)(ws + WS_STM);
    const int tid = my_tid();
    for (int u = my_bid(); u < 256; u += gridDim.x) {
        const int bh = u >> 3, idx = ((u & 7) * NT + tid) * 4;
        float C[4] = {0.f, 0.f, 0.f, 0.f};
        float nval = 0.f; const bool do_n = (u & 7) == 0 && tid < 128;
        float m = 0.f;
        for (int c0 = 0; c0 < 64; c0 += 8) {
            u32x2 raw[8]; float dn[8], dec[8], scl[8];
#pragma unroll
            for (int k = 0; k < 8; ++k) {
                raw[k] = *(const u32x2*)(ST + (size_t)(bh * 64 + c0 + k) * 16384 + idx);
                dn[k] = do_n ? STN[(size_t)(bh * 64 + c0 + k) * 128 + tid] : 0.f;
            }
#pragma unroll
            for (int k = 0; k < 8; ++k) {
                const float mloc = STM[bh * 64 + c0 + k], bl = STM[2048 + bh * 64 + c0 + k];
                const float mnew = fmaxf(bl + m, mloc);
                dec[k] = __expf(bl + m - mnew); scl[k] = __expf(mloc - mnew);
                if ((u & 7) == 0 && tid == 0) STM[4096 + bh * 64 + c0 + k] = m;
                m = mnew;
            }
#pragma unroll
            for (int k = 0; k < 8; ++k) {
                u32x2 o; o.x = pk2(C[0], C[1]); o.y = pk2(C[2], C[3]);
                *(u32x2*)(ST + (size_t)(bh * 64 + c0 + k) * 16384 + idx) = o;
                const float f[4] = {lo16(raw[k].x), hi16(raw[k].x), lo16(raw[k].y), hi16(raw[k].y)};
#pragma unroll
                for (int j = 0; j < 4; ++j) C[j] = dec[k] * C[j] + scl[k] * f[j];
                if (do_n) { STN[(size_t)(bh * 64 + c0 + k) * 128 + tid] = nval; nval = dec[k] * nval + scl[k] * dn[k]; }
            }
        }
    }
}

__device__ void phase_attn_naive(const Params& p, int l, float* lds) {
    unsigned char* ws = p.ws;
    const bf16_t* proj = (const bf16_t*)(ws + WS_PROJ); const float* gates = (const float*)(ws + WS_GATES);
    const bf16_t* kcmp = (const bf16_t*)(ws + WS_KCMP); const bf16_t* vcmp = (const bf16_t*)(ws + WS_VCMP);
    bf16_t* Y = (bf16_t*)(ws + WS_Y);
    const float* oga = p.in[I_OGA] + l * 512;
    const int tid = my_tid(), lane = tid & 63, wave = tid >> 6;
    float* qs = lds + wave * (256 + 1024);
    float* pb = qs + 256;
    for (int u = my_bid(); u < BATCH * 2 * (SEQ / 8); u += gridDim.x) {
        const int tb = u % (SEQ / 8), g = (u / (SEQ / 8)) & 1, b = u / (SEQ / 4);
        const int t = tb * 8 + wave; const int m = b * SEQ + t;
        const bf16_t* prow = proj + (size_t)m * NPROJ;
#pragma unroll
        for (int hg = 0; hg < 4; ++hg) qs[hg * 64 + lane] = bf2f(prow[C_QA + g * 256 + hg * 64 + lane]);
        float otot[4] = {0.f, 0.f, 0.f, 0.f};
        const float* gt = gates + (size_t)m * 32 + g * 12;
        const int nval = t >= 31 ? ((t - 31) >> 4) + 1 : 0;
        float sc[4][4];
        float mx[4] = {-INFINITY, -INFINITY, -INFINITY, -INFINITY};
        const bf16_t* kc = kcmp + (size_t)(b * 2 + g) * NCMPP * 64; const bf16_t* vc = vcmp + (size_t)(b * 2 + g) * NCMPP * 64;
#pragma unroll
        for (int it = 0; it < 4; ++it) {
            asm volatile("" ::: "memory");
            const int i = it * 64 + lane;
            float a[4] = {0.f, 0.f, 0.f, 0.f};
            if (i < nval) {
#pragma unroll 1
                for (int d8 = 0; d8 < 8; ++d8) {
                    const u32x4 raw = *(const u32x4*)(kc + (size_t)i * 64 + d8 * 8); float f[8]; unpack8(raw, f);
#pragma unroll
                    for (int j = 0; j < 8; ++j)
#pragma unroll
                        for (int hg = 0; hg < 4; ++hg) a[hg] += qs[hg * 64 + d8 * 8 + j] * f[j];
                }
            }
#pragma unroll
            for (int hg = 0; hg < 4; ++hg) { sc[it][hg] = i < nval ? a[hg] * 0.125f : -INFINITY; mx[hg] = fmaxf(mx[hg], sc[it][hg]); }
        }
        float sm[4];
#pragma unroll
        for (int hg = 0; hg < 4; ++hg) {
            mx[hg] = wave_max(mx[hg]);
            float s = 0.f;
#pragma unroll
            for (int it = 0; it < 4; ++it) { const float e = (it * 64 + lane) < nval ? __expf(sc[it][hg] - mx[hg]) : 0.f; sc[it][hg] = e; s += e; }
            sm[hg] = wave_sum(s);
        }
#pragma unroll
        for (int it = 0; it < 4; ++it)
#pragma unroll
            for (int hg = 0; hg < 4; ++hg) pb[hg * 256 + it * 64 + lane] = nval > 0 ? sc[it][hg] / sm[hg] : 0.f;
        {
            float o[4] = {0.f, 0.f, 0.f, 0.f};
            for (int i = 0; i < nval; ++i) {
                const float v = bf2f(vc[(size_t)i * 64 + lane]);
#pragma unroll
                for (int hg = 0; hg < 4; ++hg) o[hg] += pb[hg * 256 + i] * v;
            }
#pragma unroll
            for (int hg = 0; hg < 4; ++hg) otot[hg] += sigmoid_f(gt[hg * 3 + 0]) * o[hg];
        }
        const int cur = t >> 6;
        float imp = 0.f;
#pragma unroll
        for (int k = -1; k < 4; ++k) {
            const int i = 4 * lane + k;
            if (i >= 0 && i < nval) imp += (pb[i] + pb[256 + i]) + (pb[512 + i] + pb[768 + i]);
        }
        const bool valid = lane <= cur;
        const bool forced = (lane == 0) || (lane == cur) || (lane == cur - 1);
        const float score = valid ? imp + (forced ? 1e4f : 0.f) : -1e30f;
        int rank = 0;
        for (int k = 0; k < 64; ++k) {
            const float sk = __shfl(score, k);
            rank += (sk > score || (sk == score && k < lane)) ? 1 : 0;
        }
        const unsigned long long selmask = __ballot(rank < 16 && valid);
#pragma unroll 1
        for (int br = 0; br < 2; ++br) {
            const int kcol = (br ? C_KW : C_KS) + g * 64, vcol = (br ? C_VW : C_VS) + g * 64;
            float mr[4] = {-INFINITY, -INFINITY, -INFINITY, -INFINITY}, lr[4] = {0.f, 0.f, 0.f, 0.f}, o[4] = {0.f, 0.f, 0.f, 0.f};
            const int jlo = br ? (cur >= 8 ? cur - 8 : 0) : 0;
            for (int j = jlo; j <= cur; ++j) {
                if (br == 0 && !((selmask >> j) & 1ull)) continue;
                asm volatile("" ::: "memory");
                const int pos = j * 64 + lane;
                const bool ok = pos <= t && (br == 0 || pos > t - 512);
                float a[4] = {0.f, 0.f, 0.f, 0.f};
                const bf16_t* kr = proj + (size_t)(b * SEQ + pos) * NPROJ + kcol;
#pragma unroll 1
                for (int d8 = 0; d8 < 8; ++d8) {
                    const u32x4 raw = *(const u32x4*)(kr + d8 * 8); float f[8]; unpack8(raw, f);
#pragma unroll
                    for (int jj = 0; jj < 8; ++jj)
#pragma unroll
                        for (int hg = 0; hg < 4; ++hg) a[hg] += qs[hg * 64 + d8 * 8 + jj] * f[jj];
                }
                float alpha[4];
#pragma unroll
                for (int hg = 0; hg < 4; ++hg) {
                    const float s = ok ? a[hg] * 0.125f : -INFINITY;
                    const float bm = wave_max(s);
                    const float mn = fmaxf(mr[hg], bm);
                    alpha[hg] = (mn == -INFINITY) ? 1.f : __expf(mr[hg] - mn);
                    const float e = (ok && mn > -INFINITY) ? __expf(s - mn) : 0.f;
                    lr[hg] = lr[hg] * alpha[hg] + wave_sum(e);
                    mr[hg] = mn;
                    pb[hg * 256 + lane] = e;
                    o[hg] *= alpha[hg];
                }
                const bf16_t* vr = proj + (size_t)(b * SEQ + j * 64) * NPROJ + vcol + lane;
                for (int k = 0; k < 64; ++k) {
                    const float v = bf2f(vr[(size_t)k * NPROJ]);
#pragma unroll
                    for (int hg = 0; hg < 4; ++hg) o[hg] += pb[hg * 256 + k] * v;
                }
            }
#pragma unroll
            for (int hg = 0; hg < 4; ++hg) otot[hg] += sigmoid_f(gt[hg * 3 + 1 + br]) * (lr[hg] > 0.f ? o[hg] / lr[hg] : 0.f);
        }
#pragma unroll
        for (int hg = 0; hg < 4; ++hg) {
            const float s = wave_sum(otot[hg] * otot[hg]);
            const float y = otot[hg] * rsqrtf(s * (1.f / 64.f) + EPS) * oga[(g * 4 + hg) * 64 + lane];
            Y[(size_t)m * 1024 + (g * 4 + hg) * 64 + lane] = f2bf(y);
        }
    }
}

namespace att {
typedef short bf16x8 __attribute__((ext_vector_type(8)));
typedef short s16x4 __attribute__((ext_vector_type(4)));
typedef float f32x16 __attribute__((ext_vector_type(16)));
#define ATT_LAS __attribute__((address_space(3)))
constexpr int L_K = 0, L_V = 16384, L_IMP = 32768, IMP_STRIDE = 65, L_SEL = L_IMP + 4 * 64 * IMP_STRIDE * 4, L_INV = L_SEL + 512, L_WS = L_INV + 1024, L_OST = L_WS + 8 * 256, L_END = L_OST + 8 * 4096;
static_assert(L_END <= LDS_BYTES, "attention LDS map");
constexpr float LOG2E = 1.4426950408889634f;
__device__ __forceinline__ int crow(int r, int hi) { return (r & 3) + 8 * (r >> 2) + 4 * hi; }
__device__ __forceinline__ unsigned cvtpk(float lo, float hi) { unsigned r; asm("v_cvt_pk_bf16_f32 %0, %1, %2" : "=v"(r) : "v"(lo), "v"(hi)); return r; }
__device__ __forceinline__ s16x4 vtr(ATT_LAS const unsigned char* p) { return __builtin_bit_cast(s16x4, __builtin_amdgcn_ds_read_tr16_b64_v4i16((ATT_LAS s16x4*)p)); }

struct Ctx {
    ATT_LAS unsigned char* lds;
    int lane, wave, r32, hi;
    u32x4 kreg, vreg;
};
__device__ __forceinline__ void tile_load(Ctx& C, const bf16_t* kbase, const bf16_t* vbase, int pitch) {
    C.kreg = *(const u32x4*)(kbase + (size_t)C.lane * pitch + C.wave * 8);
    C.vreg = *(const u32x4*)(vbase + (size_t)(16 * (C.wave & 3) + (C.lane >> 2)) * pitch + (C.wave >> 2) * 32 + (C.lane & 3) * 8);
}
__device__ __forceinline__ void tile_store(Ctx& C, int buf) {
    *(ATT_LAS u32x4*)(C.lds + L_K + buf * 8192 + C.wave * 1024 + C.lane * 16) = C.kreg;
    *(ATT_LAS u32x4*)(C.lds + L_V + buf * 8192 + C.wave * 1024 + C.lane * 16) = C.vreg;
}
__device__ __forceinline__ void qkt(const Ctx& C, int buf, const bf16x8 (&qr)[4], f32x16& p0, f32x16& p1) {
    ATT_LAS const unsigned char* kb = C.lds + L_K + buf * 8192 + C.hi * 1024 + C.r32 * 16;
    p0 = (f32x16){0.f, 0.f, 0.f, 0.f, 0.f, 0.f, 0.f, 0.f, 0.f, 0.f, 0.f, 0.f, 0.f, 0.f, 0.f, 0.f}; p1 = p0;
#pragma unroll
    for (int d0 = 0; d0 < 4; ++d0) {
        const bf16x8 b0 = *(ATT_LAS const bf16x8*)(kb + d0 * 2048);
        const bf16x8 b1 = *(ATT_LAS const bf16x8*)(kb + d0 * 2048 + 512);
        p0 = __builtin_amdgcn_mfma_f32_32x32x16_bf16(b0, qr[d0], p0, 0, 0, 0);
        p1 = __builtin_amdgcn_mfma_f32_32x32x16_bf16(b1, qr[d0], p1, 0, 0, 0);
    }
}
__device__ __forceinline__ void pv(const Ctx& C, int buf, const f32x16& p0, const f32x16& p1, f32x16 (&o)[2]) {
    ATT_LAS const unsigned char* vp = C.lds + L_V + buf * 8192 + ((C.lane >> 4) & 1) * 32 + (C.lane & 3) * 8 + (4 * C.hi + ((C.lane & 15) >> 2)) * 64;
    bf16x8 pa[4];
#pragma unroll
    for (int s2 = 0; s2 < 2; ++s2) {
        u32x4 w0, w1;
        w0.x = cvtpk(p0[8 * s2 + 0], p0[8 * s2 + 1]); w0.y = cvtpk(p0[8 * s2 + 2], p0[8 * s2 + 3]); w0.z = cvtpk(p0[8 * s2 + 4], p0[8 * s2 + 5]); w0.w = cvtpk(p0[8 * s2 + 6], p0[8 * s2 + 7]);
        w1.x = cvtpk(p1[8 * s2 + 0], p1[8 * s2 + 1]); w1.y = cvtpk(p1[8 * s2 + 2], p1[8 * s2 + 3]); w1.z = cvtpk(p1[8 * s2 + 4], p1[8 * s2 + 5]); w1.w = cvtpk(p1[8 * s2 + 6], p1[8 * s2 + 7]);
        pa[s2] = __builtin_bit_cast(bf16x8, w0); pa[2 + s2] = __builtin_bit_cast(bf16x8, w1);
    }
#pragma unroll
    for (int d0 = 0; d0 < 2; ++d0)
#pragma unroll
        for (int ks = 0; ks < 4; ++ks) {
            const s16x4 lo = vtr(vp + d0 * 4096 + ks * 1024), hh = vtr(vp + d0 * 4096 + ks * 1024 + 512);
            const bf16x8 vf = (bf16x8){lo[0], lo[1], lo[2], lo[3], hh[0], hh[1], hh[2], hh[3]};
            o[d0] = __builtin_amdgcn_mfma_f32_32x32x16_bf16(pa[ks], vf, o[d0], 0, 0, 0);
        }
}
__device__ __forceinline__ float sum16(const f32x16& p) {
    return ((p[0] + p[1]) + (p[2] + p[3])) + ((p[4] + p[5]) + (p[6] + p[7])) + (((p[8] + p[9]) + (p[10] + p[11])) + ((p[12] + p[13]) + (p[14] + p[15])));
}
__device__ __forceinline__ void accum_scaled(const Ctx& C, f32x16 (&otot)[2], const f32x16 (&o)[2], float fac) {
    ATT_LAS float* wsf = (ATT_LAS float*)(C.lds + L_WS) + C.wave * 64;
    asm volatile("s_waitcnt lgkmcnt(0)" ::: "memory");
    if (C.hi == 0) wsf[C.r32] = fac;
    asm volatile("s_waitcnt lgkmcnt(0)" ::: "memory");
#pragma unroll
    for (int r = 0; r < 16; ++r) { const float f = wsf[crow(r, C.hi)]; otot[0][r] += o[0][r] * f; otot[1][r] += o[1][r] * f; }
    asm volatile("s_waitcnt lgkmcnt(0)" : "+v"(otot[0]), "+v"(otot[1]) :: "memory");
}

__device__ void unit(const Params& p, int l, int b, int g, int c, ATT_LAS unsigned char* lds) {
    unsigned char* ws = p.ws;
    const bf16_t* proj = (const bf16_t*)(ws + WS_PROJ); const float* gates = (const float*)(ws + WS_GATES);
    const bf16_t* kcmp = (const bf16_t*)(ws + WS_KCMP) + (size_t)(b * 2 + g) * NCMPP * 64; const bf16_t* vcmp = (const bf16_t*)(ws + WS_VCMP) + (size_t)(b * 2 + g) * NCMPP * 64;
    bf16_t* Y = (bf16_t*)(ws + WS_Y);
    const float* kg = p.in[I_KG] + l * 192; const float* oga = p.in[I_OGA] + l * 512;
    Ctx C; C.lds = lds;
    const int tid = my_tid(); C.lane = tid & 63; C.wave = __builtin_amdgcn_readfirstlane(tid >> 6); C.r32 = C.lane & 31; C.hi = C.lane >> 5;
    const int lane = C.lane, wave = C.wave, r32 = C.r32, hi = C.hi, hg = wave >> 1, th = wave & 1;
    const int t = 64 * c + 32 * th + r32; const size_t m = (size_t)b * SEQ + t;
    const bf16_t* prow0 = proj + (size_t)b * SEQ * NPROJ;
    bf16x8 qr[4]; float qsq = 0.f;
#pragma unroll
    for (int d0 = 0; d0 < 4; ++d0) {
        const u32x4 raw = *(const u32x4*)(proj + m * NPROJ + C_QA + g * 256 + hg * 64 + 16 * d0 + 8 * hi);
        qr[d0] = __builtin_bit_cast(bf16x8, raw);
        float f[8]; unpack8(raw, f);
#pragma unroll
        for (int j = 0; j < 8; ++j) qsq += f[j] * f[j];
    }
    qsq += __shfl_xor(qsq, 32);
    const float qn = sqrtf(qsq) * 1.01f * LOG2E;
    const float off_c = qn * wave_max(fabsf(kg[lane])), off_s = qn * wave_max(fabsf(kg[64 + lane])), off_w = qn * wave_max(fabsf(kg[128 + lane]));
    const float* gt = gates + m * 32 + (g * 4 + hg) * 3;
    const float gq0 = sigmoid_f(gt[0]), gq1 = sigmoid_f(gt[1]), gq2 = sigmoid_f(gt[2]);
    constexpr float C2 = 0.125f * LOG2E;
    f32x16 otot[2]; otot[0] = (f32x16){0.f, 0.f, 0.f, 0.f, 0.f, 0.f, 0.f, 0.f, 0.f, 0.f, 0.f, 0.f, 0.f, 0.f, 0.f, 0.f}; otot[1] = otot[0];
    const f32x16 zero16 = otot[0];
    {
        const int nval = t >= 31 ? ((t - 31) >> 4) + 1 : 0;
        const int ntc = (4 * c + 3 + 63) >> 6;
        f32x16 o[2]; o[0] = zero16; o[1] = zero16;
        float lsum = 0.f, yprev = 0.f;
        ATT_LAS float* imp = (ATT_LAS float*)(lds + L_IMP) + (hg * 64 + 32 * th + r32) * IMP_STRIDE;
        tile_load(C, kcmp, vcmp, 64); tile_store(C, 0); __syncthreads();
#pragma unroll
        for (int jt = 0; jt < 4; ++jt) {
            if (jt < ntc) {
                if (jt + 1 < ntc) tile_load(C, kcmp + (size_t)(jt + 1) * 64 * 64, vcmp + (size_t)(jt + 1) * 64 * 64, 64);
                f32x16 p0, p1; qkt(C, jt & 1, qr, p0, p1);
#pragma unroll
                for (int r = 0; r < 16; ++r) {
                    const int i0 = 64 * jt + crow(r, hi);
                    p0[r] = i0 < nval ? __builtin_amdgcn_exp2f(p0[r] * C2 - off_c) : 0.f;
                    p1[r] = i0 + 32 < nval ? __builtin_amdgcn_exp2f(p1[r] * C2 - off_c) : 0.f;
                }
                lsum += sum16(p0) + sum16(p1);
#pragma unroll
                for (int H = 0; H < 2; ++H)
#pragma unroll
                    for (int rr = 0; rr < 4; ++rr) {
                        const f32x16& pp = H ? p1 : p0;
                        const float L = pp[4 * rr + 3], S4 = (pp[4 * rr] + pp[4 * rr + 1]) + (pp[4 * rr + 2] + L);
                        const float y = __shfl_xor(L, 32);
                        imp[2 * ((jt * 2 + H) * 4 + rr) + hi] = S4 + (hi ? y : yprev);
                        yprev = y;
                    }
                pv(C, jt & 1, p0, p1, o);
                if (jt + 1 < ntc) tile_store(C, (jt + 1) & 1);
                __syncthreads();
            }
        }
        lsum += __shfl_xor(lsum, 32);
        const float inv = lsum > 0.f ? 1.f / lsum : 0.f;
        if (hi == 0) ((ATT_LAS float*)(lds + L_INV))[hg * 64 + 32 * th + r32] = inv;
        accum_scaled(C, otot, o, gq0 * inv);
    }
    __syncthreads();
    {
        ATT_LAS unsigned long long* selm = (ATT_LAS unsigned long long*)(lds + L_SEL);
        const ATT_LAS float* impb = (const ATT_LAS float*)(lds + L_IMP);
        for (int i = 0; i < 8; ++i) {
            const int q = wave * 8 + i;
            unsigned long long msk;
            if (c < 16) msk = (2ull << c) - 1ull;
            else {
                const bool valid = lane <= c;
                float sc = -1e30f;
                if (valid) {
                    const ATT_LAS float* invb = (const ATT_LAS float*)(lds + L_INV);
                    sc = (impb[(0 * 64 + q) * IMP_STRIDE + lane] * invb[q] + impb[(1 * 64 + q) * IMP_STRIDE + lane] * invb[64 + q]) + (impb[(2 * 64 + q) * IMP_STRIDE + lane] * invb[128 + q] + impb[(3 * 64 + q) * IMP_STRIDE + lane] * invb[192 + q]);
                    if (lane == 0 || lane == c || lane == c - 1) sc += 1e4f;
                }
                int rank = 0;
                for (int k = 0; k <= c; ++k) { const float sk = __shfl(sc, k); rank += (sk > sc || (sk == sc && k < lane)) ? 1 : 0; }
                msk = __ballot(valid && rank < 16);
            }
            if (lane == 0) selm[q] = msk;
        }
    }
    __syncthreads();
    const unsigned long long mysel = ((ATT_LAS const unsigned long long*)(lds + L_SEL))[32 * th + r32];
    unsigned long long blkmask;
    {
        unsigned long long v = ((ATT_LAS const unsigned long long*)(lds + L_SEL))[lane];
#pragma unroll
        for (int o2 = 1; o2 < 64; o2 <<= 1) v |= __shfl_xor(v, o2);
        blkmask = ((unsigned long long)__builtin_amdgcn_readfirstlane((unsigned)(v >> 32)) << 32) | (unsigned)__builtin_amdgcn_readfirstlane((unsigned)v);
    }
    {
        f32x16 o[2]; o[0] = zero16; o[1] = zero16; float lsum = 0.f;
        const bf16_t* kb = prow0 + C_KS + g * 64; const bf16_t* vb = prow0 + C_VS + g * 64;
        unsigned long long rem = blkmask;
        int j = __builtin_ctzll(rem); rem &= rem - 1ull;
        tile_load(C, kb + (size_t)j * 64 * NPROJ, vb + (size_t)j * 64 * NPROJ, NPROJ); tile_store(C, 0); __syncthreads();
        int buf = 0;
        for (;;) {
            const int jn = rem ? __builtin_ctzll(rem) : -1;
            if (jn >= 0) { rem &= rem - 1ull; tile_load(C, kb + (size_t)jn * 64 * NPROJ, vb + (size_t)jn * 64 * NPROJ, NPROJ); }
            f32x16 p0, p1; qkt(C, buf, qr, p0, p1);
            const bool sel = (mysel >> j) & 1ull;
            const int lim = t - 64 * j;
#pragma unroll
            for (int r = 0; r < 16; ++r) {
                const int kk = crow(r, hi);
                p0[r] = (sel && kk <= lim) ? __builtin_amdgcn_exp2f(p0[r] * C2 - off_s) : 0.f;
                p1[r] = (sel && kk + 32 <= lim) ? __builtin_amdgcn_exp2f(p1[r] * C2 - off_s) : 0.f;
            }
            lsum += sum16(p0) + sum16(p1);
            pv(C, buf, p0, p1, o);
            if (jn >= 0) tile_store(C, buf ^ 1);
            __syncthreads();
            if (jn < 0) break;
            j = jn; buf ^= 1;
        }
        lsum += __shfl_xor(lsum, 32);
        accum_scaled(C, otot, o, gq1 / lsum);
    }
    {
        f32x16 o[2]; o[0] = zero16; o[1] = zero16; float lsum = 0.f;
        const bf16_t* kb = prow0 + C_KW + g * 64; const bf16_t* vb = prow0 + C_VW + g * 64;
        const int jlo = c >= 8 ? c - 8 : 0;
        tile_load(C, kb + (size_t)jlo * 64 * NPROJ, vb + (size_t)jlo * 64 * NPROJ, NPROJ); tile_store(C, 0); __syncthreads();
        int buf = 0;
        for (int j = jlo; j <= c; ++j) {
            if (j < c) tile_load(C, kb + (size_t)(j + 1) * 64 * NPROJ, vb + (size_t)(j + 1) * 64 * NPROJ, NPROJ);
            f32x16 p0, p1; qkt(C, buf, qr, p0, p1);
            const int lim = t - 64 * j;
#pragma unroll
            for (int r = 0; r < 16; ++r) {
                const int kk = crow(r, hi);
                p0[r] = (kk <= lim && kk > lim - 512) ? __builtin_amdgcn_exp2f(p0[r] * C2 - off_w) : 0.f;
                p1[r] = (kk + 32 <= lim && kk + 32 > lim - 512) ? __builtin_amdgcn_exp2f(p1[r] * C2 - off_w) : 0.f;
            }
            lsum += sum16(p0) + sum16(p1);
            pv(C, buf, p0, p1, o);
            if (j < c) tile_store(C, buf ^ 1);
            __syncthreads();
            buf ^= 1;
        }
        lsum += __shfl_xor(lsum, 32);
        accum_scaled(C, otot, o, gq2 / lsum);
    }
    {
        ATT_LAS bf16_t* stg = (ATT_LAS bf16_t*)(lds + L_OST) + wave * 2048;
        const float g0 = oga[(g * 4 + hg) * 64 + r32], g1 = oga[(g * 4 + hg) * 64 + 32 + r32];
#pragma unroll
        for (int r = 0; r < 16; ++r) {
            float sq = otot[0][r] * otot[0][r] + otot[1][r] * otot[1][r];
            sq += __shfl_xor(sq, 1); sq += __shfl_xor(sq, 2); sq += __shfl_xor(sq, 4); sq += __shfl_xor(sq, 8); sq += __shfl_xor(sq, 16);
            const float rs = rsqrtf(sq * (1.f / 64.f) + EPS);
            const int q = crow(r, hi);
            stg[q * 64 + r32] = f2bf(otot[0][r] * rs * g0);
            stg[q * 64 + 32 + r32] = f2bf(otot[1][r] * rs * g1);
        }
        asm volatile("s_waitcnt lgkmcnt(0)" ::: "memory");
        bf16_t* yb = Y + ((size_t)b * SEQ + 64 * c + 32 * th) * 1024 + (g * 4 + hg) * 64;
#pragma unroll
        for (int i = 0; i < 4; ++i) {
            const int row = i * 8 + (lane >> 3), ch = lane & 7;
            const u32x4 v = *(ATT_LAS const u32x4*)(stg + row * 64 + ch * 8);
            *(u32x4*)(yb + (size_t)row * 1024 + ch * 8) = v;
        }
    }
    __syncthreads();
}
}

namespace att2 {
using att::bf16x8; using att::s16x4; using att::f32x16; using att::crow; using att::cvtpk; using att::vtr; using att::sum16;
constexpr int L_K = 0  , L_V = 24576  , L_IMP = 49152, IMP_STRIDE = 65, L_SEL = L_IMP + 4 * 64 * IMP_STRIDE * 4, L_INV = L_SEL + 512, L_WS = L_INV + 1024, L_OST = L_WS + 8 * 256, L_TL = L_OST + 8 * 4096, L_END = L_TL + 256;
static_assert(L_END <= LDS_WTAB, "attention LDS map");
constexpr float LOG2E = 1.4426950408889634f;

struct Ctx {
    ATT_LAS unsigned char* lds;
    int lane, wave, r32, hi;
    const bf16_t* kcmp; const bf16_t* vcmp; const bf16_t* prow0; int g;
};
__device__ __forceinline__ void tile_ptrs(const Ctx& C, int d, const bf16_t*& kb, const bf16_t*& vb, int& pitch) {
    const int br = d >> 8, j = d & 255;
    if (br == 0) { kb = C.kcmp + (size_t)j * 4096; vb = C.vcmp + (size_t)j * 4096; pitch = 64; }
    else { const size_t ro = (size_t)j * 64 * NPROJ; kb = C.prow0 + (br == 1 ? C_KS : C_KW) + C.g * 64 + ro; vb = C.prow0 + (br == 1 ? C_VS : C_VW) + C.g * 64 + ro; pitch = NPROJ; }
}
__device__ __forceinline__ u32x4 load_k(const Ctx& C, int d) { const bf16_t* kb; const bf16_t* vb; int pitch; tile_ptrs(C, d, kb, vb, pitch); return *(const u32x4*)(kb + (size_t)C.lane * pitch + C.wave * 8); }
__device__ __forceinline__ u32x4 load_v(const Ctx& C, int d) { const bf16_t* kb; const bf16_t* vb; int pitch; tile_ptrs(C, d, kb, vb, pitch);
    return *(const u32x4*)(vb + (size_t)(16 * (C.wave & 3) + (C.lane >> 2)) * pitch + (C.wave >> 2) * 32 + (C.lane & 3) * 8); }
__device__ __forceinline__ void store_k(const Ctx& C, int slot, u32x4 v) { *(ATT_LAS u32x4*)(C.lds + L_K + slot * 8192 + C.wave * 1024 + C.lane * 16) = v; }
__device__ __forceinline__ void store_v(const Ctx& C, int slot, u32x4 v) { *(ATT_LAS u32x4*)(C.lds + L_V + slot * 8192 + C.wave * 1024 + C.lane * 16) = v; }
__device__ __forceinline__ void dma_k(const Ctx& C, int d, int slot) { const bf16_t* kb; const bf16_t* vb; int pitch; tile_ptrs(C, d, kb, vb, pitch);
    __builtin_amdgcn_global_load_lds((const unsigned*)(kb + (size_t)C.lane * pitch + C.wave * 8), (ATT_LAS unsigned*)(C.lds + L_K + slot * 8192 + C.wave * 1024), 16, 0, 0); }
__device__ __forceinline__ void dma_v(const Ctx& C, int d, int slot) { const bf16_t* kb; const bf16_t* vb; int pitch; tile_ptrs(C, d, kb, vb, pitch);
    __builtin_amdgcn_global_load_lds((const unsigned*)(vb + (size_t)(16 * (C.wave & 3) + (C.lane >> 2)) * pitch + (C.wave >> 2) * 32 + (C.lane & 3) * 8), (ATT_LAS unsigned*)(C.lds + L_V + slot * 8192 + C.wave * 1024), 16, 0, 0); }
__device__ __forceinline__ void qkt(const Ctx& C, int slot, const bf16x8 (&qr)[4], float cval, f32x16& p0, f32x16& p1) {
    ATT_LAS const unsigned char* kb = C.lds + L_K + slot * 8192 + C.hi * 1024 + C.r32 * 16;
    const f32x16 cin = (f32x16){cval, cval, cval, cval, cval, cval, cval, cval, cval, cval, cval, cval, cval, cval, cval, cval};
#pragma unroll
    for (int d0 = 0; d0 < 4; ++d0) {
        const bf16x8 b0 = *(ATT_LAS const bf16x8*)(kb + d0 * 2048);
        const bf16x8 b1 = *(ATT_LAS const bf16x8*)(kb + d0 * 2048 + 512);
        if (d0 == 0) { p0 = __builtin_amdgcn_mfma_f32_32x32x16_bf16(b0, qr[0], cin, 0, 0, 0); p1 = __builtin_amdgcn_mfma_f32_32x32x16_bf16(b1, qr[0], cin, 0, 0, 0); }
        else { p0 = __builtin_amdgcn_mfma_f32_32x32x16_bf16(b0, qr[d0], p0, 0, 0, 0); p1 = __builtin_amdgcn_mfma_f32_32x32x16_bf16(b1, qr[d0], p1, 0, 0, 0); }
    }
}
__device__ __forceinline__ void pv(const Ctx& C, int slot, const f32x16& p0, const f32x16& p1, f32x16 (&o)[2]) {
    ATT_LAS const unsigned char* vp = C.lds + L_V + slot * 8192 + ((C.lane >> 4) & 1) * 32 + (C.lane & 3) * 8 + (4 * C.hi + ((C.lane & 15) >> 2)) * 64;
    bf16x8 pa[4];
#pragma unroll
    for (int s2 = 0; s2 < 2; ++s2) {
        u32x4 w0, w1;
        w0.x = cvtpk(p0[8 * s2 + 0], p0[8 * s2 + 1]); w0.y = cvtpk(p0[8 * s2 + 2], p0[8 * s2 + 3]); w0.z = cvtpk(p0[8 * s2 + 4], p0[8 * s2 + 5]); w0.w = cvtpk(p0[8 * s2 + 6], p0[8 * s2 + 7]);
        w1.x = cvtpk(p1[8 * s2 + 0], p1[8 * s2 + 1]); w1.y = cvtpk(p1[8 * s2 + 2], p1[8 * s2 + 3]); w1.z = cvtpk(p1[8 * s2 + 4], p1[8 * s2 + 5]); w1.w = cvtpk(p1[8 * s2 + 6], p1[8 * s2 + 7]);
        pa[s2] = __builtin_bit_cast(bf16x8, w0); pa[2 + s2] = __builtin_bit_cast(bf16x8, w1);
    }
    const unsigned vaddr = (unsigned)(uintptr_t)vp;
    s16x4 lo[8], hh[8];
#define ATT_TR8(D0) asm volatile( \
        "ds_read_b64_tr_b16 %0, %8 offset:%c9\n\tds_read_b64_tr_b16 %1, %8 offset:%c10\n\tds_read_b64_tr_b16 %2, %8 offset:%c11\n\tds_read_b64_tr_b16 %3, %8 offset:%c12\n\t" \
        "ds_read_b64_tr_b16 %4, %8 offset:%c13\n\tds_read_b64_tr_b16 %5, %8 offset:%c14\n\tds_read_b64_tr_b16 %6, %8 offset:%c15\n\tds_read_b64_tr_b16 %7, %8 offset:%c16\n\ts_waitcnt lgkmcnt(0)" \
        : "=&v"(lo[D0 * 4 + 0]), "=&v"(hh[D0 * 4 + 0]), "=&v"(lo[D0 * 4 + 1]), "=&v"(hh[D0 * 4 + 1]), "=&v"(lo[D0 * 4 + 2]), "=&v"(hh[D0 * 4 + 2]), "=&v"(lo[D0 * 4 + 3]), "=&v"(hh[D0 * 4 + 3]) \
        : "v"(vaddr), "i"(D0 * 4096), "i"(D0 * 4096 + 512), "i"(D0 * 4096 + 1024), "i"(D0 * 4096 + 1536), "i"(D0 * 4096 + 2048), "i"(D0 * 4096 + 2560), "i"(D0 * 4096 + 3072), "i"(D0 * 4096 + 3584) : "memory")
    ATT_TR8(0);
#pragma unroll
    for (int ks = 0; ks < 4; ++ks) {
        const s16x4 l2 = lo[ks], h2 = hh[ks];
        o[0] = __builtin_amdgcn_mfma_f32_32x32x16_bf16(pa[ks], (bf16x8){l2[0], l2[1], l2[2], l2[3], h2[0], h2[1], h2[2], h2[3]}, o[0], 0, 0, 0);
    }
    ATT_TR8(1);
#pragma unroll
    for (int ks = 0; ks < 4; ++ks) {
        const s16x4 l2 = lo[4 + ks], h2 = hh[4 + ks];
        o[1] = __builtin_amdgcn_mfma_f32_32x32x16_bf16(pa[ks], (bf16x8){l2[0], l2[1], l2[2], l2[3], h2[0], h2[1], h2[2], h2[3]}, o[1], 0, 0, 0);
    }
#undef ATT_TR8
}
__device__ __forceinline__ void accum_scaled(const Ctx& C, f32x16 (&otot)[2], const f32x16 (&o)[2], float fac) {
    ATT_LAS float* wsf = (ATT_LAS float*)(C.lds + L_WS) + C.wave * 64;
    asm volatile("s_waitcnt lgkmcnt(0)" ::: "memory");
    if (C.hi == 0) wsf[C.r32] = fac;
    asm volatile("s_waitcnt lgkmcnt(0)" ::: "memory");
#pragma unroll
    for (int r = 0; r < 16; ++r) { const float f = wsf[crow(r, C.hi)]; otot[0][r] += o[0][r] * f; otot[1][r] += o[1][r] * f; }
    asm volatile("s_waitcnt lgkmcnt(0)" : "+v"(otot[0]), "+v"(otot[1]) :: "memory");
}
__device__ __forceinline__ ATT_LAS float* park_ptr(const Ctx& C) { return (ATT_LAS float*)(C.lds + L_IMP + C.wave * 8192) + C.lane; }
__device__ __forceinline__ void park_store(const Ctx& C, const f32x16 (&otot)[2]) {
    ATT_LAS float* pp = park_ptr(C);
#pragma unroll
    for (int r = 0; r < 16; ++r) { pp[r * 64] = otot[0][r]; pp[(16 + r) * 64] = otot[1][r]; }
}
__device__ __forceinline__ void park_load(const Ctx& C, f32x16 (&otot)[2]) {
    const ATT_LAS float* pp = park_ptr(C);
#pragma unroll
    for (int r = 0; r < 16; ++r) { otot[0][r] = pp[r * 64]; otot[1][r] = pp[(16 + r) * 64]; }
}
__device__ __forceinline__ void accum_parked(const Ctx& C, const f32x16 (&o)[2], float fac) {
    ATT_LAS float* wsf = (ATT_LAS float*)(C.lds + L_WS) + C.wave * 64;
    ATT_LAS float* pp = park_ptr(C);
    asm volatile("s_waitcnt lgkmcnt(0)" ::: "memory");
    if (C.hi == 0) wsf[C.r32] = fac;
    asm volatile("s_waitcnt lgkmcnt(0)" ::: "memory");
#pragma unroll
    for (int r = 0; r < 16; ++r) { const float f = wsf[crow(r, C.hi)]; pp[r * 64] += o[0][r] * f; pp[(16 + r) * 64] += o[1][r] * f; }
    asm volatile("s_waitcnt lgkmcnt(0)" ::: "memory");
}
struct TokInfo { int t, tl, c, nval; float off_c, off_s, off_w, g0, g1, g2; unsigned long long mysel; };
template <bool CMP>
__device__ __forceinline__ float cin_of(const TokInfo& T, int d) {
    if (CMP) return -T.off_c;
    const int br = d >> 8, j = d & 255;
    const float cs = ((T.mysel >> j) & 1ull) ? -T.off_s : -INFINITY;
    return br == 2 ? -T.off_w : cs;
}
template <bool CMP>
__device__ __forceinline__ void step(const Ctx& C, const TokInfo& T, const bf16x8 (&qr)[4], f32x16 (&o)[2], f32x16 (&otot)[2], float& lsum, float& yprev, int d_cur, int d_n1, int sl) {
    const f32x16 zero16 = (f32x16){0.f, 0.f, 0.f, 0.f, 0.f, 0.f, 0.f, 0.f, 0.f, 0.f, 0.f, 0.f, 0.f, 0.f, 0.f, 0.f};
    f32x16 X0, X1;
    qkt(C, sl, qr, cin_of<CMP>(T, d_cur), X0, X1);
    const int br = d_cur >> 8, j = d_cur & 255;
    const bool bounded = CMP || j == T.c || (br == 2 && j + 8 == T.c);
    if (bounded) {
        int lo = -1, hi_lim = 64;
        if (CMP) hi_lim = T.nval - 64 * j - 1;
        else { if (j == T.c) hi_lim = T.tl; if (br == 2 && j + 8 == T.c) lo = T.tl; }
#pragma unroll
        for (int r = 0; r < 16; ++r) {
            const int kk = crow(r, C.hi);
            X0[r] = (kk > lo && kk <= hi_lim) ? __builtin_amdgcn_exp2f(X0[r]) : 0.f;
            X1[r] = (kk + 32 > lo && kk + 32 <= hi_lim) ? __builtin_amdgcn_exp2f(X1[r]) : 0.f;
        }
    } else {
#pragma unroll
        for (int r = 0; r < 16; ++r) { X0[r] = __builtin_amdgcn_exp2f(X0[r]); X1[r] = __builtin_amdgcn_exp2f(X1[r]); }
    }
    lsum += sum16(X0) + sum16(X1);
    if (CMP) {
        ATT_LAS float* imp = (ATT_LAS float*)(C.lds + L_IMP) + ((C.wave >> 1) * 64 + 32 * (C.wave & 1) + C.r32) * IMP_STRIDE + 16 * j;
#pragma unroll
        for (int H = 0; H < 2; ++H)
#pragma unroll
            for (int rr = 0; rr < 4; ++rr) {
                const f32x16& pp = H ? X1 : X0;
                const float L = pp[4 * rr + 3], S4 = (pp[4 * rr] + pp[4 * rr + 1]) + (pp[4 * rr + 2] + L);
                const float y = __shfl_xor(L, 32);
                imp[8 * H + 2 * rr + C.hi] = S4 + (C.hi ? y : yprev);
                yprev = y;
            }
    }
    pv(C, sl, X0, X1, o);
    const bool last_of_branch = d_n1 < 0 || (d_n1 >> 8) != br;
    if (last_of_branch) {
        lsum += __shfl_xor(lsum, 32);
        const float inv = lsum > 0.f ? 1.f / lsum : 0.f;
        if (CMP) { if (C.hi == 0) ((ATT_LAS float*)(C.lds + L_INV))[(C.wave >> 1) * 64 + 32 * (C.wave & 1) + C.r32] = inv; }
        accum_scaled(C, otot, o, (CMP ? T.g0 : (br == 1 ? T.g1 : T.g2)) * inv);
        o[0] = zero16; o[1] = zero16; lsum = 0.f;
    }
}
template <bool CMP>
__device__ __forceinline__ void stream(const Ctx& C, const TokInfo& T, int n, const bf16x8 (&qr)[4], f32x16 (&otot)[2]) {
    const ATT_LAS unsigned short* TL = (const ATT_LAS unsigned short*)(C.lds + L_TL);
#define ATT_DESC(i) (CMP ? (i) : (int)__builtin_amdgcn_readfirstlane((int)TL[(i)]))
    const f32x16 zero16 = (f32x16){0.f, 0.f, 0.f, 0.f, 0.f, 0.f, 0.f, 0.f, 0.f, 0.f, 0.f, 0.f, 0.f, 0.f, 0.f, 0.f};
    f32x16 o[2]; o[0] = zero16; o[1] = zero16;
    float lsum = 0.f, yprev = 0.f;
    int d_cur = ATT_DESC(0);
    { const int d1 = ATT_DESC(n > 1 ? 1 : n - 1); dma_k(C, d_cur, 0); dma_v(C, d_cur, 0); dma_k(C, d1, 1); dma_v(C, d1, 1); }
    asm volatile("s_waitcnt vmcnt(0) lgkmcnt(0)\n\ts_barrier" ::: "memory");
    int sl = 0;
    for (int i = 0; i < n; ++i) {
        const int d_n1 = (i + 1 < n) ? ATT_DESC(i + 1) : -1;
        const int d2 = ATT_DESC(i + 2 < n ? i + 2 : n - 1), s2 = sl == 0 ? 2 : sl - 1;
        dma_k(C, d2, s2); dma_v(C, d2, s2);
        step<CMP>(C, T, qr, o, otot, lsum, yprev, d_cur, d_n1, sl);
        asm volatile("s_waitcnt vmcnt(2) lgkmcnt(0)\n\ts_barrier" ::: "memory");
        d_cur = d_n1; sl = sl == 2 ? 0 : sl + 1;
    }
    asm volatile("s_waitcnt vmcnt(0) lgkmcnt(0)\n\ts_barrier" ::: "memory");
#undef ATT_DESC
}

__device__ void unit(const Params& p, int l, int b, int g, int c, ATT_LAS unsigned char* lds) {
    unsigned char* ws = p.ws;
    const bf16_t* proj = (const bf16_t*)(ws + WS_PROJ); const float* gates = (const float*)(ws + WS_GATES);
    bf16_t* Y = (bf16_t*)(ws + WS_Y);
    const float* kg = p.in[I_KG] + l * 192; const float* oga = p.in[I_OGA] + l * 512;
    Ctx C; C.lds = lds;
    const int tid = my_tid(); C.lane = tid & 63; C.wave = __builtin_amdgcn_readfirstlane(tid >> 6); C.r32 = C.lane & 31; C.hi = C.lane >> 5;
    C.kcmp = (const bf16_t*)(ws + WS_KCMP) + (size_t)(b * 2 + g) * NCMPP * 64; C.vcmp = (const bf16_t*)(ws + WS_VCMP) + (size_t)(b * 2 + g) * NCMPP * 64;
    C.prow0 = proj + (size_t)b * SEQ * NPROJ; C.g = g;
    const int lane = C.lane, wave = C.wave, r32 = C.r32, hi = C.hi, hg = wave >> 1, th = wave & 1;
    TokInfo T; T.c = c; T.tl = 32 * th + r32; T.t = 64 * c + T.tl; T.nval = T.t >= 31 ? ((T.t - 31) >> 4) + 1 : 0; T.mysel = 0ull;
    const size_t m = (size_t)b * SEQ + T.t;
    bf16x8 qr[4]; float qsq = 0.f;
    constexpr float C2 = 0.125f * LOG2E;
#pragma unroll
    for (int d0 = 0; d0 < 4; ++d0) {
        const u32x4 raw = *(const u32x4*)(proj + m * NPROJ + C_QA + g * 256 + hg * 64 + 16 * d0 + 8 * hi);
        float f[8]; unpack8(raw, f);
#pragma unroll
        for (int j = 0; j < 8; ++j) qsq += f[j] * f[j];
        u32x4 w; w.x = cvtpk(f[0] * C2, f[1] * C2); w.y = cvtpk(f[2] * C2, f[3] * C2); w.z = cvtpk(f[4] * C2, f[5] * C2); w.w = cvtpk(f[6] * C2, f[7] * C2);
        qr[d0] = __builtin_bit_cast(bf16x8, w);
    }
    qsq += __shfl_xor(qsq, 32);
    const float qn = sqrtf(qsq) * 1.01f * LOG2E;
    T.off_c = qn * wave_max(fabsf(kg[lane])); T.off_s = qn * wave_max(fabsf(kg[64 + lane])); T.off_w = qn * wave_max(fabsf(kg[128 + lane]));
    const float* gt = gates + m * 32 + (g * 4 + hg) * 3;
    T.g0 = sigmoid_f(gt[0]); T.g1 = sigmoid_f(gt[1]); T.g2 = sigmoid_f(gt[2]);
    f32x16 otot[2]; otot[0] = (f32x16){0.f, 0.f, 0.f, 0.f, 0.f, 0.f, 0.f, 0.f, 0.f, 0.f, 0.f, 0.f, 0.f, 0.f, 0.f, 0.f}; otot[1] = otot[0];
    stream<true>(C, T, (4 * c + 3 + 63) >> 6, qr, otot);
    {
        ATT_LAS unsigned long long* selm = (ATT_LAS unsigned long long*)(lds + L_SEL);
        const ATT_LAS float* impb = (const ATT_LAS float*)(lds + L_IMP);
        const ATT_LAS float* invb = (const ATT_LAS float*)(lds + L_INV);
        for (int i = 0; i < 8; ++i) {
            const int q = wave * 8 + i;
            unsigned long long msk;
            if (c < 16) msk = (2ull << c) - 1ull;
            else {
                const bool valid = lane <= c;
                float sc = -1e30f;
                if (valid) {
                    sc = (impb[(0 * 64 + q) * IMP_STRIDE + lane] * invb[q] + impb[(1 * 64 + q) * IMP_STRIDE + lane] * invb[64 + q]) + (impb[(2 * 64 + q) * IMP_STRIDE + lane] * invb[128 + q] + impb[(3 * 64 + q) * IMP_STRIDE + lane] * invb[192 + q]);
                    if (lane == 0 || lane == c || lane == c - 1) sc += 1e4f;
                }
                int rank = 0;
                for (int k = 0; k <= c; ++k) { const float sk = __shfl(sc, k); rank += (sk > sc || (sk == sc && k < lane)) ? 1 : 0; }
                msk = __ballot(valid && rank < 16);
            }
            if (lane == 0) selm[q] = msk;
        }
    }
    __syncthreads();
    T.mysel = ((ATT_LAS const unsigned long long*)(lds + L_SEL))[T.tl];
    int ntile;
    {
        unsigned long long v = ((ATT_LAS const unsigned long long*)(lds + L_SEL))[lane];
#pragma unroll
        for (int o2 = 1; o2 < 64; o2 <<= 1) v |= __shfl_xor(v, o2);
        const unsigned long long blkmask = ((unsigned long long)__builtin_amdgcn_readfirstlane((unsigned)(v >> 32)) << 32) | (unsigned)__builtin_amdgcn_readfirstlane((unsigned)v);
        const int nsel = __builtin_popcountll(blkmask), jlo = c >= 8 ? c - 8 : 0;
        ntile = nsel + (c - jlo + 1);
        if (wave == 0) {
            ATT_LAS unsigned short* TL = (ATT_LAS unsigned short*)(lds + L_TL);
            if ((blkmask >> lane) & 1ull) TL[__builtin_popcountll(blkmask & ((1ull << lane) - 1ull))] = (unsigned short)(256 + lane);
            if (lane <= c - jlo) TL[nsel + lane] = (unsigned short)(512 + jlo + lane);
        }
    }
    __syncthreads();
    stream<false>(C, T, ntile, qr, otot);
    {
        ATT_LAS bf16_t* stg = (ATT_LAS bf16_t*)(lds + L_OST) + wave * 2048;
        const float g0 = oga[(g * 4 + hg) * 64 + r32], g1 = oga[(g * 4 + hg) * 64 + 32 + r32];
#pragma unroll
        for (int r = 0; r < 16; ++r) {
            float sq = otot[0][r] * otot[0][r] + otot[1][r] * otot[1][r];
            sq += __shfl_xor(sq, 1); sq += __shfl_xor(sq, 2); sq += __shfl_xor(sq, 4); sq += __shfl_xor(sq, 8); sq += __shfl_xor(sq, 16);
            const float rs = rsqrtf(sq * (1.f / 64.f) + EPS);
            const int q = crow(r, hi);
            stg[q * 64 + r32] = f2bf(otot[0][r] * rs * g0);
            stg[q * 64 + 32 + r32] = f2bf(otot[1][r] * rs * g1);
        }
        asm volatile("s_waitcnt lgkmcnt(0)" ::: "memory");
        bf16_t* yb = Y + ((size_t)b * SEQ + 64 * c + 32 * th) * 1024 + (g * 4 + hg) * 64;
#pragma unroll
        for (int i = 0; i < 4; ++i) {
            const int row = i * 8 + (lane >> 3), ch = lane & 7;
            const u32x4 v = *(ATT_LAS const u32x4*)(stg + row * 64 + ch * 8);
            *(u32x4*)(yb + (size_t)row * 1024 + ch * 8) = v;
        }
    }
    __syncthreads();
}
}

__device__ void phase_attn_mfma(const Params& p, int l, unsigned char* lds_raw) {
    for (int v = my_bid(); v < 1024; v += gridDim.x) {
        const int r = v >> 8, x = (v >> 4) & 15, bg = v & 15;
        const int c = r == 0 ? 63 - x : (r == 1 ? 32 + x : (r == 2 ? 31 - x : x));
        att2::unit(p, l, bg >> 1, bg & 1, c, (ATT_LAS unsigned char*)lds_raw);
    }
}

__device__ void phase_mlstm_out(const Params& p, int l, float* lds) {
    unsigned char* ws = p.ws;
    const bf16_t* proj = (const bf16_t*)(ws + WS_PROJ); const float* gates = (const float*)(ws + WS_GATES);
    const bf16_t* qkc = (const bf16_t*)p.out;
    const bf16_t* ST = (const bf16_t*)(ws + WS_ST); const float* STN = (const float*)(ws + WS_STN); const float* STM = (const float*)(ws + WS_STM);
    const float* fb = p.in[I_FB] + l * 4; const float* ogm = p.in[I_OGM] + l * 512;
    bf16_t* Y = (bf16_t*)(ws + WS_Y);
    float* qq = lds;
    float* kk = lds + 8192;
    float* Cs = lds + 16384;
    float* Ws = lds + 32768;
    float* bcum = Ws + 64 * 65; float* ig = bcum + 64; float* mt = ig + 64; float* wint = mt + 64; float* den = wint + 64; float* npv = den + 64;
    const int tid = my_tid(), lane = tid & 63, wave = tid >> 6;
    for (int u = my_bid(); u < BATCH * 4 * 64; u += gridDim.x) {
        const int c = u & 63, h = (u >> 6) & 3, b = u >> 8;
        const int m0 = b * SEQ + c * 64, bh = b * 4 + h;
        mlstm_gates(gates, fb, m0, h, bcum, ig);
        const float mprev = STM[4096 + bh * 64 + c];
        for (int e = tid; e < 64 * 16; e += NT) {
            const int s = e >> 4, d0 = (e & 15) * 8;
            const u32x4 rq = *(const u32x4*)(qkc + (size_t)(m0 + s) * 1024 + h * 128 + d0); float f[8]; unpack8(rq, f);
            const u32x4 rk = *(const u32x4*)(qkc + (size_t)(m0 + s) * 1024 + 512 + h * 128 + d0); float fk[8]; unpack8(rk, fk);
#pragma unroll
            for (int j = 0; j < 8; ++j) { qq[s * 128 + d0 + j] = f[j]; kk[s * 128 + d0 + j] = fk[j]; }
        }
        if (tid < 128) npv[tid] = STN[(size_t)(bh * 64 + c) * 128 + tid];
        for (int e8 = tid; e8 < 128 * 16; e8 += NT) {
            const int e = e8 >> 4, d0 = (e8 & 15) * 8;
            const u32x4 rc = *(const u32x4*)(ST + ((size_t)(bh * 64 + c) * 128 + e) * 128 + d0); float f[8]; unpack8(rc, f);
#pragma unroll
            for (int j = 0; j < 8; ++j) Cs[(d0 + j) * 128 + e] = f[j];
        }
        __syncthreads();
        {
            const int t = tid >> 3, s0 = (tid & 7) * 8;
            float a[8] = {0.f, 0.f, 0.f, 0.f, 0.f, 0.f, 0.f, 0.f};
#pragma unroll 2
            for (int d = 0; d < 128; ++d) {
                const float qv = qq[t * 128 + d];
#pragma unroll
                for (int j = 0; j < 8; ++j) a[j] += qv * kk[(s0 + j) * 128 + d];
            }
#pragma unroll
            for (int j = 0; j < 8; ++j) Ws[t * 65 + s0 + j] = a[j];
        }
        __syncthreads();
        for (int r = 0; r < 8; ++r) {
            const int t = wave * 8 + r;
            const float dv = lane <= t ? bcum[t] - bcum[lane] + ig[lane] : -INFINITY;
            const float a = bcum[t] + mprev;
            const float m_t = fmaxf(a, wave_max(dv));
            const float w = lane <= t ? __expf(dv - m_t) * Ws[t * 65 + lane] : 0.f;
            Ws[t * 65 + lane] = w;
            const float wi = __expf(a - m_t);
            const float qn = wave_sum(qq[t * 128 + lane] * npv[lane] + qq[t * 128 + 64 + lane] * npv[64 + lane]);
            const float dsum = wave_sum(w);
            if (lane == 0) { mt[t] = m_t; wint[t] = wi; den[t] = wi * qn + dsum; }
        }
        __syncthreads();
        for (int e = tid; e < 64 * 16; e += NT) {
            const int s = e >> 4, d0 = (e & 15) * 8;
            const u32x4 rv = *(const u32x4*)(proj + (size_t)(m0 + s) * NPROJ + C_VB + h * 128 + d0); float f[8]; unpack8(rv, f);
#pragma unroll
            for (int j = 0; j < 8; ++j) kk[s * 128 + d0 + j] = f[j];
        }
        __syncthreads();
        float hv[16];
        {
            const int e = tid & 127, t0 = (tid >> 7) * 16;
            float a1[16], a2[16];
#pragma unroll
            for (int i = 0; i < 16; ++i) { a1[i] = 0.f; a2[i] = 0.f; }
#pragma unroll 2
            for (int d = 0; d < 128; ++d) {
                const float cv = Cs[d * 128 + e];
#pragma unroll
                for (int i = 0; i < 16; ++i) a1[i] += qq[(t0 + i) * 128 + d] * cv;
            }
#pragma unroll 2
            for (int s = 0; s < 64; ++s) {
                const float vv = kk[s * 128 + e];
#pragma unroll
                for (int i = 0; i < 16; ++i) a2[i] += Ws[(t0 + i) * 65 + s] * vv;
            }
#pragma unroll
            for (int i = 0; i < 16; ++i) {
                const int t = t0 + i;
                const float num = wint[t] * a1[i] + a2[i];
                hv[i] = num / fmaxf(fabsf(den[t]), __expf(-mt[t]));
            }
        }
        __syncthreads();
        {
            const int e = tid & 127, t0 = (tid >> 7) * 16;
#pragma unroll
            for (int i = 0; i < 16; ++i) Cs[(t0 + i) * 128 + e] = hv[i];
        }
        __syncthreads();
        for (int r = 0; r < 8; ++r) {
            const int t = wave * 8 + r;
            const float h0 = Cs[t * 128 + lane], h1 = Cs[t * 128 + 64 + lane];
            const float s = wave_sum(h0 * h0 + h1 * h1);
            const float rr = rsqrtf(s * (1.f / 128.f) + EPS);
            const bf16_t* op = proj + (size_t)(m0 + t) * NPROJ + C_OB + h * 128;
            const float y0 = h0 * rr * ogm[h * 128 + lane] * sigmoid_f(bf2f(op[lane]));
            const float y1 = h1 * rr * ogm[h * 128 + 64 + lane] * sigmoid_f(bf2f(op[64 + lane]));
            Y[(size_t)(m0 + t) * 1024 + 512 + h * 128 + lane] = f2bf(y0);
            Y[(size_t)(m0 + t) * 1024 + 512 + h * 128 + 64 + lane] = f2bf(y1);
        }
        __syncthreads();
    }
}

namespace mls {
typedef short bf16x8 __attribute__((ext_vector_type(8)));
typedef short s16x4 __attribute__((ext_vector_type(4)));
typedef float f32x16 __attribute__((ext_vector_type(16)));
#define MLS_LAS __attribute__((address_space(3)))
__device__ __forceinline__ s16x4 vtr(MLS_LAS const unsigned char* p) { return __builtin_bit_cast(s16x4, __builtin_amdgcn_ds_read_tr16_b64_v4i16((MLS_LAS s16x4*)p)); }
__device__ __forceinline__ bf16x8 trfrag(MLS_LAS const unsigned char* p) { const s16x4 lo = vtr(p), hh = vtr(p + 512); return (bf16x8){lo[0], lo[1], lo[2], lo[3], hh[0], hh[1], hh[2], hh[3]}; }
__device__ __forceinline__ float incl_scan64(float v, int lane) {
#pragma unroll
    for (int o = 1; o < 64; o <<= 1) { const float t = __shfl_up(v, o); if (lane >= o) v += t; }
    return v;
}
constexpr float KSCALE = 0.08838834764831845f;
constexpr int LC_W = 131072;

__device__ void chunk_unit(const Params& p, int l, int b, int c, MLS_LAS unsigned char* lds) {
    unsigned char* ws = p.ws;
    const bf16_t* proj = (const bf16_t*)(ws + WS_PROJ); const float* gates = (const float*)(ws + WS_GATES);
    const float* cw = p.in[I_CW] + l * 4096; const float* cb = p.in[I_CB] + l * 1024; const float* fb = p.in[I_FB] + l * 4;
    bf16_t* ST = (bf16_t*)(ws + WS_ST); float* STN = (float*)(ws + WS_STN); float* STM = (float*)(ws + WS_STM);
    const int tid = my_tid(), lane = tid & 63, wave = __builtin_amdgcn_readfirstlane(tid >> 6), r32 = lane & 31, hi = lane >> 5, h = wave >> 1, half = wave & 1;
    const size_t m0 = (size_t)b * SEQ + 64 * c; const int bh = b * 4 + h;
    const float lf = log_sigmoid_f(gates[(m0 + lane) * 32 + 28 + h] + fb[h]);
    const float igv = gates[(m0 + lane) * 32 + 24 + h];
    const float bc = incl_scan64(lf, lane);
    const float blast = __uint_as_float(__builtin_amdgcn_readlane(__float_as_uint(bc), 63));
    const float gv = blast - bc + igv;
    const float mloc = wave_max(gv);
    const float wsc = __expf(gv - mloc);
    if (half == 0 && lane == 0) { STM[bh * 64 + c] = mloc; STM[2048 + bh * 64 + c] = blast; }
    MLS_LAS unsigned char* vimg = lds + h * 32768; MLS_LAS unsigned char* kimg = vimg + 16384;
    bf16_t* qkc = (bf16_t*)p.out;
    const MLS_LAS float* cwl = (const MLS_LAS float*)(lds + LC_W);
    {
        const int pc = lane & 15;
#pragma unroll
        for (int isk = 1; isk >= 0; --isk) {
            const int ch = isk * 512 + h * 128 + pc * 8;
            float cwv[4][8], cbv[8];
#pragma unroll
            for (int w = 0; w < 4; ++w) { const f32x4 a0 = *(const MLS_LAS f32x4*)(cwl + w * 1024 + ch), a1 = *(const MLS_LAS f32x4*)(cwl + w * 1024 + ch + 4);
                cwv[w][0] = a0.x; cwv[w][1] = a0.y; cwv[w][2] = a0.z; cwv[w][3] = a0.w; cwv[w][4] = a1.x; cwv[w][5] = a1.y; cwv[w][6] = a1.z; cwv[w][7] = a1.w; }
            { const f32x4 a0 = *(const MLS_LAS f32x4*)(cwl + 4096 + ch), a1 = *(const MLS_LAS f32x4*)(cwl + 4096 + ch + 4);
                cbv[0] = a0.x; cbv[1] = a0.y; cbv[2] = a0.z; cbv[3] = a0.w; cbv[4] = a1.x; cbv[5] = a1.y; cbv[6] = a1.z; cbv[7] = a1.w; }
#pragma unroll 1
            for (int bq = 0; bq < 2; ++bq) {
                u32x4 taps[4][4], vv[4];
#pragma unroll
                for (int i = 0; i < 4; ++i) {
                    const int s = 32 * half + 4 * (4 * bq + i) + (lane >> 4);
#pragma unroll
                    for (int w = 0; w < 4; ++w) {
                        const bool ok = 64 * c + s - 3 + w >= 0;
                        taps[i][w] = *(const u32x4*)(proj + (m0 + (ok ? s - 3 + w : 0)) * NPROJ + C_QB + ch);
                    }
                    if (isk) vv[i] = *(const u32x4*)(proj + (m0 + s) * NPROJ + C_VB + h * 128 + pc * 8);
                }
#pragma unroll
                for (int i = 0; i < 4; ++i) {
                    const int s = 32 * half + 4 * (4 * bq + i) + (lane >> 4);
                    if (isk) *(MLS_LAS u32x4*)(vimg + (pc >> 2) * 4096 + s * 64 + (pc & 3) * 16) = vv[i];
                    float acc[8];
#pragma unroll
                    for (int j = 0; j < 8; ++j) acc[j] = cbv[j];
#pragma unroll
                    for (int w = 0; w < 4; ++w) {
                        const float z = (64 * c + s - 3 + w >= 0) ? 1.f : 0.f;
                        float f[8]; unpack8(taps[i][w], f);
#pragma unroll
                        for (int j = 0; j < 8; ++j) acc[j] += f[j] * (cwv[w][j] * z);
                    }
                    float y[8];
#pragma unroll
                    for (int j = 0; j < 8; ++j) y[j] = silu_f(acc[j]) * (isk ? KSCALE : 1.f);
                    u32x4 o; o.x = pk2(y[0], y[1]); o.y = pk2(y[2], y[3]); o.z = pk2(y[4], y[5]); o.w = pk2(y[6], y[7]);
                    *(u32x4*)(qkc + (m0 + s) * 1024 + ch) = o;
                    if (isk) {
                        const float sc = __shfl(wsc, s);
                        u32x4 o2; o2.x = pk2(y[0] * sc, y[1] * sc); o2.y = pk2(y[2] * sc, y[3] * sc); o2.z = pk2(y[4] * sc, y[5] * sc); o2.w = pk2(y[6] * sc, y[7] * sc);
                        *(MLS_LAS u32x4*)(kimg + (pc >> 2) * 4096 + s * 64 + (pc & 3) * 16) = o2;
                    }
                }
            }
        }
    }
    {
#pragma unroll 1
        for (int pass = 0; pass < 2; ++pass) {
            if (pass == 1 && tid >= 256) break;
            bf16_t* ptr; const MLS_LAS float* gn;
            if (pass == 0) { ptr = (bf16_t*)proj + (m0 + (tid >> 3)) * NPROJ + C_QA + (tid & 7) * 64; gn = cwl + 5120; }
            else { const int kind = (tid >> 1) & 1; ptr = (bf16_t*)proj + (m0 + (tid >> 2)) * NPROJ + (kind ? C_KW : C_KS) + (tid & 1) * 64; gn = cwl + 5120 + 64 + (1 + kind) * 64; }
            u32x4 raw[8]; float sq = 0.f;
#pragma unroll
            for (int i = 0; i < 8; ++i) { raw[i] = *(const u32x4*)(ptr + 8 * i); float f[8]; unpack8(raw[i], f);
#pragma unroll
                for (int j = 0; j < 8; ++j) sq += f[j] * f[j]; }
            const float r = rsqrtf(sq * (1.f / 64.f) + EPS);
#pragma unroll
            for (int i = 0; i < 8; ++i) { float f[8]; unpack8(raw[i], f);
                const f32x4 g0 = *(const MLS_LAS f32x4*)(gn + 8 * i), g1 = *(const MLS_LAS f32x4*)(gn + 8 * i + 4);
                u32x4 o; o.x = pk2(f[0] * r * g0.x, f[1] * r * g0.y); o.y = pk2(f[2] * r * g0.z, f[3] * r * g0.w); o.z = pk2(f[4] * r * g1.x, f[5] * r * g1.y); o.w = pk2(f[6] * r * g1.z, f[7] * r * g1.w);
                *(u32x4*)(ptr + 8 * i) = o; }
        }
    }
    __syncthreads();
    f32x16 acc[2][4];
#pragma unroll
    for (int e2 = 0; e2 < 2; ++e2)
#pragma unroll
        for (int db = 0; db < 4; ++db) acc[e2][db] = (f32x16){0.f, 0.f, 0.f, 0.f, 0.f, 0.f, 0.f, 0.f, 0.f, 0.f, 0.f, 0.f, 0.f, 0.f, 0.f, 0.f};
    {
        const int tro = ((lane >> 4) & 1) * 32 + (lane & 3) * 8 + (4 * hi + ((lane & 15) >> 2)) * 64;
#pragma unroll
        for (int ks = 0; ks < 4; ++ks) {
            const bf16x8 a0 = trfrag(vimg + tro + (2 * half) * 4096 + ks * 1024), a1 = trfrag(vimg + tro + (2 * half + 1) * 4096 + ks * 1024);
#pragma unroll
            for (int db = 0; db < 4; ++db) {
                const bf16x8 bfr = trfrag(kimg + tro + db * 4096 + ks * 1024);
                acc[0][db] = __builtin_amdgcn_mfma_f32_32x32x16_bf16(a0, bfr, acc[0][db], 0, 0, 0);
                acc[1][db] = __builtin_amdgcn_mfma_f32_32x32x16_bf16(a1, bfr, acc[1][db], 0, 0, 0);
            }
        }
    }
    {
        const int hh = tid >> 7, d = tid & 127;
        MLS_LAS const bf16_t* kp = (MLS_LAS const bf16_t*)(lds + hh * 32768 + 16384 + (d >> 5) * 4096) + (d & 31);
        float sm = 0.f;
#pragma unroll 8
        for (int s2 = 0; s2 < 64; ++s2) sm += bf2f(kp[s2 * 32]);
        STN[(size_t)((b * 4 + hh) * 64 + c) * 128 + d] = sm;
    }
    __syncthreads();
    {
        MLS_LAS bf16_t* stg = (MLS_LAS bf16_t*)(lds + h * 32768 + half * 16384);
#pragma unroll
        for (int e2 = 0; e2 < 2; ++e2)
#pragma unroll
            for (int db = 0; db < 4; ++db)
#pragma unroll
                for (int r = 0; r < 16; ++r) stg[(32 * e2 + att::crow(r, hi)) * 128 + 32 * db + r32] = f2bf(acc[e2][db][r]);
        asm volatile("s_waitcnt lgkmcnt(0)" ::: "memory");
        bf16_t* dst = ST + ((size_t)(bh * 64 + c) * 128 + 64 * half) * 128;
#pragma unroll 4
        for (int it = 0; it < 16; ++it) {
            const int idx = it * 64 + lane;
            *(u32x4*)(dst + (size_t)idx * 8) = *(MLS_LAS const u32x4*)(stg + idx * 8);
        }
    }
    __syncthreads();
}

constexpr int LO_V = 0, LO_STG = 65536, LO_G = 131072;
__device__ void out_unit(const Params& p, int l, int b, int c, MLS_LAS unsigned char* lds) {
    unsigned char* ws = p.ws;
    const bf16_t* proj = (const bf16_t*)(ws + WS_PROJ); const float* gates = (const float*)(ws + WS_GATES);
    const bf16_t* qkc = (const bf16_t*)p.out;
    const bf16_t* ST = (const bf16_t*)(ws + WS_ST); const float* STN = (const float*)(ws + WS_STN); const float* STM = (const float*)(ws + WS_STM);
    const float* fb = p.in[I_FB] + l * 4; const float* ogm = p.in[I_OGM] + l * 512;
    bf16_t* Y = (bf16_t*)(ws + WS_Y);
    const int tid = my_tid(), lane = tid & 63, wave = __builtin_amdgcn_readfirstlane(tid >> 6), r32 = lane & 31, hi = lane >> 5, h = wave >> 1, th = wave & 1;
    const size_t m0 = (size_t)b * SEQ + 64 * c; const int bh = b * 4 + h;
    MLS_LAS unsigned char* vimg = lds + LO_V + h * 16384;
    MLS_LAS float* garr = (MLS_LAS float*)(lds + LO_G + wave * 512);
#pragma unroll 4
    for (int it = 0; it < 8; ++it) {
        const int s = 32 * th + 4 * it + (lane >> 4), pc = lane & 15;
        const u32x4 rv = *(const u32x4*)(proj + (m0 + s) * NPROJ + C_VB + h * 128 + pc * 8);
        *(MLS_LAS u32x4*)(vimg + (pc >> 2) * 4096 + s * 64 + (pc & 3) * 16) = rv;
    }
    {
        const float lf = log_sigmoid_f(gates[(m0 + lane) * 32 + 28 + h] + fb[h]);
        garr[lane] = incl_scan64(lf, lane);
        garr[64 + lane] = gates[(m0 + lane) * 32 + 24 + h];
    }
    const float mprev = STM[4096 + bh * 64 + c];
    const int tl = 32 * th + r32;
    bf16x8 qf[8];
#pragma unroll
    for (int ks = 0; ks < 8; ++ks) qf[ks] = __builtin_bit_cast(bf16x8, *(const u32x4*)(qkc + (m0 + tl) * 1024 + h * 128 + 16 * ks + 8 * hi));
    f32x16 p0 = (f32x16){0.f, 0.f, 0.f, 0.f, 0.f, 0.f, 0.f, 0.f, 0.f, 0.f, 0.f, 0.f, 0.f, 0.f, 0.f, 0.f}, p1 = p0;
#pragma unroll
    for (int ks = 0; ks < 8; ++ks) {
        const bf16x8 k0 = __builtin_bit_cast(bf16x8, *(const u32x4*)(qkc + (m0 + r32) * 1024 + 512 + h * 128 + 16 * ks + 8 * hi));
        const bf16x8 k1 = __builtin_bit_cast(bf16x8, *(const u32x4*)(qkc + (m0 + 32 + r32) * 1024 + 512 + h * 128 + 16 * ks + 8 * hi));
        p0 = __builtin_amdgcn_mfma_f32_32x32x16_bf16(k0, qf[ks], p0, 0, 0, 0);
        p1 = __builtin_amdgcn_mfma_f32_32x32x16_bf16(k1, qf[ks], p1, 0, 0, 0);
    }
    float qn = 0.f;
    {
        const float* np = STN + (size_t)(bh * 64 + c) * 128;
#pragma unroll
        for (int ks = 0; ks < 8; ++ks) {
            const f32x4 n0 = *(const f32x4*)(np + 16 * ks + 8 * hi), n1 = *(const f32x4*)(np + 16 * ks + 8 * hi + 4);
            float f[8]; unpack8(__builtin_bit_cast(u32x4, qf[ks]), f);
            qn += (f[0] * n0.x + f[1] * n0.y) + (f[2] * n0.z + f[3] * n0.w) + (f[4] * n1.x + f[5] * n1.y) + (f[6] * n1.z + f[7] * n1.w);
        }
        qn += __shfl_xor(qn, 32);
    }
    asm volatile("s_waitcnt lgkmcnt(0)" ::: "memory");
    const float bt = garr[tl];
    float dv0[16], dv1[16]; float mx = -INFINITY;
#pragma unroll
    for (int r = 0; r < 16; ++r) {
        const int s0 = att::crow(r, hi);
        dv0[r] = s0 <= tl ? bt - garr[s0] + garr[64 + s0] : -INFINITY;
        dv1[r] = s0 + 32 <= tl ? bt - garr[s0 + 32] + garr[64 + s0 + 32] : -INFINITY;
        mx = fmaxf(mx, fmaxf(dv0[r], dv1[r]));
    }
    mx = fmaxf(mx, __shfl_xor(mx, 32));
    const float a_t = bt + mprev;
    const float m_t = fmaxf(a_t, mx);
    float dsum = 0.f;
#pragma unroll
    for (int r = 0; r < 16; ++r) {
        p0[r] = __expf(dv0[r] - m_t) * p0[r];
        p1[r] = __expf(dv1[r] - m_t) * p1[r];
        dsum += p0[r] + p1[r];
    }
    dsum += __shfl_xor(dsum, 32);
    const float winter = __expf(a_t - m_t);
    const float den = winter * qn + dsum;
    const float scl = 1.f / fmaxf(fabsf(den), __expf(-m_t));
    const float fq = winter * scl;
    bf16x8 pa[4];
#pragma unroll
    for (int s2 = 0; s2 < 2; ++s2) {
        u32x4 w0, w1;
        w0.x = att::cvtpk(p0[8 * s2 + 0] * scl, p0[8 * s2 + 1] * scl); w0.y = att::cvtpk(p0[8 * s2 + 2] * scl, p0[8 * s2 + 3] * scl); w0.z = att::cvtpk(p0[8 * s2 + 4] * scl, p0[8 * s2 + 5] * scl); w0.w = att::cvtpk(p0[8 * s2 + 6] * scl, p0[8 * s2 + 7] * scl);
        w1.x = att::cvtpk(p1[8 * s2 + 0] * scl, p1[8 * s2 + 1] * scl); w1.y = att::cvtpk(p1[8 * s2 + 2] * scl, p1[8 * s2 + 3] * scl); w1.z = att::cvtpk(p1[8 * s2 + 4] * scl, p1[8 * s2 + 5] * scl); w1.w = att::cvtpk(p1[8 * s2 + 6] * scl, p1[8 * s2 + 7] * scl);
        pa[s2] = __builtin_bit_cast(bf16x8, w0); pa[2 + s2] = __builtin_bit_cast(bf16x8, w1);
    }
#pragma unroll
    for (int ks = 0; ks < 8; ++ks) {
        float f[8]; unpack8(__builtin_bit_cast(u32x4, qf[ks]), f);
        u32x4 w; w.x = att::cvtpk(f[0] * fq, f[1] * fq); w.y = att::cvtpk(f[2] * fq, f[3] * fq); w.z = att::cvtpk(f[4] * fq, f[5] * fq); w.w = att::cvtpk(f[6] * fq, f[7] * fq);
        qf[ks] = __builtin_bit_cast(bf16x8, w);
    }
    f32x16 acc[4];
#pragma unroll
    for (int eb = 0; eb < 4; ++eb) acc[eb] = (f32x16){0.f, 0.f, 0.f, 0.f, 0.f, 0.f, 0.f, 0.f, 0.f, 0.f, 0.f, 0.f, 0.f, 0.f, 0.f, 0.f};
    {
        const bf16_t* cp = ST + (size_t)(bh * 64 + c) * 16384 + (size_t)r32 * 128 + 8 * hi;
#pragma unroll
        for (int eb = 0; eb < 4; ++eb)
#pragma unroll
            for (int ks = 0; ks < 8; ++ks) {
                const bf16x8 cf = __builtin_bit_cast(bf16x8, *(const u32x4*)(cp + eb * 32 * 128 + 16 * ks));
                acc[eb] = __builtin_amdgcn_mfma_f32_32x32x16_bf16(qf[ks], cf, acc[eb], 0, 0, 0);
            }
    }
    __syncthreads();
    {
        const int tro = ((lane >> 4) & 1) * 32 + (lane & 3) * 8 + (4 * hi + ((lane & 15) >> 2)) * 64;
#pragma unroll
        for (int eb = 0; eb < 4; ++eb)
#pragma unroll
            for (int ks = 0; ks < 4; ++ks) acc[eb] = __builtin_amdgcn_mfma_f32_32x32x16_bf16(pa[ks], trfrag(vimg + tro + eb * 4096 + ks * 1024), acc[eb], 0, 0, 0);
    }
    {
        MLS_LAS bf16_t* stg = (MLS_LAS bf16_t*)(lds + LO_STG + wave * 8192);
        float gn[4];
#pragma unroll
        for (int eb = 0; eb < 4; ++eb) gn[eb] = ogm[h * 128 + 32 * eb + r32];
#pragma unroll
        for (int r = 0; r < 16; ++r) {
            float sq = (acc[0][r] * acc[0][r] + acc[1][r] * acc[1][r]) + (acc[2][r] * acc[2][r] + acc[3][r] * acc[3][r]);
            sq += __shfl_xor(sq, 1); sq += __shfl_xor(sq, 2); sq += __shfl_xor(sq, 4); sq += __shfl_xor(sq, 8); sq += __shfl_xor(sq, 16);
            const float rs = rsqrtf(sq * (1.f / 128.f) + EPS);
            const int q = att::crow(r, hi);
#pragma unroll
            for (int eb = 0; eb < 4; ++eb) stg[q * 128 + 32 * eb + r32] = f2bf(acc[eb][r] * rs * gn[eb]);
        }
        asm volatile("s_waitcnt lgkmcnt(0)" ::: "memory");
#pragma unroll 2
        for (int it = 0; it < 8; ++it) {
            const int idx = it * 64 + lane, row = idx >> 4, pc = idx & 15;
            const u32x4 hv = *(MLS_LAS const u32x4*)(stg + row * 128 + pc * 8);
            const u32x4 ov = *(const u32x4*)(proj + (m0 + 32 * th + row) * NPROJ + C_OB + h * 128 + pc * 8);
            float fh[8], fo[8]; unpack8(hv, fh); unpack8(ov, fo);
            float y[8];
#pragma unroll
            for (int j = 0; j < 8; ++j) y[j] = fh[j] * sigmoid_f(fo[j]);
            u32x4 o; o.x = pk2(y[0], y[1]); o.y = pk2(y[2], y[3]); o.z = pk2(y[4], y[5]); o.w = pk2(y[6], y[7]);
            *(u32x4*)(Y + (m0 + 32 * th + row) * 1024 + 512 + h * 128 + pc * 8) = o;
        }
    }
    __syncthreads();
}
}

__device__ void phase_chunkstate_mfma(const Params& p, int l, unsigned char* lds_raw) {
    {
        float* wl = (float*)(lds_raw + mls::LC_W);
        const float* cw = p.in[I_CW] + l * 4096; const float* cb = p.in[I_CB] + l * 1024; const float* qg = p.in[I_QG] + l * 64; const float* kg = p.in[I_KG] + l * 192;
        for (int i = my_tid(); i < 5376; i += NT) wl[i] = i < 4096 ? cw[i] : (i < 5120 ? cb[i - 4096] : (i < 5184 ? qg[i - 5120] : kg[i - 5184]));
        __syncthreads();
    }
    for (int u = my_bid(); u < BATCH * 64; u += gridDim.x) mls::chunk_unit(p, l, u >> 6, u & 63, (MLS_LAS unsigned char*)lds_raw);
}
__device__ void phase_mlstm_out_mfma(const Params& p, int l, unsigned char* lds_raw) {
    for (int u = my_bid(); u < BATCH * 64; u += gridDim.x) mls::out_unit(p, l, u >> 6, u & 63, (MLS_LAS unsigned char*)lds_raw);
}

namespace cmpx {
typedef short bf16x8 __attribute__((ext_vector_type(8)));
typedef float f32x16 __attribute__((ext_vector_type(16)));
#define CMP_LAS __attribute__((address_space(3)))
constexpr int LC_PART = 0  , LC_HID = 32768  ;
__device__ void unit(const Params& p, int l, int b, int g, int kv, int ib, CMP_LAS unsigned char* lds) {
    unsigned char* ws = p.ws;
    const bf16_t* proj = (const bf16_t*)(ws + WS_PROJ);
    const bf16_t* w1t = (const bf16_t*)(ws + WS_CW1) + (size_t)(l * 2 + kv) * 128 * 2048;
    const bf16_t* w2t = (const bf16_t*)(ws + WS_W2T) + (size_t)(l * 2 + kv) * 64 * 128;
    const float* peb = (const float*)(ws + WS_PEB) + (l * 2 + kv) * 128;
    const float* kg0 = p.in[I_KG] + l * 192;
    const int tid = my_tid(), lane = tid & 63, wave = __builtin_amdgcn_readfirstlane(tid >> 6), r32 = lane & 31, hi = lane >> 5, hb = wave & 3, kh = wave >> 2;
    const int col = (kv ? C_VC : C_KC) + g * 64;
    const int i = 32 * ib + r32;
    const f32x16 zero16 = (f32x16){0.f, 0.f, 0.f, 0.f, 0.f, 0.f, 0.f, 0.f, 0.f, 0.f, 0.f, 0.f, 0.f, 0.f, 0.f, 0.f};
    {
        f32x16 acc = zero16;
        const bf16_t* bp = w1t + (size_t)(32 * hb + r32) * 2048 + 1024 * kh + 8 * hi;
        const int tok0 = 16 * i + 16 * kh;
#pragma unroll 16
        for (int ks = 0; ks < 64; ++ks) {
            int tok = tok0 + (ks >> 2); tok = tok < SEQ ? tok : SEQ - 1;
            const bf16x8 af = __builtin_bit_cast(bf16x8, *(const u32x4*)(proj + ((size_t)b * SEQ + tok) * NPROJ + col + 16 * (ks & 3) + 8 * hi));
            const bf16x8 bf = __builtin_bit_cast(bf16x8, *(const u32x4*)(bp + 16 * ks));
            acc = __builtin_amdgcn_mfma_f32_32x32x16_bf16(af, bf, acc, 0, 0, 0);
        }
        CMP_LAS float* part = (CMP_LAS float*)(lds + LC_PART) + kh * 32 * 128;
#pragma unroll
        for (int r = 0; r < 16; ++r) part[att::crow(r, hi) * 128 + 32 * hb + r32] = acc[r];
    }
    __syncthreads();
    {
        const CMP_LAS float* part = (const CMP_LAS float*)(lds + LC_PART);
        CMP_LAS bf16_t* hbuf = (CMP_LAS bf16_t*)(lds + LC_HID);
#pragma unroll
        for (int e = 0; e < 8; ++e) {
            const int idx = e * NT + tid, row = idx >> 7, hid = idx & 127;
            hbuf[row * 136 + hid] = f2bf(silu_f(part[idx] + part[4096 + idx] + peb[hid]));
        }
    }
    __syncthreads();
    if (wave == 0) {
        const CMP_LAS bf16_t* hbuf = (const CMP_LAS bf16_t*)(lds + LC_HID);
        f32x16 o0 = zero16, o1 = zero16;
#pragma unroll
        for (int ks = 0; ks < 8; ++ks) {
            const bf16x8 af = *(const CMP_LAS bf16x8*)(hbuf + r32 * 136 + 16 * ks + 8 * hi);
            const bf16x8 b0 = __builtin_bit_cast(bf16x8, *(const u32x4*)(w2t + (size_t)r32 * 128 + 16 * ks + 8 * hi));
            const bf16x8 b1 = __builtin_bit_cast(bf16x8, *(const u32x4*)(w2t + (size_t)(32 + r32) * 128 + 16 * ks + 8 * hi));
            o0 = __builtin_amdgcn_mfma_f32_32x32x16_bf16(af, b0, o0, 0, 0, 0);
            o1 = __builtin_amdgcn_mfma_f32_32x32x16_bf16(af, b1, o1, 0, 0, 0);
        }
        bf16_t* dst = (bf16_t*)(ws + (kv ? WS_VCMP : WS_KCMP)) + (size_t)(b * 2 + g) * NCMPP * 64;
        const float g0 = kv ? 1.f : kg0[r32], g1 = kv ? 1.f : kg0[32 + r32];
#pragma unroll
        for (int r = 0; r < 16; ++r) {
            float rs = 1.f;
            if (kv == 0) {
                float sq = o0[r] * o0[r] + o1[r] * o1[r];
                sq += __shfl_xor(sq, 1); sq += __shfl_xor(sq, 2); sq += __shfl_xor(sq, 4); sq += __shfl_xor(sq, 8); sq += __shfl_xor(sq, 16);
                rs = rsqrtf(sq * (1.f / 64.f) + EPS);
            }
            const int row = 32 * ib + att::crow(r, hi);
            const bool ok = row < NCMP;
            dst[(size_t)row * 64 + r32] = ok ? f2bf(o0[r] * rs * g0) : (bf16_t)0;
            dst[(size_t)row * 64 + 32 + r32] = ok ? f2bf(o1[r] * rs * g1) : (bf16_t)0;
        }
    }
    __syncthreads();
}
}
__device__ void phase_compress_mfma(const Params& p, int l, unsigned char* lds_raw) {
    for (int u = my_bid(); u < BATCH * 2 * 2 * 8; u += gridDim.x) cmpx::unit(p, l, u >> 5, (u >> 4) & 1, (u >> 3) & 1, u & 7, (CMP_LAS unsigned char*)lds_raw);
}

#define XB_TMO      128
#define XB_XCNT(j)  (256  + 64 * (j))
#define XB_XSUB(j)  (1280 + 64 * (j))
#define XB_XGEN(j)  (2304 + 64 * (j))
#define XB_TOP      3328
#define XB_TOPGEN   3392
#define XCD_BAR_WORDS 3456
#define XB_SPIN_CAP (1u << 18)
#define XLAS __attribute__((address_space(3)))
__device__ __forceinline__ unsigned xb_ld(unsigned* p)              { return __hip_atomic_load(p, __ATOMIC_RELAXED, __HIP_MEMORY_SCOPE_AGENT); }
__device__ __forceinline__ unsigned xb_add(unsigned* p, unsigned v) { return __hip_atomic_fetch_add(p, v, __ATOMIC_RELAXED, __HIP_MEMORY_SCOPE_AGENT); }
__device__ __forceinline__ unsigned xb_xcc_id() { return (unsigned)__builtin_amdgcn_s_getreg((3 << 11) | 20) & 0xFu; }
#define XB_SPIN(cond, bar) do { unsigned _sp = 0; while (cond) { __builtin_amdgcn_s_sleep(1); \
    if ((++_sp & 255u) == 0u) { if (xb_ld(&(bar)[XB_TMO])) break; if (_sp > XB_SPIN_CAP) { atomicAdd(&(bar)[XB_TMO], 1u); break; } } } } while (0)
struct XcdBarrier { unsigned* bar; unsigned x; volatile XLAS unsigned* st; };
__device__ __forceinline__ XcdBarrier xcd_barrier_post(unsigned* bar, volatile XLAS unsigned* st) {
    XcdBarrier b; b.bar = bar; b.x = xb_xcc_id(); b.st = st;
    if (my_tid() == 0) (void)xb_add(&bar[XB_XCNT(b.x)], 1u);
    return b;
}
__device__ __forceinline__ void xcd_barrier_complete(unsigned* bar, unsigned x, unsigned& nloc, unsigned& nx) {
    const unsigned G = gridDim.x * gridDim.y * gridDim.z;
    unsigned sum, cnt, mine, sp = 0u;
    for (;;) {
        sum = 0u; cnt = 0u; mine = 0u;
#pragma unroll
        for (unsigned j = 0; j < 16; ++j) { const unsigned c = xb_ld(&bar[XB_XCNT(j)]); sum += c; cnt += (c > 0u) ? 1u : 0u; mine = (j == x) ? c : mine; }
        if (sum == G) break;
        __builtin_amdgcn_s_sleep(1);
        if ((++sp & 255u) == 0u) { if (xb_ld(&bar[XB_TMO])) break; if (sp > XB_SPIN_CAP) { atomicAdd(&bar[XB_TMO], 1u); break; } }
    }
    nloc = mine > 0u ? mine : 1u; nx = cnt > 0u ? cnt : 1u;
}
__device__ __forceinline__ void xcd_barrier(const XcdBarrier& b) {
    asm volatile("s_waitcnt vmcnt(0)" ::: "memory");
    __syncthreads();
    if (my_tid() == 0) {
        unsigned* bar = b.bar;
        __builtin_amdgcn_s_waitcnt(0);
        unsigned nloc = b.st[0], nx = b.st[1];
        if (nloc == 0u) { xcd_barrier_complete(bar, b.x, nloc, nx); b.st[0] = nloc; b.st[1] = nx; }
        const unsigned old = xb_add(&bar[XB_XSUB(b.x)], 1u);
        const unsigned gen = old / nloc;
        if (old + 1u == (gen + 1u) * nloc) {
            __builtin_amdgcn_fence(__ATOMIC_RELEASE, "agent");
            asm volatile("s_waitcnt vmcnt(0)" ::: "memory");
            const unsigned og = xb_add(&bar[XB_TOP], 1u);
            const unsigned tg = og / nx;
            if (og + 1u == (tg + 1u) * nx) xb_add(&bar[XB_TOPGEN], 1u);
            else XB_SPIN(xb_ld(&bar[XB_TOPGEN]) == tg, bar);
            __builtin_amdgcn_fence(__ATOMIC_ACQUIRE, "agent");
            xb_add(&bar[XB_XGEN(b.x)], 1u);
            asm volatile("s_waitcnt vmcnt(0)" ::: "memory");
        } else {
            XB_SPIN(xb_ld(&bar[XB_XGEN(b.x)]) == gen, bar);
            __builtin_amdgcn_fence(__ATOMIC_ACQUIRE, "agent");
            asm volatile("s_waitcnt vmcnt(0)" ::: "memory");
        }
    }
    __syncthreads();
}

#ifndef DUP
#define DUP 0
#endif
#define REP(bit) for (int rep_ = 0; rep_ < ((DUP & (bit)) ? 2 : 1); ++rep_)
constexpr int NPHASE = 1 + 7 * DEPTH;
template <bool COOP, int PMASK>
__global__ void __launch_bounds__(NT) mega(Params p) {
    extern __shared__ __attribute__((aligned(16))) unsigned char lds_raw[];
    float* lds = (float*)lds_raw;
    unsigned char* ws = p.ws;
    volatile XLAS unsigned* bst = (volatile XLAS unsigned*)((XLAS unsigned char*)lds_raw + LDS_BYTES - 16);
    if (threadIdx.x < 4) bst[threadIdx.x] = 0u;
    if ((threadIdx.x & 63) == 0) *(volatile XLAS int*)((XLAS unsigned char*)lds_raw + LDS_WTAB + 4 * hw_slot()) = (int)(threadIdx.x >> 6);
    __syncthreads();
    XcdBarrier gbar = xcd_barrier_post((unsigned*)(ws + WS_CTL), bst);
#ifndef PROBE_MASK
#define PROBE_MASK 0
#endif
    unsigned long long pr_t0 = 0, pr_acc = 0;
    for (int ph = p.lo; ph < p.hi; ++ph) {
        if (PROBE_MASK && ((PROBE_MASK >> ph) & 1)) pr_t0 = __builtin_amdgcn_s_memrealtime();
        if (ph == 0) {
            if (PMASK & 128) phase_prologue(p, lds);
        } else {
            const int l = (ph - 1) / 7, k = (ph - 1) % 7;
            if (k == 0 && (PMASK & 1)) {
                pg8::Gemm g{(const bf16_t*)(ws + WS_XB), (const bf16_t*)(ws + WS_WIN) + (size_t)l * NPAD * DM, M, NPAD, DM};
                pg8::StaticOrder S; S.init(M, NPAD, (int)gridDim.x, (int)blockIdx.x);
                pg8::EpiInT E{(const float*)(ws + WS_SS), (const float*)(ws + WS_BIAS) + l * NPAD, (bf16_t*)(ws + WS_PROJ), (float*)(ws + WS_GATES)};
                REP(1) pg8::gemm_phase<pg8::EpiInT, pg8::StaticOrder, true, true>((PG8_LAS unsigned char*)lds_raw, g, S, E);
            } else if (k == 1 && (PMASK & 2)) {
                REP(2) phase_compress_mfma(p, l, lds_raw);
                REP(4) phase_chunkstate_mfma(p, l, lds_raw);
            } else if (k == 2 && (PMASK & 4)) {
                phase_scan(p);
                REP(8) phase_attn_mfma(p, l, lds_raw);
            } else if (k == 3 && (PMASK & 8)) {
                REP(16) phase_mlstm_out_mfma(p, l, lds_raw);
            } else if (k == 4 && (PMASK & 16)) {
                pg8::Gemm g{(const bf16_t*)(ws + WS_Y), (const bf16_t*)(ws + WS_WOUT) + (size_t)l * DM * DM, M, DM, DM};
                pg8::StaticOrder S; S.init(M, DM, (int)gridDim.x, (int)blockIdx.x);
                pg8::EpiResT<false> E{(bf16_t*)(ws + WS_XB), (float*)(ws + WS_SS), nullptr};
                pg8::gemm_phase<pg8::EpiResT<false>, pg8::StaticOrder, true, true>((PG8_LAS unsigned char*)lds_raw, g, S, E);
            } else if (k == 5 && (PMASK & 32)) {
                pg8::Gemm g{(const bf16_t*)(ws + WS_XB), (const bf16_t*)(ws + WS_WGU) + (size_t)l * NGU * DM, M, NGU, DM};
                pg8::StaticOrder S; S.init(M, NGU, (int)gridDim.x, (int)blockIdx.x);
                pg8::EpiGUT E{(const float*)(ws + WS_SS), (bf16_t*)(ws + WS_PROJ)};
                REP(32) pg8::gemm_phase<pg8::EpiGUT, pg8::StaticOrder, true, true>((PG8_LAS unsigned char*)lds_raw, g, S, E);
            } else if (k == 6 && (PMASK & 64)) {
                pg8::Gemm g{(const bf16_t*)(ws + WS_PROJ), (const bf16_t*)(ws + WS_WD) + (size_t)l * DM * FF, M, DM, FF};
                pg8::StaticOrder S; S.init(M, DM, (int)gridDim.x, (int)blockIdx.x);
                if (l + 1 < DEPTH) {
                    pg8::EpiResT<false> E{(bf16_t*)(ws + WS_XB), (float*)(ws + WS_SS), nullptr};
                    pg8::gemm_phase<pg8::EpiResT<false>, pg8::StaticOrder, true, true>((PG8_LAS unsigned char*)lds_raw, g, S, E);
                } else {
                    pg8::EpiResT<true> E{(bf16_t*)(ws + WS_XB), nullptr, p.out};
                    pg8::gemm_phase<pg8::EpiResT<true>, pg8::StaticOrder, true, true>((PG8_LAS unsigned char*)lds_raw, g, S, E);
                }
            }
        }
        if (COOP && ph + 1 < p.hi) {
            if (ph == 0) cg::this_grid().sync();
            else xcd_barrier(gbar);
        }
        if (PROBE_MASK && ((PROBE_MASK >> ph) & 1)) pr_acc += __builtin_amdgcn_s_memrealtime() - pr_t0;
    }
    if (PROBE_MASK && blockIdx.x == 0) {
        const unsigned long long te = __builtin_amdgcn_s_memrealtime();
        while (__builtin_amdgcn_s_memrealtime() - te < 4ull * pr_acc) __builtin_amdgcn_s_sleep(8);
    }
}

extern "C" void kernel_launch(void* const* d_in, const int* in_sizes, int n_in, void* d_out, int out_size, void* d_ws, size_t ws_size, hipStream_t stream) {
    static int grid = 0;
    if (grid == 0) {
        if (n_in != 18 || ws_size < WS_END) { fprintf(stderr, "kernel_launch: unexpected n_in %d / ws_size %zu\n", n_in, ws_size); grid = -1; return; }
        int dev = 0, cus = 0, per_cu = 0;
        (void)hipGetDevice(&dev);
        (void)hipDeviceGetAttribute(&cus, hipDeviceAttributeMultiprocessorCount, dev);
        (void)hipFuncSetAttribute((const void*)mega<true, 0xff>, hipFuncAttributeMaxDynamicSharedMemorySize, LDS_BYTES);
        (void)hipOccupancyMaxActiveBlocksPerMultiprocessor(&per_cu, (const void*)mega<true, 0xff>, NT, LDS_BYTES);
        if (per_cu < 1) { fprintf(stderr, "kernel_launch: occupancy query reports %d blocks/CU\n", per_cu); grid = -1; return; }
        grid = (cus > 0 ? cus : 256) * 1;
        (void)hipGetLastError();
    }
    if (grid < 0) return;
    Params p{};
    for (int i = 0; i < 18; ++i) p.in[i] = (const float*)d_in[i];
    p.out = (float*)d_out; p.ws = (unsigned char*)d_ws;
    p.lo = 0; p.hi = NPHASE;
    (void)hipMemsetAsync((unsigned char*)d_ws + WS_CTL, 0, 16384, stream);
    void* args[] = {&p};
    hipError_t e = hipLaunchCooperativeKernel((const void*)mega<true, 0xff>, dim3(grid), dim3(NT), args, LDS_BYTES, stream);
    if (e != hipSuccess) fprintf(stderr, "cooperative launch failed: %s (grid %d)\n", hipGetErrorString(e), grid);
}
```
